# Optimizing an MI355X kernel written in HIP

```python
import math
import jax
import jax.numpy as jnp
from jax import lax
import numpy as np

D_MODEL = 2048
BATCH = 1
SEQ = 16384
DEPTH = 1

PLE_DIM = 256
SSM_WIDTH = D_MODEL // 2
SSM_GROUP = 16
SSM_GROUPS = SSM_WIDTH // SSM_GROUP
SSM_STATE = 64
DT_MIN = 1e-3
DT_MAX = 1e-1
RET_HEADS = 8
RET_HEAD_DIM = D_MODEL // (2 * RET_HEADS)
RET_WIDTH = RET_HEADS * RET_HEAD_DIM
RET_CHUNK = 128
ROPE_BASE = 10000.0
N_EXPERTS = 32
TOP_K = 4
EXPERT_FF = D_MODEL
SWIGLU_LIMIT = 7.0
SWIGLU_ALPHA = 1.702
MOE_BLOCK = 256
NORM_EPS = 1e-6
IN_COLS = SSM_WIDTH + 4 * RET_WIDTH + 2 * D_MODEL

kernel_name = 'hybrid_s5_retention_moe_block'


def rms_norm(x, g):
    xf = x.astype(jnp.float32)
    y = xf * lax.rsqrt(jnp.mean(xf * xf, axis=-1, keepdims=True) + NORM_EPS)
    return (y * g.astype(jnp.float32)).astype(x.dtype)


def _cmul(ar, ai, br, bi):
    return ar * br - ai * bi, ar * bi + ai * br


def s5_branch(u, lam_re, lam_im, log_dt, b_re, b_im, c_re, c_im, d_skip, w_glu, b_glu):
    f32 = jnp.float32
    bsz, seq, _ = u.shape
    uf = u.astype(f32).reshape(bsz, seq, SSM_GROUPS, SSM_GROUP)
    lr, li = lam_re.astype(f32), lam_im.astype(f32)
    dt = jnp.exp(log_dt.astype(f32))[:, None]
    mag = jnp.exp(lr * dt)
    ab_re, ab_im = mag * jnp.cos(li * dt), mag * jnp.sin(li * dt)
    den = lr * lr + li * li
    nr, ni = ab_re - 1.0, ab_im
    f_re = (nr * lr + ni * li) / den
    f_im = (ni * lr - nr * li) / den
    bb_re, bb_im = _cmul(f_re[..., None], f_im[..., None], b_re.astype(f32), b_im.astype(f32))
    bu_re = jnp.einsum('blgc,gnc->blgn', uf, bb_re)
    bu_im = jnp.einsum('blgc,gnc->blgn', uf, bb_im)
    a_re = jnp.broadcast_to(ab_re, bu_re.shape)
    a_im = jnp.broadcast_to(ab_im, bu_im.shape)

    def combine(e1, e2):
        a1r, a1i, b1r, b1i = e1
        a2r, a2i, b2r, b2i = e2
        ar, ai = _cmul(a2r, a2i, a1r, a1i)
        tr, ti = _cmul(a2r, a2i, b1r, b1i)
        return ar, ai, tr + b2r, ti + b2i

    _, _, s_re, s_im = lax.associative_scan(combine, (a_re, a_im, bu_re, bu_im), axis=1)
    y = (jnp.einsum('blgn,gcn->blgc', s_re, c_re.astype(f32))
         - jnp.einsum('blgn,gcn->blgc', s_im, c_im.astype(f32))
         + d_skip.astype(f32) * uf)
    y = jax.nn.gelu(y.reshape(bsz, seq, SSM_WIDTH))
    y = y * jax.nn.sigmoid(y @ w_glu.astype(f32) + b_glu.astype(f32))
    return y.astype(u.dtype)


def rotary(x, positions):
    half = x.shape[-1] // 2
    inv = ROPE_BASE ** (-jnp.arange(half, dtype=jnp.float32) / half)
    ang = positions.astype(jnp.float32)[..., None] * inv
    cos, sin = jnp.cos(ang)[:, :, None, :], jnp.sin(ang)[:, :, None, :]
    x1, x2 = x[..., :half], x[..., half:]
    return jnp.concatenate([x1 * cos - x2 * sin, x1 * sin + x2 * cos], axis=-1)


def retention_branch(q, k, v, gate, positions):
    f32 = jnp.float32
    bsz, seq, _ = q.shape
    H, dk = RET_HEADS, RET_HEAD_DIM
    C = RET_CHUNK
    nc = seq // C
    q = rotary(q.astype(f32).reshape(bsz, seq, H, dk), positions)
    k = rotary(k.astype(f32).reshape(bsz, seq, H, dk), positions) * (dk ** -0.5)
    v = v.astype(f32).reshape(bsz, seq, H, dk)
    log_gamma = jnp.log(1.0 - jnp.exp2(-5.0 - jnp.arange(H, dtype=f32)))
    qc = q.reshape(bsz, nc, C, H, dk)
    kc = k.reshape(bsz, nc, C, H, dk)
    vc = v.reshape(bsz, nc, C, H, dk)
    idx = jnp.arange(C, dtype=f32)
    rel = idx[:, None] - idx[None, :]
    decay = jnp.where(rel >= 0, jnp.exp(jnp.maximum(rel, 0.0)[None] * log_gamma[:, None, None]), 0.0)
    scores = jnp.einsum('bnihd,bnjhd->bnhij', qc, kc) * decay
    inner = jnp.einsum('bnhij,bnjhe->bnihe', scores, vc)
    zeta = jnp.exp((C - 1.0 - idx)[:, None] * log_gamma[None])
    kv = jnp.einsum('bnjhd,bnjhe->bnhde', kc * zeta[..., None], vc)
    chunk_decay = jnp.exp(C * log_gamma)[None, :, None, None]

    def step(state, kv_n):
        return state * chunk_decay + kv_n, state

    _, r_prev = lax.scan(step, jnp.zeros((bsz, H, dk, dk), f32), jnp.moveaxis(kv, 1, 0))
    r_prev = jnp.moveaxis(r_prev, 0, 1)
    xi = jnp.exp((idx + 1.0)[:, None] * log_gamma[None])
    cross = jnp.einsum('bnihd,bnhde->bnihe', qc, r_prev) * xi[..., None]
    o = (inner + cross).reshape(bsz, seq, H, dk)
    mu = jnp.mean(o, axis=-1, keepdims=True)
    oc = o - mu
    o = oc * lax.rsqrt(jnp.mean(oc * oc, axis=-1, keepdims=True) + NORM_EPS)
    o = jax.nn.silu(gate.astype(f32)) * o.reshape(bsz, seq, RET_WIDTH)
    return o.astype(gate.dtype)


def moe(h, router_w, router_b, w_gu, b_gu, w_dn, b_dn):
    bsz, seq, d = h.shape
    n_tok = bsz * seq
    n_asg = n_tok * TOP_K
    xt = h.reshape(n_tok, d)
    logits = (xt @ router_w + router_b).astype(jnp.float32)
    top_val, top_idx = lax.top_k(logits, TOP_K)
    gates = jax.nn.softmax(top_val, axis=-1)
    e_flat = top_idx.reshape(-1).astype(jnp.int32)
    tok_flat = jnp.arange(n_asg, dtype=jnp.int32) // TOP_K
    g_flat = gates.reshape(-1)
    order = jnp.argsort(e_flat)
    e_s, tok_s, g_s = e_flat[order], tok_flat[order], g_flat[order]
    counts = jnp.bincount(e_flat, length=N_EXPERTS).astype(jnp.int32)
    start = jnp.cumsum(counts) - counts
    pcounts = (counts + MOE_BLOCK - 1) // MOE_BLOCK * MOE_BLOCK
    pend = jnp.cumsum(pcounts)
    pstart = pend - pcounts
    dest = pstart[e_s] + (jnp.arange(n_asg, dtype=jnp.int32) - start[e_s])
    n_rows = n_asg + N_EXPERTS * MOE_BLOCK
    n_blocks = n_rows // MOE_BLOCK
    row_tok = jnp.zeros((n_rows,), jnp.int32).at[dest].set(tok_s)
    row_g = jnp.zeros((n_rows,), jnp.float32).at[dest].set(g_s)
    blk_start = jnp.arange(n_blocks, dtype=jnp.int32) * MOE_BLOCK
    blk_e = jnp.minimum(jnp.searchsorted(pend, blk_start, side='right'), N_EXPERTS - 1)

    def run_block(args):
        toks, e = args
        xb = xt[toks]
        gu = xb @ w_gu[e] + b_gu[e]
        g, u = gu[:, 0::2], gu[:, 1::2]
        g = jnp.minimum(g, SWIGLU_LIMIT)
        u = jnp.clip(u, -SWIGLU_LIMIT, SWIGLU_LIMIT)
        a = g * jax.nn.sigmoid(SWIGLU_ALPHA * g) * (u + 1.0)
        return a @ w_dn[e] + b_dn[e]

    yb = lax.map(run_block, (row_tok.reshape(n_blocks, MOE_BLOCK), blk_e))
    y = jnp.zeros((n_tok, d), jnp.float32).at[row_tok].add(
        yb.reshape(n_rows, d).astype(jnp.float32) * row_g[:, None])
    return y.reshape(bsz, seq, d).astype(h.dtype)


def setup_inputs(seed: int = 0) -> dict:
    key = jax.random.key(seed)
    ks = jax.random.split(key, 32)
    f32 = jnp.float32

    def nrm(k, shape, scale):
        return jax.random.normal(k, shape, f32) * scale

    Ld, G, N, E, F = DEPTH, SSM_GROUPS, SSM_STATE, N_EXPERTS, EXPERT_FF
    return {
        'x': nrm(ks[0], (BATCH, SEQ, D_MODEL), 1.0),
        'p': nrm(ks[1], (DEPTH, BATCH, SEQ, PLE_DIM), 1.0),
        'positions': jnp.broadcast_to(jnp.arange(SEQ, dtype=jnp.int32), (BATCH, SEQ)),
        'norm1_g': 1.0 + nrm(ks[2], (Ld, D_MODEL), 0.01),
        'w_in': nrm(ks[3], (Ld, D_MODEL, IN_COLS), D_MODEL ** -0.5),
        'ssm_lam_re': -0.5 + nrm(ks[4], (Ld, G, N), 0.01),
        'ssm_lam_im': math.pi * jnp.arange(N, dtype=f32) + nrm(ks[5], (Ld, G, N), 0.01),
        'ssm_log_dt': jax.random.uniform(ks[6], (Ld, G), f32, math.log(DT_MIN), math.log(DT_MAX)),
        'ssm_b_re': nrm(ks[7], (Ld, G, N, SSM_GROUP), (2 * SSM_GROUP) ** -0.5),
        'ssm_b_im': nrm(ks[8], (Ld, G, N, SSM_GROUP), (2 * SSM_GROUP) ** -0.5),
        'ssm_c_re': nrm(ks[9], (Ld, G, SSM_GROUP, N), (2 * N) ** -0.5),
        'ssm_c_im': nrm(ks[10], (Ld, G, SSM_GROUP, N), (2 * N) ** -0.5),
        'ssm_d': nrm(ks[11], (Ld, G, SSM_GROUP), 1.0),
        'ssm_w_glu': nrm(ks[12], (Ld, SSM_WIDTH, SSM_WIDTH), SSM_WIDTH ** -0.5),
        'ssm_b_glu': nrm(ks[13], (Ld, SSM_WIDTH), 0.01),
        'w_branch_ssm': nrm(ks[14], (Ld, SSM_WIDTH, D_MODEL), SSM_WIDTH ** -0.5),
        'w_branch_ret': nrm(ks[15], (Ld, RET_WIDTH, D_MODEL), RET_WIDTH ** -0.5),
        'w_out': nrm(ks[16], (Ld, D_MODEL, D_MODEL), D_MODEL ** -0.5),
        'norm2_g': 1.0 + nrm(ks[17], (Ld, D_MODEL), 0.01),
        'router_w': nrm(ks[18], (Ld, D_MODEL, E), D_MODEL ** -0.5),
        'router_b': nrm(ks[19], (Ld, E), 0.01),
        'exp_w_gate_up': nrm(ks[20], (Ld, E, D_MODEL, 2 * F), D_MODEL ** -0.5),
        'exp_b_gate_up': nrm(ks[21], (Ld, E, 2 * F), 0.01),
        'exp_w_down': nrm(ks[22], (Ld, E, F, D_MODEL), F ** -0.5),
        'exp_b_down': nrm(ks[23], (Ld, E, D_MODEL), 0.01),
        'norm3_g': 1.0 + nrm(ks[24], (Ld, D_MODEL), 0.01),
        'ple_w_gate': nrm(ks[25], (Ld, D_MODEL, D_MODEL), D_MODEL ** -0.5),
        'ple_w_proj': nrm(ks[26], (Ld, PLE_DIM, D_MODEL), PLE_DIM ** -0.5),
        'final_norm_g': 1.0 + nrm(ks[27], (D_MODEL,), 0.01),
    }


def reference(x, p, positions, norm1_g, w_in, ssm_lam_re, ssm_lam_im, ssm_log_dt,
              ssm_b_re, ssm_b_im, ssm_c_re, ssm_c_im, ssm_d, ssm_w_glu, ssm_b_glu,
              w_branch_ssm, w_branch_ret, w_out, norm2_g, router_w, router_b,
              exp_w_gate_up, exp_b_gate_up, exp_w_down, exp_b_down, norm3_g,
              ple_w_gate, ple_w_proj, final_norm_g):
    cuts = [SSM_WIDTH,
            SSM_WIDTH + RET_WIDTH,
            SSM_WIDTH + 2 * RET_WIDTH,
            SSM_WIDTH + 3 * RET_WIDTH,
            SSM_WIDTH + 4 * RET_WIDTH,
            SSM_WIDTH + 4 * RET_WIDTH + D_MODEL]
    for i in range(DEPTH):
        h = rms_norm(x, norm1_g[i])
        z = h @ w_in[i]
        u_s, q, k, v, g_ret, m_s, m_r = jnp.split(z, cuts, axis=-1)
        ys = s5_branch(u_s, ssm_lam_re[i], ssm_lam_im[i], ssm_log_dt[i], ssm_b_re[i], ssm_b_im[i],
                       ssm_c_re[i], ssm_c_im[i], ssm_d[i], ssm_w_glu[i], ssm_b_glu[i])
        yr = retention_branch(q, k, v, g_ret, positions)
        merged = (jax.nn.sigmoid(m_s) * (ys @ w_branch_ssm[i])
                  + jax.nn.sigmoid(m_r) * (yr @ w_branch_ret[i]))
        x = x + merged @ w_out[i]
        x = x + moe(rms_norm(x, norm2_g[i]), router_w[i], router_b[i], exp_w_gate_up[i],
                    exp_b_gate_up[i], exp_w_down[i], exp_b_down[i])
        ple_gate = jax.nn.sigmoid(rms_norm(x, norm3_g[i]) @ ple_w_gate[i])
        x = x + ple_gate * (p[i] @ ple_w_proj[i])
    return rms_norm(x, final_norm_g)
```

```cpp
#include <hip/hip_runtime.h>
#include <cstdio>
#include <cstdint>

#ifndef MK_N_LAUNCHES
#define MK_N_LAUNCHES 15
#endif

constexpr int SEQ = 16384, DM = 2048, INC = 9216, NEXP = 32, FFN = 2048, PLED = 256;
constexpr int NG5 = 64, T5 = 32, NCH5 = SEQ / T5, K5 = 640;
constexpr int RCH = 128, NRC = SEQ / RCH, RH = 8;
constexpr int MAXROWS = SEQ * 4 + NEXP * 256;

namespace pg8 {
#define PG8_LAS __attribute__((address_space(3)))
typedef unsigned short bf16_t;
typedef short bf16x8 __attribute__((ext_vector_type(8)));
typedef float f32x4 __attribute__((ext_vector_type(4)));
typedef unsigned u32x4 __attribute__((ext_vector_type(4)));
typedef unsigned u32x2 __attribute__((ext_vector_type(2)));
constexpr int BM = 256, BK = 64, HALF = 128, HTB = HALF * BK * 2, STAGE_BYTES = 8 * HTB, NXCD = 8, WGM = 8;

__host__ __device__ __forceinline__ int lds_byte(int r, int c) { const int st = (r >> 4) * 2 + (c >> 5), rr = r & 15, cc = c & 31, ob = rr * 64 + cc * 2; return st * 1024 + (ob ^ (((ob >> 9) & 1) << 5)); }
__host__ __device__ __forceinline__ void stage_rc(int b, int& R, int& C) { const int st = b / 1024, sb = b % 1024, swz = sb ^ (((sb >> 9) & 1) << 5); R = (st >> 1) * 16 + swz / 64; C = (st & 1) * 32 + (swz % 64) / 2; }
__host__ __device__ __forceinline__ int perm32(int rho) { const int n = rho >> 4, i = rho & 15; return 8 * (i >> 2) + 4 * n + (i & 3); }

struct Unit { int pm, pn; };
struct Gemm { const bf16_t* A; const bf16_t* Bt; int lda, ldb, K; };

struct StaticOrder {
    int nM, nN, nwg, G, c;
    __host__ __device__ void init(int M, int N, int G_, int c_) { nM = M / BM; nN = N / BM; nwg = nM * nN; G = G_; c = c_; }
    __host__ __device__ bool next(int i, Unit& u) const {
        const long L = (long)i * G + c; if (L >= nwg) return false;
        int wgid = (int)L; { const int q = nwg / NXCD, r = nwg % NXCD, xcd = wgid % NXCD, off = wgid / NXCD; wgid = (xcd < r ? xcd * (q + 1) : r * (q + 1) + (xcd - r) * q) + off; }
        const int nig = WGM * nN, gid = wgid / nig, fm = gid * WGM, gsz = (nM - fm) < WGM ? (nM - fm) : WGM;
        u.pm = fm + ((wgid % nig) % gsz); u.pn = (wgid % nig) / gsz; return true;
    }
    __device__ __forceinline__ void a_ready(const Unit&) const {}
    __device__ __forceinline__ void done(const Unit&) const {}
};
struct OrderS3 {
    int G, c;
    __device__ bool next(int i, Unit& u) const { const int L = i * G + c; if (L >= 256) return false; const int g = L >> 2; u.pm = 2 * g + ((L >> 1) & 1); u.pn = 2 * g + (L & 1); return true; }
    __device__ __forceinline__ void a_ready(const Unit&) const {}
    __device__ __forceinline__ void done(const Unit&) const {}
};
struct OrderS1 {
    int G, c;
    __device__ bool next(int i, Unit& u) const { const int L = i * G + c; if (L >= 128) return false; u.pm = L; u.pn = L >> 1; return true; }
    __device__ __forceinline__ void a_ready(const Unit&) const {}
    __device__ __forceinline__ void done(const Unit&) const {}
};
struct OrderMoe {
    StaticOrder so; const int* blk_e; int ntn;
    __device__ bool next(int i, Unit& u) const { if (!so.next(i, u)) return false; u.pn = blk_e[u.pm] * ntn + u.pn; return true; }
    __device__ __forceinline__ void a_ready(const Unit&) const {}
    __device__ __forceinline__ void done(const Unit&) const {}
};

__device__ __forceinline__ unsigned cvt_pk_bf16(float lo, float hi) { unsigned r; asm volatile("v_cvt_pk_bf16_f32 %0, %1, %2" : "=v"(r) : "v"(lo), "v"(hi)); return r; }
__device__ __forceinline__ u32x4 pack8(const f32x4& a, const f32x4& b) { u32x4 w; w.x = cvt_pk_bf16(a[0], a[1]); w.y = cvt_pk_bf16(a[2], a[3]); w.z = cvt_pk_bf16(b[0], b[1]); w.w = cvt_pk_bf16(b[2], b[3]); return w; }
__device__ __forceinline__ float bf_lo(unsigned w) { return __builtin_bit_cast(float, w << 16); }
__device__ __forceinline__ float bf_hi(unsigned w) { return __builtin_bit_cast(float, w & 0xffff0000u); }
__device__ __forceinline__ void unpack8(const u32x4& w, f32x4& a, f32x4& b) { a = (f32x4){bf_lo(w.x), bf_hi(w.x), bf_lo(w.y), bf_hi(w.y)}; b = (f32x4){bf_lo(w.z), bf_hi(w.z), bf_lo(w.w), bf_hi(w.w)}; }
__device__ __forceinline__ float sigm(float x) { return __builtin_amdgcn_rcpf(1.0f + __builtin_amdgcn_exp2f(-1.4426950408889634f * x)); }
__device__ __forceinline__ f32x4 sigm4(const f32x4& x) { return (f32x4){sigm(x[0]), sigm(x[1]), sigm(x[2]), sigm(x[3])}; }
__device__ __forceinline__ float gelu_t(float x) { return x * sigm(1.5957691216057308f * (x + 0.044715f * x * x * x)); }
__device__ __forceinline__ f32x4 gelu4(const f32x4& x) { return (f32x4){gelu_t(x[0]), gelu_t(x[1]), gelu_t(x[2]), gelu_t(x[3])}; }

#define EPI_LOOP_AM _Pragma("unroll") for (int ai = 0; ai < 2; ++ai) _Pragma("unroll") for (int m = 0; m < 4; ++m)
#define EPI_LOOP_BJ _Pragma("unroll") for (int bj = 0; bj < 2; ++bj)
typedef f32x4 AccT[2][2][4][2];
#ifndef EPIZ_MASK
#define EPIZ_MASK 31
#endif
#define EPIZ_EN(k) ((EPIZ_MASK >> (k)) & 1)

struct EpiZU {
    static constexpr bool PERM = true, AFTER_DRAIN = false;
    bf16_t* xg5;
    __device__ __forceinline__ void operator()(const AccT& acc, const Unit& u, int wr, int wc, int fr, int fq) const {
        const int row0 = u.pm * BM + wr * 64 + fr, tc = wc * 32 + 8 * fq, pn = u.pn;
        EPI_LOOP_AM { const int t = row0 + ai * HALF + m * 16, j = t >> 5, i = t & 31;
            EPI_LOOP_BJ { const int col = pn * BM + bj * HALF + tc, g = col >> 4, c0 = col & 15;
                *(u32x4*)(xg5 + ((size_t)(g * NCH5 + j) * K5 + i * 16 + c0)) = pack8(acc[ai][bj][m][0], acc[ai][bj][m][1]); } }
    }
};
struct EpiZR {
    static constexpr bool PERM = true, AFTER_DRAIN = false;
    bf16_t *q, *k; const float *cs, *sn;
    __device__ __forceinline__ void operator()(const AccT& acc, const Unit& u, int wr, int wc, int fr, int fq) const {
        const int row0 = u.pm * BM + wr * 64 + fr, pn = u.pn;
        const bool isk = pn >= 4; bf16_t* dst = isk ? k : q; const float sc = isk ? 0.08838834764831845f : 1.0f;
        const int head = 2 * (pn & 3) + (wc >> 1), dd = 32 * (wc & 1) + 8 * fq;
        EPI_LOOP_AM { const int t = row0 + ai * HALF + m * 16;
            const float* cp = cs + (size_t)t * 64 + dd; const float* sp = sn + (size_t)t * 64 + dd;
            const f32x4 c0 = *(const f32x4*)cp * sc, c1 = *(const f32x4*)(cp + 4) * sc, s0 = *(const f32x4*)sp * sc, s1 = *(const f32x4*)(sp + 4) * sc;
            const f32x4 x1a = acc[ai][0][m][0], x1b = acc[ai][0][m][1], x2a = acc[ai][1][m][0], x2b = acc[ai][1][m][1];
            bf16_t* o = dst + (size_t)t * 1024 + head * 128 + dd;
            *(u32x4*)o = pack8(x1a * c0 - x2a * s0, x1b * c1 - x2b * s1);
            *(u32x4*)(o + 64) = pack8(x1a * s0 + x2a * c0, x1b * s1 + x2b * c1); asm volatile("" ::: "memory"); }
    }
};
struct EpiZA {
    static constexpr bool PERM = true, AFTER_DRAIN = false;
    bf16_t *v, *gs, *sgs, *sgr;
    __device__ __forceinline__ void operator()(const AccT& acc, const Unit& u, int wr, int wc, int fr, int fq) const {
        const int row0 = u.pm * BM + wr * 64 + fr, tc = wc * 32 + 8 * fq, pn = u.pn;
        bf16_t* dst = pn < 4 ? v : (pn < 8 ? gs : (pn < 16 ? sgs : sgr));
        const int ldc = pn < 8 ? 1024 : 2048, cb = (pn < 8 ? (pn & 3) : (pn & 7)) * BM + tc;
        const float ka = pn < 4 ? 0.0f : 1.0f, kb = (pn >= 4 && pn < 8) ? 1.0f : 0.0f;
        EPI_LOOP_AM { const size_t off = (size_t)(row0 + ai * HALF + m * 16) * ldc + cb;
            EPI_LOOP_BJ { f32x4 r[2];
#pragma unroll
                for (int n = 0; n < 2; ++n) { const f32x4 x = acc[ai][bj][m][n], sg = sigm4(x); r[n] = x * (1.0f - ka) + sg * (ka - kb) + (x * sg) * kb; }
                *(u32x4*)(dst + off + bj * HALF) = pack8(r[0], r[1]); } }
    }
};
struct EpiS1 {
    static constexpr bool PERM = true, AFTER_DRAIN = false;
    float* sloc;
    __device__ __forceinline__ void operator()(const AccT& acc, const Unit& u, int wr, int wc, int fr, int fq) const {
        const int row0 = u.pm * BM + wr * 64 + fr, tc = wc * 32 + 8 * fq;
        EPI_LOOP_AM { float* o = sloc + (size_t)(row0 + ai * HALF + m * 16) * 128 + tc; *(f32x4*)o = acc[ai][0][m][0]; *(f32x4*)(o + 4) = acc[ai][0][m][1]; }
    }
};
struct EpiS3 {
    static constexpr bool PERM = true, AFTER_DRAIN = false;
    bf16_t* ysp;
    __device__ __forceinline__ void operator()(const AccT& acc, const Unit& u, int wr, int wc, int fr, int fq) const {
        const int g = u.pm >> 1, j0 = (u.pm & 1) * BM + wr * 64 + fr, cl0 = (u.pn & 1) * BM + wc * 32 + 8 * fq;
        EPI_LOOP_AM { const int j = j0 + ai * HALF + m * 16;
            EPI_LOOP_BJ { const int cl = cl0 + bj * HALF, i = cl >> 4, c0 = cl & 15;
                *(u32x4*)(ysp + (size_t)(j * T5 + i) * 1024 + g * 16 + c0) = pack8(gelu4(acc[ai][bj][m][0]), gelu4(acc[ai][bj][m][1])); } }
    }
};
struct EpiGLU {
    static constexpr bool PERM = true, AFTER_DRAIN = false;
    const bf16_t* ysp; const float* bias; bf16_t* ys;
    __device__ __forceinline__ void operator()(const AccT& acc, const Unit& u, int wr, int wc, int fr, int fq) const {
        const int row0 = u.pm * BM + wr * 64 + fr, col0 = u.pn * BM + wc * 32 + 8 * fq;
        f32x4 bv[2][2];
        EPI_LOOP_BJ { bv[bj][0] = *(const f32x4*)(bias + col0 + bj * HALF); bv[bj][1] = *(const f32x4*)(bias + col0 + bj * HALF + 4); }
        EPI_LOOP_AM { const size_t off = (size_t)(row0 + ai * HALF + m * 16) * 1024 + col0;
            EPI_LOOP_BJ { f32x4 ya, yb; unpack8(*(const u32x4*)(ysp + off + bj * HALF), ya, yb);
                *(u32x4*)(ys + off + bj * HALF) = pack8(ya * sigm4(acc[ai][bj][m][0] + bv[bj][0]), yb * sigm4(acc[ai][bj][m][1] + bv[bj][1])); } }
    }
};
struct EpiM1 {
    static constexpr bool PERM = true, AFTER_DRAIN = false;
    const bf16_t* sg; float* tmp;
    __device__ __forceinline__ void operator()(const AccT& acc, const Unit& u, int wr, int wc, int fr, int fq) const {
        const int row0 = u.pm * BM + wr * 64 + fr, col0 = u.pn * BM + wc * 32 + 8 * fq;
        EPI_LOOP_AM { const size_t off = (size_t)(row0 + ai * HALF + m * 16) * 2048 + col0;
            EPI_LOOP_BJ { f32x4 ga, gb; unpack8(*(const u32x4*)(sg + off + bj * HALF), ga, gb);
                *(f32x4*)(tmp + off + bj * HALF) = ga * acc[ai][bj][m][0]; *(f32x4*)(tmp + off + bj * HALF + 4) = gb * acc[ai][bj][m][1]; } }
    }
};
struct EpiM2 {
    static constexpr bool PERM = true, AFTER_DRAIN = false;
    const bf16_t* sg; const float* tmp; bf16_t* mrg;
    __device__ __forceinline__ void operator()(const AccT& acc, const Unit& u, int wr, int wc, int fr, int fq) const {
        const int row0 = u.pm * BM + wr * 64 + fr, col0 = u.pn * BM + wc * 32 + 8 * fq;
        EPI_LOOP_AM { const size_t off = (size_t)(row0 + ai * HALF + m * 16) * 2048 + col0;
            EPI_LOOP_BJ { f32x4 ga, gb; unpack8(*(const u32x4*)(sg + off + bj * HALF), ga, gb);
                const f32x4 ta = *(const f32x4*)(tmp + off + bj * HALF), tb = *(const f32x4*)(tmp + off + bj * HALF + 4);
                *(u32x4*)(mrg + off + bj * HALF) = pack8(ta + ga * acc[ai][bj][m][0], tb + gb * acc[ai][bj][m][1]); } }
    }
};
struct EpiRes {
    static constexpr bool PERM = true, AFTER_DRAIN = false;
    const float* x; float* o;
    __device__ __forceinline__ void operator()(const AccT& acc, const Unit& u, int wr, int wc, int fr, int fq) const {
        const int row0 = u.pm * BM + wr * 64 + fr, col0 = u.pn * BM + wc * 32 + 8 * fq;
        EPI_LOOP_AM { const size_t off = (size_t)(row0 + ai * HALF + m * 16) * 2048 + col0;
            EPI_LOOP_BJ { *(f32x4*)(o + off + bj * HALF) = *(const f32x4*)(x + off + bj * HALF) + acc[ai][bj][m][0];
                *(f32x4*)(o + off + bj * HALF + 4) = *(const f32x4*)(x + off + bj * HALF + 4) + acc[ai][bj][m][1]; } }
    }
};
struct EpiPlain {
    static constexpr bool PERM = true, AFTER_DRAIN = false;
    bf16_t* o; int ldc;
    __device__ __forceinline__ void operator()(const AccT& acc, const Unit& u, int wr, int wc, int fr, int fq) const {
        const int row0 = u.pm * BM + wr * 64 + fr, col0 = u.pn * BM + wc * 32 + 8 * fq;
        EPI_LOOP_AM { const size_t off = (size_t)(row0 + ai * HALF + m * 16) * ldc + col0;
            EPI_LOOP_BJ { *(u32x4*)(o + off + bj * HALF) = pack8(acc[ai][bj][m][0], acc[ai][bj][m][1]); } }
    }
};
struct EpiGU {
    static constexpr bool PERM = true, AFTER_DRAIN = false;
    const float* bgu; bf16_t* act;
    __device__ __forceinline__ void operator()(const AccT& acc, const Unit& u, int wr, int wc, int fr, int fq) const {
        const int e = u.pn >> 4, ct = u.pn & 15, row0 = u.pm * BM + wr * 64 + fr, f0 = ct * HALF + wc * 32 + 8 * fq;
        const float* bp = bgu + (size_t)e * 4096 + 2 * f0;
        const f32x4 b0 = *(const f32x4*)bp, b1 = *(const f32x4*)(bp + 4), b2 = *(const f32x4*)(bp + 8), b3 = *(const f32x4*)(bp + 12);
        const f32x4 bg0 = (f32x4){b0[0], b0[2], b1[0], b1[2]}, bu0 = (f32x4){b0[1], b0[3], b1[1], b1[3]}, bg1 = (f32x4){b2[0], b2[2], b3[0], b3[2]}, bu1 = (f32x4){b2[1], b2[3], b3[1], b3[3]};
        EPI_LOOP_AM { const size_t off = (size_t)(row0 + ai * HALF + m * 16) * FFN + f0;
            f32x4 r[2];
#pragma unroll
            for (int n = 0; n < 2; ++n) { const f32x4 gv = acc[ai][0][m][n] + (n ? bg1 : bg0), uv = acc[ai][1][m][n] + (n ? bu1 : bu0);
#pragma unroll
                for (int x = 0; x < 4; ++x) { const float gg = fminf(gv[x], 7.0f), uu = fminf(fmaxf(uv[x], -7.0f), 7.0f); r[n][x] = gg * sigm(1.702f * gg) * (uu + 1.0f); } }
            *(u32x4*)(act + off) = pack8(r[0], r[1]); }
    }
};
struct EpiDN {
    static constexpr bool PERM = true, AFTER_DRAIN = false;
    const float* bdn; const float* rowg; bf16_t* yb;
    __device__ __forceinline__ void operator()(const AccT& acc, const Unit& u, int wr, int wc, int fr, int fq) const {
        const int e = u.pn >> 3, ct = u.pn & 7, row0 = u.pm * BM + wr * 64 + fr, col0 = ct * BM + wc * 32 + 8 * fq;
        f32x4 bv[2][2];
        EPI_LOOP_BJ { bv[bj][0] = *(const f32x4*)(bdn + (size_t)e * 2048 + col0 + bj * HALF); bv[bj][1] = *(const f32x4*)(bdn + (size_t)e * 2048 + col0 + bj * HALF + 4); }
        EPI_LOOP_AM { const int row = row0 + ai * HALF + m * 16; const float gt = rowg[row]; const size_t off = (size_t)row * 2048 + col0;
            EPI_LOOP_BJ { *(u32x4*)(yb + off + bj * HALF) = pack8((acc[ai][bj][m][0] + bv[bj][0]) * gt, (acc[ai][bj][m][1] + bv[bj][1]) * gt); } }
    }
};
struct EpiPLE {
    static constexpr bool PERM = true, AFTER_DRAIN = false;
    const float* x3; const bf16_t* pp; float* o;
    __device__ __forceinline__ void operator()(const AccT& acc, const Unit& u, int wr, int wc, int fr, int fq) const {
        const int row0 = u.pm * BM + wr * 64 + fr, col0 = u.pn * BM + wc * 32 + 8 * fq;
        EPI_LOOP_AM { const size_t off = (size_t)(row0 + ai * HALF + m * 16) * 2048 + col0;
            EPI_LOOP_BJ { f32x4 pa, pb; unpack8(*(const u32x4*)(pp + off + bj * HALF), pa, pb);
                *(f32x4*)(o + off + bj * HALF) = *(const f32x4*)(x3 + off + bj * HALF) + sigm4(acc[ai][bj][m][0]) * pa;
                *(f32x4*)(o + off + bj * HALF + 4) = *(const f32x4*)(x3 + off + bj * HALF + 4) + sigm4(acc[ai][bj][m][1]) * pb; } }
    }
};

template <class Epi, class Sched, bool ALIGN_EPI = false, bool SP2 = false>
__device__ __forceinline__ void gemm_phase(PG8_LAS unsigned char* lds, const Gemm g, const Sched& S, const Epi& E) {
    const int tid = threadIdx.x, wid = __builtin_amdgcn_readfirstlane(tid >> 6), lane = tid & 63, wr = wid >> 2, wc = wid & 3, fr = lane & 15, fq = lane >> 4;
    const int K = g.K, nt = K / BK;
    unsigned voffA[2], voffB[2];
#pragma unroll
    for (int i = 0; i < 2; ++i) { int R, C; stage_rc(tid * 16 + i * 8192, R, C); const int Rb = Epi::PERM ? ((R & ~31) + perm32(R & 31)) : R;
        voffA[i] = (unsigned)(R * g.lda + C) * 2u; voffB[i] = (unsigned)(Rb * g.ldb + C) * 2u; }
    const size_t kstep = (size_t)(BK * 2);
    const size_t hstepA = (size_t)HALF * g.lda * 2, hstepB = (size_t)HALF * g.ldb * 2;
    const size_t tstepA = 2 * hstepA, tstepB = 2 * hstepB;
    const unsigned ldsw = (unsigned)wid * 1024u;
    const int aoff = lds_byte(wr * 64 + fr, fq * 8), boff = lds_byte(wc * 32 + fr, fq * 8);
#define PG8_SA(b, h) (((b) * 2 + (h)) * HTB)
#define PG8_SB(b, h) ((4 + (b) * 2 + (h)) * HTB)
#define PG8_STAGE(bufoff, gbase, voff) do { _Pragma("unroll") for (int _i = 0; _i < 2; ++_i) \
        __builtin_amdgcn_global_load_lds((const unsigned*)((const char*)(gbase) + (voff)[_i]), (PG8_LAS unsigned*)(lds + (bufoff) + ldsw + _i * 8192), 16, 0, 0); } while (0)
#define PG8_LDA(dst, b, h) do { _Pragma("unroll") for (int m = 0; m < 4; ++m) _Pragma("unroll") for (int k = 0; k < 2; ++k) dst[m][k] = *(const PG8_LAS bf16x8*)(lds + PG8_SA(b, h) + aoff + m * 2048 + k * 1024); } while (0)
#define PG8_LDB(dst, b, h) do { _Pragma("unroll") for (int n = 0; n < 2; ++n) _Pragma("unroll") for (int k = 0; k < 2; ++k) dst[n][k] = *(const PG8_LAS bf16x8*)(lds + PG8_SB(b, h) + boff + n * 2048 + k * 1024); } while (0)
#define PG8_MMA(ai, bj, At, Bt) do { __builtin_amdgcn_s_setprio(1); _Pragma("unroll") for (int m = 0; m < 4; ++m) _Pragma("unroll") for (int n = 0; n < 2; ++n) _Pragma("unroll") for (int k = 0; k < 2; ++k) \
        acc[ai][bj][m][n] = __builtin_amdgcn_mfma_f32_16x16x32_bf16(Bt[n][k], At[m][k], acc[ai][bj][m][n], 0, 0, 0); __builtin_amdgcn_s_setprio(0); } while (0)
#define PG8_WAIT_V(n) asm volatile("s_waitcnt vmcnt(" #n ")" ::: "memory")
#define PG8_WAIT_L(n) asm volatile("s_waitcnt lgkmcnt(" #n ")" ::: "memory")
#define PG8_BAR __builtin_amdgcn_s_barrier()
#define PG8_SCHED __builtin_amdgcn_sched_barrier(0)
    Unit cur, nxt; int ui = 0;
    if (!S.next(0, cur)) return;
    f32x4 acc[2][2][4][2];
#pragma unroll
    for (int a = 0; a < 2; ++a)
#pragma unroll
        for (int b = 0; b < 2; ++b)
#pragma unroll
            for (int m = 0; m < 4; ++m)
#pragma unroll
                for (int n = 0; n < 2; ++n) acc[a][b][m][n] = (f32x4){0.f, 0.f, 0.f, 0.f};
    bf16x8 At[4][2], B0[2][2], B1[2][2];
    const char* cA = (const char*)g.A + (size_t)cur.pm * tstepA; const char* cB = (const char*)g.Bt + (size_t)cur.pn * tstepB;
    S.a_ready(cur);
    if constexpr (SP2) {
        PG8_STAGE(PG8_SB(0, 0), cB, voffB); PG8_STAGE(PG8_SB(0, 1), cB + hstepB, voffB); PG8_STAGE(PG8_SA(0, 0), cA, voffA); PG8_STAGE(PG8_SA(0, 1), cA + hstepA, voffA);
        if (wr == 1) PG8_BAR;
        PG8_WAIT_V(2); PG8_BAR;
        PG8_STAGE(PG8_SB(1, 0), cB + kstep, voffB); PG8_STAGE(PG8_SA(1, 0), cA + kstep, voffA); PG8_STAGE(PG8_SB(1, 1), cB + hstepB + kstep, voffB);
        PG8_WAIT_V(6); PG8_BAR;
    } else {
        PG8_STAGE(PG8_SB(0, 0), cB, voffB); PG8_STAGE(PG8_SA(0, 0), cA, voffA); PG8_STAGE(PG8_SB(0, 1), cB + hstepB, voffB); PG8_STAGE(PG8_SA(0, 1), cA + hstepA, voffA);
        if (wr == 1) PG8_BAR;
        PG8_WAIT_V(4); PG8_BAR;
        PG8_STAGE(PG8_SB(1, 0), cB + kstep, voffB); PG8_STAGE(PG8_SA(1, 0), cA + kstep, voffA); PG8_STAGE(PG8_SB(1, 1), cB + hstepB + kstep, voffB);
        PG8_WAIT_V(6); PG8_BAR;
    }
    for (;;) {
        const bool has_next = S.next(ui + 1, nxt);
        const char* nA = has_next ? (const char*)g.A + (size_t)nxt.pm * tstepA : cA; const char* nB = has_next ? (const char*)g.Bt + (size_t)nxt.pn * tstepB : cB;
#pragma nounroll
        for (int t = 0; t < nt; t += 2) {
            const bool last = (t == nt - 2);
            const char* a1 = cA + (size_t)(t + 1) * kstep;
            const char* a2 = last ? nA : cA + (size_t)(t + 2) * kstep; const char* b2 = last ? nB : cB + (size_t)(t + 2) * kstep;
            const char* a3 = a2 + kstep; const char* b3 = b2 + kstep;
            if (last && has_next) S.a_ready(nxt);
            if constexpr (SP2) {
            PG8_LDB(B0, 0, 0); PG8_LDB(B1, 0, 1); PG8_SCHED; PG8_LDA(At, 0, 0); PG8_STAGE(PG8_SA(1, 1), a1 + hstepA, voffA);
            PG8_WAIT_V(8); PG8_WAIT_L(0); PG8_BAR; PG8_MMA(0, 0, At, B0); PG8_MMA(0, 1, At, B1); PG8_BAR; PG8_SCHED;
            PG8_LDA(At, 0, 1); PG8_STAGE(PG8_SB(0, 0), b2, voffB); PG8_STAGE(PG8_SB(0, 1), b2 + hstepB, voffB); PG8_STAGE(PG8_SA(0, 0), a2, voffA);
            PG8_WAIT_V(8); PG8_WAIT_L(0); PG8_BAR; PG8_MMA(1, 0, At, B0); PG8_MMA(1, 1, At, B1); PG8_BAR; PG8_SCHED;
            PG8_LDB(B0, 1, 0); PG8_LDB(B1, 1, 1); PG8_SCHED; PG8_LDA(At, 1, 0); PG8_STAGE(PG8_SA(0, 1), a2 + hstepA, voffA);
            PG8_WAIT_V(8); PG8_WAIT_L(0); PG8_BAR; PG8_MMA(0, 0, At, B0); PG8_MMA(0, 1, At, B1); PG8_BAR; PG8_SCHED;
            PG8_LDA(At, 1, 1); PG8_STAGE(PG8_SB(1, 0), b3, voffB); PG8_STAGE(PG8_SB(1, 1), b3 + hstepB, voffB); PG8_STAGE(PG8_SA(1, 0), a3, voffA);
            PG8_WAIT_V(8); PG8_WAIT_L(0); PG8_BAR; PG8_MMA(1, 0, At, B0); PG8_MMA(1, 1, At, B1); PG8_BAR; PG8_SCHED;
            } else {
            PG8_LDB(B0, 0, 0); PG8_SCHED; PG8_LDA(At, 0, 0); PG8_STAGE(PG8_SA(1, 1), a1 + hstepA, voffA);
            PG8_WAIT_L(8); PG8_BAR; PG8_WAIT_L(0); PG8_MMA(0, 0, At, B0); PG8_BAR; PG8_SCHED;
            PG8_LDB(B1, 0, 1); PG8_STAGE(PG8_SB(0, 0), b2, voffB);
            PG8_BAR; PG8_WAIT_L(0); PG8_MMA(0, 1, At, B1); PG8_BAR;
            PG8_LDA(At, 0, 1); PG8_STAGE(PG8_SA(0, 0), a2, voffA);
            PG8_BAR; PG8_WAIT_L(0); PG8_MMA(1, 0, At, B0); PG8_BAR; PG8_SCHED;
            PG8_STAGE(PG8_SB(0, 1), b2 + hstepB, voffB);
            PG8_WAIT_V(6); PG8_BAR; PG8_MMA(1, 1, At, B1); PG8_BAR;
            PG8_LDB(B0, 1, 0); PG8_SCHED; PG8_LDA(At, 1, 0); PG8_STAGE(PG8_SA(0, 1), a2 + hstepA, voffA);
            PG8_WAIT_L(8); PG8_BAR; PG8_WAIT_L(0); PG8_MMA(0, 0, At, B0); PG8_BAR; PG8_SCHED;
            PG8_LDB(B1, 1, 1); PG8_STAGE(PG8_SB(1, 0), b3, voffB);
            PG8_BAR; PG8_WAIT_L(0); PG8_MMA(0, 1, At, B1); PG8_BAR;
            PG8_LDA(At, 1, 1); PG8_STAGE(PG8_SA(1, 0), a3, voffA);
            PG8_BAR; PG8_WAIT_L(0); PG8_MMA(1, 0, At, B0); PG8_BAR; PG8_SCHED;
            PG8_STAGE(PG8_SB(1, 1), b3 + hstepB, voffB);
            PG8_WAIT_V(6); PG8_BAR; PG8_MMA(1, 1, At, B1); PG8_BAR;
            }
        }
        if constexpr (ALIGN_EPI) { if (wr == 0) PG8_BAR; }
        if constexpr (!Epi::AFTER_DRAIN) { E(acc, cur, wr, wc, fr, fq); S.done(cur); }
        if (!has_next) break;
#pragma unroll
        for (int a = 0; a < 2; ++a)
#pragma unroll
            for (int b = 0; b < 2; ++b)
#pragma unroll
                for (int m = 0; m < 4; ++m)
#pragma unroll
                    for (int n = 0; n < 2; ++n) acc[a][b][m][n] = (f32x4){0.f, 0.f, 0.f, 0.f};
        cur = nxt; cA = nA; cB = nB; ++ui;
        if constexpr (ALIGN_EPI) { if (wr == 1) PG8_BAR; }
    }
    PG8_WAIT_V(0);
    if constexpr (!ALIGN_EPI) { if (wr == 0) PG8_BAR; }
    PG8_BAR;
#undef PG8_SA
#undef PG8_SB
#undef PG8_STAGE
#undef PG8_LDA
#undef PG8_LDB
#undef PG8_MMA
#undef PG8_WAIT_V
#undef PG8_WAIT_L
#undef PG8_BAR
#undef PG8_SCHED
}
}

constexpr size_t MiB = 1u << 20;
constexpr size_t WS_CTL = 0, CTL_ZERO_BYTES = 1 * MiB;
constexpr size_t WS_BTIN  = 1 * MiB;
constexpr size_t WS_BTGLU = WS_BTIN + 36 * MiB;
constexpr size_t WS_BTPS  = WS_BTGLU + 2 * MiB;
constexpr size_t WS_BTPR  = WS_BTPS + 4 * MiB;
constexpr size_t WS_BTOUT = WS_BTPR + 4 * MiB;
constexpr size_t WS_BTPG  = WS_BTOUT + 8 * MiB;
constexpr size_t WS_BTPP  = WS_BTPG + 8 * MiB;
constexpr size_t WS_BTGU  = WS_BTPP + 1 * MiB;
constexpr size_t WS_BTDN  = WS_BTGU + 512 * MiB;
constexpr size_t WS_BTS3  = WS_BTDN + 256 * MiB;
constexpr size_t WS_BTS1  = WS_BTS3 + 40 * MiB;
constexpr size_t WS_ATAB  = WS_BTS1 + 16 * MiB;
constexpr size_t WS_CS    = WS_ATAB + 1 * MiB;
constexpr size_t WS_SN    = WS_CS + 4 * MiB;
constexpr size_t WS_WG    = WS_SN + 4 * MiB;
constexpr size_t WS_PBF   = WS_WG + 1 * MiB;
constexpr size_t WS_HB    = WS_PBF + 8 * MiB;
constexpr size_t WS_XG5   = WS_HB + 64 * MiB;
constexpr size_t WS_Q     = WS_XG5 + 40 * MiB;
constexpr size_t WS_K     = WS_Q + 32 * MiB;
constexpr size_t WS_V     = WS_K + 32 * MiB;
constexpr size_t WS_GS    = WS_V + 32 * MiB;
constexpr size_t WS_SGS   = WS_GS + 32 * MiB;
constexpr size_t WS_SGR   = WS_SGS + 64 * MiB;
constexpr size_t WS_SLOC  = WS_SGR + 64 * MiB;
constexpr size_t WS_KVT   = WS_SLOC + 16 * MiB;
constexpr size_t WS_RT    = WS_KVT + 64 * MiB;
constexpr size_t WS_YSP   = WS_RT + 32 * MiB;
constexpr size_t WS_YS    = WS_YSP + 32 * MiB;
constexpr size_t WS_YR    = WS_YS + 32 * MiB;
constexpr size_t WS_TMP   = WS_YR + 32 * MiB;
constexpr size_t WS_MRG   = WS_TMP + 128 * MiB;
constexpr size_t WS_X2    = WS_MRG + 64 * MiB;
constexpr size_t WS_PP    = WS_X2 + 128 * MiB;
constexpr size_t WS_TOKE  = WS_PP + 64 * MiB;
constexpr size_t WS_TOKG  = WS_TOKE + 1 * MiB;
constexpr size_t WS_TOKP  = WS_TOKG + 1 * MiB;
constexpr size_t WS_ROWG  = WS_TOKP + 1 * MiB;
constexpr size_t WS_AROW  = WS_ROWG + 1 * MiB;
constexpr size_t WS_BLKE  = WS_AROW + 1 * MiB;
constexpr size_t WS_XG    = WS_BLKE + 1 * MiB;
constexpr size_t WS_ACT   = WS_XG + 288 * MiB;
constexpr size_t WS_YB    = WS_ACT + 288 * MiB;
constexpr size_t WS_END   = WS_YB + 288 * MiB;
constexpr int CW_CNT = 64;
constexpr int CW_BAR = 4096;

constexpr int RING_OFF = 0, RING_BYTES = 131072;
constexpr int LDS_BYTES = 159744;
constexpr int LDSCTL_OFF = LDS_BYTES - 256;
constexpr int NWAVES = 8;

#define GAS __attribute__((address_space(1)))
#define LAS __attribute__((address_space(3)))
typedef unsigned short bf16;
typedef unsigned v4u __attribute__((ext_vector_type(4)));
typedef unsigned v2u __attribute__((ext_vector_type(2)));
typedef float f32x4 __attribute__((ext_vector_type(4)));
typedef float f32x16 __attribute__((ext_vector_type(16)));
typedef short bf16x8 __attribute__((ext_vector_type(8)));
#define RLX_AGENT __ATOMIC_RELAXED, __HIP_MEMORY_SCOPE_AGENT
#define LDS_WAIT() asm volatile("s_waitcnt lgkmcnt(0)" ::: "memory")
#define VM_WAIT() asm volatile("s_waitcnt vmcnt(0)" ::: "memory")
__device__ __forceinline__ unsigned f2bf(float f) { unsigned u = __builtin_bit_cast(unsigned, f); return (u + 0x7fffu + ((u >> 16) & 1u)) >> 16; }
__device__ __forceinline__ unsigned pk2(float lo, float hi) { return f2bf(lo) | (f2bf(hi) << 16); }
__device__ __forceinline__ float bf2f(unsigned short b) { return __builtin_bit_cast(float, (unsigned)b << 16); }

#define XB_TMO      128
#define XB_XCNT(j)  (256  + 64 * (j))
#define XB_XSUB(j)  (1280 + 64 * (j))
#define XB_XGEN(j)  (2304 + 64 * (j))
#define XB_TOP      3328
#define XB_TOPGEN   3392
#define XCD_BAR_WORDS 3456
#define XB_SPIN_CAP (1u << 20)
__device__ __forceinline__ unsigned xb_ld(unsigned* p)              { return __hip_atomic_load(p, __ATOMIC_RELAXED, __HIP_MEMORY_SCOPE_AGENT); }
__device__ __forceinline__ unsigned xb_add(unsigned* p, unsigned v) { return __hip_atomic_fetch_add(p, v, __ATOMIC_RELAXED, __HIP_MEMORY_SCOPE_AGENT); }
__device__ __forceinline__ unsigned xb_xcc_id() { return (unsigned)__builtin_amdgcn_s_getreg((3 << 11) | 20) & 0xFu; }
#define XB_SPIN(cond, bar) do { unsigned _sp = 0; while (cond) { __builtin_amdgcn_s_sleep(1); \
    if ((++_sp & 255u) == 0u) { if (xb_ld(&(bar)[XB_TMO])) break; if (_sp > XB_SPIN_CAP) { atomicAdd(&(bar)[XB_TMO], 1u); break; } } } } while (0)
struct XcdBarrier { unsigned* bar; unsigned x; volatile LAS unsigned* st; };
__device__ __forceinline__ XcdBarrier xcd_barrier_post(unsigned* bar, volatile LAS unsigned* st) {
    XcdBarrier b; b.bar = bar; b.x = xb_xcc_id(); b.st = st;
    if (threadIdx.x == 0) (void)xb_add(&bar[XB_XCNT(b.x)], 1u);
    return b;
}
__device__ __forceinline__ void xcd_barrier_complete(unsigned* bar, unsigned x, unsigned& nloc, unsigned& nx) {
    const unsigned G = gridDim.x * gridDim.y * gridDim.z;
    unsigned sum, cnt, mine, sp = 0u;
    for (;;) {
        sum = 0u; cnt = 0u; mine = 0u;
#pragma unroll
        for (unsigned j = 0; j < 16; ++j) { const unsigned c = xb_ld(&bar[XB_XCNT(j)]); sum += c; cnt += (c > 0u) ? 1u : 0u; mine = (j == x) ? c : mine; }
        if (sum == G) break;
        __builtin_amdgcn_s_sleep(1);
        if ((++sp & 255u) == 0u) { if (xb_ld(&bar[XB_TMO])) break; if (sp > XB_SPIN_CAP) { atomicAdd(&bar[XB_TMO], 1u); break; } }
    }
    nloc = mine > 0u ? mine : 1u; nx = cnt > 0u ? cnt : 1u;
}
__device__ __forceinline__ void xcd_barrier(const XcdBarrier& b) {
    asm volatile("s_waitcnt vmcnt(0)" ::: "memory");
    __syncthreads();
    if (threadIdx.x == 0) {
        unsigned* bar = b.bar;
        __builtin_amdgcn_s_waitcnt(0);
        unsigned nloc = b.st[0], nx = b.st[1];
        if (nloc == 0u) { xcd_barrier_complete(bar, b.x, nloc, nx); b.st[0] = nloc; b.st[1] = nx; }
        const unsigned old = xb_add(&bar[XB_XSUB(b.x)], 1u);
        const unsigned gen = old / nloc;
        if (old + 1u == (gen + 1u) * nloc) {
            __builtin_amdgcn_fence(__ATOMIC_RELEASE, "agent");
            asm volatile("s_waitcnt vmcnt(0)" ::: "memory");
            const unsigned og = xb_add(&bar[XB_TOP], 1u);
            const unsigned tg = og / nx;
            if (og + 1u == (tg + 1u) * nx) xb_add(&bar[XB_TOPGEN], 1u);
            else XB_SPIN(xb_ld(&bar[XB_TOPGEN]) == tg, bar);
            __builtin_amdgcn_fence(__ATOMIC_ACQUIRE, "agent");
            xb_add(&bar[XB_XGEN(b.x)], 1u);
            asm volatile("s_waitcnt vmcnt(0)" ::: "memory");
        } else {
            XB_SPIN(xb_ld(&bar[XB_XGEN(b.x)]) == gen, bar);
            __builtin_amdgcn_fence(__ATOMIC_ACQUIRE, "agent");
            asm volatile("s_waitcnt vmcnt(0)" ::: "memory");
        }
    }
    __syncthreads();
}

__device__ __forceinline__ float wave_sum(float v) {
#pragma unroll
    for (int o = 1; o < 64; o <<= 1) v += __shfl_xor(v, o);
    return v;
}
__device__ __forceinline__ int rowmap(int mode, int n) {
    if (mode == 1) { if (n < 1024 || n >= 3072) return n; const int nn = n - 1024, r = nn >> 10, hn = nn & 1023, head = hn >> 7, half = (hn >> 6) & 1, dd = hn & 63;
        return 1024 + r * 1024 + (head >> 1) * 256 + half * 128 + (head & 1) * 64 + dd; }
    if (mode == 2) { const int f = n >> 1, s = n & 1; return (f >> 7) * 256 + (f & 127) + 128 * s; }
    return n;
}
__device__ __forceinline__ void transpose_item(const float* W, int K, int N, bf16* WT, int mode, LAS float* scr, int kb, int nb, int lane) {
    const int k0 = 64 * kb, n0 = 64 * nb;
    const float* src = W + (size_t)k0 * N + n0 + lane;
#pragma unroll 16
    for (int kk = 0; kk < 64; ++kk) scr[kk * 65 + lane] = src[(size_t)kk * N];
    LDS_WAIT(); asm volatile("" ::: "memory");
    const int c = lane & 7;
#pragma unroll
    for (int j = 0; j < 8; ++j) { const int n = (lane >> 3) + 8 * j; const LAS float* s = scr + (8 * c) * 65 + n;
        v4u o; o.x = pk2(s[0 * 65], s[1 * 65]); o.y = pk2(s[2 * 65], s[3 * 65]); o.z = pk2(s[4 * 65], s[5 * 65]); o.w = pk2(s[6 * 65], s[7 * 65]);
        *(v4u*)(WT + (size_t)rowmap(mode, n0 + n) * K + k0 + 8 * c) = o; }
    LDS_WAIT(); asm volatile("" ::: "memory");
}
__device__ __forceinline__ void rms_row_bf16(const float* xrow, const float* gain, bf16* orow, int lane) {
    const f32x4* xr = (const f32x4*)xrow + lane; const f32x4* gr = (const f32x4*)gain + lane;
    f32x4 v[8]; float s = 0.f;
#pragma unroll
    for (int j = 0; j < 8; ++j) { v[j] = xr[64 * j]; s += (v[j].x * v[j].x + v[j].y * v[j].y) + (v[j].z * v[j].z + v[j].w * v[j].w); }
    const float rstd = 1.0f / sqrtf(wave_sum(s) * (1.0f / 2048.0f) + 1e-6f);
    v2u* o8 = (v2u*)orow + lane;
#pragma unroll
    for (int j = 0; j < 8; ++j) { const f32x4 g = gr[64 * j]; v2u w; w.x = pk2(v[j].x * rstd * g.x, v[j].y * rstd * g.y); w.y = pk2(v[j].z * rstd * g.z, v[j].w * rstd * g.w); o8[64 * j] = w; }
}

struct Args {
    const float* x; const float* p; const int* pos; const float* norm1_g; const float* w_in;
    const float* lam_re; const float* lam_im; const float* log_dt; const float* b_re; const float* b_im; const float* c_re; const float* c_im; const float* d_skip;
    const float* w_glu; const float* b_glu; const float* w_bs; const float* w_br; const float* w_out; const float* norm2_g; const float* router_w; const float* router_b;
    const float* w_gu; const float* b_gu; const float* w_dn; const float* b_dn; const float* norm3_g; const float* w_pg; const float* w_pp; const float* fin_g;
    float* out; unsigned char* ws; int ph_lo, ph_hi;
};

__device__ __forceinline__ void s5_tables(const Args& a, int g, LAS unsigned char* lds, int tid) {
    LAS float* Pre = (LAS float*)lds;
    LAS float* Pim = Pre + 33 * 64;
    LAS float* Bre = Pim + 33 * 64;
    LAS float* Bim = Bre + 1024;
    LAS float* Cre = Bim + 1024;
    LAS float* Cim = Cre + 1024;
    LAS float* Kt  = Cim + 1024;
    const float dt = expf(a.log_dt[g]);
    for (int e = tid; e < 33 * 64; e += 512) { const int p = e >> 6, n = e & 63; const float lr = a.lam_re[g * 64 + n], li = a.lam_im[g * 64 + n];
        const float mag = expf(lr * dt * (float)p), ang = li * dt * (float)p; Pre[e] = mag * cosf(ang); Pim[e] = mag * sinf(ang); }
    for (int e = tid; e < 1024; e += 512) { const int n = e >> 4; const float lr = a.lam_re[g * 64 + n], li = a.lam_im[g * 64 + n];
        const float mag = expf(lr * dt), abr = mag * cosf(li * dt), abi = mag * sinf(li * dt);
        const float den = lr * lr + li * li, nr = abr - 1.0f, ni = abi, fre = (nr * lr + ni * li) / den, fim = (ni * lr - nr * li) / den;
        const float br = a.b_re[(size_t)g * 1024 + e], bi = a.b_im[(size_t)g * 1024 + e];
        Bre[e] = fre * br - fim * bi; Bim[e] = fre * bi + fim * br;
        Cre[e] = a.c_re[(size_t)g * 1024 + e]; Cim[e] = a.c_im[(size_t)g * 1024 + e]; }
    __syncthreads();
    for (int e = tid; e < 8192; e += 512) { const int tau = e >> 8, c = (e >> 4) & 15, cp = e & 15; float s = 0.f;
        for (int n = 0; n < 64; ++n) { const float pr = Pre[tau * 64 + n], pi = Pim[tau * 64 + n], br = Bre[n * 16 + cp], bi = Bim[n * 16 + cp];
            const float zr = pr * br - pi * bi, zi = pr * bi + pi * br; s += Cre[c * 64 + n] * zr - Cim[c * 64 + n] * zi; }
        if (tau == 0 && c == cp) s += a.d_skip[g * 16 + c];
        Kt[e] = s; }
    __syncthreads();
    bf16* bt3 = (bf16*)(a.ws + WS_BTS3) + (size_t)g * 512 * K5;
    for (int ch = tid; ch < 512 * 80; ch += 512) { const int row = ch / 80, cc = ch % 80, i = row >> 4, c = row & 15; float v[8];
        if (cc < 64) { const int ip = cc >> 1, c0 = (cc & 1) * 8;
#pragma unroll
            for (int x = 0; x < 8; ++x) v[x] = (i >= ip) ? Kt[(i - ip) * 256 + c * 16 + c0 + x] : 0.f;
        } else { const int m0 = (cc - 64) * 8;
#pragma unroll
            for (int x = 0; x < 8; ++x) { const int m = m0 + x, n = m & 63; const float cr = Cre[c * 64 + n], ci = Cim[c * 64 + n], pr = Pre[(i + 1) * 64 + n], pi = Pim[(i + 1) * 64 + n];
                v[x] = (m < 64) ? (cr * pr - ci * pi) : -(cr * pi + ci * pr); } }
        v4u o; o.x = pk2(v[0], v[1]); o.y = pk2(v[2], v[3]); o.z = pk2(v[4], v[5]); o.w = pk2(v[6], v[7]);
        *(v4u*)(bt3 + (size_t)row * K5 + cc * 8) = o; }
    bf16* bt1 = (bf16*)(a.ws + WS_BTS1) + (size_t)g * 256 * 512;
    for (int ch = tid; ch < 256 * 64; ch += 512) { const int row = ch >> 6, cc = ch & 63, ip = cc >> 1, c0 = (cc & 1) * 8; float v[8];
#pragma unroll
        for (int x = 0; x < 8; ++x) { if (row < 128) { const int n = row & 63; const float pr = Pre[(31 - ip) * 64 + n], pi = Pim[(31 - ip) * 64 + n], br = Bre[n * 16 + c0 + x], bi = Bim[n * 16 + c0 + x];
                v[x] = (row < 64) ? (pr * br - pi * bi) : (pr * bi + pi * br); } else v[x] = 0.f; }
        v4u o; o.x = pk2(v[0], v[1]); o.y = pk2(v[2], v[3]); o.z = pk2(v[4], v[5]); o.w = pk2(v[6], v[7]);
        *(v4u*)(bt1 + (size_t)row * 512 + cc * 8) = o; }
    float* at = (float*)(a.ws + WS_ATAB) + g * 128;
    if (tid < 64) { at[tid * 2] = Pre[32 * 64 + tid]; at[tid * 2 + 1] = Pim[32 * 64 + tid]; }
    __syncthreads();
}

__device__ __forceinline__ void s5_scan_item(const Args& a, int item, LAS unsigned char* lds, int tid) {
    LAS float* seg_re = (LAS float*)lds; LAS float* seg_im = seg_re + 512;
    const int sl = tid & 31, seg = tid >> 5, sidx = item * 32 + sl, g = sidx >> 6, n = sidx & 63;
    const float* at = (const float*)(a.ws + WS_ATAB) + g * 128 + n * 2; const float ar = at[0], ai = at[1];
    const float* sloc = (const float*)(a.ws + WS_SLOC) + ((size_t)g * NCH5 + seg * 32) * 128 + n;
    float er = 0.f, ei = 0.f;
#pragma unroll 8
    for (int j = 0; j < 32; ++j) { const float lr = sloc[j * 128], li = sloc[j * 128 + 64]; const float tr = ar * er - ai * ei + lr, ti = ar * ei + ai * er + li; er = tr; ei = ti; }
    seg_re[seg * 32 + sl] = er; seg_im[seg * 32 + sl] = ei;
    __syncthreads();
    float pr = ar, pi = ai;
#pragma unroll
    for (int q = 0; q < 5; ++q) { const float tr = pr * pr - pi * pi, ti = 2.f * pr * pi; pr = tr; pi = ti; }
    float sr = 0.f, si = 0.f;
    for (int s2 = 0; s2 < seg; ++s2) { const float tr = pr * sr - pi * si + seg_re[s2 * 32 + sl], ti = pr * si + pi * sr + seg_im[s2 * 32 + sl]; sr = tr; si = ti; }
    bf16* xg = (bf16*)(a.ws + WS_XG5) + ((size_t)g * NCH5 + seg * 32) * K5 + 512 + n;
#pragma unroll 8
    for (int j = 0; j < 32; ++j) { xg[(size_t)j * K5] = (bf16)f2bf(sr); xg[(size_t)j * K5 + 64] = (bf16)f2bf(si);
        const float lr = sloc[j * 128], li = sloc[j * 128 + 64]; const float tr = ar * sr - ai * si + lr, ti = ar * si + ai * sr + li; sr = tr; si = ti; }
    __syncthreads();
}

constexpr int RS = 130;
__device__ __forceinline__ float ret_l2g(int h) { return log2f(1.0f - exp2f(-5.0f - (float)h)); }
__device__ __forceinline__ bf16x8 lds_frag_col(const LAS bf16* base, int stride) {
    bf16x8 f;
#pragma unroll
    for (int x = 0; x < 8; ++x) f[x] = (short)base[x * stride];
    return f;
}
template <bool ZETA> __device__ __forceinline__ void ret_stage(const bf16* src, LAS bf16* dst, int tid, float l2g) {
#pragma unroll
    for (int q = 0; q < 4; ++q) { const int id = tid + 512 * q, row = id >> 4, c8 = id & 15; v4u w = *(const v4u*)(src + (size_t)row * 1024 + 8 * c8);
        if (ZETA) { const float z = exp2f(l2g * (float)(127 - row));
            w.x = pk2(pg8::bf_lo(w.x) * z, pg8::bf_hi(w.x) * z); w.y = pk2(pg8::bf_lo(w.y) * z, pg8::bf_hi(w.y) * z); w.z = pk2(pg8::bf_lo(w.z) * z, pg8::bf_hi(w.z) * z); w.w = pk2(pg8::bf_lo(w.w) * z, pg8::bf_hi(w.w) * z); }
        LAS unsigned* d = (LAS unsigned*)(dst + row * RS + 8 * c8); d[0] = w.x; d[1] = w.y; d[2] = w.z; d[3] = w.w; }
}
__device__ __forceinline__ void ret_kv_unit(const Args& a, int unit, LAS unsigned char* lds, int tid) {
    const int n = unit >> 3, h = unit & 7, t0 = n * RCH, lane = tid & 63, w = __builtin_amdgcn_readfirstlane(tid >> 6), fr = lane & 15, fg = lane >> 4;
    LAS bf16* Ks = (LAS bf16*)lds; LAS bf16* Vs = Ks + 128 * RS;
    const float l2g = ret_l2g(h);
    ret_stage<true>((const bf16*)(a.ws + WS_K) + (size_t)t0 * 1024 + h * 128, Ks, tid, l2g);
    ret_stage<false>((const bf16*)(a.ws + WS_V) + (size_t)t0 * 1024 + h * 128, Vs, tid, l2g);
    __syncthreads();
    bf16x8 af[4];
#pragma unroll
    for (int ks = 0; ks < 4; ++ks) af[ks] = lds_frag_col(Vs + (32 * ks + 8 * fg) * RS + 16 * w + fr, RS);
    float* out = (float*)(a.ws + WS_KVT) + ((size_t)unit * 128 + 16 * w + 4 * fg) * 128 + fr;
#pragma unroll
    for (int dt = 0; dt < 8; ++dt) { f32x4 acc = (f32x4){0.f, 0.f, 0.f, 0.f};
#pragma unroll
        for (int ks = 0; ks < 4; ++ks) { const bf16x8 bfv = lds_frag_col(Ks + (32 * ks + 8 * fg) * RS + 16 * dt + fr, RS);
            acc = __builtin_amdgcn_mfma_f32_16x16x32_bf16(af[ks], bfv, acc, 0, 0, 0); }
#pragma unroll
        for (int r = 0; r < 4; ++r) out[(size_t)r * 128 + 16 * dt] = acc[r]; }
    __syncthreads();
}
__device__ __forceinline__ void ret_state_scan(const Args& a, int gtid, int gthreads) {
    const float* kvt = (const float*)(a.ws + WS_KVT); bf16* rt = (bf16*)(a.ws + WS_RT);
    for (int idx = gtid; idx < RH * 128 * 128; idx += gthreads) { const int h = idx >> 14; const float dec = exp2f(128.0f * ret_l2g(h)); float st = 0.f;
#pragma unroll 8
        for (int n = 0; n < NRC; ++n) { rt[(size_t)n * 131072 + idx] = (bf16)f2bf(st); st = st * dec + kvt[(size_t)n * 131072 + idx]; } }
}
__device__ __forceinline__ void ret_out_unit(const Args& a, int unit, LAS unsigned char* lds, int tid) {
    const int n = unit >> 3, h = unit & 7, t0 = n * RCH, lane = tid & 63, w = __builtin_amdgcn_readfirstlane(tid >> 6), fr = lane & 15, fg = lane >> 4;
    LAS bf16* Ks = (LAS bf16*)lds; LAS bf16* Vs = Ks + 128 * RS; LAS bf16* Ps = Vs + 128 * RS;
    const float l2g = ret_l2g(h);
    ret_stage<false>((const bf16*)(a.ws + WS_K) + (size_t)t0 * 1024 + h * 128, Ks, tid, l2g);
    ret_stage<false>((const bf16*)(a.ws + WS_V) + (size_t)t0 * 1024 + h * 128, Vs, tid, l2g);
    const int i0 = 16 * w, il = i0 + fr;
    bf16x8 qf[4];
    { const bf16* qp = (const bf16*)(a.ws + WS_Q) + (size_t)(t0 + il) * 1024 + h * 128 + 8 * fg;
#pragma unroll
      for (int ks = 0; ks < 4; ++ks) qf[ks] = *(const bf16x8*)(qp + 32 * ks); }
    __syncthreads();
#pragma unroll
    for (int jt = 0; jt < 8; ++jt) {
        if (jt <= w) { f32x4 acc = (f32x4){0.f, 0.f, 0.f, 0.f};
#pragma unroll
            for (int ks = 0; ks < 4; ++ks) { bf16x8 kf;
#pragma unroll
                for (int x = 0; x < 8; ++x) kf[x] = (short)Ks[(16 * jt + fr) * RS + 32 * ks + 8 * fg + x];
                acc = __builtin_amdgcn_mfma_f32_16x16x32_bf16(kf, qf[ks], acc, 0, 0, 0); }
            float pv[4];
#pragma unroll
            for (int r = 0; r < 4; ++r) { const int j = 16 * jt + 4 * fg + r; pv[r] = (il >= j) ? acc[r] * exp2f(l2g * (float)(il - j)) : 0.f; }
            LAS unsigned* pp = (LAS unsigned*)(Ps + il * RS + 16 * jt + 4 * fg); pp[0] = pk2(pv[0], pv[1]); pp[1] = pk2(pv[2], pv[3]);
        } else if (jt == w + 1 && (w & 1) == 0) { LAS unsigned* pp = (LAS unsigned*)(Ps + il * RS + 16 * jt + 4 * fg); pp[0] = 0u; pp[1] = 0u; }
    }
    __syncthreads();
    f32x4 accI[8], accC[8];
#pragma unroll
    for (int et = 0; et < 8; ++et) { accI[et] = (f32x4){0.f, 0.f, 0.f, 0.f}; accC[et] = (f32x4){0.f, 0.f, 0.f, 0.f}; }
    const int nks = (w >> 1) + 1;
    for (int ks = 0; ks < nks; ++ks) { bf16x8 pf;
#pragma unroll
        for (int x = 0; x < 8; ++x) pf[x] = (short)Ps[il * RS + 32 * ks + 8 * fg + x];
#pragma unroll
        for (int et = 0; et < 8; ++et) { const bf16x8 vf = lds_frag_col(Vs + (32 * ks + 8 * fg) * RS + 16 * et + fr, RS);
            accI[et] = __builtin_amdgcn_mfma_f32_16x16x32_bf16(vf, pf, accI[et], 0, 0, 0); } }
    { const bf16* rp = (const bf16*)(a.ws + WS_RT) + ((size_t)unit * 128 + fr) * 128 + 8 * fg;
#pragma unroll
      for (int et = 0; et < 8; ++et)
#pragma unroll
          for (int ks = 0; ks < 4; ++ks) { const bf16x8 rf = *(const bf16x8*)(rp + (size_t)(16 * et) * 128 + 32 * ks);
              accC[et] = __builtin_amdgcn_mfma_f32_16x16x32_bf16(rf, qf[ks], accC[et], 0, 0, 0); } }
    const float xi = exp2f(l2g * (float)(il + 1));
    float s = 0.f;
#pragma unroll
    for (int et = 0; et < 8; ++et) { accI[et] = accI[et] + accC[et] * xi; s += (accI[et][0] + accI[et][1]) + (accI[et][2] + accI[et][3]); }
    s += __shfl_xor(s, 16); s += __shfl_xor(s, 32);
    const float mu = s * (1.0f / 128.0f); float q2 = 0.f;
#pragma unroll
    for (int et = 0; et < 8; ++et) { accI[et] = accI[et] - mu; q2 += (accI[et][0] * accI[et][0] + accI[et][1] * accI[et][1]) + (accI[et][2] * accI[et][2] + accI[et][3] * accI[et][3]); }
    q2 += __shfl_xor(q2, 16); q2 += __shfl_xor(q2, 32);
    const float rstd = 1.0f / sqrtf(q2 * (1.0f / 128.0f) + 1e-6f);
    const size_t ob = (size_t)(t0 + il) * 1024 + h * 128 + 4 * fg;
    const bf16* gp = (const bf16*)(a.ws + WS_GS) + ob; bf16* yp = (bf16*)(a.ws + WS_YR) + ob;
#pragma unroll
    for (int et = 0; et < 8; ++et) { const v2u gw = *(const v2u*)(gp + 16 * et); v2u o;
        o.x = pk2(accI[et][0] * rstd * pg8::bf_lo(gw.x), accI[et][1] * rstd * pg8::bf_hi(gw.x)); o.y = pk2(accI[et][2] * rstd * pg8::bf_lo(gw.y), accI[et][3] * rstd * pg8::bf_hi(gw.y));
        *(v2u*)(yp + 16 * et) = o; }
    __syncthreads();
}

__device__ __forceinline__ void router_item(const Args& a, int item, LAS unsigned char* lds, int tid) {
    LAS float* rs = (LAS float*)lds;
    LAS float* part = rs + 64;
    LAS float* lg = part + 4 * 64 * 33;
    LAS int* hist = (LAS int*)(lg + 64 * 33);
    LAS int* base = hist + 32;
    const int lane = tid & 63, w = __builtin_amdgcn_readfirstlane(tid >> 6), tb = item * 64;
    const float* x2 = (const float*)(a.ws + WS_X2);
    if (tid < 32) hist[tid] = 0;
    for (int r = 0; r < 8; ++r) { const int t = tb + 8 * w + r; const float* xrow = x2 + (size_t)t * 2048;
        const f32x4* xr = (const f32x4*)xrow + lane; const f32x4* gr = (const f32x4*)a.norm2_g + lane;
        f32x4 v[8]; float s = 0.f;
#pragma unroll
        for (int j = 0; j < 8; ++j) { v[j] = xr[64 * j]; s += (v[j].x * v[j].x + v[j].y * v[j].y) + (v[j].z * v[j].z + v[j].w * v[j].w); }
        const float rstd = 1.0f / sqrtf(wave_sum(s) * (1.0f / 2048.0f) + 1e-6f);
        if (lane == 0) rs[8 * w + r] = rstd;
        v2u* o8 = (v2u*)((bf16*)(a.ws + WS_HB) + (size_t)t * 2048) + lane;
#pragma unroll
        for (int j = 0; j < 8; ++j) { const f32x4 g = gr[64 * j]; v2u o; o.x = pk2(v[j].x * rstd * g.x, v[j].y * rstd * g.y); o.y = pk2(v[j].z * rstd * g.z, v[j].w * rstd * g.w); o8[64 * j] = o; } }
    { const int tg = w & 1, kq = w >> 1, hl = lane >> 5, l31 = lane & 31;
      const float* xp = x2 + (size_t)(tb + 32 * tg + l31) * 2048 + 512 * kq + 4 * hl;
      const float* wp = (const float*)(a.ws + WS_WG) + (size_t)(512 * kq + 4 * hl) * 32 + l31;
      f32x16 acc;
#pragma unroll
      for (int x = 0; x < 16; ++x) acc[x] = 0.f;
#pragma unroll 4
      for (int kk = 0; kk < 64; ++kk) { const f32x4 av = *(const f32x4*)(xp + 8 * kk); const float* wq = wp + (size_t)(8 * kk) * 32;
          acc = __builtin_amdgcn_mfma_f32_32x32x2f32(av.x, wq[0], acc, 0, 0, 0); acc = __builtin_amdgcn_mfma_f32_32x32x2f32(av.y, wq[32], acc, 0, 0, 0);
          acc = __builtin_amdgcn_mfma_f32_32x32x2f32(av.z, wq[64], acc, 0, 0, 0); acc = __builtin_amdgcn_mfma_f32_32x32x2f32(av.w, wq[96], acc, 0, 0, 0); }
#pragma unroll
      for (int x = 0; x < 16; ++x) { const int tl = (x & 3) + 8 * (x >> 2) + 4 * hl; part[(kq * 64 + 32 * tg + tl) * 33 + l31] = acc[x]; } }
    __syncthreads();
    for (int e = tid; e < 64 * 32; e += 512) { const int tl = e >> 5, ex = e & 31;
        lg[tl * 33 + ex] = rs[tl] * ((part[(0 * 64 + tl) * 33 + ex] + part[(1 * 64 + tl) * 33 + ex]) + (part[(2 * 64 + tl) * 33 + ex] + part[(3 * 64 + tl) * 33 + ex])) + a.router_b[ex]; }
    __syncthreads();
    int e0 = 0, e1 = 0, e2 = 0, e3 = 0, r0 = 0, r1 = 0, r2 = 0, r3 = 0; float g0 = 0.f, g1 = 0.f, g2 = 0.f, g3 = 0.f;
    if (tid < 64) { const LAS float* L = lg + tid * 33; float v0 = -3.0e38f, v1 = -3.0e38f, v2 = -3.0e38f, v3 = -3.0e38f;
        for (int ex = 0; ex < 32; ++ex) { const float v = L[ex]; if (v > v0) { v0 = v; e0 = ex; } }
        for (int ex = 0; ex < 32; ++ex) { const float v = L[ex]; if (ex != e0 && v > v1) { v1 = v; e1 = ex; } }
        for (int ex = 0; ex < 32; ++ex) { const float v = L[ex]; if (ex != e0 && ex != e1 && v > v2) { v2 = v; e2 = ex; } }
        for (int ex = 0; ex < 32; ++ex) { const float v = L[ex]; if (ex != e0 && ex != e1 && ex != e2 && v > v3) { v3 = v; e3 = ex; } }
        const float p0 = 1.0f, p1 = expf(v1 - v0), p2 = expf(v2 - v0), p3 = expf(v3 - v0), inv = 1.0f / (p0 + p1 + p2 + p3);
        g0 = p0 * inv; g1 = p1 * inv; g2 = p2 * inv; g3 = p3 * inv;
        r0 = __hip_atomic_fetch_add(&hist[e0], 1, __ATOMIC_RELAXED, __HIP_MEMORY_SCOPE_WORKGROUP); r1 = __hip_atomic_fetch_add(&hist[e1], 1, __ATOMIC_RELAXED, __HIP_MEMORY_SCOPE_WORKGROUP);
        r2 = __hip_atomic_fetch_add(&hist[e2], 1, __ATOMIC_RELAXED, __HIP_MEMORY_SCOPE_WORKGROUP); r3 = __hip_atomic_fetch_add(&hist[e3], 1, __ATOMIC_RELAXED, __HIP_MEMORY_SCOPE_WORKGROUP); }
    __syncthreads();
    if (tid < 32) base[tid] = (int)__hip_atomic_fetch_add((unsigned*)(a.ws + WS_CTL) + CW_CNT + tid, (unsigned)hist[tid], RLX_AGENT);
    __syncthreads();
    if (tid < 64) { const int t = tb + tid; int* te = (int*)(a.ws + WS_TOKE) + t * 4; float* tg = (float*)(a.ws + WS_TOKG) + t * 4; int* tp = (int*)(a.ws + WS_TOKP) + t * 4;
        te[0] = e0; te[1] = e1; te[2] = e2; te[3] = e3; tg[0] = g0; tg[1] = g1; tg[2] = g2; tg[3] = g3;
        tp[0] = base[e0] + r0; tp[1] = base[e1] + r1; tp[2] = base[e2] + r2; tp[3] = base[e3] + r3; }
    __syncthreads();
}

constexpr int N_PHASES = 15;
__global__ void __launch_bounds__(NWAVES * 64, 2) mk_fwd(Args kargs) {
    extern __shared__ __attribute__((aligned(16))) unsigned char lds_raw[];
    LAS unsigned char* lds = (LAS unsigned char*)lds_raw;
    const int tid = threadIdx.x, lane = tid & 63, wave = __builtin_amdgcn_readfirstlane(tid >> 6);
    const int G = gridDim.x, bx = blockIdx.x, gw = bx * NWAVES + wave, NGW = G * NWAVES, gtid = bx * (NWAVES * 64) + tid, GT = G * NWAVES * 64;
    unsigned char* const ws = kargs.ws;
#define LOAD_ARGS() const __attribute__((address_space(4))) Args* ap_ = (const __attribute__((address_space(4))) Args*)__builtin_amdgcn_kernarg_segment_ptr(); asm volatile("" : "+s"(ap_)); Args a; { const __attribute__((address_space(4))) unsigned long long* q_ = (const __attribute__((address_space(4))) unsigned long long*)ap_; unsigned long long* d_ = (unsigned long long*)&a; _Pragma("unroll") for (int i_ = 0; i_ < (int)(sizeof(Args) / 8); ++i_) d_[i_] = q_[i_]; }
    for (int u = tid; u < (LDS_BYTES - LDSCTL_OFF) / 4; u += NWAVES * 64) ((LAS unsigned*)(lds + LDSCTL_OFF))[u] = 0u;
    __syncthreads();
    XcdBarrier bar = xcd_barrier_post((unsigned*)(ws + WS_CTL) + CW_BAR, (volatile LAS unsigned*)(lds + LDSCTL_OFF) + 8);
    const int lo = kargs.ph_lo, hi = kargs.ph_hi;
#ifndef PH_MASK
#define PH_MASK 0x7fff
#endif
#define IN(k) (((PH_MASK >> (k)) & 1) && lo <= (k) && (k) < hi)
#define SEAM(k) do { if (IN(k) && IN((k) + 1)) xcd_barrier(bar); } while (0)
    bf16* const HB = (bf16*)(ws + WS_HB);

    if (IN(0)) { LOAD_ARGS();
        for (int g = bx; g < NG5; g += G) s5_tables(a, g, lds, tid);
        LAS float* scr = (LAS float*)(lds + wave * 16640);
#define TR(src, K_, N_, dst, mode, nmat, sstride, dstride) do { const int nbk = (N_) / 64, per = ((K_) / 64) * nbk; \
        for (int it = gw; it < (nmat) * per; it += NGW) { const int mat = it / per, r = it % per; \
            transpose_item((src) + (size_t)mat * (sstride), (K_), (N_), (dst) + (size_t)mat * (dstride), (mode), scr, r / nbk, r % nbk, lane); } } while (0)
        TR(a.w_in, 2048, INC, (bf16*)(ws + WS_BTIN), 1, 1, 0, 0);
        TR(a.w_pp, PLED, 2048, (bf16*)(ws + WS_BTPP), 0, 1, 0, 0);
        TR(a.w_glu, 1024, 1024, (bf16*)(ws + WS_BTGLU), 0, 1, 0, 0);
        TR(a.w_bs, 1024, 2048, (bf16*)(ws + WS_BTPS), 0, 1, 0, 0);
        TR(a.w_br, 1024, 2048, (bf16*)(ws + WS_BTPR), 0, 1, 0, 0);
        TR(a.w_out, 2048, 2048, (bf16*)(ws + WS_BTOUT), 0, 1, 0, 0);
        TR(a.w_pg, 2048, 2048, (bf16*)(ws + WS_BTPG), 0, 1, 0, 0);
        TR(a.w_gu, 2048, 4096, (bf16*)(ws + WS_BTGU), 2, NEXP, (size_t)2048 * 4096, (size_t)4096 * 2048);
        TR(a.w_dn, 2048, 2048, (bf16*)(ws + WS_BTDN), 0, NEXP, (size_t)2048 * 2048, (size_t)2048 * 2048);
#undef TR
        for (int t = gw; t < SEQ; t += NGW) rms_row_bf16(a.x + (size_t)t * 2048, a.norm1_g, HB + (size_t)t * 2048, lane);
        { float* cs = (float*)(ws + WS_CS); float* sn = (float*)(ws + WS_SN);
          for (int e = gtid; e < SEQ * 64; e += GT) { const int t = e >> 6, i = e & 63; const float inv = powf(10000.0f, -(float)i / 64.0f), ang = (float)a.pos[t] * inv; cs[e] = cosf(ang); sn[e] = sinf(ang); } }
        { float* wg = (float*)(ws + WS_WG); for (int e = gtid; e < 2048 * 32; e += GT) wg[e] = a.norm2_g[e >> 5] * a.router_w[e]; }
        { v2u* pb = (v2u*)(ws + WS_PBF); const f32x4* pf = (const f32x4*)a.p;
          for (int e = gtid; e < SEQ * PLED / 4; e += GT) { const f32x4 v = pf[e]; v2u o; o.x = pk2(v.x, v.y); o.y = pk2(v.z, v.w); pb[e] = o; } }
    }
    SEAM(0);
    if (IN(1)) { LOAD_ARGS();
#ifndef P1_MASK
#define P1_MASK 15
#endif
        if (P1_MASK & 1) { pg8::Gemm g{HB, (const bf16*)(ws + WS_BTIN), 2048, 2048, 2048}; pg8::StaticOrder S; S.init(SEQ, 1024, G, bx);
          pg8::EpiZU E{(bf16*)(ws + WS_XG5)};
          pg8::gemm_phase<pg8::EpiZU, pg8::StaticOrder, true, true>(lds + RING_OFF, g, S, E); }
        if (P1_MASK & 2) { pg8::Gemm g{HB, (const bf16*)(ws + WS_BTIN) + (size_t)1024 * 2048, 2048, 2048, 2048}; pg8::StaticOrder S; S.init(SEQ, 2048, G, bx);
          pg8::EpiZR E{(bf16*)(ws + WS_Q), (bf16*)(ws + WS_K), (const float*)(ws + WS_CS), (const float*)(ws + WS_SN)};
          pg8::gemm_phase<pg8::EpiZR, pg8::StaticOrder, true, true>(lds + RING_OFF, g, S, E); }
        if (P1_MASK & 4) { pg8::Gemm g{HB, (const bf16*)(ws + WS_BTIN) + (size_t)3072 * 2048, 2048, 2048, 2048}; pg8::StaticOrder S; S.init(SEQ, 6144, G, bx);
          pg8::EpiZA E{(bf16*)(ws + WS_V), (bf16*)(ws + WS_GS), (bf16*)(ws + WS_SGS), (bf16*)(ws + WS_SGR)};
          pg8::gemm_phase<pg8::EpiZA, pg8::StaticOrder, true, true>(lds + RING_OFF, g, S, E); }
        if (P1_MASK & 8) { pg8::Gemm g{(const bf16*)(ws + WS_PBF), (const bf16*)(ws + WS_BTPP), PLED, PLED, PLED}; pg8::StaticOrder S; S.init(SEQ, 2048, G, bx);
          pg8::EpiPlain E{(bf16*)(ws + WS_PP), 2048};
          pg8::gemm_phase<pg8::EpiPlain, pg8::StaticOrder, true, true>(lds + RING_OFF, g, S, E); }
    }
    SEAM(1);
    if (IN(2)) { LOAD_ARGS();
        { pg8::Gemm g{(const bf16*)(ws + WS_XG5), (const bf16*)(ws + WS_BTS1), K5, 512, 512}; pg8::OrderS1 S{G, bx}; pg8::EpiS1 E{(float*)(ws + WS_SLOC)};
          pg8::gemm_phase<pg8::EpiS1, pg8::OrderS1, false, true>(lds + RING_OFF, g, S, E); }
        __syncthreads();
        for (int u = bx; u < NRC * RH; u += G) ret_kv_unit(a, u, lds, tid);
    }
    SEAM(2);
    if (IN(3)) { LOAD_ARGS();
        for (int it = G - 1 - bx; it < 128; it += G) s5_scan_item(a, it, lds, tid);
        ret_state_scan(a, gtid, GT);
    }
    SEAM(3);
    if (IN(4)) { LOAD_ARGS();
        { pg8::Gemm g{(const bf16*)(ws + WS_XG5), (const bf16*)(ws + WS_BTS3), K5, K5, K5}; pg8::OrderS3 S{G, bx}; pg8::EpiS3 E{(bf16*)(ws + WS_YSP)};
          pg8::gemm_phase<pg8::EpiS3, pg8::OrderS3, false, true>(lds + RING_OFF, g, S, E); }
        __syncthreads();
        for (int u = bx; u < NRC * RH; u += G) ret_out_unit(a, u, lds, tid);
    }
    SEAM(4);
    if (IN(5)) { LOAD_ARGS();
        pg8::Gemm g{(const bf16*)(ws + WS_YSP), (const bf16*)(ws + WS_BTGLU), 1024, 1024, 1024}; pg8::StaticOrder S; S.init(SEQ, 1024, G, bx);
        pg8::EpiGLU E{(const bf16*)(ws + WS_YSP), a.b_glu, (bf16*)(ws + WS_YS)};
        pg8::gemm_phase<pg8::EpiGLU, pg8::StaticOrder, true, true>(lds + RING_OFF, g, S, E);
    }
    SEAM(5);
    if (IN(6)) { LOAD_ARGS();
        { pg8::Gemm g{(const bf16*)(ws + WS_YS), (const bf16*)(ws + WS_BTPS), 1024, 1024, 1024}; pg8::StaticOrder S; S.init(SEQ, 2048, G, bx);
          pg8::EpiM1 E{(const bf16*)(ws + WS_SGS), (float*)(ws + WS_TMP)};
          pg8::gemm_phase<pg8::EpiM1, pg8::StaticOrder, true, true>(lds + RING_OFF, g, S, E); }
        VM_WAIT(); __syncthreads();
        { pg8::Gemm g{(const bf16*)(ws + WS_YR), (const bf16*)(ws + WS_BTPR), 1024, 1024, 1024}; pg8::StaticOrder S; S.init(SEQ, 2048, G, bx);
          pg8::EpiM2 E{(const bf16*)(ws + WS_SGR), (const float*)(ws + WS_TMP), (bf16*)(ws + WS_MRG)};
          pg8::gemm_phase<pg8::EpiM2, pg8::StaticOrder, true, true>(lds + RING_OFF, g, S, E); }
    }
    SEAM(6);
    if (IN(7)) { LOAD_ARGS();
        pg8::Gemm g{(const bf16*)(ws + WS_MRG), (const bf16*)(ws + WS_BTOUT), 2048, 2048, 2048}; pg8::StaticOrder S; S.init(SEQ, 2048, G, bx);
        pg8::EpiRes E{a.x, (float*)(ws + WS_X2)};
        pg8::gemm_phase<pg8::EpiRes, pg8::StaticOrder, true, true>(lds + RING_OFF, g, S, E);
    }
    SEAM(7);
    if (IN(8)) { LOAD_ARGS(); for (int it = bx; it < SEQ / 64; it += G) router_item(a, it, lds, tid); }
    SEAM(8);
    if (IN(9)) { LOAD_ARGS();
        LAS int* ps = (LAS int*)lds;
        if (tid == 0) { int accp = 0; for (int e = 0; e < NEXP; ++e) { const int c = (int)__hip_atomic_load((unsigned*)(ws + WS_CTL) + CW_CNT + e, RLX_AGENT); ps[e] = accp; accp += (c + 255) / 256 * 256; } ps[NEXP] = accp; }
        __syncthreads();
        int* blke = (int*)(ws + WS_BLKE);
        if (bx == 0 && tid < NEXP) { for (int rt = ps[tid] >> 8; rt < (ps[tid + 1] >> 8); ++rt) blke[rt] = tid; }
        if (bx == 0 && tid == 0) blke[511] = ps[NEXP] >> 8;
        const int* toke = (const int*)(ws + WS_TOKE); const int* tokp = (const int*)(ws + WS_TOKP); const float* tokg = (const float*)(ws + WS_TOKG);
        float* rowg = (float*)(ws + WS_ROWG); int* arow = (int*)(ws + WS_AROW);
        for (int as = gw; as < SEQ * 4; as += NGW) { const int tok = as >> 2, row = ps[toke[as]] + tokp[as];
            const v4u* s = (const v4u*)(HB + (size_t)tok * 2048) + lane; v4u* d = (v4u*)((bf16*)(ws + WS_XG) + (size_t)row * 2048) + lane;
            const v4u v0 = s[0], v1 = s[64], v2 = s[128], v3 = s[192]; d[0] = v0; d[64] = v1; d[128] = v2; d[192] = v3;
            if (lane == 0) { rowg[row] = tokg[as]; arow[as] = row; } }
        __syncthreads();
    }
    SEAM(9);
    if (IN(10)) { LOAD_ARGS();
        const int* blke = (const int*)(ws + WS_BLKE); const int nrt = blke[511];
        pg8::Gemm g{(const bf16*)(ws + WS_XG), (const bf16*)(ws + WS_BTGU), 2048, 2048, 2048}; pg8::OrderMoe S; S.so.init(nrt * 256, 4096, G, bx); S.blk_e = blke; S.ntn = 16;
        pg8::EpiGU E{a.b_gu, (bf16*)(ws + WS_ACT)};
        pg8::gemm_phase<pg8::EpiGU, pg8::OrderMoe, true, true>(lds + RING_OFF, g, S, E);
    }
    SEAM(10);
    if (IN(11)) { LOAD_ARGS();
        const int* blke = (const int*)(ws + WS_BLKE); const int nrt = blke[511];
        pg8::Gemm g{(const bf16*)(ws + WS_ACT), (const bf16*)(ws + WS_BTDN), 2048, 2048, 2048}; pg8::OrderMoe S; S.so.init(nrt * 256, 2048, G, bx); S.blk_e = blke; S.ntn = 8;
        pg8::EpiDN E{a.b_dn, (const float*)(ws + WS_ROWG), (bf16*)(ws + WS_YB)};
        pg8::gemm_phase<pg8::EpiDN, pg8::OrderMoe, true, true>(lds + RING_OFF, g, S, E);
    }
    SEAM(11);
    if (IN(12)) { LOAD_ARGS();
        const int* arow = (const int*)(ws + WS_AROW); const bf16* yb = (const bf16*)(ws + WS_YB);
        for (int t = gw; t < SEQ; t += NGW) { f32x4* xr = (f32x4*)((float*)(ws + WS_X2) + (size_t)t * 2048) + lane;
            const int r0 = arow[t * 4], r1 = arow[t * 4 + 1], r2 = arow[t * 4 + 2], r3 = arow[t * 4 + 3];
            const v2u* y0 = (const v2u*)(yb + (size_t)r0 * 2048) + lane; const v2u* y1 = (const v2u*)(yb + (size_t)r1 * 2048) + lane;
            const v2u* y2 = (const v2u*)(yb + (size_t)r2 * 2048) + lane; const v2u* y3 = (const v2u*)(yb + (size_t)r3 * 2048) + lane;
            f32x4 v[8]; float s = 0.f;
#pragma unroll
            for (int j = 0; j < 8; ++j) { f32x4 x = xr[64 * j]; const v2u w0 = y0[64 * j], w1 = y1[64 * j], w2 = y2[64 * j], w3 = y3[64 * j];
                x.x += (pg8::bf_lo(w0.x) + pg8::bf_lo(w1.x)) + (pg8::bf_lo(w2.x) + pg8::bf_lo(w3.x)); x.y += (pg8::bf_hi(w0.x) + pg8::bf_hi(w1.x)) + (pg8::bf_hi(w2.x) + pg8::bf_hi(w3.x));
                x.z += (pg8::bf_lo(w0.y) + pg8::bf_lo(w1.y)) + (pg8::bf_lo(w2.y) + pg8::bf_lo(w3.y)); x.w += (pg8::bf_hi(w0.y) + pg8::bf_hi(w1.y)) + (pg8::bf_hi(w2.y) + pg8::bf_hi(w3.y));
                v[j] = x; xr[64 * j] = x; s += (x.x * x.x + x.y * x.y) + (x.z * x.z + x.w * x.w); }
            const float rstd = 1.0f / sqrtf(wave_sum(s) * (1.0f / 2048.0f) + 1e-6f);
            const f32x4* gr = (const f32x4*)a.norm3_g + lane; v2u* o8 = (v2u*)(HB + (size_t)t * 2048) + lane;
#pragma unroll
            for (int j = 0; j < 8; ++j) { const f32x4 g = gr[64 * j]; v2u o; o.x = pk2(v[j].x * rstd * g.x, v[j].y * rstd * g.y); o.y = pk2(v[j].z * rstd * g.z, v[j].w * rstd * g.w); o8[64 * j] = o; } }
    }
    SEAM(12);
    if (IN(13)) { LOAD_ARGS();
        pg8::Gemm g{HB, (const bf16*)(ws + WS_BTPG), 2048, 2048, 2048}; pg8::StaticOrder S; S.init(SEQ, 2048, G, bx);
        pg8::EpiPLE E{(const float*)(ws + WS_X2), (const bf16*)(ws + WS_PP), a.out};
        pg8::gemm_phase<pg8::EpiPLE, pg8::StaticOrder, true, true>(lds + RING_OFF, g, S, E);
    }
    SEAM(13);
    if (IN(14)) { LOAD_ARGS();
        for (int t = gw; t < SEQ; t += NGW) { f32x4* xr = (f32x4*)(a.out + (size_t)t * 2048) + lane; const f32x4* gr = (const f32x4*)a.fin_g + lane;
            f32x4 v[8]; float s = 0.f;
#pragma unroll
            for (int j = 0; j < 8; ++j) { v[j] = xr[64 * j]; s += (v[j].x * v[j].x + v[j].y * v[j].y) + (v[j].z * v[j].z + v[j].w * v[j].w); }
            const float rstd = 1.0f / sqrtf(wave_sum(s) * (1.0f / 2048.0f) + 1e-6f);
#pragma unroll
            for (int j = 0; j < 8; ++j) xr[64 * j] = v[j] * rstd * gr[64 * j]; }
    }
#undef IN
#undef SEAM
}

extern "C" void kernel_launch(void* const* d_in, const int* in_sizes, int n_in, void* d_out, int out_size, void* d_ws, size_t ws_size, hipStream_t stream) {
    static int grid = 0;
    if (grid == 0) {
        if (n_in != 29 || in_sizes[0] != SEQ * DM || out_size != SEQ * DM || ws_size < WS_END) { fprintf(stderr, "kernel_launch: unexpected shapes (n_in %d, ws %zu < %zu?)\n", n_in, ws_size, (size_t)WS_END); grid = -1; return; }
        int dev = 0, cus = 0, per_cu = 0;
        if (hipGetDevice(&dev) != hipSuccess || hipDeviceGetAttribute(&cus, hipDeviceAttributeMultiprocessorCount, dev) != hipSuccess) { grid = -1; return; }
        if (hipFuncSetAttribute((const void*)mk_fwd, hipFuncAttributeMaxDynamicSharedMemorySize, LDS_BYTES) != hipSuccess) { fprintf(stderr, "kernel_launch: hipFuncSetAttribute failed\n"); grid = -1; return; }
        if (hipOccupancyMaxActiveBlocksPerMultiprocessor(&per_cu, (const void*)mk_fwd, NWAVES * 64, LDS_BYTES) != hipSuccess || per_cu < 1) { fprintf(stderr, "kernel_launch: occupancy query says %d\n", per_cu); }
        (void)hipGetLastError();
        grid = cus;
    }
    if (grid < 0) return;
    if (hipMemsetAsync((char*)d_ws + WS_CTL, 0, CTL_ZERO_BYTES, stream) != hipSuccess) return;
    Args a{};
    a.x = (const float*)d_in[0]; a.p = (const float*)d_in[1]; a.pos = (const int*)d_in[2]; a.norm1_g = (const float*)d_in[3]; a.w_in = (const float*)d_in[4];
    a.lam_re = (const float*)d_in[5]; a.lam_im = (const float*)d_in[6]; a.log_dt = (const float*)d_in[7]; a.b_re = (const float*)d_in[8]; a.b_im = (const float*)d_in[9];
    a.c_re = (const float*)d_in[10]; a.c_im = (const float*)d_in[11]; a.d_skip = (const float*)d_in[12]; a.w_glu = (const float*)d_in[13]; a.b_glu = (const float*)d_in[14];
    a.w_bs = (const float*)d_in[15]; a.w_br = (const float*)d_in[16]; a.w_out = (const float*)d_in[17]; a.norm2_g = (const float*)d_in[18]; a.router_w = (const float*)d_in[19];
    a.router_b = (const float*)d_in[20]; a.w_gu = (const float*)d_in[21]; a.b_gu = (const float*)d_in[22]; a.w_dn = (const float*)d_in[23]; a.b_dn = (const float*)d_in[24];
    a.norm3_g = (const float*)d_in[25]; a.w_pg = (const float*)d_in[26]; a.w_pp = (const float*)d_in[27]; a.fin_g = (const float*)d_in[28];
    a.out = (float*)d_out; a.ws = (unsigned char*)d_ws;
#if MK_N_LAUNCHES == 1
    a.ph_lo = 0; a.ph_hi = N_PHASES;
    hipLaunchKernelGGL(mk_fwd, dim3(grid), dim3(NWAVES * 64), LDS_BYTES, stream, a);
#else
    for (int ph = 0; ph < N_PHASES; ++ph) { a.ph_lo = ph; a.ph_hi = ph + 1; hipLaunchKernelGGL(mk_fwd, dim3(grid), dim3(NWAVES * 64), LDS_BYTES, stream, a); }
#endif
    const hipError_t le = hipPeekAtLastError();
    if (le != hipSuccess) fprintf(stderr, "kernel_launch: launch failed: %s\n", hipGetErrorName(le));
}
```

```cpp
#include <hip/hip_runtime.h>
#include <cstdio>
#include <cstdint>

#ifndef MK_N_LAUNCHES
#define MK_N_LAUNCHES 1
#endif

constexpr int SEQ = 16384, DM = 2048, INC = 9216, NEXP = 32, FFN = 2048, PLED = 256;
constexpr int NG5 = 64, T5 = 32, NCH5 = SEQ / T5, K5 = 640;
constexpr int RCH = 128, NRC = SEQ / RCH, RH = 8;
constexpr int MAXROWS = SEQ * 4 + NEXP * 256;

namespace pg8 {
#define PG8_LAS __attribute__((address_space(3)))
typedef unsigned short bf16_t;
typedef short bf16x8 __attribute__((ext_vector_type(8)));
typedef float f32x4 __attribute__((ext_vector_type(4)));
typedef unsigned u32x4 __attribute__((ext_vector_type(4)));
typedef unsigned u32x2 __attribute__((ext_vector_type(2)));
constexpr int BM = 256, BK = 64, HALF = 128, HTB = HALF * BK * 2, STAGE_BYTES = 8 * HTB, NXCD = 8, WGM = 8;

__host__ __device__ __forceinline__ int lds_byte(int r, int c) { const int st = (r >> 4) * 2 + (c >> 5), rr = r & 15, cc = c & 31, ob = rr * 64 + cc * 2; return st * 1024 + (ob ^ (((ob >> 9) & 1) << 5)); }
__host__ __device__ __forceinline__ void stage_rc(int b, int& R, int& C) { const int st = b / 1024, sb = b % 1024, swz = sb ^ (((sb >> 9) & 1) << 5); R = (st >> 1) * 16 + swz / 64; C = (st & 1) * 32 + (swz % 64) / 2; }
__host__ __device__ __forceinline__ int perm32(int rho) { const int n = rho >> 4, i = rho & 15; return 8 * (i >> 2) + 4 * n + (i & 3); }

struct Unit { int pm, pn; };
struct Gemm { const bf16_t* A; const bf16_t* Bt; int lda, ldb, K; };

struct StaticOrder {
    int nM, nN, nwg, G, c;
    __host__ __device__ void init(int M, int N, int G_, int c_) { nM = M / BM; nN = N / BM; nwg = nM * nN; G = G_; c = c_; }
    __host__ __device__ bool next(int i, Unit& u) const {
        const long L = (long)i * G + c; if (L >= nwg) return false;
        int wgid = (int)L; { const int q = nwg / NXCD, r = nwg % NXCD, xcd = wgid % NXCD, off = wgid / NXCD; wgid = (xcd < r ? xcd * (q + 1) : r * (q + 1) + (xcd - r) * q) + off; }
        const int nig = WGM * nN, gid = wgid / nig, fm = gid * WGM, gsz = (nM - fm) < WGM ? (nM - fm) : WGM;
        u.pm = fm + ((wgid % nig) % gsz); u.pn = (wgid % nig) / gsz; return true;
    }
    __device__ __forceinline__ void a_ready(const Unit&) const {}
    __device__ __forceinline__ void done(const Unit&) const {}
};
struct OrderS3 {
    int G, c;
    __device__ bool next(int i, Unit& u) const { const int L = i * G + c; if (L >= 256) return false; const int g = L >> 2; u.pm = 2 * g + ((L >> 1) & 1); u.pn = 2 * g + (L & 1); return true; }
    __device__ __forceinline__ void a_ready(const Unit&) const {}
    __device__ __forceinline__ void done(const Unit&) const {}
};
struct OrderS1 {
    int G, c;
    __device__ bool next(int i, Unit& u) const { const int L = i * G + c; if (L >= 128) return false; u.pm = L; u.pn = L >> 1; return true; }
    __device__ __forceinline__ void a_ready(const Unit&) const {}
    __device__ __forceinline__ void done(const Unit&) const {}
};
struct OrderMoe {
    StaticOrder so; const int* blk_e; int ntn;
    __device__ bool next(int i, Unit& u) const { if (!so.next(i, u)) return false; u.pn = blk_e[u.pm] * ntn + u.pn; return true; }
    __device__ __forceinline__ void a_ready(const Unit&) const {}
    __device__ __forceinline__ void done(const Unit&) const {}
};

__device__ __forceinline__ unsigned cvt_pk_bf16(float lo, float hi) { unsigned r; asm volatile("v_cvt_pk_bf16_f32 %0, %1, %2" : "=v"(r) : "v"(lo), "v"(hi)); return r; }
__device__ __forceinline__ u32x4 pack8(const f32x4& a, const f32x4& b) { u32x4 w; w.x = cvt_pk_bf16(a[0], a[1]); w.y = cvt_pk_bf16(a[2], a[3]); w.z = cvt_pk_bf16(b[0], b[1]); w.w = cvt_pk_bf16(b[2], b[3]); return w; }
__device__ __forceinline__ float bf_lo(unsigned w) { return __builtin_bit_cast(float, w << 16); }
__device__ __forceinline__ float bf_hi(unsigned w) { return __builtin_bit_cast(float, w & 0xffff0000u); }
__device__ __forceinline__ void unpack8(const u32x4& w, f32x4& a, f32x4& b) { a = (f32x4){bf_lo(w.x), bf_hi(w.x), bf_lo(w.y), bf_hi(w.y)}; b = (f32x4){bf_lo(w.z), bf_hi(w.z), bf_lo(w.w), bf_hi(w.w)}; }
__device__ __forceinline__ float sigm(float x) { return __builtin_amdgcn_rcpf(1.0f + __builtin_amdgcn_exp2f(-1.4426950408889634f * x)); }
__device__ __forceinline__ f32x4 sigm4(const f32x4& x) { return (f32x4){sigm(x[0]), sigm(x[1]), sigm(x[2]), sigm(x[3])}; }
__device__ __forceinline__ float gelu_t(float x) { return x * sigm(1.5957691216057308f * (x + 0.044715f * x * x * x)); }
__device__ __forceinline__ f32x4 gelu4(const f32x4& x) { return (f32x4){gelu_t(x[0]), gelu_t(x[1]), gelu_t(x[2]), gelu_t(x[3])}; }

#define EPI_LOOP_AM _Pragma("unroll") for (int ai = 0; ai < 2; ++ai) _Pragma("unroll") for (int m = 0; m < 4; ++m)
#define EPI_LOOP_BJ _Pragma("unroll") for (int bj = 0; bj < 2; ++bj)
typedef f32x4 AccT[2][2][4][2];
#ifndef EPIZ_MASK
#define EPIZ_MASK 31
#endif
#define EPIZ_EN(k) ((EPIZ_MASK >> (k)) & 1)

struct EpiZU {
    static constexpr bool PERM = true, AFTER_DRAIN = false;
    bf16_t* xg5;
    __device__ __forceinline__ void operator()(const AccT& acc, const Unit& u, int wr, int wc, int fr, int fq) const {
        const int row0 = u.pm * BM + wr * 64 + fr, tc = wc * 32 + 8 * fq, pn = u.pn;
        EPI_LOOP_AM { const int t = row0 + ai * HALF + m * 16, j = t >> 5, i = t & 31;
            EPI_LOOP_BJ { const int col = pn * BM + bj * HALF + tc, g = col >> 4, c0 = col & 15;
                *(u32x4*)(xg5 + ((size_t)(g * NCH5 + j) * K5 + i * 16 + c0)) = pack8(acc[ai][bj][m][0], acc[ai][bj][m][1]); } }
    }
};
struct EpiZR {
    static constexpr bool PERM = true, AFTER_DRAIN = false;
    bf16_t *q, *k; const float *cs, *sn;
    __device__ __forceinline__ void operator()(const AccT& acc, const Unit& u, int wr, int wc, int fr, int fq) const {
        const int row0 = u.pm * BM + wr * 64 + fr, pn = u.pn;
        const bool isk = pn >= 4; bf16_t* dst = isk ? k : q; const float sc = isk ? 0.08838834764831845f : 1.0f;
        const int head = 2 * (pn & 3) + (wc >> 1), dd = 32 * (wc & 1) + 8 * fq;
        EPI_LOOP_AM { const int t = row0 + ai * HALF + m * 16;
            const float* cp = cs + (size_t)t * 64 + dd; const float* sp = sn + (size_t)t * 64 + dd;
            const f32x4 c0 = *(const f32x4*)cp * sc, c1 = *(const f32x4*)(cp + 4) * sc, s0 = *(const f32x4*)sp * sc, s1 = *(const f32x4*)(sp + 4) * sc;
            const f32x4 x1a = acc[ai][0][m][0], x1b = acc[ai][0][m][1], x2a = acc[ai][1][m][0], x2b = acc[ai][1][m][1];
            bf16_t* o = dst + (size_t)t * 1024 + head * 128 + dd;
            *(u32x4*)o = pack8(x1a * c0 - x2a * s0, x1b * c1 - x2b * s1);
            *(u32x4*)(o + 64) = pack8(x1a * s0 + x2a * c0, x1b * s1 + x2b * c1); asm volatile("" ::: "memory"); }
    }
};
struct EpiZA {
    static constexpr bool PERM = true, AFTER_DRAIN = false;
    bf16_t *v, *gs, *sgs, *sgr;
    __device__ __forceinline__ void operator()(const AccT& acc, const Unit& u, int wr, int wc, int fr, int fq) const {
        const int row0 = u.pm * BM + wr * 64 + fr, tc = wc * 32 + 8 * fq, pn = u.pn;
        bf16_t* dst = pn < 4 ? v : (pn < 8 ? gs : (pn < 16 ? sgs : sgr));
        const int ldc = pn < 8 ? 1024 : 2048, cb = (pn < 8 ? (pn & 3) : (pn & 7)) * BM + tc;
        const float ka = pn < 4 ? 0.0f : 1.0f, kb = (pn >= 4 && pn < 8) ? 1.0f : 0.0f;
        EPI_LOOP_AM { const size_t off = (size_t)(row0 + ai * HALF + m * 16) * ldc + cb;
            EPI_LOOP_BJ { f32x4 r[2];
#pragma unroll
                for (int n = 0; n < 2; ++n) { const f32x4 x = acc[ai][bj][m][n], sg = sigm4(x); r[n] = x * (1.0f - ka) + sg * (ka - kb) + (x * sg) * kb; }
                *(u32x4*)(dst + off + bj * HALF) = pack8(r[0], r[1]); } }
    }
};
struct EpiS1 {
    static constexpr bool PERM = true, AFTER_DRAIN = false;
    float* sloc;
    __device__ __forceinline__ void operator()(const AccT& acc, const Unit& u, int wr, int wc, int fr, int fq) const {
        const int row0 = u.pm * BM + wr * 64 + fr, tc = wc * 32 + 8 * fq;
        EPI_LOOP_AM { float* o = sloc + (size_t)(row0 + ai * HALF + m * 16) * 128 + tc; *(f32x4*)o = acc[ai][0][m][0]; *(f32x4*)(o + 4) = acc[ai][0][m][1]; }
    }
};
struct EpiS3 {
    static constexpr bool PERM = true, AFTER_DRAIN = false;
    bf16_t* ysp;
    __device__ __forceinline__ void operator()(const AccT& acc, const Unit& u, int wr, int wc, int fr, int fq) const {
        const int g = u.pm >> 1, j0 = (u.pm & 1) * BM + wr * 64 + fr, cl0 = (u.pn & 1) * BM + wc * 32 + 8 * fq;
        EPI_LOOP_AM { const int j = j0 + ai * HALF + m * 16;
            EPI_LOOP_BJ { const int cl = cl0 + bj * HALF, i = cl >> 4, c0 = cl & 15;
                *(u32x4*)(ysp + (size_t)(j * T5 + i) * 1024 + g * 16 + c0) = pack8(gelu4(acc[ai][bj][m][0]), gelu4(acc[ai][bj][m][1])); } }
    }
};
struct EpiGLU {
    static constexpr bool PERM = true, AFTER_DRAIN = false;
    const bf16_t* ysp; const float* bias; bf16_t* ys;
    __device__ __forceinline__ void operator()(const AccT& acc, const Unit& u, int wr, int wc, int fr, int fq) const {
        const int row0 = u.pm * BM + wr * 64 + fr, col0 = u.pn * BM + wc * 32 + 8 * fq;
        f32x4 bv[2][2];
        EPI_LOOP_BJ { bv[bj][0] = *(const f32x4*)(bias + col0 + bj * HALF); bv[bj][1] = *(const f32x4*)(bias + col0 + bj * HALF + 4); }
        EPI_LOOP_AM { const size_t off = (size_t)(row0 + ai * HALF + m * 16) * 1024 + col0;
            EPI_LOOP_BJ { f32x4 ya, yb; unpack8(*(const u32x4*)(ysp + off + bj * HALF), ya, yb);
                *(u32x4*)(ys + off + bj * HALF) = pack8(ya * sigm4(acc[ai][bj][m][0] + bv[bj][0]), yb * sigm4(acc[ai][bj][m][1] + bv[bj][1])); } }
    }
};
struct EpiM1 {
    static constexpr bool PERM = true, AFTER_DRAIN = false;
    const bf16_t* sg; float* tmp;
    __device__ __forceinline__ void operator()(const AccT& acc, const Unit& u, int wr, int wc, int fr, int fq) const {
        const int row0 = u.pm * BM + wr * 64 + fr, col0 = u.pn * BM + wc * 32 + 8 * fq;
        EPI_LOOP_AM { const size_t off = (size_t)(row0 + ai * HALF + m * 16) * 2048 + col0;
            EPI_LOOP_BJ { f32x4 ga, gb; unpack8(*(const u32x4*)(sg + off + bj * HALF), ga, gb);
                *(f32x4*)(tmp + off + bj * HALF) = ga * acc[ai][bj][m][0]; *(f32x4*)(tmp + off + bj * HALF + 4) = gb * acc[ai][bj][m][1]; } }
    }
};
struct EpiM2 {
    static constexpr bool PERM = true, AFTER_DRAIN = false;
    const bf16_t* sg; const float* tmp; bf16_t* mrg;
    __device__ __forceinline__ void operator()(const AccT& acc, const Unit& u, int wr, int wc, int fr, int fq) const {
        const int row0 = u.pm * BM + wr * 64 + fr, col0 = u.pn * BM + wc * 32 + 8 * fq;
        EPI_LOOP_AM { const size_t off = (size_t)(row0 + ai * HALF + m * 16) * 2048 + col0;
            EPI_LOOP_BJ { f32x4 ga, gb; unpack8(*(const u32x4*)(sg + off + bj * HALF), ga, gb);
                const f32x4 ta = *(const f32x4*)(tmp + off + bj * HALF), tb = *(const f32x4*)(tmp + off + bj * HALF + 4);
                *(u32x4*)(mrg + off + bj * HALF) = pack8(ta + ga * acc[ai][bj][m][0], tb + gb * acc[ai][bj][m][1]); } }
    }
};
struct EpiRes {
    static constexpr bool PERM = true, AFTER_DRAIN = false;
    const float* x; float* o;
    __device__ __forceinline__ void operator()(const AccT& acc, const Unit& u, int wr, int wc, int fr, int fq) const {
        const int row0 = u.pm * BM + wr * 64 + fr, col0 = u.pn * BM + wc * 32 + 8 * fq;
        EPI_LOOP_AM { const size_t off = (size_t)(row0 + ai * HALF + m * 16) * 2048 + col0;
            EPI_LOOP_BJ { *(f32x4*)(o + off + bj * HALF) = *(const f32x4*)(x + off + bj * HALF) + acc[ai][bj][m][0];
                *(f32x4*)(o + off + bj * HALF + 4) = *(const f32x4*)(x + off + bj * HALF + 4) + acc[ai][bj][m][1]; } }
    }
};
struct EpiPlain {
    static constexpr bool PERM = true, AFTER_DRAIN = false;
    bf16_t* o; int ldc;
    __device__ __forceinline__ void operator()(const AccT& acc, const Unit& u, int wr, int wc, int fr, int fq) const {
        const int row0 = u.pm * BM + wr * 64 + fr, col0 = u.pn * BM + wc * 32 + 8 * fq;
        EPI_LOOP_AM { const size_t off = (size_t)(row0 + ai * HALF + m * 16) * ldc + col0;
            EPI_LOOP_BJ { *(u32x4*)(o + off + bj * HALF) = pack8(acc[ai][bj][m][0], acc[ai][bj][m][1]); } }
    }
};
struct EpiGU {
    static constexpr bool PERM = true, AFTER_DRAIN = false;
    const float* bgu; bf16_t* act;
    __device__ __forceinline__ void operator()(const AccT& acc, const Unit& u, int wr, int wc, int fr, int fq) const {
        const int e = u.pn >> 4, ct = u.pn & 15, row0 = u.pm * BM + wr * 64 + fr, f0 = ct * HALF + wc * 32 + 8 * fq;
        const float* bp = bgu + (size_t)e * 4096 + 2 * f0;
        const f32x4 b0 = *(const f32x4*)bp, b1 = *(const f32x4*)(bp + 4), b2 = *(const f32x4*)(bp + 8), b3 = *(const f32x4*)(bp + 12);
        const f32x4 bg0 = (f32x4){b0[0], b0[2], b1[0], b1[2]}, bu0 = (f32x4){b0[1], b0[3], b1[1], b1[3]}, bg1 = (f32x4){b2[0], b2[2], b3[0], b3[2]}, bu1 = (f32x4){b2[1], b2[3], b3[1], b3[3]};
        EPI_LOOP_AM { const size_t off = (size_t)(row0 + ai * HALF + m * 16) * FFN + f0;
            f32x4 r[2];
#pragma unroll
            for (int n = 0; n < 2; ++n) { const f32x4 gv = acc[ai][0][m][n] + (n ? bg1 : bg0), uv = acc[ai][1][m][n] + (n ? bu1 : bu0);
#pragma unroll
                for (int x = 0; x < 4; ++x) { const float gg = fminf(gv[x], 7.0f), uu = fminf(fmaxf(uv[x], -7.0f), 7.0f); r[n][x] = gg * sigm(1.702f * gg) * (uu + 1.0f); } }
            *(u32x4*)(act + off) = pack8(r[0], r[1]); }
    }
};
struct EpiDN {
    static constexpr bool PERM = true, AFTER_DRAIN = false;
    const float* bdn; const float* rowg; bf16_t* yb;
    __device__ __forceinline__ void operator()(const AccT& acc, const Unit& u, int wr, int wc, int fr, int fq) const {
        const int e = u.pn >> 3, ct = u.pn & 7, row0 = u.pm * BM + wr * 64 + fr, col0 = ct * BM + wc * 32 + 8 * fq;
        f32x4 bv[2][2];
        EPI_LOOP_BJ { bv[bj][0] = *(const f32x4*)(bdn + (size_t)e * 2048 + col0 + bj * HALF); bv[bj][1] = *(const f32x4*)(bdn + (size_t)e * 2048 + col0 + bj * HALF + 4); }
        EPI_LOOP_AM { const int row = row0 + ai * HALF + m * 16; const float gt = rowg[row]; const size_t off = (size_t)row * 2048 + col0;
            EPI_LOOP_BJ { *(u32x4*)(yb + off + bj * HALF) = pack8((acc[ai][bj][m][0] + bv[bj][0]) * gt, (acc[ai][bj][m][1] + bv[bj][1]) * gt); } }
    }
};
struct EpiPLE {
    static constexpr bool PERM = true, AFTER_DRAIN = false;
    const float* x3; const bf16_t* pp; float* o;
    __device__ __forceinline__ void operator()(const AccT& acc, const Unit& u, int wr, int wc, int fr, int fq) const {
        const int row0 = u.pm * BM + wr * 64 + fr, col0 = u.pn * BM + wc * 32 + 8 * fq;
        EPI_LOOP_AM { const size_t off = (size_t)(row0 + ai * HALF + m * 16) * 2048 + col0;
            EPI_LOOP_BJ { f32x4 pa, pb; unpack8(*(const u32x4*)(pp + off + bj * HALF), pa, pb);
                *(f32x4*)(o + off + bj * HALF) = *(const f32x4*)(x3 + off + bj * HALF) + sigm4(acc[ai][bj][m][0]) * pa;
                *(f32x4*)(o + off + bj * HALF + 4) = *(const f32x4*)(x3 + off + bj * HALF + 4) + sigm4(acc[ai][bj][m][1]) * pb; } }
    }
};

template <class Epi, class Sched, bool ALIGN_EPI = false, bool SP2 = false>
__device__ __forceinline__ void gemm_phase(PG8_LAS unsigned char* lds, const Gemm g, const Sched& S, const Epi& E) {
    const int tid = threadIdx.x, wid = __builtin_amdgcn_readfirstlane(tid >> 6), lane = tid & 63, wr = wid >> 2, wc = wid & 3, fr = lane & 15, fq = lane >> 4;
    const int K = g.K, nt = K / BK;
    unsigned voffA[2], voffB[2];
#pragma unroll
    for (int i = 0; i < 2; ++i) { int R, C; stage_rc(tid * 16 + i * 8192, R, C); const int Rb = Epi::PERM ? ((R & ~31) + perm32(R & 31)) : R;
        voffA[i] = (unsigned)(R * g.lda + C) * 2u; voffB[i] = (unsigned)(Rb * g.ldb + C) * 2u; }
    const size_t kstep = (size_t)(BK * 2);
    const size_t hstepA = (size_t)HALF * g.lda * 2, hstepB = (size_t)HALF * g.ldb * 2;
    const size_t tstepA = 2 * hstepA, tstepB = 2 * hstepB;
    const unsigned ldsw = (unsigned)wid * 1024u;
    const int aoff = lds_byte(wr * 64 + fr, fq * 8), boff = lds_byte(wc * 32 + fr, fq * 8);
#define PG8_SA(b, h) (((b) * 2 + (h)) * HTB)
#define PG8_SB(b, h) ((4 + (b) * 2 + (h)) * HTB)
#define PG8_STAGE(bufoff, gbase, voff) do { _Pragma("unroll") for (int _i = 0; _i < 2; ++_i) \
        __builtin_amdgcn_global_load_lds((const unsigned*)((const char*)(gbase) + (voff)[_i]), (PG8_LAS unsigned*)(lds + (bufoff) + ldsw + _i * 8192), 16, 0, 0); } while (0)
#define PG8_LDA(dst, b, h) do { _Pragma("unroll") for (int m = 0; m < 4; ++m) _Pragma("unroll") for (int k = 0; k < 2; ++k) dst[m][k] = *(const PG8_LAS bf16x8*)(lds + PG8_SA(b, h) + aoff + m * 2048 + k * 1024); } while (0)
#define PG8_LDB(dst, b, h) do { _Pragma("unroll") for (int n = 0; n < 2; ++n) _Pragma("unroll") for (int k = 0; k < 2; ++k) dst[n][k] = *(const PG8_LAS bf16x8*)(lds + PG8_SB(b, h) + boff + n * 2048 + k * 1024); } while (0)
#define PG8_MMA(ai, bj, At, Bt) do { __builtin_amdgcn_s_setprio(1); _Pragma("unroll") for (int m = 0; m < 4; ++m) _Pragma("unroll") for (int n = 0; n < 2; ++n) _Pragma("unroll") for (int k = 0; k < 2; ++k) \
        acc[ai][bj][m][n] = __builtin_amdgcn_mfma_f32_16x16x32_bf16(Bt[n][k], At[m][k], acc[ai][bj][m][n], 0, 0, 0); __builtin_amdgcn_s_setprio(0); } while (0)
#define PG8_WAIT_V(n) asm volatile("s_waitcnt vmcnt(" #n ")" ::: "memory")
#define PG8_WAIT_L(n) asm volatile("s_waitcnt lgkmcnt(" #n ")" ::: "memory")
#define PG8_BAR __builtin_amdgcn_s_barrier()
#define PG8_SCHED __builtin_amdgcn_sched_barrier(0)
    Unit cur, nxt; int ui = 0;
    if (!S.next(0, cur)) return;
    f32x4 acc[2][2][4][2];
#pragma unroll
    for (int a = 0; a < 2; ++a)
#pragma unroll
        for (int b = 0; b < 2; ++b)
#pragma unroll
            for (int m = 0; m < 4; ++m)
#pragma unroll
                for (int n = 0; n < 2; ++n) acc[a][b][m][n] = (f32x4){0.f, 0.f, 0.f, 0.f};
    bf16x8 At[4][2], B0[2][2], B1[2][2];
    const char* cA = (const char*)g.A + (size_t)cur.pm * tstepA; const char* cB = (const char*)g.Bt + (size_t)cur.pn * tstepB;
    S.a_ready(cur);
    if constexpr (SP2) {
        PG8_STAGE(PG8_SB(0, 0), cB, voffB); PG8_STAGE(PG8_SB(0, 1), cB + hstepB, voffB); PG8_STAGE(PG8_SA(0, 0), cA, voffA); PG8_STAGE(PG8_SA(0, 1), cA + hstepA, voffA);
        if (wr == 1) PG8_BAR;
        PG8_WAIT_V(2); PG8_BAR;
        PG8_STAGE(PG8_SB(1, 0), cB + kstep, voffB); PG8_STAGE(PG8_SA(1, 0), cA + kstep, voffA); PG8_STAGE(PG8_SB(1, 1), cB + hstepB + kstep, voffB);
        PG8_WAIT_V(6); PG8_BAR;
    } else {
        PG8_STAGE(PG8_SB(0, 0), cB, voffB); PG8_STAGE(PG8_SA(0, 0), cA, voffA); PG8_STAGE(PG8_SB(0, 1), cB + hstepB, voffB); PG8_STAGE(PG8_SA(0, 1), cA + hstepA, voffA);
        if (wr == 1) PG8_BAR;
        PG8_WAIT_V(4); PG8_BAR;
        PG8_STAGE(PG8_SB(1, 0), cB + kstep, voffB); PG8_STAGE(PG8_SA(1, 0), cA + kstep, voffA); PG8_STAGE(PG8_SB(1, 1), cB + hstepB + kstep, voffB);
        PG8_WAIT_V(6); PG8_BAR;
    }
    for (;;) {
        const bool has_next = S.next(ui + 1, nxt);
        const char* nA = has_next ? (const char*)g.A + (size_t)nxt.pm * tstepA : cA; const char* nB = has_next ? (const char*)g.Bt + (size_t)nxt.pn * tstepB : cB;
#pragma nounroll
        for (int t = 0; t < nt; t += 2) {
            const bool last = (t == nt - 2);
            const char* a1 = cA + (size_t)(t + 1) * kstep;
            const char* a2 = last ? nA : cA + (size_t)(t + 2) * kstep; const char* b2 = last ? nB : cB + (size_t)(t + 2) * kstep;
            const char* a3 = a2 + kstep; const char* b3 = b2 + kstep;
            if (last && has_next) S.a_ready(nxt);
            if constexpr (SP2) {
            PG8_LDB(B0, 0, 0); PG8_LDB(B1, 0, 1); PG8_SCHED; PG8_LDA(At, 0, 0); PG8_STAGE(PG8_SA(1, 1), a1 + hstepA, voffA);
            PG8_WAIT_V(8); PG8_WAIT_L(0); PG8_BAR; PG8_MMA(0, 0, At, B0); PG8_MMA(0, 1, At, B1); PG8_BAR; PG8_SCHED;
            PG8_LDA(At, 0, 1); PG8_STAGE(PG8_SB(0, 0), b2, voffB); PG8_STAGE(PG8_SB(0, 1), b2 + hstepB, voffB); PG8_STAGE(PG8_SA(0, 0), a2, voffA);
            PG8_WAIT_V(8); PG8_WAIT_L(0); PG8_BAR; PG8_MMA(1, 0, At, B0); PG8_MMA(1, 1, At, B1); PG8_BAR; PG8_SCHED;
            PG8_LDB(B0, 1, 0); PG8_LDB(B1, 1, 1); PG8_SCHED; PG8_LDA(At, 1, 0); PG8_STAGE(PG8_SA(0, 1), a2 + hstepA, voffA);
            PG8_WAIT_V(8); PG8_WAIT_L(0); PG8_BAR; PG8_MMA(0, 0, At, B0); PG8_MMA(0, 1, At, B1); PG8_BAR; PG8_SCHED;
            PG8_LDA(At, 1, 1); PG8_STAGE(PG8_SB(1, 0), b3, voffB); PG8_STAGE(PG8_SB(1, 1), b3 + hstepB, voffB); PG8_STAGE(PG8_SA(1, 0), a3, voffA);
            PG8_WAIT_V(8); PG8_WAIT_L(0); PG8_BAR; PG8_MMA(1, 0, At, B0); PG8_MMA(1, 1, At, B1); PG8_BAR; PG8_SCHED;
            } else {
            PG8_LDB(B0, 0, 0); PG8_SCHED; PG8_LDA(At, 0, 0); PG8_STAGE(PG8_SA(1, 1), a1 + hstepA, voffA);
            PG8_WAIT_L(8); PG8_BAR; PG8_WAIT_L(0); PG8_MMA(0, 0, At, B0); PG8_BAR; PG8_SCHED;
            PG8_LDB(B1, 0, 1); PG8_STAGE(PG8_SB(0, 0), b2, voffB);
            PG8_BAR; PG8_WAIT_L(0); PG8_MMA(0, 1, At, B1); PG8_BAR;
            PG8_LDA(At, 0, 1); PG8_STAGE(PG8_SA(0, 0), a2, voffA);
            PG8_BAR; PG8_WAIT_L(0); PG8_MMA(1, 0, At, B0); PG8_BAR; PG8_SCHED;
            PG8_STAGE(PG8_SB(0, 1), b2 + hstepB, voffB);
            PG8_WAIT_V(6); PG8_BAR; PG8_MMA(1, 1, At, B1); PG8_BAR;
            PG8_LDB(B0, 1, 0); PG8_SCHED; PG8_LDA(At, 1, 0); PG8_STAGE(PG8_SA(0, 1), a2 + hstepA, voffA);
            PG8_WAIT_L(8); PG8_BAR; PG8_WAIT_L(0); PG8_MMA(0, 0, At, B0); PG8_BAR; PG8_SCHED;
            PG8_LDB(B1, 1, 1); PG8_STAGE(PG8_SB(1, 0), b3, voffB);
            PG8_BAR; PG8_WAIT_L(0); PG8_MMA(0, 1, At, B1); PG8_BAR;
            PG8_LDA(At, 1, 1); PG8_STAGE(PG8_SA(1, 0), a3, voffA);
            PG8_BAR; PG8_WAIT_L(0); PG8_MMA(1, 0, At, B0); PG8_BAR; PG8_SCHED;
            PG8_STAGE(PG8_SB(1, 1), b3 + hstepB, voffB);
            PG8_WAIT_V(6); PG8_BAR; PG8_MMA(1, 1, At, B1); PG8_BAR;
            }
        }
        if constexpr (ALIGN_EPI) { if (wr == 0) PG8_BAR; }
        if constexpr (!Epi::AFTER_DRAIN) { E(acc, cur, wr, wc, fr, fq); S.done(cur); }
        if (!has_next) break;
#pragma unroll
        for (int a = 0; a < 2; ++a)
#pragma unroll
            for (int b = 0; b < 2; ++b)
#pragma unroll
                for (int m = 0; m < 4; ++m)
#pragma unroll
                    for (int n = 0; n < 2; ++n) acc[a][b][m][n] = (f32x4){0.f, 0.f, 0.f, 0.f};
        cur = nxt; cA = nA; cB = nB; ++ui;
        if constexpr (ALIGN_EPI) { if (wr == 1) PG8_BAR; }
    }
    PG8_WAIT_V(0);
    if constexpr (!ALIGN_EPI) { if (wr == 0) PG8_BAR; }
    PG8_BAR;
#undef PG8_SA
#undef PG8_SB
#undef PG8_STAGE
#undef PG8_LDA
#undef PG8_LDB
#undef PG8_MMA
#undef PG8_WAIT_V
#undef PG8_WAIT_L
#undef PG8_BAR
#undef PG8_SCHED
}
}

constexpr size_t MiB = 1u << 20;
constexpr size_t WS_CTL = 0, CTL_ZERO_BYTES = 1 * MiB;
constexpr size_t WS_BTIN  = 1 * MiB;
constexpr size_t WS_BTGLU = WS_BTIN + 36 * MiB;
constexpr size_t WS_BTPS  = WS_BTGLU + 2 * MiB;
constexpr size_t WS_BTPR  = WS_BTPS + 4 * MiB;
constexpr size_t WS_BTOUT = WS_BTPR + 4 * MiB;
constexpr size_t WS_BTPG  = WS_BTOUT + 8 * MiB;
constexpr size_t WS_BTPP  = WS_BTPG + 8 * MiB;
constexpr size_t WS_BTGU  = WS_BTPP + 1 * MiB;
constexpr size_t WS_BTDN  = WS_BTGU + 512 * MiB;
constexpr size_t WS_BTS3  = WS_BTDN + 256 * MiB;
constexpr size_t WS_BTS1  = WS_BTS3 + 40 * MiB;
constexpr size_t WS_ATAB  = WS_BTS1 + 16 * MiB;
constexpr size_t WS_CS    = WS_ATAB + 1 * MiB;
constexpr size_t WS_SN    = WS_CS + 4 * MiB;
constexpr size_t WS_WG    = WS_SN + 4 * MiB;
constexpr size_t WS_PBF   = WS_WG + 1 * MiB;
constexpr size_t WS_HB    = WS_PBF + 8 * MiB;
constexpr size_t WS_XG5   = WS_HB + 64 * MiB;
constexpr size_t WS_Q     = WS_XG5 + 40 * MiB;
constexpr size_t WS_K     = WS_Q + 32 * MiB;
constexpr size_t WS_V     = WS_K + 32 * MiB;
constexpr size_t WS_GS    = WS_V + 32 * MiB;
constexpr size_t WS_SGS   = WS_GS + 32 * MiB;
constexpr size_t WS_SGR   = WS_SGS + 64 * MiB;
constexpr size_t WS_SLOC  = WS_SGR + 64 * MiB;
constexpr size_t WS_KVT   = WS_SLOC + 16 * MiB;
constexpr size_t WS_RT    = WS_KVT + 64 * MiB;
constexpr size_t WS_YSP   = WS_RT + 32 * MiB;
constexpr size_t WS_YS    = WS_YSP + 32 * MiB;
constexpr size_t WS_YR    = WS_YS + 32 * MiB;
constexpr size_t WS_TMP   = WS_YR + 32 * MiB;
constexpr size_t WS_MRG   = WS_TMP + 128 * MiB;
constexpr size_t WS_X2    = WS_MRG + 64 * MiB;
constexpr size_t WS_PP    = WS_X2 + 128 * MiB;
constexpr size_t WS_TOKE  = WS_PP + 64 * MiB;
constexpr size_t WS_TOKG  = WS_TOKE + 1 * MiB;
constexpr size_t WS_TOKP  = WS_TOKG + 1 * MiB;
constexpr size_t WS_ROWG  = WS_TOKP + 1 * MiB;
constexpr size_t WS_AROW  = WS_ROWG + 1 * MiB;
constexpr size_t WS_BLKE  = WS_AROW + 1 * MiB;
constexpr size_t WS_XG    = WS_BLKE + 1 * MiB;
constexpr size_t WS_ACT   = WS_XG + 288 * MiB;
constexpr size_t WS_YB    = WS_ACT + 288 * MiB;
constexpr size_t WS_END   = WS_YB + 288 * MiB;
constexpr int CW_CNT = 64;
constexpr int CW_BAR = 4096;

constexpr int RING_OFF = 0, RING_BYTES = 131072;
constexpr int LDS_BYTES = 159744;
constexpr int LDSCTL_OFF = LDS_BYTES - 256;
constexpr int NWAVES = 8;

#define GAS __attribute__((address_space(1)))
#define LAS __attribute__((address_space(3)))
typedef unsigned short bf16;
typedef unsigned v4u __attribute__((ext_vector_type(4)));
typedef unsigned v2u __attribute__((ext_vector_type(2)));
typedef float f32x4 __attribute__((ext_vector_type(4)));
typedef float f32x16 __attribute__((ext_vector_type(16)));
typedef short bf16x8 __attribute__((ext_vector_type(8)));
#define RLX_AGENT __ATOMIC_RELAXED, __HIP_MEMORY_SCOPE_AGENT
#define LDS_WAIT() asm volatile("s_waitcnt lgkmcnt(0)" ::: "memory")
#define VM_WAIT() asm volatile("s_waitcnt vmcnt(0)" ::: "memory")
__device__ __forceinline__ unsigned f2bf(float f) { unsigned u = __builtin_bit_cast(unsigned, f); return (u + 0x7fffu + ((u >> 16) & 1u)) >> 16; }
__device__ __forceinline__ unsigned pk2(float lo, float hi) { return f2bf(lo) | (f2bf(hi) << 16); }
__device__ __forceinline__ float bf2f(unsigned short b) { return __builtin_bit_cast(float, (unsigned)b << 16); }

#define XB_TMO      128
#define XB_XCNT(j)  (256  + 64 * (j))
#define XB_XSUB(j)  (1280 + 64 * (j))
#define XB_XGEN(j)  (2304 + 64 * (j))
#define XB_TOP      3328
#define XB_TOPGEN   3392
#define XCD_BAR_WORDS 3456
#define XB_SPIN_CAP (1u << 20)
__device__ __forceinline__ unsigned xb_ld(unsigned* p)              { return __hip_atomic_load(p, __ATOMIC_RELAXED, __HIP_MEMORY_SCOPE_AGENT); }
__device__ __forceinline__ unsigned xb_add(unsigned* p, unsigned v) { return __hip_atomic_fetch_add(p, v, __ATOMIC_RELAXED, __HIP_MEMORY_SCOPE_AGENT); }
__device__ __forceinline__ unsigned xb_xcc_id() { return (unsigned)__builtin_amdgcn_s_getreg((3 << 11) | 20) & 0xFu; }
#define XB_SPIN(cond, bar) do { unsigned _sp = 0; while (cond) { __builtin_amdgcn_s_sleep(1); \
    if ((++_sp & 255u) == 0u) { if (xb_ld(&(bar)[XB_TMO])) break; if (_sp > XB_SPIN_CAP) { atomicAdd(&(bar)[XB_TMO], 1u); break; } } } } while (0)
struct XcdBarrier { unsigned* bar; unsigned x; volatile LAS unsigned* st; };
__device__ __forceinline__ XcdBarrier xcd_barrier_post(unsigned* bar, volatile LAS unsigned* st) {
    XcdBarrier b; b.bar = bar; b.x = xb_xcc_id(); b.st = st;
    if (threadIdx.x == 0) (void)xb_add(&bar[XB_XCNT(b.x)], 1u);
    return b;
}
__device__ __forceinline__ void xcd_barrier_complete(unsigned* bar, unsigned x, unsigned& nloc, unsigned& nx) {
    const unsigned G = gridDim.x * gridDim.y * gridDim.z;
    unsigned sum, cnt, mine, sp = 0u;
    for (;;) {
        sum = 0u; cnt = 0u; mine = 0u;
#pragma unroll
        for (unsigned j = 0; j < 16; ++j) { const unsigned c = xb_ld(&bar[XB_XCNT(j)]); sum += c; cnt += (c > 0u) ? 1u : 0u; mine = (j == x) ? c : mine; }
        if (sum == G) break;
        __builtin_amdgcn_s_sleep(1);
        if ((++sp & 255u) == 0u) { if (xb_ld(&bar[XB_TMO])) break; if (sp > XB_SPIN_CAP) { atomicAdd(&bar[XB_TMO], 1u); break; } }
    }
    nloc = mine > 0u ? mine : 1u; nx = cnt > 0u ? cnt : 1u;
}
__device__ __forceinline__ void xcd_barrier(const XcdBarrier& b) {
    asm volatile("s_waitcnt vmcnt(0)" ::: "memory");
    __syncthreads();
    if (threadIdx.x == 0) {
        unsigned* bar = b.bar;
        __builtin_amdgcn_s_waitcnt(0);
        unsigned nloc = b.st[0], nx = b.st[1];
        if (nloc == 0u) { xcd_barrier_complete(bar, b.x, nloc, nx); b.st[0] = nloc; b.st[1] = nx; }
        const unsigned old = xb_add(&bar[XB_XSUB(b.x)], 1u);
        const unsigned gen = old / nloc;
        if (old + 1u == (gen + 1u) * nloc) {
            __builtin_amdgcn_fence(__ATOMIC_RELEASE, "agent");
            asm volatile("s_waitcnt vmcnt(0)" ::: "memory");
            const unsigned og = xb_add(&bar[XB_TOP], 1u);
            const unsigned tg = og / nx;
            if (og + 1u == (tg + 1u) * nx) xb_add(&bar[XB_TOPGEN], 1u);
            else XB_SPIN(xb_ld(&bar[XB_TOPGEN]) == tg, bar);
            __builtin_amdgcn_fence(__ATOMIC_ACQUIRE, "agent");
            xb_add(&bar[XB_XGEN(b.x)], 1u);
            asm volatile("s_waitcnt vmcnt(0)" ::: "memory");
        } else {
            XB_SPIN(xb_ld(&bar[XB_XGEN(b.x)]) == gen, bar);
            __builtin_amdgcn_fence(__ATOMIC_ACQUIRE, "agent");
            asm volatile("s_waitcnt vmcnt(0)" ::: "memory");
        }
    }
    __syncthreads();
}

__device__ __forceinline__ float wave_sum(float v) {
#pragma unroll
    for (int o = 1; o < 64; o <<= 1) v += __shfl_xor(v, o);
    return v;
}
__device__ __forceinline__ int rowmap(int mode, int n) {
    if (mode == 1) { if (n < 1024 || n >= 3072) return n; const int nn = n - 1024, r = nn >> 10, hn = nn & 1023, head = hn >> 7, half = (hn >> 6) & 1, dd = hn & 63;
        return 1024 + r * 1024 + (head >> 1) * 256 + half * 128 + (head & 1) * 64 + dd; }
    if (mode == 2) { const int f = n >> 1, s = n & 1; return (f >> 7) * 256 + (f & 127) + 128 * s; }
    return n;
}
__device__ __forceinline__ void transpose_item(const float* W, int K, int N, bf16* WT, int mode, LAS float* scr, int kb, int nb, int lane) {
    const int k0 = 64 * kb, n0 = 64 * nb;
    const float* src = W + (size_t)k0 * N + n0 + lane;
#pragma unroll 16
    for (int kk = 0; kk < 64; ++kk) scr[kk * 65 + lane] = src[(size_t)kk * N];
    LDS_WAIT(); asm volatile("" ::: "memory");
    const int c = lane & 7;
#pragma unroll
    for (int j = 0; j < 8; ++j) { const int n = (lane >> 3) + 8 * j; const LAS float* s = scr + (8 * c) * 65 + n;
        v4u o; o.x = pk2(s[0 * 65], s[1 * 65]); o.y = pk2(s[2 * 65], s[3 * 65]); o.z = pk2(s[4 * 65], s[5 * 65]); o.w = pk2(s[6 * 65], s[7 * 65]);
        *(v4u*)(WT + (size_t)rowmap(mode, n0 + n) * K + k0 + 8 * c) = o; }
    LDS_WAIT(); asm volatile("" ::: "memory");
}
__device__ __forceinline__ void rms_row_bf16(const float* xrow, const float* gain, bf16* orow, int lane) {
    const f32x4* xr = (const f32x4*)xrow + lane; const f32x4* gr = (const f32x4*)gain + lane;
    f32x4 v[8]; float s = 0.f;
#pragma unroll
    for (int j = 0; j < 8; ++j) { v[j] = xr[64 * j]; s += (v[j].x * v[j].x + v[j].y * v[j].y) + (v[j].z * v[j].z + v[j].w * v[j].w); }
    const float rstd = 1.0f / sqrtf(wave_sum(s) * (1.0f / 2048.0f) + 1e-6f);
    v2u* o8 = (v2u*)orow + lane;
#pragma unroll
    for (int j = 0; j < 8; ++j) { const f32x4 g = gr[64 * j]; v2u w; w.x = pk2(v[j].x * rstd * g.x, v[j].y * rstd * g.y); w.y = pk2(v[j].z * rstd * g.z, v[j].w * rstd * g.w); o8[64 * j] = w; }
}

struct Args {
    const float* x; const float* p; const int* pos; const float* norm1_g; const float* w_in;
    const float* lam_re; const float* lam_im; const float* log_dt; const float* b_re; const float* b_im; const float* c_re; const float* c_im; const float* d_skip;
    const float* w_glu; const float* b_glu; const float* w_bs; const float* w_br; const float* w_out; const float* norm2_g; const float* router_w; const float* router_b;
    const float* w_gu; const float* b_gu; const float* w_dn; const float* b_dn; const float* norm3_g; const float* w_pg; const float* w_pp; const float* fin_g;
    float* out; unsigned char* ws; int ph_lo, ph_hi;
};

__device__ __forceinline__ void s5_tables(const Args& a, int g, LAS unsigned char* lds, int tid) {
    LAS float* Pre = (LAS float*)lds;
    LAS float* Pim = Pre + 33 * 64;
    LAS float* Bre = Pim + 33 * 64;
    LAS float* Bim = Bre + 1024;
    LAS float* Cre = Bim + 1024;
    LAS float* Cim = Cre + 1024;
    LAS float* Kt  = Cim + 1024;
    const float dt = expf(a.log_dt[g]);
    for (int e = tid; e < 33 * 64; e += 512) { const int p = e >> 6, n = e & 63; const float lr = a.lam_re[g * 64 + n], li = a.lam_im[g * 64 + n];
        const float mag = expf(lr * dt * (float)p), ang = li * dt * (float)p; Pre[e] = mag * cosf(ang); Pim[e] = mag * sinf(ang); }
    for (int e = tid; e < 1024; e += 512) { const int n = e >> 4; const float lr = a.lam_re[g * 64 + n], li = a.lam_im[g * 64 + n];
        const float mag = expf(lr * dt), abr = mag * cosf(li * dt), abi = mag * sinf(li * dt);
        const float den = lr * lr + li * li, nr = abr - 1.0f, ni = abi, fre = (nr * lr + ni * li) / den, fim = (ni * lr - nr * li) / den;
        const float br = a.b_re[(size_t)g * 1024 + e], bi = a.b_im[(size_t)g * 1024 + e];
        Bre[e] = fre * br - fim * bi; Bim[e] = fre * bi + fim * br;
        Cre[e] = a.c_re[(size_t)g * 1024 + e]; Cim[e] = a.c_im[(size_t)g * 1024 + e]; }
    __syncthreads();
    for (int e = tid; e < 8192; e += 512) { const int tau = e >> 8, c = (e >> 4) & 15, cp = e & 15; float s = 0.f;
        for (int n = 0; n < 64; ++n) { const float pr = Pre[tau * 64 + n], pi = Pim[tau * 64 + n], br = Bre[n * 16 + cp], bi = Bim[n * 16 + cp];
            const float zr = pr * br - pi * bi, zi = pr * bi + pi * br; s += Cre[c * 64 + n] * zr - Cim[c * 64 + n] * zi; }
        if (tau == 0 && c == cp) s += a.d_skip[g * 16 + c];
        Kt[e] = s; }
    __syncthreads();
    bf16* bt3 = (bf16*)(a.ws + WS_BTS3) + (size_t)g * 512 * K5;
    for (int ch = tid; ch < 512 * 80; ch += 512) { const int row = ch / 80, cc = ch % 80, i = row >> 4, c = row & 15; float v[8];
        if (cc < 64) { const int ip = cc >> 1, c0 = (cc & 1) * 8;
#pragma unroll
            for (int x = 0; x < 8; ++x) v[x] = (i >= ip) ? Kt[(i - ip) * 256 + c * 16 + c0 + x] : 0.f;
        } else { const int m0 = (cc - 64) * 8;
#pragma unroll
            for (int x = 0; x < 8; ++x) { const int m = m0 + x, n = m & 63; const float cr = Cre[c * 64 + n], ci = Cim[c * 64 + n], pr = Pre[(i + 1) * 64 + n], pi = Pim[(i + 1) * 64 + n];
                v[x] = (m < 64) ? (cr * pr - ci * pi) : -(cr * pi + ci * pr); } }
        v4u o; o.x = pk2(v[0], v[1]); o.y = pk2(v[2], v[3]); o.z = pk2(v[4], v[5]); o.w = pk2(v[6], v[7]);
        *(v4u*)(bt3 + (size_t)row * K5 + cc * 8) = o; }
    bf16* bt1 = (bf16*)(a.ws + WS_BTS1) + (size_t)g * 256 * 512;
    for (int ch = tid; ch < 256 * 64; ch += 512) { const int row = ch >> 6, cc = ch & 63, ip = cc >> 1, c0 = (cc & 1) * 8; float v[8];
#pragma unroll
        for (int x = 0; x < 8; ++x) { if (row < 128) { const int n = row & 63; const float pr = Pre[(31 - ip) * 64 + n], pi = Pim[(31 - ip) * 64 + n], br = Bre[n * 16 + c0 + x], bi = Bim[n * 16 + c0 + x];
                v[x] = (row < 64) ? (pr * br - pi * bi) : (pr * bi + pi * br); } else v[x] = 0.f; }
        v4u o; o.x = pk2(v[0], v[1]); o.y = pk2(v[2], v[3]); o.z = pk2(v[4], v[5]); o.w = pk2(v[6], v[7]);
        *(v4u*)(bt1 + (size_t)row * 512 + cc * 8) = o; }
    float* at = (float*)(a.ws + WS_ATAB) + g * 128;
    if (tid < 64) { at[tid * 2] = Pre[32 * 64 + tid]; at[tid * 2 + 1] = Pim[32 * 64 + tid]; }
    __syncthreads();
}

__device__ __forceinline__ void s5_scan_item(const Args& a, int item, LAS unsigned char* lds, int tid) {
    LAS float* seg_re = (LAS float*)lds; LAS float* seg_im = seg_re + 512;
    const int sl = tid & 31, seg = tid >> 5, sidx = item * 32 + sl, g = sidx >> 6, n = sidx & 63;
    const float* at = (const float*)(a.ws + WS_ATAB) + g * 128 + n * 2; const float ar = at[0], ai = at[1];
    const float* sloc = (const float*)(a.ws + WS_SLOC) + ((size_t)g * NCH5 + seg * 32) * 128 + n;
    float er = 0.f, ei = 0.f;
#pragma unroll 8
    for (int j = 0; j < 32; ++j) { const float lr = sloc[j * 128], li = sloc[j * 128 + 64]; const float tr = ar * er - ai * ei + lr, ti = ar * ei + ai * er + li; er = tr; ei = ti; }
    seg_re[seg * 32 + sl] = er; seg_im[seg * 32 + sl] = ei;
    __syncthreads();
    float pr = ar, pi = ai;
#pragma unroll
    for (int q = 0; q < 5; ++q) { const float tr = pr * pr - pi * pi, ti = 2.f * pr * pi; pr = tr; pi = ti; }
    float sr = 0.f, si = 0.f;
    for (int s2 = 0; s2 < seg; ++s2) { const float tr = pr * sr - pi * si + seg_re[s2 * 32 + sl], ti = pr * si + pi * sr + seg_im[s2 * 32 + sl]; sr = tr; si = ti; }
    bf16* xg = (bf16*)(a.ws + WS_XG5) + ((size_t)g * NCH5 + seg * 32) * K5 + 512 + n;
#pragma unroll 8
    for (int j = 0; j < 32; ++j) { xg[(size_t)j * K5] = (bf16)f2bf(sr); xg[(size_t)j * K5 + 64] = (bf16)f2bf(si);
        const float lr = sloc[j * 128], li = sloc[j * 128 + 64]; const float tr = ar * sr - ai * si + lr, ti = ar * si + ai * sr + li; sr = tr; si = ti; }
    __syncthreads();
}

constexpr int RS = 130;
__device__ __forceinline__ float ret_l2g(int h) { return log2f(1.0f - exp2f(-5.0f - (float)h)); }
__device__ __forceinline__ bf16x8 lds_frag_col(const LAS bf16* base, int stride) {
    bf16x8 f;
#pragma unroll
    for (int x = 0; x < 8; ++x) f[x] = (short)base[x * stride];
    return f;
}
template <bool ZETA> __device__ __forceinline__ void ret_stage(const bf16* src, LAS bf16* dst, int tid, float l2g) {
#pragma unroll
    for (int q = 0; q < 4; ++q) { const int id = tid + 512 * q, row = id >> 4, c8 = id & 15; v4u w = *(const v4u*)(src + (size_t)row * 1024 + 8 * c8);
        if (ZETA) { const float z = exp2f(l2g * (float)(127 - row));
            w.x = pk2(pg8::bf_lo(w.x) * z, pg8::bf_hi(w.x) * z); w.y = pk2(pg8::bf_lo(w.y) * z, pg8::bf_hi(w.y) * z); w.z = pk2(pg8::bf_lo(w.z) * z, pg8::bf_hi(w.z) * z); w.w = pk2(pg8::bf_lo(w.w) * z, pg8::bf_hi(w.w) * z); }
        LAS unsigned* d = (LAS unsigned*)(dst + row * RS + 8 * c8); d[0] = w.x; d[1] = w.y; d[2] = w.z; d[3] = w.w; }
}
__device__ __forceinline__ void ret_kv_unit(const Args& a, int unit, LAS unsigned char* lds, int tid) {
    const int n = unit >> 3, h = unit & 7, t0 = n * RCH, lane = tid & 63, w = __builtin_amdgcn_readfirstlane(tid >> 6), fr = lane & 15, fg = lane >> 4;
    LAS bf16* Ks = (LAS bf16*)lds; LAS bf16* Vs = Ks + 128 * RS;
    const float l2g = ret_l2g(h);
    ret_stage<true>((const bf16*)(a.ws + WS_K) + (size_t)t0 * 1024 + h * 128, Ks, tid, l2g);
    ret_stage<false>((const bf16*)(a.ws + WS_V) + (size_t)t0 * 1024 + h * 128, Vs, tid, l2g);
    __syncthreads();
    bf16x8 af[4];
#pragma unroll
    for (int ks = 0; ks < 4; ++ks) af[ks] = lds_frag_col(Vs + (32 * ks + 8 * fg) * RS + 16 * w + fr, RS);
    float* out = (float*)(a.ws + WS_KVT) + ((size_t)unit * 128 + 16 * w + 4 * fg) * 128 + fr;
#pragma unroll
    for (int dt = 0; dt < 8; ++dt) { f32x4 acc = (f32x4){0.f, 0.f, 0.f, 0.f};
#pragma unroll
        for (int ks = 0; ks < 4; ++ks) { const bf16x8 bfv = lds_frag_col(Ks + (32 * ks + 8 * fg) * RS + 16 * dt + fr, RS);
            acc = __builtin_amdgcn_mfma_f32_16x16x32_bf16(af[ks], bfv, acc, 0, 0, 0); }
#pragma unroll
        for (int r = 0; r < 4; ++r) out[(size_t)r * 128 + 16 * dt] = acc[r]; }
    __syncthreads();
}
__device__ __forceinline__ void ret_state_scan(const Args& a, int gtid, int gthreads) {
    const float* kvt = (const float*)(a.ws + WS_KVT); bf16* rt = (bf16*)(a.ws + WS_RT);
    for (int idx = gtid; idx < RH * 128 * 128; idx += gthreads) { const int h = idx >> 14; const float dec = exp2f(128.0f * ret_l2g(h)); float st = 0.f;
#pragma unroll 8
        for (int n = 0; n < NRC; ++n) { rt[(size_t)n * 131072 + idx] = (bf16)f2bf(st); st = st * dec + kvt[(size_t)n * 131072 + idx]; } }
}
__device__ __forceinline__ void ret_out_unit(const Args& a, int unit, LAS unsigned char* lds, int tid) {
    const int n = unit >> 3, h = unit & 7, t0 = n * RCH, lane = tid & 63, w = __builtin_amdgcn_readfirstlane(tid >> 6), fr = lane & 15, fg = lane >> 4;
    LAS bf16* Ks = (LAS bf16*)lds; LAS bf16* Vs = Ks + 128 * RS; LAS bf16* Ps = Vs + 128 * RS;
    const float l2g = ret_l2g(h);
    ret_stage<false>((const bf16*)(a.ws + WS_K) + (size_t)t0 * 1024 + h * 128, Ks, tid, l2g);
    ret_stage<false>((const bf16*)(a.ws + WS_V) + (size_t)t0 * 1024 + h * 128, Vs, tid, l2g);
    const int i0 = 16 * w, il = i0 + fr;
    bf16x8 qf[4];
    { const bf16* qp = (const bf16*)(a.ws + WS_Q) + (size_t)(t0 + il) * 1024 + h * 128 + 8 * fg;
#pragma unroll
      for (int ks = 0; ks < 4; ++ks) qf[ks] = *(const bf16x8*)(qp + 32 * ks); }
    __syncthreads();
#pragma unroll
    for (int jt = 0; jt < 8; ++jt) {
        if (jt <= w) { f32x4 acc = (f32x4){0.f, 0.f, 0.f, 0.f};
#pragma unroll
            for (int ks = 0; ks < 4; ++ks) { bf16x8 kf;
#pragma unroll
                for (int x = 0; x < 8; ++x) kf[x] = (short)Ks[(16 * jt + fr) * RS + 32 * ks + 8 * fg + x];
                acc = __builtin_amdgcn_mfma_f32_16x16x32_bf16(kf, qf[ks], acc, 0, 0, 0); }
            float pv[4];
#pragma unroll
            for (int r = 0; r < 4; ++r) { const int j = 16 * jt + 4 * fg + r; pv[r] = (il >= j) ? acc[r] * exp2f(l2g * (float)(il - j)) : 0.f; }
            LAS unsigned* pp = (LAS unsigned*)(Ps + il * RS + 16 * jt + 4 * fg); pp[0] = pk2(pv[0], pv[1]); pp[1] = pk2(pv[2], pv[3]);
        } else if (jt == w + 1 && (w & 1) == 0) { LAS unsigned* pp = (LAS unsigned*)(Ps + il * RS + 16 * jt + 4 * fg); pp[0] = 0u; pp[1] = 0u; }
    }
    __syncthreads();
    f32x4 accI[8], accC[8];
#pragma unroll
    for (int et = 0; et < 8; ++et) { accI[et] = (f32x4){0.f, 0.f, 0.f, 0.f}; accC[et] = (f32x4){0.f, 0.f, 0.f, 0.f}; }
    const int nks = (w >> 1) + 1;
    for (int ks = 0; ks < nks; ++ks) { bf16x8 pf;
#pragma unroll
        for (int x = 0; x < 8; ++x) pf[x] = (short)Ps[il * RS + 32 * ks + 8 * fg + x];
#pragma unroll
        for (int et = 0; et < 8; ++et) { const bf16x8 vf = lds_frag_col(Vs + (32 * ks + 8 * fg) * RS + 16 * et + fr, RS);
            accI[et] = __builtin_amdgcn_mfma_f32_16x16x32_bf16(vf, pf, accI[et], 0, 0, 0); } }
    { const bf16* rp = (const bf16*)(a.ws + WS_RT) + ((size_t)unit * 128 + fr) * 128 + 8 * fg;
#pragma unroll
      for (int et = 0; et < 8; ++et)
#pragma unroll
          for (int ks = 0; ks < 4; ++ks) { const bf16x8 rf = *(const bf16x8*)(rp + (size_t)(16 * et) * 128 + 32 * ks);
              accC[et] = __builtin_amdgcn_mfma_f32_16x16x32_bf16(rf, qf[ks], accC[et], 0, 0, 0); } }
    const float xi = exp2f(l2g * (float)(il + 1));
    float s = 0.f;
#pragma unroll
    for (int et = 0; et < 8; ++et) { accI[et] = accI[et] + accC[et] * xi; s += (accI[et][0] + accI[et][1]) + (accI[et][2] + accI[et][3]); }
    s += __shfl_xor(s, 16); s += __shfl_xor(s, 32);
    const float mu = s * (1.0f / 128.0f); float q2 = 0.f;
#pragma unroll
    for (int et = 0; et < 8; ++et) { accI[et] = accI[et] - mu; q2 += (accI[et][0] * accI[et][0] + accI[et][1] * accI[et][1]) + (accI[et][2] * accI[et][2] + accI[et][3] * accI[et][3]); }
    q2 += __shfl_xor(q2, 16); q2 += __shfl_xor(q2, 32);
    const float rstd = 1.0f / sqrtf(q2 * (1.0f / 128.0f) + 1e-6f);
    const size_t ob = (size_t)(t0 + il) * 1024 + h * 128 + 4 * fg;
    const bf16* gp = (const bf16*)(a.ws + WS_GS) + ob; bf16* yp = (bf16*)(a.ws + WS_YR) + ob;
#pragma unroll
    for (int et = 0; et < 8; ++et) { const v2u gw = *(const v2u*)(gp + 16 * et); v2u o;
        o.x = pk2(accI[et][0] * rstd * pg8::bf_lo(gw.x), accI[et][1] * rstd * pg8::bf_hi(gw.x)); o.y = pk2(accI[et][2] * rstd * pg8::bf_lo(gw.y), accI[et][3] * rstd * pg8::bf_hi(gw.y));
        *(v2u*)(yp + 16 * et) = o; }
    __syncthreads();
}

__device__ __forceinline__ void router_item(const Args& a, int item, LAS unsigned char* lds, int tid) {
    LAS float* rs = (LAS float*)lds;
    LAS float* part = rs + 64;
    LAS float* lg = part + 4 * 64 * 33;
    LAS int* hist = (LAS int*)(lg + 64 * 33);
    LAS int* base = hist + 32;
    const int lane = tid & 63, w = __builtin_amdgcn_readfirstlane(tid >> 6), tb = item * 64;
    const float* x2 = (const float*)(a.ws + WS_X2);
    if (tid < 32) hist[tid] = 0;
    for (int r = 0; r < 8; ++r) { const int t = tb + 8 * w + r; const float* xrow = x2 + (size_t)t * 2048;
        const f32x4* xr = (const f32x4*)xrow + lane; const f32x4* gr = (const f32x4*)a.norm2_g + lane;
        f32x4 v[8]; float s = 0.f;
#pragma unroll
        for (int j = 0; j < 8; ++j) { v[j] = xr[64 * j]; s += (v[j].x * v[j].x + v[j].y * v[j].y) + (v[j].z * v[j].z + v[j].w * v[j].w); }
        const float rstd = 1.0f / sqrtf(wave_sum(s) * (1.0f / 2048.0f) + 1e-6f);
        if (lane == 0) rs[8 * w + r] = rstd;
        v2u* o8 = (v2u*)((bf16*)(a.ws + WS_HB) + (size_t)t * 2048) + lane;
#pragma unroll
        for (int j = 0; j < 8; ++j) { const f32x4 g = gr[64 * j]; v2u o; o.x = pk2(v[j].x * rstd * g.x, v[j].y * rstd * g.y); o.y = pk2(v[j].z * rstd * g.z, v[j].w * rstd * g.w); o8[64 * j] = o; } }
    { const int tg = w & 1, kq = w >> 1, hl = lane >> 5, l31 = lane & 31;
      const float* xp = x2 + (size_t)(tb + 32 * tg + l31) * 2048 + 512 * kq + 4 * hl;
      const float* wp = (const float*)(a.ws + WS_WG) + (size_t)(512 * kq + 4 * hl) * 32 + l31;
      f32x16 acc;
#pragma unroll
      for (int x = 0; x < 16; ++x) acc[x] = 0.f;
#pragma unroll 4
      for (int kk = 0; kk < 64; ++kk) { const f32x4 av = *(const f32x4*)(xp + 8 * kk); const float* wq = wp + (size_t)(8 * kk) * 32;
          acc = __builtin_amdgcn_mfma_f32_32x32x2f32(av.x, wq[0], acc, 0, 0, 0); acc = __builtin_amdgcn_mfma_f32_32x32x2f32(av.y, wq[32], acc, 0, 0, 0);
          acc = __builtin_amdgcn_mfma_f32_32x32x2f32(av.z, wq[64], acc, 0, 0, 0); acc = __builtin_amdgcn_mfma_f32_32x32x2f32(av.w, wq[96], acc, 0, 0, 0); }
#pragma unroll
      for (int x = 0; x < 16; ++x) { const int tl = (x & 3) + 8 * (x >> 2) + 4 * hl; part[(kq * 64 + 32 * tg + tl) * 33 + l31] = acc[x]; } }
    __syncthreads();
    for (int e = tid; e < 64 * 32; e += 512) { const int tl = e >> 5, ex = e & 31;
        lg[tl * 33 + ex] = rs[tl] * ((part[(0 * 64 + tl) * 33 + ex] + part[(1 * 64 + tl) * 33 + ex]) + (part[(2 * 64 + tl) * 33 + ex] + part[(3 * 64 + tl) * 33 + ex])) + a.router_b[ex]; }
    __syncthreads();
    int e0 = 0, e1 = 0, e2 = 0, e3 = 0, r0 = 0, r1 = 0, r2 = 0, r3 = 0; float g0 = 0.f, g1 = 0.f, g2 = 0.f, g3 = 0.f;
    if (tid < 64) { const LAS float* L = lg + tid * 33; float v0 = -3.0e38f, v1 = -3.0e38f, v2 = -3.0e38f, v3 = -3.0e38f;
        for (int ex = 0; ex < 32; ++ex) { const float v = L[ex]; if (v > v0) { v0 = v; e0 = ex; } }
        for (int ex = 0; ex < 32; ++ex) { const float v = L[ex]; if (ex != e0 && v > v1) { v1 = v; e1 = ex; } }
        for (int ex = 0; ex < 32; ++ex) { const float v = L[ex]; if (ex != e0 && ex != e1 && v > v2) { v2 = v; e2 = ex; } }
        for (int ex = 0; ex < 32; ++ex) { const float v = L[ex]; if (ex != e0 && ex != e1 && ex != e2 && v > v3) { v3 = v; e3 = ex; } }
        const float p0 = 1.0f, p1 = expf(v1 - v0), p2 = expf(v2 - v0), p3 = expf(v3 - v0), inv = 1.0f / (p0 + p1 + p2 + p3);
        g0 = p0 * inv; g1 = p1 * inv; g2 = p2 * inv; g3 = p3 * inv;
        r0 = __hip_atomic_fetch_add(&hist[e0], 1, __ATOMIC_RELAXED, __HIP_MEMORY_SCOPE_WORKGROUP); r1 = __hip_atomic_fetch_add(&hist[e1], 1, __ATOMIC_RELAXED, __HIP_MEMORY_SCOPE_WORKGROUP);
        r2 = __hip_atomic_fetch_add(&hist[e2], 1, __ATOMIC_RELAXED, __HIP_MEMORY_SCOPE_WORKGROUP); r3 = __hip_atomic_fetch_add(&hist[e3], 1, __ATOMIC_RELAXED, __HIP_MEMORY_SCOPE_WORKGROUP); }
    __syncthreads();
    if (tid < 32) base[tid] = (int)__hip_atomic_fetch_add((unsigned*)(a.ws + WS_CTL) + CW_CNT + tid, (unsigned)hist[tid], RLX_AGENT);
    __syncthreads();
    if (tid < 64) { const int t = tb + tid; int* te = (int*)(a.ws + WS_TOKE) + t * 4; float* tg = (float*)(a.ws + WS_TOKG) + t * 4; int* tp = (int*)(a.ws + WS_TOKP) + t * 4;
        te[0] = e0; te[1] = e1; te[2] = e2; te[3] = e3; tg[0] = g0; tg[1] = g1; tg[2] = g2; tg[3] = g3;
        tp[0] = base[e0] + r0; tp[1] = base[e1] + r1; tp[2] = base[e2] + r2; tp[3] = base[e3] + r3; }
    __syncthreads();
}

constexpr int N_PHASES = 15;
__global__ void __launch_bounds__(NWAVES * 64, 2) mk_fwd(Args kargs) {
    extern __shared__ __attribute__((aligned(16))) unsigned char lds_raw[];
    LAS unsigned char* lds = (LAS unsigned char*)lds_raw;
    const int tid = threadIdx.x, lane = tid & 63, wave = __builtin_amdgcn_readfirstlane(tid >> 6);
    const int G = gridDim.x, bx = blockIdx.x, gw = bx * NWAVES + wave, NGW = G * NWAVES, gtid = bx * (NWAVES * 64) + tid, GT = G * NWAVES * 64;
    unsigned char* const ws = kargs.ws;
#define LOAD_ARGS() const __attribute__((address_space(4))) Args* ap_ = (const __attribute__((address_space(4))) Args*)__builtin_amdgcn_kernarg_segment_ptr(); asm volatile("" : "+s"(ap_)); Args a; { const __attribute__((address_space(4))) unsigned long long* q_ = (const __attribute__((address_space(4))) unsigned long long*)ap_; unsigned long long* d_ = (unsigned long long*)&a; _Pragma("unroll") for (int i_ = 0; i_ < (int)(sizeof(Args) / 8); ++i_) d_[i_] = q_[i_]; }
    for (int u = tid; u < (LDS_BYTES - LDSCTL_OFF) / 4; u += NWAVES * 64) ((LAS unsigned*)(lds + LDSCTL_OFF))[u] = 0u;
    __syncthreads();
    XcdBarrier bar = xcd_barrier_post((unsigned*)(ws + WS_CTL) + CW_BAR, (volatile LAS unsigned*)(lds + LDSCTL_OFF) + 8);
    const int lo = kargs.ph_lo, hi = kargs.ph_hi;
#ifndef PH_MASK
#define PH_MASK 0x7fff
#endif
#define IN(k) (((PH_MASK >> (k)) & 1) && lo <= (k) && (k) < hi)
#define SEAM(k) do { if (IN(k) && IN((k) + 1)) xcd_barrier(bar); } while (0)
    bf16* const HB = (bf16*)(ws + WS_HB);

    if (IN(0)) { LOAD_ARGS();
        for (int g = bx; g < NG5; g += G) s5_tables(a, g, lds, tid);
        LAS float* scr = (LAS float*)(lds + wave * 16640);
#define TR(src, K_, N_, dst, mode, nmat, sstride, dstride) do { const int nbk = (N_) / 64, per = ((K_) / 64) * nbk; \
        for (int it = gw; it < (nmat) * per; it += NGW) { const int mat = it / per, r = it % per; \
            transpose_item((src) + (size_t)mat * (sstride), (K_), (N_), (dst) + (size_t)mat * (dstride), (mode), scr, r / nbk, r % nbk, lane); } } while (0)
        TR(a.w_in, 2048, INC, (bf16*)(ws + WS_BTIN), 1, 1, 0, 0);
        TR(a.w_pp, PLED, 2048, (bf16*)(ws + WS_BTPP), 0, 1, 0, 0);
        TR(a.w_glu, 1024, 1024, (bf16*)(ws + WS_BTGLU), 0, 1, 0, 0);
        TR(a.w_bs, 1024, 2048, (bf16*)(ws + WS_BTPS), 0, 1, 0, 0);
        TR(a.w_br, 1024, 2048, (bf16*)(ws + WS_BTPR), 0, 1, 0, 0);
        TR(a.w_out, 2048, 2048, (bf16*)(ws + WS_BTOUT), 0, 1, 0, 0);
        TR(a.w_pg, 2048, 2048, (bf16*)(ws + WS_BTPG), 0, 1, 0, 0);
        TR(a.w_gu, 2048, 4096, (bf16*)(ws + WS_BTGU), 2, NEXP, (size_t)2048 * 4096, (size_t)4096 * 2048);
        TR(a.w_dn, 2048, 2048, (bf16*)(ws + WS_BTDN), 0, NEXP, (size_t)2048 * 2048, (size_t)2048 * 2048);
#undef TR
        for (int t = gw; t < SEQ; t += NGW) rms_row_bf16(a.x + (size_t)t * 2048, a.norm1_g, HB + (size_t)t * 2048, lane);
        { float* cs = (float*)(ws + WS_CS); float* sn = (float*)(ws + WS_SN);
          for (int e = gtid; e < SEQ * 64; e += GT) { const int t = e >> 6, i = e & 63; const float inv = powf(10000.0f, -(float)i / 64.0f), ang = (float)a.pos[t] * inv; cs[e] = cosf(ang); sn[e] = sinf(ang); } }
        { float* wg = (float*)(ws + WS_WG); for (int e = gtid; e < 2048 * 32; e += GT) wg[e] = a.norm2_g[e >> 5] * a.router_w[e]; }
        { v2u* pb = (v2u*)(ws + WS_PBF); const f32x4* pf = (const f32x4*)a.p;
          for (int e = gtid; e < SEQ * PLED / 4; e += GT) { const f32x4 v = pf[e]; v2u o; o.x = pk2(v.x, v.y); o.y = pk2(v.z, v.w); pb[e] = o; } }
    }
    SEAM(0);
    if (IN(1)) { LOAD_ARGS();
#ifndef P1_MASK
#define P1_MASK 15
#endif
        if (P1_MASK & 1) { pg8::Gemm g{HB, (const bf16*)(ws + WS_BTIN), 2048, 2048, 2048}; pg8::StaticOrder S; S.init(SEQ, 1024, G, bx);
          pg8::EpiZU E{(bf16*)(ws + WS_XG5)};
          pg8::gemm_phase<pg8::EpiZU, pg8::StaticOrder, true, true>(lds + RING_OFF, g, S, E); }
        if (P1_MASK & 2) { pg8::Gemm g{HB, (const bf16*)(ws + WS_BTIN) + (size_t)1024 * 2048, 2048, 2048, 2048}; pg8::StaticOrder S; S.init(SEQ, 2048, G, bx);
          pg8::EpiZR E{(bf16*)(ws + WS_Q), (bf16*)(ws + WS_K), (const float*)(ws + WS_CS), (const float*)(ws + WS_SN)};
          pg8::gemm_phase<pg8::EpiZR, pg8::StaticOrder, true, true>(lds + RING_OFF, g, S, E); }
        if (P1_MASK & 4) { pg8::Gemm g{HB, (const bf16*)(ws + WS_BTIN) + (size_t)3072 * 2048, 2048, 2048, 2048}; pg8::StaticOrder S; S.init(SEQ, 6144, G, bx);
          pg8::EpiZA E{(bf16*)(ws + WS_V), (bf16*)(ws + WS_GS), (bf16*)(ws + WS_SGS), (bf16*)(ws + WS_SGR)};
          pg8::gemm_phase<pg8::EpiZA, pg8::StaticOrder, true, true>(lds + RING_OFF, g, S, E); }
        if (P1_MASK & 8) { pg8::Gemm g{(const bf16*)(ws + WS_PBF), (const bf16*)(ws + WS_BTPP), PLED, PLED, PLED}; pg8::StaticOrder S; S.init(SEQ, 2048, G, bx);
          pg8::EpiPlain E{(bf16*)(ws + WS_PP), 2048};
          pg8::gemm_phase<pg8::EpiPlain, pg8::StaticOrder, true, true>(lds + RING_OFF, g, S, E); }
    }
    SEAM(1);
    if (IN(2)) { LOAD_ARGS();
        { pg8::Gemm g{(const bf16*)(ws + WS_XG5), (const bf16*)(ws + WS_BTS1), K5, 512, 512}; pg8::OrderS1 S{G, bx}; pg8::EpiS1 E{(float*)(ws + WS_SLOC)};
          pg8::gemm_phase<pg8::EpiS1, pg8::OrderS1, false, true>(lds + RING_OFF, g, S, E); }
        __syncthreads();
        for (int u = bx; u < NRC * RH; u += G) ret_kv_unit(a, u, lds, tid);
    }
    SEAM(2);
    if (IN(3)) { LOAD_ARGS();
        for (int it = G - 1 - bx; it < 128; it += G) s5_scan_item(a, it, lds, tid);
        ret_state_scan(a, gtid, GT);
    }
    SEAM(3);
    if (IN(4)) { LOAD_ARGS();
        { pg8::Gemm g{(const bf16*)(ws + WS_XG5), (const bf16*)(ws + WS_BTS3), K5, K5, K5}; pg8::OrderS3 S{G, bx}; pg8::EpiS3 E{(bf16*)(ws + WS_YSP)};
          pg8::gemm_phase<pg8::EpiS3, pg8::OrderS3, false, true>(lds + RING_OFF, g, S, E); }
        __syncthreads();
        for (int u = bx; u < NRC * RH; u += G) ret_out_unit(a, u, lds, tid);
    }
    SEAM(4);
    if (IN(5)) { LOAD_ARGS();
        pg8::Gemm g{(const bf16*)(ws + WS_YSP), (const bf16*)(ws + WS_BTGLU), 1024, 1024, 1024}; pg8::StaticOrder S; S.init(SEQ, 1024, G, bx);
        pg8::EpiGLU E{(const bf16*)(ws + WS_YSP), a.b_glu, (bf16*)(ws + WS_YS)};
        pg8::gemm_phase<pg8::EpiGLU, pg8::StaticOrder, true, true>(lds + RING_OFF, g, S, E);
    }
    SEAM(5);
    if (IN(6)) { LOAD_ARGS();
        { pg8::Gemm g{(const bf16*)(ws + WS_YS), (const bf16*)(ws + WS_BTPS), 1024, 1024, 1024}; pg8::StaticOrder S; S.init(SEQ, 2048, G, bx);
          pg8::EpiM1 E{(const bf16*)(ws + WS_SGS), (float*)(ws + WS_TMP)};
          pg8::gemm_phase<pg8::EpiM1, pg8::StaticOrder, true, true>(lds + RING_OFF, g, S, E); }
        VM_WAIT(); __syncthreads();
        { pg8::Gemm g{(const bf16*)(ws + WS_YR), (const bf16*)(ws + WS_BTPR), 1024, 1024, 1024}; pg8::StaticOrder S; S.init(SEQ, 2048, G, bx);
          pg8::EpiM2 E{(const bf16*)(ws + WS_SGR), (const float*)(ws + WS_TMP), (bf16*)(ws + WS_MRG)};
          pg8::gemm_phase<pg8::EpiM2, pg8::StaticOrder, true, true>(lds + RING_OFF, g, S, E); }
    }
    SEAM(6);
    if (IN(7)) { LOAD_ARGS();
        pg8::Gemm g{(const bf16*)(ws + WS_MRG), (const bf16*)(ws + WS_BTOUT), 2048, 2048, 2048}; pg8::StaticOrder S; S.init(SEQ, 2048, G, bx);
        pg8::EpiRes E{a.x, (float*)(ws + WS_X2)};
        pg8::gemm_phase<pg8::EpiRes, pg8::StaticOrder, true, true>(lds + RING_OFF, g, S, E);
    }
    SEAM(7);
    if (IN(8)) { LOAD_ARGS(); for (int it = bx; it < SEQ / 64; it += G) router_item(a, it, lds, tid); }
    SEAM(8);
    if (IN(9)) { LOAD_ARGS();
        LAS int* ps = (LAS int*)lds;
        if (tid == 0) { int accp = 0; for (int e = 0; e < NEXP; ++e) { const int c = (int)__hip_atomic_load((unsigned*)(ws + WS_CTL) + CW_CNT + e, RLX_AGENT); ps[e] = accp; accp += (c + 255) / 256 * 256; } ps[NEXP] = accp; }
        __syncthreads();
        int* blke = (int*)(ws + WS_BLKE);
        if (bx == 0 && tid < NEXP) { for (int rt = ps[tid] >> 8; rt < (ps[tid + 1] >> 8); ++rt) blke[rt] = tid; }
        if (bx == 0 && tid == 0) blke[511] = ps[NEXP] >> 8;
        const int* toke = (const int*)(ws + WS_TOKE); const int* tokp = (const int*)(ws + WS_TOKP); const float* tokg = (const float*)(ws + WS_TOKG);
        float* rowg = (float*)(ws + WS_ROWG); int* arow = (int*)(ws + WS_AROW);
        for (int as = gw; as < SEQ * 4; as += NGW) { const int tok = as >> 2, row = ps[toke[as]] + tokp[as];
            const v4u* s = (const v4u*)(HB + (size_t)tok * 2048) + lane; v4u* d = (v4u*)((bf16*)(ws + WS_XG) + (size_t)row * 2048) + lane;
            const v4u v0 = s[0], v1 = s[64], v2 = s[128], v3 = s[192]; d[0] = v0; d[64] = v1; d[128] = v2; d[192] = v3;
            if (lane == 0) { rowg[row] = tokg[as]; arow[as] = row; } }
        __syncthreads();
    }
    SEAM(9);
    if (IN(10)) { LOAD_ARGS();
        const int* blke = (const int*)(ws + WS_BLKE); const int nrt = blke[511];
        pg8::Gemm g{(const bf16*)(ws + WS_XG), (const bf16*)(ws + WS_BTGU), 2048, 2048, 2048}; pg8::OrderMoe S; S.so.init(nrt * 256, 4096, G, bx); S.blk_e = blke; S.ntn = 16;
        pg8::EpiGU E{a.b_gu, (bf16*)(ws + WS_ACT)};
        pg8::gemm_phase<pg8::EpiGU, pg8::OrderMoe, true, true>(lds + RING_OFF, g, S, E);
    }
    SEAM(10);
    if (IN(11)) { LOAD_ARGS();
        const int* blke = (const int*)(ws + WS_BLKE); const int nrt = blke[511];
        pg8::Gemm g{(const bf16*)(ws + WS_ACT), (const bf16*)(ws + WS_BTDN), 2048, 2048, 2048}; pg8::OrderMoe S; S.so.init(nrt * 256, 2048, G, bx); S.blk_e = blke; S.ntn = 8;
        pg8::EpiDN E{a.b_dn, (const float*)(ws + WS_ROWG), (bf16*)(ws + WS_YB)};
        pg8::gemm_phase<pg8::EpiDN, pg8::OrderMoe, true, true>(lds + RING_OFF, g, S, E);
    }
    SEAM(11);
    if (IN(12)) { LOAD_ARGS();
        const int* arow = (const int*)(ws + WS_AROW); const bf16* yb = (const bf16*)(ws + WS_YB);
        for (int t = gw; t < SEQ; t += NGW) { f32x4* xr = (f32x4*)((float*)(ws + WS_X2) + (size_t)t * 2048) + lane;
            const int r0 = arow[t * 4], r1 = arow[t * 4 + 1], r2 = arow[t * 4 + 2], r3 = arow[t * 4 + 3];
            const v2u* y0 = (const v2u*)(yb + (size_t)r0 * 2048) + lane; const v2u* y1 = (const v2u*)(yb + (size_t)r1 * 2048) + lane;
            const v2u* y2 = (const v2u*)(yb + (size_t)r2 * 2048) + lane; const v2u* y3 = (const v2u*)(yb + (size_t)r3 * 2048) + lane;
            f32x4 v[8]; float s = 0.f;
#pragma unroll
            for (int j = 0; j < 8; ++j) { f32x4 x = xr[64 * j]; const v2u w0 = y0[64 * j], w1 = y1[64 * j], w2 = y2[64 * j], w3 = y3[64 * j];
                x.x += (pg8::bf_lo(w0.x) + pg8::bf_lo(w1.x)) + (pg8::bf_lo(w2.x) + pg8::bf_lo(w3.x)); x.y += (pg8::bf_hi(w0.x) + pg8::bf_hi(w1.x)) + (pg8::bf_hi(w2.x) + pg8::bf_hi(w3.x));
                x.z += (pg8::bf_lo(w0.y) + pg8::bf_lo(w1.y)) + (pg8::bf_lo(w2.y) + pg8::bf_lo(w3.y)); x.w += (pg8::bf_hi(w0.y) + pg8::bf_hi(w1.y)) + (pg8::bf_hi(w2.y) + pg8::bf_hi(w3.y));
                v[j] = x; xr[64 * j] = x; s += (x.x * x.x + x.y * x.y) + (x.z * x.z + x.w * x.w); }
            const float rstd = 1.0f / sqrtf(wave_sum(s) * (1.0f / 2048.0f) + 1e-6f);
            const f32x4* gr = (const f32x4*)a.norm3_g + lane; v2u* o8 = (v2u*)(HB + (size_t)t * 2048) + lane;
#pragma unroll
            for (int j = 0; j < 8; ++j) { const f32x4 g = gr[64 * j]; v2u o; o.x = pk2(v[j].x * rstd * g.x, v[j].y * rstd * g.y); o.y = pk2(v[j].z * rstd * g.z, v[j].w * rstd * g.w); o8[64 * j] = o; } }
    }
    SEAM(12);
    if (IN(13)) { LOAD_ARGS();
        pg8::Gemm g{HB, (const bf16*)(ws + WS_BTPG), 2048, 2048, 2048}; pg8::StaticOrder S; S.init(SEQ, 2048, G, bx);
        pg8::EpiPLE E{(const float*)(ws + WS_X2), (const bf16*)(ws + WS_PP), a.out};
        pg8::gemm_phase<pg8::EpiPLE, pg8::StaticOrder, true, true>(lds + RING_OFF, g, S, E);
    }
    SEAM(13);
    if (IN(14)) { LOAD_ARGS();
        for (int t = gw; t < SEQ; t += NGW) { f32x4* xr = (f32x4*)(a.out + (size_t)t * 2048) + lane; const f32x4* gr = (const f32x4*)a.fin_g + lane;
            f32x4 v[8]; float s = 0.f;
#pragma unroll
            for (int j = 0; j < 8; ++j) { v[j] = xr[64 * j]; s += (v[j].x * v[j].x + v[j].y * v[j].y) + (v[j].z * v[j].z + v[j].w * v[j].w); }
            const float rstd = 1.0f / sqrtf(wave_sum(s) * (1.0f / 2048.0f) + 1e-6f);
#pragma unroll
            for (int j = 0; j < 8; ++j) xr[64 * j] = v[j] * rstd * gr[64 * j]; }
    }
#undef IN
#undef SEAM
}

extern "C" void kernel_launch(void* const* d_in, const int* in_sizes, int n_in, void* d_out, int out_size, void* d_ws, size_t ws_size, hipStream_t stream) {
    static int grid = 0;
    if (grid == 0) {
        if (n_in != 29 || in_sizes[0] != SEQ * DM || out_size != SEQ * DM || ws_size < WS_END) { fprintf(stderr, "kernel_launch: unexpected shapes (n_in %d, ws %zu < %zu?)\n", n_in, ws_size, (size_t)WS_END); grid = -1; return; }
        int dev = 0, cus = 0, per_cu = 0;
        if (hipGetDevice(&dev) != hipSuccess || hipDeviceGetAttribute(&cus, hipDeviceAttributeMultiprocessorCount, dev) != hipSuccess) { grid = -1; return; }
        if (hipFuncSetAttribute((const void*)mk_fwd, hipFuncAttributeMaxDynamicSharedMemorySize, LDS_BYTES) != hipSuccess) { fprintf(stderr, "kernel_launch: hipFuncSetAttribute failed\n"); grid = -1; return; }
        if (hipOccupancyMaxActiveBlocksPerMultiprocessor(&per_cu, (const void*)mk_fwd, NWAVES * 64, LDS_BYTES) != hipSuccess || per_cu < 1) { fprintf(stderr, "kernel_launch: occupancy query says %d\n", per_cu); }
        (void)hipGetLastError();
        grid = cus;
    }
    if (grid < 0) return;
    if (hipMemsetAsync((char*)d_ws + WS_CTL, 0, CTL_ZERO_BYTES, stream) != hipSuccess) return;
    Args a{};
    a.x = (const float*)d_in[0]; a.p = (const float*)d_in[1]; a.pos = (const int*)d_in[2]; a.norm1_g = (const float*)d_in[3]; a.w_in = (const float*)d_in[4];
    a.lam_re = (const float*)d_in[5]; a.lam_im = (const float*)d_in[6]; a.log_dt = (const float*)d_in[7]; a.b_re = (const float*)d_in[8]; a.b_im = (const float*)d_in[9];
    a.c_re = (const float*)d_in[10]; a.c_im = (const float*)d_in[11]; a.d_skip = (const float*)d_in[12]; a.w_glu = (const float*)d_in[13]; a.b_glu = (const float*)d_in[14];
    a.w_bs = (const float*)d_in[15]; a.w_br = (const float*)d_in[16]; a.w_out = (const float*)d_in[17]; a.norm2_g = (const float*)d_in[18]; a.router_w = (const float*)d_in[19];
    a.router_b = (const float*)d_in[20]; a.w_gu = (const float*)d_in[21]; a.b_gu = (const float*)d_in[22]; a.w_dn = (const float*)d_in[23]; a.b_dn = (const float*)d_in[24];
    a.norm3_g = (const float*)d_in[25]; a.w_pg = (const float*)d_in[26]; a.w_pp = (const float*)d_in[27]; a.fin_g = (const float*)d_in[28];
    a.out = (float*)d_out; a.ws = (unsigned char*)d_ws;
#if MK_N_LAUNCHES == 1
    a.ph_lo = 0; a.ph_hi = N_PHASES;
    hipLaunchKernelGGL(mk_fwd, dim3(grid), dim3(NWAVES * 64), LDS_BYTES, stream, a);
#else
    for (int ph = 0; ph < N_PHASES; ++ph) { a.ph_lo = ph; a.ph_hi = ph + 1; hipLaunchKernelGGL(mk_fwd, dim3(grid), dim3(NWAVES * 64), LDS_BYTES, stream, a); }
#endif
    const hipError_t le = hipPeekAtLastError();
    if (le != hipSuccess) fprintf(stderr, "kernel_launch: launch failed: %s\n", hipGetErrorName(le));
}
```

```cpp
#include <hip/hip_runtime.h>
#include <cstdio>
#include <cstdint>

#ifndef MK_N_LAUNCHES
#define MK_N_LAUNCHES 1
#endif

constexpr int SEQ = 16384, DM = 2048, INC = 9216, NEXP = 32, FFN = 2048, PLED = 256;
constexpr int NG5 = 64, T5 = 32, NCH5 = SEQ / T5, K5 = 640;
constexpr int RCH = 128, NRC = SEQ / RCH, RH = 8;
constexpr int MAXROWS = SEQ * 4 + NEXP * 256;

namespace pg8 {
#define PG8_LAS __attribute__((address_space(3)))
typedef unsigned short bf16_t;
typedef short bf16x8 __attribute__((ext_vector_type(8)));
typedef float f32x4 __attribute__((ext_vector_type(4)));
typedef unsigned u32x4 __attribute__((ext_vector_type(4)));
typedef unsigned u32x2 __attribute__((ext_vector_type(2)));
constexpr int BM = 256, BK = 64, HALF = 128, HTB = HALF * BK * 2, STAGE_BYTES = 8 * HTB, NXCD = 8, WGM = 8;

__host__ __device__ __forceinline__ int lds_byte(int r, int c) { const int st = (r >> 4) * 2 + (c >> 5), rr = r & 15, cc = c & 31, ob = rr * 64 + cc * 2; return st * 1024 + (ob ^ (((ob >> 9) & 1) << 5)); }
__host__ __device__ __forceinline__ void stage_rc(int b, int& R, int& C) { const int st = b / 1024, sb = b % 1024, swz = sb ^ (((sb >> 9) & 1) << 5); R = (st >> 1) * 16 + swz / 64; C = (st & 1) * 32 + (swz % 64) / 2; }
__host__ __device__ __forceinline__ int perm32(int rho) { const int n = rho >> 4, i = rho & 15; return 8 * (i >> 2) + 4 * n + (i & 3); }

struct Unit { int pm, pn; };
struct Gemm { const bf16_t* A; const bf16_t* Bt; int lda, ldb, K; };

struct StaticOrder {
    int nM, nN, nwg, G, c;
    __host__ __device__ void init(int M, int N, int G_, int c_) { nM = M / BM; nN = N / BM; nwg = nM * nN; G = G_; c = c_; }
    __host__ __device__ bool next(int i, Unit& u) const {
        const long L = (long)i * G + c; if (L >= nwg) return false;
        int wgid = (int)L; { const int q = nwg / NXCD, r = nwg % NXCD, xcd = wgid % NXCD, off = wgid / NXCD; wgid = (xcd < r ? xcd * (q + 1) : r * (q + 1) + (xcd - r) * q) + off; }
        const int nig = WGM * nN, gid = wgid / nig, fm = gid * WGM, gsz = (nM - fm) < WGM ? (nM - fm) : WGM;
        u.pm = fm + ((wgid % nig) % gsz); u.pn = (wgid % nig) / gsz; return true;
    }
    __device__ __forceinline__ void a_ready(const Unit&) const {}
    __device__ __forceinline__ void done(const Unit&) const {}
};
struct OrderS3 {
    int G, c;
    __device__ bool next(int i, Unit& u) const { const int L = i * G + c; if (L >= 256) return false; const int g = L >> 2; u.pm = 2 * g + ((L >> 1) & 1); u.pn = 2 * g + (L & 1); return true; }
    __device__ __forceinline__ void a_ready(const Unit&) const {}
    __device__ __forceinline__ void done(const Unit&) const {}
};
struct OrderS1 {
    int G, c;
    __device__ bool next(int i, Unit& u) const { const int L = i * G + c; if (L >= 128) return false; u.pm = L; u.pn = L >> 1; return true; }
    __device__ __forceinline__ void a_ready(const Unit&) const {}
    __device__ __forceinline__ void done(const Unit&) const {}
};
struct OrderMoe {
    StaticOrder so; const int* blk_e; int ntn;
    __device__ bool next(int i, Unit& u) const { if (!so.next(i, u)) return false; u.pn = blk_e[u.pm] * ntn + u.pn; return true; }
    __device__ __forceinline__ void a_ready(const Unit&) const {}
    __device__ __forceinline__ void done(const Unit&) const {}
};

__device__ __forceinline__ unsigned cvt_pk_bf16(float lo, float hi) { unsigned r; asm volatile("v_cvt_pk_bf16_f32 %0, %1, %2" : "=v"(r) : "v"(lo), "v"(hi)); return r; }
__device__ __forceinline__ u32x4 pack8(const f32x4& a, const f32x4& b) { u32x4 w; w.x = cvt_pk_bf16(a[0], a[1]); w.y = cvt_pk_bf16(a[2], a[3]); w.z = cvt_pk_bf16(b[0], b[1]); w.w = cvt_pk_bf16(b[2], b[3]); return w; }
__device__ __forceinline__ float bf_lo(unsigned w) { return __builtin_bit_cast(float, w << 16); }
__device__ __forceinline__ float bf_hi(unsigned w) { return __builtin_bit_cast(float, w & 0xffff0000u); }
__device__ __forceinline__ void unpack8(const u32x4& w, f32x4& a, f32x4& b) { a = (f32x4){bf_lo(w.x), bf_hi(w.x), bf_lo(w.y), bf_hi(w.y)}; b = (f32x4){bf_lo(w.z), bf_hi(w.z), bf_lo(w.w), bf_hi(w.w)}; }
__device__ __forceinline__ float sigm(float x) { return __builtin_amdgcn_rcpf(1.0f + __builtin_amdgcn_exp2f(-1.4426950408889634f * x)); }
__device__ __forceinline__ f32x4 sigm4(const f32x4& x) { return (f32x4){sigm(x[0]), sigm(x[1]), sigm(x[2]), sigm(x[3])}; }
__device__ __forceinline__ float gelu_t(float x) { return x * sigm(1.5957691216057308f * (x + 0.044715f * x * x * x)); }
__device__ __forceinline__ f32x4 gelu4(const f32x4& x) { return (f32x4){gelu_t(x[0]), gelu_t(x[1]), gelu_t(x[2]), gelu_t(x[3])}; }

#define EPI_LOOP_AM _Pragma("unroll") for (int ai = 0; ai < 2; ++ai) _Pragma("unroll") for (int m = 0; m < 4; ++m)
#define EPI_LOOP_BJ _Pragma("unroll") for (int bj = 0; bj < 2; ++bj)
typedef f32x4 AccT[2][2][4][2];
#ifndef EPIZ_MASK
#define EPIZ_MASK 31
#endif
#define EPIZ_EN(k) ((EPIZ_MASK >> (k)) & 1)

struct EpiZU {
    static constexpr bool PERM = true, AFTER_DRAIN = false;
    bf16_t* xg5;
    __device__ __forceinline__ void operator()(const AccT& acc, const Unit& u, int wr, int wc, int fr, int fq) const {
        const int row0 = u.pm * BM + wr * 64 + fr, tc = wc * 32 + 8 * fq, pn = u.pn;
        EPI_LOOP_AM { const int t = row0 + ai * HALF + m * 16, j = t >> 5, i = t & 31;
            EPI_LOOP_BJ { const int col = pn * BM + bj * HALF + tc, g = col >> 4, c0 = col & 15;
                *(u32x4*)(xg5 + ((size_t)(g * NCH5 + j) * K5 + i * 16 + c0)) = pack8(acc[ai][bj][m][0], acc[ai][bj][m][1]); } }
    }
};
struct EpiZR {
    static constexpr bool PERM = true, AFTER_DRAIN = false;
    bf16_t *q, *k; const float *cs, *sn;
    __device__ __forceinline__ void operator()(const AccT& acc, const Unit& u, int wr, int wc, int fr, int fq) const {
        const int row0 = u.pm * BM + wr * 64 + fr, pn = u.pn;
        const bool isk = pn >= 4; bf16_t* dst = isk ? k : q; const float sc = isk ? 0.08838834764831845f : 1.0f;
        const int head = 2 * (pn & 3) + (wc >> 1), dd = 32 * (wc & 1) + 8 * fq;
        EPI_LOOP_AM { const int t = row0 + ai * HALF + m * 16;
            const float* cp = cs + (size_t)t * 64 + dd; const float* sp = sn + (size_t)t * 64 + dd;
            const f32x4 c0 = *(const f32x4*)cp * sc, c1 = *(const f32x4*)(cp + 4) * sc, s0 = *(const f32x4*)sp * sc, s1 = *(const f32x4*)(sp + 4) * sc;
            const f32x4 x1a = acc[ai][0][m][0], x1b = acc[ai][0][m][1], x2a = acc[ai][1][m][0], x2b = acc[ai][1][m][1];
            bf16_t* o = dst + (size_t)t * 1024 + head * 128 + dd;
            *(u32x4*)o = pack8(x1a * c0 - x2a * s0, x1b * c1 - x2b * s1);
            *(u32x4*)(o + 64) = pack8(x1a * s0 + x2a * c0, x1b * s1 + x2b * c1); asm volatile("" ::: "memory"); }
    }
};
struct EpiZA {
    static constexpr bool PERM = true, AFTER_DRAIN = false;
    bf16_t *v, *gs, *sgs, *sgr;
    __device__ __forceinline__ void operator()(const AccT& acc, const Unit& u, int wr, int wc, int fr, int fq) const {
        const int row0 = u.pm * BM + wr * 64 + fr, tc = wc * 32 + 8 * fq, pn = u.pn;
        bf16_t* dst = pn < 4 ? v : (pn < 8 ? gs : (pn < 16 ? sgs : sgr));
        const int ldc = pn < 8 ? 1024 : 2048, cb = (pn < 8 ? (pn & 3) : (pn & 7)) * BM + tc;
        const float ka = pn < 4 ? 0.0f : 1.0f, kb = (pn >= 4 && pn < 8) ? 1.0f : 0.0f;
        EPI_LOOP_AM { const size_t off = (size_t)(row0 + ai * HALF + m * 16) * ldc + cb;
            EPI_LOOP_BJ { f32x4 r[2];
#pragma unroll
                for (int n = 0; n < 2; ++n) { const f32x4 x = acc[ai][bj][m][n], sg = sigm4(x); r[n] = x * (1.0f - ka) + sg * (ka - kb) + (x * sg) * kb; }
                *(u32x4*)(dst + off + bj * HALF) = pack8(r[0], r[1]); } }
    }
};
struct EpiS1 {
    static constexpr bool PERM = true, AFTER_DRAIN = false;
    float* sloc;
    __device__ __forceinline__ void operator()(const AccT& acc, const Unit& u, int wr, int wc, int fr, int fq) const {
        const int row0 = u.pm * BM + wr * 64 + fr, tc = wc * 32 + 8 * fq;
        EPI_LOOP_AM { float* o = sloc + (size_t)(row0 + ai * HALF + m * 16) * 128 + tc; *(f32x4*)o = acc[ai][0][m][0]; *(f32x4*)(o + 4) = acc[ai][0][m][1]; }
    }
};
struct EpiS3 {
    static constexpr bool PERM = true, AFTER_DRAIN = false;
    bf16_t* ysp;
    __device__ __forceinline__ void operator()(const AccT& acc, const Unit& u, int wr, int wc, int fr, int fq) const {
        const int g = u.pm >> 1, j0 = (u.pm & 1) * BM + wr * 64 + fr, cl0 = (u.pn & 1) * BM + wc * 32 + 8 * fq;
        EPI_LOOP_AM { const int j = j0 + ai * HALF + m * 16;
            EPI_LOOP_BJ { const int cl = cl0 + bj * HALF, i = cl >> 4, c0 = cl & 15;
                *(u32x4*)(ysp + (size_t)(j * T5 + i) * 1024 + g * 16 + c0) = pack8(gelu4(acc[ai][bj][m][0]), gelu4(acc[ai][bj][m][1])); } }
    }
};
struct EpiGLU {
    static constexpr bool PERM = true, AFTER_DRAIN = false;
    const bf16_t* ysp; const float* bias; bf16_t* ys;
    __device__ __forceinline__ void operator()(const AccT& acc, const Unit& u, int wr, int wc, int fr, int fq) const {
        const int row0 = u.pm * BM + wr * 64 + fr, col0 = u.pn * BM + wc * 32 + 8 * fq;
        f32x4 bv[2][2];
        EPI_LOOP_BJ { bv[bj][0] = *(const f32x4*)(bias + col0 + bj * HALF); bv[bj][1] = *(const f32x4*)(bias + col0 + bj * HALF + 4); }
        EPI_LOOP_AM { const size_t off = (size_t)(row0 + ai * HALF + m * 16) * 1024 + col0;
            EPI_LOOP_BJ { f32x4 ya, yb; unpack8(*(const u32x4*)(ysp + off + bj * HALF), ya, yb);
                *(u32x4*)(ys + off + bj * HALF) = pack8(ya * sigm4(acc[ai][bj][m][0] + bv[bj][0]), yb * sigm4(acc[ai][bj][m][1] + bv[bj][1])); } }
    }
};
struct EpiM1 {
    static constexpr bool PERM = true, AFTER_DRAIN = false;
    const bf16_t* sg; float* tmp;
    __device__ __forceinline__ void operator()(const AccT& acc, const Unit& u, int wr, int wc, int fr, int fq) const {
        const int row0 = u.pm * BM + wr * 64 + fr, col0 = u.pn * BM + wc * 32 + 8 * fq;
        EPI_LOOP_AM { const size_t off = (size_t)(row0 + ai * HALF + m * 16) * 2048 + col0;
            EPI_LOOP_BJ { f32x4 ga, gb; unpack8(*(const u32x4*)(sg + off + bj * HALF), ga, gb);
                *(f32x4*)(tmp + off + bj * HALF) = ga * acc[ai][bj][m][0]; *(f32x4*)(tmp + off + bj * HALF + 4) = gb * acc[ai][bj][m][1]; } }
    }
};
struct EpiM2 {
    static constexpr bool PERM = true, AFTER_DRAIN = false;
    const bf16_t* sg; const float* tmp; bf16_t* mrg;
    __device__ __forceinline__ void operator()(const AccT& acc, const Unit& u, int wr, int wc, int fr, int fq) const {
        const int row0 = u.pm * BM + wr * 64 + fr, col0 = u.pn * BM + wc * 32 + 8 * fq;
        EPI_LOOP_AM { const size_t off = (size_t)(row0 + ai * HALF + m * 16) * 2048 + col0;
            EPI_LOOP_BJ { f32x4 ga, gb; unpack8(*(const u32x4*)(sg + off + bj * HALF), ga, gb);
                const f32x4 ta = *(const f32x4*)(tmp + off + bj * HALF), tb = *(const f32x4*)(tmp + off + bj * HALF + 4);
                *(u32x4*)(mrg + off + bj * HALF) = pack8(ta + ga * acc[ai][bj][m][0], tb + gb * acc[ai][bj][m][1]); } }
    }
};
struct EpiRes {
    static constexpr bool PERM = true, AFTER_DRAIN = false;
    const float* x; float* o;
    __device__ __forceinline__ void operator()(const AccT& acc, const Unit& u, int wr, int wc, int fr, int fq) const {
        const int row0 = u.pm * BM + wr * 64 + fr, col0 = u.pn * BM + wc * 32 + 8 * fq;
        EPI_LOOP_AM { const size_t off = (size_t)(row0 + ai * HALF + m * 16) * 2048 + col0;
            EPI_LOOP_BJ { *(f32x4*)(o + off + bj * HALF) = *(const f32x4*)(x + off + bj * HALF) + acc[ai][bj][m][0];
                *(f32x4*)(o + off + bj * HALF + 4) = *(const f32x4*)(x + off + bj * HALF + 4) + acc[ai][bj][m][1]; } }
    }
};
struct EpiPlain {
    static constexpr bool PERM = true, AFTER_DRAIN = false;
    bf16_t* o; int ldc;
    __device__ __forceinline__ void operator()(const AccT& acc, const Unit& u, int wr, int wc, int fr, int fq) const {
        const int row0 = u.pm * BM + wr * 64 + fr, col0 = u.pn * BM + wc * 32 + 8 * fq;
        EPI_LOOP_AM { const size_t off = (size_t)(row0 + ai * HALF + m * 16) * ldc + col0;
            EPI_LOOP_BJ { *(u32x4*)(o + off + bj * HALF) = pack8(acc[ai][bj][m][0], acc[ai][bj][m][1]); } }
    }
};
struct EpiGU {
    static constexpr bool PERM = true, AFTER_DRAIN = false;
    const float* bgu; bf16_t* act;
    __device__ __forceinline__ void operator()(const AccT& acc, const Unit& u, int wr, int wc, int fr, int fq) const {
        const int e = u.pn >> 4, ct = u.pn & 15, row0 = u.pm * BM + wr * 64 + fr, f0 = ct * HALF + wc * 32 + 8 * fq;
        const float* bp = bgu + (size_t)e * 4096 + 2 * f0;
        const f32x4 b0 = *(const f32x4*)bp, b1 = *(const f32x4*)(bp + 4), b2 = *(const f32x4*)(bp + 8), b3 = *(const f32x4*)(bp + 12);
        const f32x4 bg0 = (f32x4){b0[0], b0[2], b1[0], b1[2]}, bu0 = (f32x4){b0[1], b0[3], b1[1], b1[3]}, bg1 = (f32x4){b2[0], b2[2], b3[0], b3[2]}, bu1 = (f32x4){b2[1], b2[3], b3[1], b3[3]};
        EPI_LOOP_AM { const size_t off = (size_t)(row0 + ai * HALF + m * 16) * FFN + f0;
            f32x4 r[2];
#pragma unroll
            for (int n = 0; n < 2; ++n) { const f32x4 gv = acc[ai][0][m][n] + (n ? bg1 : bg0), uv = acc[ai][1][m][n] + (n ? bu1 : bu0);
#pragma unroll
                for (int x = 0; x < 4; ++x) { const float gg = fminf(gv[x], 7.0f), uu = fminf(fmaxf(uv[x], -7.0f), 7.0f); r[n][x] = gg * sigm(1.702f * gg) * (uu + 1.0f); } }
            *(u32x4*)(act + off) = pack8(r[0], r[1]); }
    }
};
struct EpiDN {
    static constexpr bool PERM = true, AFTER_DRAIN = false;
    const float* bdn; const float* rowg; bf16_t* yb;
    __device__ __forceinline__ void operator()(const AccT& acc, const Unit& u, int wr, int wc, int fr, int fq) const {
        const int e = u.pn >> 3, ct = u.pn & 7, row0 = u.pm * BM + wr * 64 + fr, col0 = ct * BM + wc * 32 + 8 * fq;
        f32x4 bv[2][2];
        EPI_LOOP_BJ { bv[bj][0] = *(const f32x4*)(bdn + (size_t)e * 2048 + col0 + bj * HALF); bv[bj][1] = *(const f32x4*)(bdn + (size_t)e * 2048 + col0 + bj * HALF + 4); }
        EPI_LOOP_AM { const int row = row0 + ai * HALF + m * 16; const float gt = rowg[row]; const size_t off = (size_t)row * 2048 + col0;
            EPI_LOOP_BJ { *(u32x4*)(yb + off + bj * HALF) = pack8((acc[ai][bj][m][0] + bv[bj][0]) * gt, (acc[ai][bj][m][1] + bv[bj][1]) * gt); } }
    }
};
struct EpiPLE {
    static constexpr bool PERM = true, AFTER_DRAIN = false;
    const float* x3; const bf16_t* pp; float* o;
    __device__ __forceinline__ void operator()(const AccT& acc, const Unit& u, int wr, int wc, int fr, int fq) const {
        const int row0 = u.pm * BM + wr * 64 + fr, col0 = u.pn * BM + wc * 32 + 8 * fq;
        EPI_LOOP_AM { const size_t off = (size_t)(row0 + ai * HALF + m * 16) * 2048 + col0;
            EPI_LOOP_BJ { f32x4 pa, pb; unpack8(*(const u32x4*)(pp + off + bj * HALF), pa, pb);
                *(f32x4*)(o + off + bj * HALF) = *(const f32x4*)(x3 + off + bj * HALF) + sigm4(acc[ai][bj][m][0]) * pa;
                *(f32x4*)(o + off + bj * HALF + 4) = *(const f32x4*)(x3 + off + bj * HALF + 4) + sigm4(acc[ai][bj][m][1]) * pb; } }
    }
};

template <class Epi, class Sched, bool ALIGN_EPI = false, bool SP2 = false>
__device__ __forceinline__ void gemm_phase(PG8_LAS unsigned char* lds, const Gemm g, const Sched& S, const Epi& E) {
    const int tid = threadIdx.x, wid = __builtin_amdgcn_readfirstlane(tid >> 6), lane = tid & 63, wr = wid >> 2, wc = wid & 3, fr = lane & 15, fq = lane >> 4;
    const int K = g.K, nt = K / BK;
    unsigned voffA[2], voffB[2];
#pragma unroll
    for (int i = 0; i < 2; ++i) { int R, C; stage_rc(tid * 16 + i * 8192, R, C); const int Rb = Epi::PERM ? ((R & ~31) + perm32(R & 31)) : R;
        voffA[i] = (unsigned)(R * g.lda + C) * 2u; voffB[i] = (unsigned)(Rb * g.ldb + C) * 2u; }
    const size_t kstep = (size_t)(BK * 2);
    const size_t hstepA = (size_t)HALF * g.lda * 2, hstepB = (size_t)HALF * g.ldb * 2;
    const size_t tstepA = 2 * hstepA, tstepB = 2 * hstepB;
    const unsigned ldsw = (unsigned)wid * 1024u;
    const int aoff = lds_byte(wr * 64 + fr, fq * 8), boff = lds_byte(wc * 32 + fr, fq * 8);
#define PG8_SA(b, h) (((b) * 2 + (h)) * HTB)
#define PG8_SB(b, h) ((4 + (b) * 2 + (h)) * HTB)
#define PG8_STAGE(bufoff, gbase, voff) do { _Pragma("unroll") for (int _i = 0; _i < 2; ++_i) \
        __builtin_amdgcn_global_load_lds((const unsigned*)((const char*)(gbase) + (voff)[_i]), (PG8_LAS unsigned*)(lds + (bufoff) + ldsw + _i * 8192), 16, 0, 0); } while (0)
#define PG8_LDA(dst, b, h) do { _Pragma("unroll") for (int m = 0; m < 4; ++m) _Pragma("unroll") for (int k = 0; k < 2; ++k) dst[m][k] = *(const PG8_LAS bf16x8*)(lds + PG8_SA(b, h) + aoff + m * 2048 + k * 1024); } while (0)
#define PG8_LDB(dst, b, h) do { _Pragma("unroll") for (int n = 0; n < 2; ++n) _Pragma("unroll") for (int k = 0; k < 2; ++k) dst[n][k] = *(const PG8_LAS bf16x8*)(lds + PG8_SB(b, h) + boff + n * 2048 + k * 1024); } while (0)
#define PG8_MMA(ai, bj, At, Bt) do { __builtin_amdgcn_s_setprio(1); _Pragma("unroll") for (int m = 0; m < 4; ++m) _Pragma("unroll") for (int n = 0; n < 2; ++n) _Pragma("unroll") for (int k = 0; k < 2; ++k) \
        acc[ai][bj][m][n] = __builtin_amdgcn_mfma_f32_16x16x32_bf16(Bt[n][k], At[m][k], acc[ai][bj][m][n], 0, 0, 0); __builtin_amdgcn_s_setprio(0); } while (0)
#define PG8_WAIT_V(n) asm volatile("s_waitcnt vmcnt(" #n ")" ::: "memory")
#define PG8_WAIT_L(n) asm volatile("s_waitcnt lgkmcnt(" #n ")" ::: "memory")
#define PG8_BAR __builtin_amdgcn_s_barrier()
#define PG8_SCHED __builtin_amdgcn_sched_barrier(0)
    Unit cur, nxt; int ui = 0;
    if (!S.next(0, cur)) return;
    f32x4 acc[2][2][4][2];
#pragma unroll
    for (int a = 0; a < 2; ++a)
#pragma unroll
        for (int b = 0; b < 2; ++b)
#pragma unroll
            for (int m = 0; m < 4; ++m)
#pragma unroll
                for (int n = 0; n < 2; ++n) acc[a][b][m][n] = (f32x4){0.f, 0.f, 0.f, 0.f};
    bf16x8 At[4][2], B0[2][2], B1[2][2];
    const char* cA = (const char*)g.A + (size_t)cur.pm * tstepA; const char* cB = (const char*)g.Bt + (size_t)cur.pn * tstepB;
    S.a_ready(cur);
    if constexpr (SP2) {
        PG8_STAGE(PG8_SB(0, 0), cB, voffB); PG8_STAGE(PG8_SB(0, 1), cB + hstepB, voffB); PG8_STAGE(PG8_SA(0, 0), cA, voffA); PG8_STAGE(PG8_SA(0, 1), cA + hstepA, voffA);
        if (wr == 1) PG8_BAR;
        PG8_WAIT_V(2); PG8_BAR;
        PG8_STAGE(PG8_SB(1, 0), cB + kstep, voffB); PG8_STAGE(PG8_SA(1, 0), cA + kstep, voffA); PG8_STAGE(PG8_SB(1, 1), cB + hstepB + kstep, voffB);
        PG8_WAIT_V(6); PG8_BAR;
    } else {
        PG8_STAGE(PG8_SB(0, 0), cB, voffB); PG8_STAGE(PG8_SA(0, 0), cA, voffA); PG8_STAGE(PG8_SB(0, 1), cB + hstepB, voffB); PG8_STAGE(PG8_SA(0, 1), cA + hstepA, voffA);
        if (wr == 1) PG8_BAR;
        PG8_WAIT_V(4); PG8_BAR;
        PG8_STAGE(PG8_SB(1, 0), cB + kstep, voffB); PG8_STAGE(PG8_SA(1, 0), cA + kstep, voffA); PG8_STAGE(PG8_SB(1, 1), cB + hstepB + kstep, voffB);
        PG8_WAIT_V(6); PG8_BAR;
    }
    for (;;) {
        const bool has_next = S.next(ui + 1, nxt);
        const char* nA = has_next ? (const char*)g.A + (size_t)nxt.pm * tstepA : cA; const char* nB = has_next ? (const char*)g.Bt + (size_t)nxt.pn * tstepB : cB;
#pragma nounroll
        for (int t = 0; t < nt; t += 2) {
            const bool last = (t == nt - 2);
            const char* a1 = cA + (size_t)(t + 1) * kstep;
            const char* a2 = last ? nA : cA + (size_t)(t + 2) * kstep; const char* b2 = last ? nB : cB + (size_t)(t + 2) * kstep;
            const char* a3 = a2 + kstep; const char* b3 = b2 + kstep;
            if (last && has_next) S.a_ready(nxt);
            if constexpr (SP2) {
            PG8_LDB(B0, 0, 0); PG8_LDB(B1, 0, 1); PG8_SCHED; PG8_LDA(At, 0, 0); PG8_STAGE(PG8_SA(1, 1), a1 + hstepA, voffA);
            PG8_WAIT_V(8); PG8_WAIT_L(0); PG8_BAR; PG8_MMA(0, 0, At, B0); PG8_MMA(0, 1, At, B1); PG8_BAR; PG8_SCHED;
            PG8_LDA(At, 0, 1); PG8_STAGE(PG8_SB(0, 0), b2, voffB); PG8_STAGE(PG8_SB(0, 1), b2 + hstepB, voffB); PG8_STAGE(PG8_SA(0, 0), a2, voffA);
            PG8_WAIT_V(8); PG8_WAIT_L(0); PG8_BAR; PG8_MMA(1, 0, At, B0); PG8_MMA(1, 1, At, B1); PG8_BAR; PG8_SCHED;
            PG8_LDB(B0, 1, 0); PG8_LDB(B1, 1, 1); PG8_SCHED; PG8_LDA(At, 1, 0); PG8_STAGE(PG8_SA(0, 1), a2 + hstepA, voffA);
            PG8_WAIT_V(8); PG8_WAIT_L(0); PG8_BAR; PG8_MMA(0, 0, At, B0); PG8_MMA(0, 1, At, B1); PG8_BAR; PG8_SCHED;
            PG8_LDA(At, 1, 1); PG8_STAGE(PG8_SB(1, 0), b3, voffB); PG8_STAGE(PG8_SB(1, 1), b3 + hstepB, voffB); PG8_STAGE(PG8_SA(1, 0), a3, voffA);
            PG8_WAIT_V(8); PG8_WAIT_L(0); PG8_BAR; PG8_MMA(1, 0, At, B0); PG8_MMA(1, 1, At, B1); PG8_BAR; PG8_SCHED;
            } else {
            PG8_LDB(B0, 0, 0); PG8_SCHED; PG8_LDA(At, 0, 0); PG8_STAGE(PG8_SA(1, 1), a1 + hstepA, voffA);
            PG8_WAIT_L(8); PG8_BAR; PG8_WAIT_L(0); PG8_MMA(0, 0, At, B0); PG8_BAR; PG8_SCHED;
            PG8_LDB(B1, 0, 1); PG8_STAGE(PG8_SB(0, 0), b2, voffB);
            PG8_BAR; PG8_WAIT_L(0); PG8_MMA(0, 1, At, B1); PG8_BAR;
            PG8_LDA(At, 0, 1); PG8_STAGE(PG8_SA(0, 0), a2, voffA);
            PG8_BAR; PG8_WAIT_L(0); PG8_MMA(1, 0, At, B0); PG8_BAR; PG8_SCHED;
            PG8_STAGE(PG8_SB(0, 1), b2 + hstepB, voffB);
            PG8_WAIT_V(6); PG8_BAR; PG8_MMA(1, 1, At, B1); PG8_BAR;
            PG8_LDB(B0, 1, 0); PG8_SCHED; PG8_LDA(At, 1, 0); PG8_STAGE(PG8_SA(0, 1), a2 + hstepA, voffA);
            PG8_WAIT_L(8); PG8_BAR; PG8_WAIT_L(0); PG8_MMA(0, 0, At, B0); PG8_BAR; PG8_SCHED;
            PG8_LDB(B1, 1, 1); PG8_STAGE(PG8_SB(1, 0), b3, voffB);
            PG8_BAR; PG8_WAIT_L(0); PG8_MMA(0, 1, At, B1); PG8_BAR;
            PG8_LDA(At, 1, 1); PG8_STAGE(PG8_SA(1, 0), a3, voffA);
            PG8_BAR; PG8_WAIT_L(0); PG8_MMA(1, 0, At, B0); PG8_BAR; PG8_SCHED;
            PG8_STAGE(PG8_SB(1, 1), b3 + hstepB, voffB);
            PG8_WAIT_V(6); PG8_BAR; PG8_MMA(1, 1, At, B1); PG8_BAR;
            }
        }
        if constexpr (ALIGN_EPI) { if (wr == 0) PG8_BAR; }
        if constexpr (!Epi::AFTER_DRAIN) { E(acc, cur, wr, wc, fr, fq); S.done(cur); }
        if (!has_next) break;
#pragma unroll
        for (int a = 0; a < 2; ++a)
#pragma unroll
            for (int b = 0; b < 2; ++b)
#pragma unroll
                for (int m = 0; m < 4; ++m)
#pragma unroll
                    for (int n = 0; n < 2; ++n) acc[a][b][m][n] = (f32x4){0.f, 0.f, 0.f, 0.f};
        cur = nxt; cA = nA; cB = nB; ++ui;
        if constexpr (ALIGN_EPI) { if (wr == 1) PG8_BAR; }
    }
    PG8_WAIT_V(0);
    if constexpr (!ALIGN_EPI) { if (wr == 0) PG8_BAR; }
    PG8_BAR;
#undef PG8_SA
#undef PG8_SB
#undef PG8_STAGE
#undef PG8_LDA
#undef PG8_LDB
#undef PG8_MMA
#undef PG8_WAIT_V
#undef PG8_WAIT_L
#undef PG8_BAR
#undef PG8_SCHED
}
}

constexpr size_t MiB = 1u << 20;
constexpr size_t WS_CTL = 0, CTL_ZERO_BYTES = 1 * MiB;
constexpr size_t WS_BTIN  = 1 * MiB;
constexpr size_t WS_BTGLU = WS_BTIN + 36 * MiB;
constexpr size_t WS_BTPS  = WS_BTGLU + 2 * MiB;
constexpr size_t WS_BTPR  = WS_BTPS + 4 * MiB;
constexpr size_t WS_BTOUT = WS_BTPR + 4 * MiB;
constexpr size_t WS_BTPG  = WS_BTOUT + 8 * MiB;
constexpr size_t WS_BTPP  = WS_BTPG + 8 * MiB;
constexpr size_t WS_BTGU  = WS_BTPP + 1 * MiB;
constexpr size_t WS_BTDN  = WS_BTGU + 512 * MiB;
constexpr size_t WS_BTS3  = WS_BTDN + 256 * MiB;
constexpr size_t WS_BTS1  = WS_BTS3 + 40 * MiB;
constexpr size_t WS_ATAB  = WS_BTS1 + 16 * MiB;
constexpr size_t WS_CS    = WS_ATAB + 1 * MiB;
constexpr size_t WS_SN    = WS_CS + 4 * MiB;
constexpr size_t WS_WG    = WS_SN + 4 * MiB;
constexpr size_t WS_PBF   = WS_WG + 1 * MiB;
constexpr size_t WS_HB    = WS_PBF + 8 * MiB;
constexpr size_t WS_XG5   = WS_HB + 64 * MiB;
constexpr size_t WS_Q     = WS_XG5 + 40 * MiB;
constexpr size_t WS_K     = WS_Q + 32 * MiB;
constexpr size_t WS_V     = WS_K + 32 * MiB;
constexpr size_t WS_GS    = WS_V + 32 * MiB;
constexpr size_t WS_SGS   = WS_GS + 32 * MiB;
constexpr size_t WS_SGR   = WS_SGS + 64 * MiB;
constexpr size_t WS_SLOC  = WS_SGR + 64 * MiB;
constexpr size_t WS_KVT   = WS_SLOC + 16 * MiB;
constexpr size_t WS_RT    = WS_KVT + 64 * MiB;
constexpr size_t WS_YSP   = WS_RT + 32 * MiB;
constexpr size_t WS_YS    = WS_YSP + 32 * MiB;
constexpr size_t WS_YR    = WS_YS + 32 * MiB;
constexpr size_t WS_TMP   = WS_YR + 32 * MiB;
constexpr size_t WS_MRG   = WS_TMP + 128 * MiB;
constexpr size_t WS_X2    = WS_MRG + 64 * MiB;
constexpr size_t WS_PP    = WS_X2 + 128 * MiB;
constexpr size_t WS_TOKE  = WS_PP + 64 * MiB;
constexpr size_t WS_TOKG  = WS_TOKE + 1 * MiB;
constexpr size_t WS_TOKP  = WS_TOKG + 1 * MiB;
constexpr size_t WS_ROWG  = WS_TOKP + 1 * MiB;
constexpr size_t WS_AROW  = WS_ROWG + 1 * MiB;
constexpr size_t WS_BLKE  = WS_AROW + 1 * MiB;
constexpr size_t WS_XG    = WS_BLKE + 1 * MiB;
constexpr size_t WS_ACT   = WS_XG + 288 * MiB;
constexpr size_t WS_YB    = WS_ACT + 288 * MiB;
constexpr size_t WS_END   = WS_YB + 288 * MiB;
constexpr int CW_CNT = 64;
constexpr int CW_BAR = 4096;

constexpr int RING_OFF = 0, RING_BYTES = 131072;
constexpr int LDS_BYTES = 159744;
constexpr int LDSCTL_OFF = LDS_BYTES - 256;
constexpr int NWAVES = 8;

#define GAS __attribute__((address_space(1)))
#define LAS __attribute__((address_space(3)))
typedef unsigned short bf16;
typedef unsigned v4u __attribute__((ext_vector_type(4)));
typedef unsigned v2u __attribute__((ext_vector_type(2)));
typedef float f32x4 __attribute__((ext_vector_type(4)));
typedef float f32x16 __attribute__((ext_vector_type(16)));
typedef short bf16x8 __attribute__((ext_vector_type(8)));
#define RLX_AGENT __ATOMIC_RELAXED, __HIP_MEMORY_SCOPE_AGENT
#define LDS_WAIT() asm volatile("s_waitcnt lgkmcnt(0)" ::: "memory")
#define VM_WAIT() asm volatile("s_waitcnt vmcnt(0)" ::: "memory")
__device__ __forceinline__ unsigned f2bf(float f) { unsigned u = __builtin_bit_cast(unsigned, f); return (u + 0x7fffu + ((u >> 16) & 1u)) >> 16; }
__device__ __forceinline__ unsigned pk2(float lo, float hi) { return f2bf(lo) | (f2bf(hi) << 16); }
__device__ __forceinline__ float bf2f(unsigned short b) { return __builtin_bit_cast(float, (unsigned)b << 16); }

#define XB_TMO      128
#define XB_XCNT(j)  (256  + 64 * (j))
#define XB_XSUB(j)  (1280 + 64 * (j))
#define XB_XGEN(j)  (2304 + 64 * (j))
#define XB_TOP      3328
#define XB_TOPGEN   3392
#define XCD_BAR_WORDS 3456
#define XB_SPIN_CAP (1u << 20)
__device__ __forceinline__ unsigned xb_ld(unsigned* p)              { return __hip_atomic_load(p, __ATOMIC_RELAXED, __HIP_MEMORY_SCOPE_AGENT); }
__device__ __forceinline__ unsigned xb_add(unsigned* p, unsigned v) { return __hip_atomic_fetch_add(p, v, __ATOMIC_RELAXED, __HIP_MEMORY_SCOPE_AGENT); }
__device__ __forceinline__ unsigned xb_xcc_id() { return (unsigned)__builtin_amdgcn_s_getreg((3 << 11) | 20) & 0xFu; }
#define XB_SPIN(cond, bar) do { unsigned _sp = 0; while (cond) { __builtin_amdgcn_s_sleep(1); \
    if ((++_sp & 255u) == 0u) { if (xb_ld(&(bar)[XB_TMO])) break; if (_sp > XB_SPIN_CAP) { atomicAdd(&(bar)[XB_TMO], 1u); break; } } } } while (0)
struct XcdBarrier { unsigned* bar; unsigned x; volatile LAS unsigned* st; };
__device__ __forceinline__ XcdBarrier xcd_barrier_post(unsigned* bar, volatile LAS unsigned* st) {
    XcdBarrier b; b.bar = bar; b.x = xb_xcc_id(); b.st = st;
    if (threadIdx.x == 0) (void)xb_add(&bar[XB_XCNT(b.x)], 1u);
    return b;
}
__device__ __forceinline__ void xcd_barrier_complete(unsigned* bar, unsigned x, unsigned& nloc, unsigned& nx) {
    const unsigned G = gridDim.x * gridDim.y * gridDim.z;
    unsigned sum, cnt, mine, sp = 0u;
    for (;;) {
        sum = 0u; cnt = 0u; mine = 0u;
#pragma unroll
        for (unsigned j = 0; j < 16; ++j) { const unsigned c = xb_ld(&bar[XB_XCNT(j)]); sum += c; cnt += (c > 0u) ? 1u : 0u; mine = (j == x) ? c : mine; }
        if (sum == G) break;
        __builtin_amdgcn_s_sleep(1);
        if ((++sp & 255u) == 0u) { if (xb_ld(&bar[XB_TMO])) break; if (sp > XB_SPIN_CAP) { atomicAdd(&bar[XB_TMO], 1u); break; } }
    }
    nloc = mine > 0u ? mine : 1u; nx = cnt > 0u ? cnt : 1u;
}
__device__ __forceinline__ void xcd_barrier(const XcdBarrier& b) {
    asm volatile("s_waitcnt vmcnt(0)" ::: "memory");
    __syncthreads();
    if (threadIdx.x == 0) {
        unsigned* bar = b.bar;
        __builtin_amdgcn_s_waitcnt(0);
        unsigned nloc = b.st[0], nx = b.st[1];
        if (nloc == 0u) { xcd_barrier_complete(bar, b.x, nloc, nx); b.st[0] = nloc; b.st[1] = nx; }
        const unsigned old = xb_add(&bar[XB_XSUB(b.x)], 1u);
        const unsigned gen = old / nloc;
        if (old + 1u == (gen + 1u) * nloc) {
            __builtin_amdgcn_fence(__ATOMIC_RELEASE, "agent");
            asm volatile("s_waitcnt vmcnt(0)" ::: "memory");
            const unsigned og = xb_add(&bar[XB_TOP], 1u);
            const unsigned tg = og / nx;
            if (og + 1u == (tg + 1u) * nx) xb_add(&bar[XB_TOPGEN], 1u);
            else XB_SPIN(xb_ld(&bar[XB_TOPGEN]) == tg, bar);
            __builtin_amdgcn_fence(__ATOMIC_ACQUIRE, "agent");
            xb_add(&bar[XB_XGEN(b.x)], 1u);
            asm volatile("s_waitcnt vmcnt(0)" ::: "memory");
        } else {
            XB_SPIN(xb_ld(&bar[XB_XGEN(b.x)]) == gen, bar);
            __builtin_amdgcn_fence(__ATOMIC_ACQUIRE, "agent");
            asm volatile("s_waitcnt vmcnt(0)" ::: "memory");
        }
    }
    __syncthreads();
}

__device__ __forceinline__ float wave_sum(float v) {
#pragma unroll
    for (int o = 1; o < 64; o <<= 1) v += __shfl_xor(v, o);
    return v;
}
__device__ __forceinline__ int rowmap(int mode, int n) {
    if (mode == 1) { if (n < 1024 || n >= 3072) return n; const int nn = n - 1024, r = nn >> 10, hn = nn & 1023, head = hn >> 7, half = (hn >> 6) & 1, dd = hn & 63;
        return 1024 + r * 1024 + (head >> 1) * 256 + half * 128 + (head & 1) * 64 + dd; }
    if (mode == 2) { const int f = n >> 1, s = n & 1; return (f >> 7) * 256 + (f & 127) + 128 * s; }
    return n;
}
__device__ __forceinline__ void transpose_item(const float* W, int K, int N, bf16* WT, int mode, LAS float* scr, int kb, int nb, int lane) {
    const int k0 = 64 * kb, n0 = 64 * nb;
    const GAS float* src = (const GAS float*)W + (size_t)k0 * N + n0 + lane;
#pragma unroll
    for (int kq = 0; kq < 2; ++kq) { float r[32];
#pragma unroll
        for (int i = 0; i < 32; ++i) r[i] = src[(size_t)(kq * 32 + i) * N];
#pragma unroll
        for (int i = 0; i < 32; ++i) scr[(kq * 32 + i) * 65 + lane] = r[i]; }
    LDS_WAIT(); asm volatile("" ::: "memory");
    const int c = lane & 7;
    GAS bf16* dst = (GAS bf16*)WT;
#pragma unroll
    for (int j = 0; j < 8; ++j) { const int n = (lane >> 3) + 8 * j; const LAS float* s = scr + (8 * c) * 65 + n;
        v4u o; o.x = pk2(s[0 * 65], s[1 * 65]); o.y = pk2(s[2 * 65], s[3 * 65]); o.z = pk2(s[4 * 65], s[5 * 65]); o.w = pk2(s[6 * 65], s[7 * 65]);
        *(GAS v4u*)(dst + (size_t)rowmap(mode, n0 + n) * K + k0 + 8 * c) = o; }
    LDS_WAIT(); asm volatile("" ::: "memory");
}
__device__ __forceinline__ void rms_row_bf16(const float* xrow, const float* gain, bf16* orow, int lane) {
    const f32x4* xr = (const f32x4*)xrow + lane; const f32x4* gr = (const f32x4*)gain + lane;
    f32x4 v[8]; float s = 0.f;
#pragma unroll
    for (int j = 0; j < 8; ++j) { v[j] = xr[64 * j]; s += (v[j].x * v[j].x + v[j].y * v[j].y) + (v[j].z * v[j].z + v[j].w * v[j].w); }
    const float rstd = 1.0f / sqrtf(wave_sum(s) * (1.0f / 2048.0f) + 1e-6f);
    v2u* o8 = (v2u*)orow + lane;
#pragma unroll
    for (int j = 0; j < 8; ++j) { const f32x4 g = gr[64 * j]; v2u w; w.x = pk2(v[j].x * rstd * g.x, v[j].y * rstd * g.y); w.y = pk2(v[j].z * rstd * g.z, v[j].w * rstd * g.w); o8[64 * j] = w; }
}

struct Args {
    const float* x; const float* p; const int* pos; const float* norm1_g; const float* w_in;
    const float* lam_re; const float* lam_im; const float* log_dt; const float* b_re; const float* b_im; const float* c_re; const float* c_im; const float* d_skip;
    const float* w_glu; const float* b_glu; const float* w_bs; const float* w_br; const float* w_out; const float* norm2_g; const float* router_w; const float* router_b;
    const float* w_gu; const float* b_gu; const float* w_dn; const float* b_dn; const float* norm3_g; const float* w_pg; const float* w_pp; const float* fin_g;
    float* out; unsigned char* ws; int ph_lo, ph_hi, li, pad;
};

__device__ __forceinline__ void s5_tables(const Args& a, int g, LAS unsigned char* lds, int tid) {
    LAS float* Pre = (LAS float*)lds;
    LAS float* Pim = Pre + 33 * 64;
    LAS float* Bre = Pim + 33 * 64;
    LAS float* Bim = Bre + 1024;
    LAS float* Cre = Bim + 1024;
    LAS float* Cim = Cre + 1024;
    LAS float* Kt  = Cim + 1024;
    const float dt = expf(a.log_dt[g]);
    for (int e = tid; e < 33 * 64; e += 512) { const int p = e >> 6, n = e & 63; const float lr = a.lam_re[g * 64 + n], li = a.lam_im[g * 64 + n];
        const float mag = expf(lr * dt * (float)p), ang = li * dt * (float)p; Pre[e] = mag * cosf(ang); Pim[e] = mag * sinf(ang); }
    for (int e = tid; e < 1024; e += 512) { const int n = e >> 4; const float lr = a.lam_re[g * 64 + n], li = a.lam_im[g * 64 + n];
        const float mag = expf(lr * dt), abr = mag * cosf(li * dt), abi = mag * sinf(li * dt);
        const float den = lr * lr + li * li, nr = abr - 1.0f, ni = abi, fre = (nr * lr + ni * li) / den, fim = (ni * lr - nr * li) / den;
        const float br = a.b_re[(size_t)g * 1024 + e], bi = a.b_im[(size_t)g * 1024 + e];
        Bre[e] = fre * br - fim * bi; Bim[e] = fre * bi + fim * br;
        Cre[e] = a.c_re[(size_t)g * 1024 + e]; Cim[e] = a.c_im[(size_t)g * 1024 + e]; }
    __syncthreads();
    for (int e = tid; e < 8192; e += 512) { const int tau = e >> 8, c = (e >> 4) & 15, cp = e & 15; float s = 0.f;
        for (int n = 0; n < 64; ++n) { const float pr = Pre[tau * 64 + n], pi = Pim[tau * 64 + n], br = Bre[n * 16 + cp], bi = Bim[n * 16 + cp];
            const float zr = pr * br - pi * bi, zi = pr * bi + pi * br; s += Cre[c * 64 + n] * zr - Cim[c * 64 + n] * zi; }
        if (tau == 0 && c == cp) s += a.d_skip[g * 16 + c];
        Kt[e] = s; }
    __syncthreads();
    bf16* bt3 = (bf16*)(a.ws + WS_BTS3) + (size_t)g * 512 * K5;
    for (int ch = tid; ch < 512 * 80; ch += 512) { const int row = ch / 80, cc = ch % 80, i = row >> 4, c = row & 15; float v[8];
        if (cc < 64) { const int ip = cc >> 1, c0 = (cc & 1) * 8;
#pragma unroll
            for (int x = 0; x < 8; ++x) v[x] = (i >= ip) ? Kt[(i - ip) * 256 + c * 16 + c0 + x] : 0.f;
        } else { const int m0 = (cc - 64) * 8;
#pragma unroll
            for (int x = 0; x < 8; ++x) { const int m = m0 + x, n = m & 63; const float cr = Cre[c * 64 + n], ci = Cim[c * 64 + n], pr = Pre[(i + 1) * 64 + n], pi = Pim[(i + 1) * 64 + n];
                v[x] = (m < 64) ? (cr * pr - ci * pi) : -(cr * pi + ci * pr); } }
        v4u o; o.x = pk2(v[0], v[1]); o.y = pk2(v[2], v[3]); o.z = pk2(v[4], v[5]); o.w = pk2(v[6], v[7]);
        *(v4u*)(bt3 + (size_t)row * K5 + cc * 8) = o; }
    bf16* bt1 = (bf16*)(a.ws + WS_BTS1) + (size_t)g * 256 * 512;
    for (int ch = tid; ch < 256 * 64; ch += 512) { const int row = ch >> 6, cc = ch & 63, ip = cc >> 1, c0 = (cc & 1) * 8; float v[8];
#pragma unroll
        for (int x = 0; x < 8; ++x) { if (row < 128) { const int n = row & 63; const float pr = Pre[(31 - ip) * 64 + n], pi = Pim[(31 - ip) * 64 + n], br = Bre[n * 16 + c0 + x], bi = Bim[n * 16 + c0 + x];
                v[x] = (row < 64) ? (pr * br - pi * bi) : (pr * bi + pi * br); } else v[x] = 0.f; }
        v4u o; o.x = pk2(v[0], v[1]); o.y = pk2(v[2], v[3]); o.z = pk2(v[4], v[5]); o.w = pk2(v[6], v[7]);
        *(v4u*)(bt1 + (size_t)row * 512 + cc * 8) = o; }
    float* at = (float*)(a.ws + WS_ATAB) + g * 128;
    if (tid < 64) { at[tid * 2] = Pre[32 * 64 + tid]; at[tid * 2 + 1] = Pim[32 * 64 + tid]; }
    __syncthreads();
}

__device__ __forceinline__ void s5_scan_item(const Args& a, int item, LAS unsigned char* lds, int tid) {
    LAS float* seg_re = (LAS float*)lds; LAS float* seg_im = seg_re + 512;
    const int sl = tid & 31, seg = tid >> 5, sidx = item * 32 + sl, g = sidx >> 6, n = sidx & 63;
    const float* at = (const float*)(a.ws + WS_ATAB) + g * 128 + n * 2; const float ar = at[0], ai = at[1];
    const float* sloc = (const float*)(a.ws + WS_SLOC) + ((size_t)g * NCH5 + seg * 32) * 128 + n;
    float er = 0.f, ei = 0.f;
#pragma unroll 8
    for (int j = 0; j < 32; ++j) { const float lr = sloc[j * 128], li = sloc[j * 128 + 64]; const float tr = ar * er - ai * ei + lr, ti = ar * ei + ai * er + li; er = tr; ei = ti; }
    seg_re[seg * 32 + sl] = er; seg_im[seg * 32 + sl] = ei;
    __syncthreads();
    float pr = ar, pi = ai;
#pragma unroll
    for (int q = 0; q < 5; ++q) { const float tr = pr * pr - pi * pi, ti = 2.f * pr * pi; pr = tr; pi = ti; }
    float sr = 0.f, si = 0.f;
    for (int s2 = 0; s2 < seg; ++s2) { const float tr = pr * sr - pi * si + seg_re[s2 * 32 + sl], ti = pr * si + pi * sr + seg_im[s2 * 32 + sl]; sr = tr; si = ti; }
    bf16* xg = (bf16*)(a.ws + WS_XG5) + ((size_t)g * NCH5 + seg * 32) * K5 + 512 + n;
#pragma unroll 8
    for (int j = 0; j < 32; ++j) { xg[(size_t)j * K5] = (bf16)f2bf(sr); xg[(size_t)j * K5 + 64] = (bf16)f2bf(si);
        const float lr = sloc[j * 128], li = sloc[j * 128 + 64]; const float tr = ar * sr - ai * si + lr, ti = ar * si + ai * sr + li; sr = tr; si = ti; }
    __syncthreads();
}

constexpr int RS = 130;
__device__ __forceinline__ float ret_l2g(int h) { return log2f(1.0f - exp2f(-5.0f - (float)h)); }
__device__ __forceinline__ bf16x8 lds_frag_col(const LAS bf16* base, int stride) {
    bf16x8 f;
#pragma unroll
    for (int x = 0; x < 8; ++x) f[x] = (short)base[x * stride];
    return f;
}
template <bool ZETA> __device__ __forceinline__ void ret_stage(const bf16* src_, LAS bf16* dst, int tid, float l2g) {
    const GAS bf16* src = (const GAS bf16*)src_; v4u wv[4];
#pragma unroll
    for (int q = 0; q < 4; ++q) { const int id = tid + 512 * q, row = id >> 4, c8 = id & 15; wv[q] = *(const GAS v4u*)(src + (size_t)row * 1024 + 8 * c8); }
#pragma unroll
    for (int q = 0; q < 4; ++q) { const int id = tid + 512 * q, row = id >> 4, c8 = id & 15; v4u w = wv[q];
        if (ZETA) { const float z = exp2f(l2g * (float)(127 - row));
            w.x = pk2(pg8::bf_lo(w.x) * z, pg8::bf_hi(w.x) * z); w.y = pk2(pg8::bf_lo(w.y) * z, pg8::bf_hi(w.y) * z); w.z = pk2(pg8::bf_lo(w.z) * z, pg8::bf_hi(w.z) * z); w.w = pk2(pg8::bf_lo(w.w) * z, pg8::bf_hi(w.w) * z); }
        LAS unsigned* d = (LAS unsigned*)(dst + row * RS + 8 * c8); d[0] = w.x; d[1] = w.y; d[2] = w.z; d[3] = w.w; }
}
__device__ __forceinline__ void ret_kv_unit(const Args& a, int unit, LAS unsigned char* lds, int tid) {
    const int n = unit >> 3, h = unit & 7, t0 = n * RCH, lane = tid & 63, w = __builtin_amdgcn_readfirstlane(tid >> 6), fr = lane & 15, fg = lane >> 4;
    LAS bf16* Ks = (LAS bf16*)lds; LAS bf16* Vs = Ks + 128 * RS;
    const float l2g = ret_l2g(h);
    ret_stage<true>((const bf16*)(a.ws + WS_K) + (size_t)t0 * 1024 + h * 128, Ks, tid, l2g);
    ret_stage<false>((const bf16*)(a.ws + WS_V) + (size_t)t0 * 1024 + h * 128, Vs, tid, l2g);
    __syncthreads();
    bf16x8 af[4];
#pragma unroll
    for (int ks = 0; ks < 4; ++ks) af[ks] = lds_frag_col(Vs + (32 * ks + 8 * fg) * RS + 16 * w + fr, RS);
    float* out = (float*)(a.ws + WS_KVT) + ((size_t)unit * 128 + 16 * w + 4 * fg) * 128 + fr;
#pragma unroll
    for (int dt = 0; dt < 8; ++dt) { f32x4 acc = (f32x4){0.f, 0.f, 0.f, 0.f};
#pragma unroll
        for (int ks = 0; ks < 4; ++ks) { const bf16x8 bfv = lds_frag_col(Ks + (32 * ks + 8 * fg) * RS + 16 * dt + fr, RS);
            acc = __builtin_amdgcn_mfma_f32_16x16x32_bf16(af[ks], bfv, acc, 0, 0, 0); }
#pragma unroll
        for (int r = 0; r < 4; ++r) out[(size_t)r * 128 + 16 * dt] = acc[r]; }
    __syncthreads();
}
__device__ __forceinline__ void ret_state_scan(const Args& a, int gtid, int gthreads) {
    const float* kvt = (const float*)(a.ws + WS_KVT); bf16* rt = (bf16*)(a.ws + WS_RT);
    for (int idx = gtid; idx < RH * 128 * 128; idx += gthreads) { const int h = idx >> 14; const float dec = exp2f(128.0f * ret_l2g(h)); float st = 0.f;
#pragma unroll 8
        for (int n = 0; n < NRC; ++n) { rt[(size_t)n * 131072 + idx] = (bf16)f2bf(st); st = st * dec + kvt[(size_t)n * 131072 + idx]; } }
}
__device__ __forceinline__ void ret_out_unit(const Args& a, int unit, LAS unsigned char* lds, int tid) {
    const int n = unit >> 3, h = unit & 7, t0 = n * RCH, lane = tid & 63, w = __builtin_amdgcn_readfirstlane(tid >> 6), fr = lane & 15, fg = lane >> 4;
    LAS bf16* Ks = (LAS bf16*)lds; LAS bf16* Vs = Ks + 128 * RS; LAS bf16* Ps = Vs + 128 * RS;
    const float l2g = ret_l2g(h);
    ret_stage<false>((const bf16*)(a.ws + WS_K) + (size_t)t0 * 1024 + h * 128, Ks, tid, l2g);
    ret_stage<false>((const bf16*)(a.ws + WS_V) + (size_t)t0 * 1024 + h * 128, Vs, tid, l2g);
    const int i0 = 16 * w, il = i0 + fr;
    bf16x8 qf[4];
    { const bf16* qp = (const bf16*)(a.ws + WS_Q) + (size_t)(t0 + il) * 1024 + h * 128 + 8 * fg;
#pragma unroll
      for (int ks = 0; ks < 4; ++ks) qf[ks] = *(const bf16x8*)(qp + 32 * ks); }
    __syncthreads();
#pragma unroll
    for (int jt = 0; jt < 8; ++jt) {
        if (jt <= w) { f32x4 acc = (f32x4){0.f, 0.f, 0.f, 0.f};
#pragma unroll
            for (int ks = 0; ks < 4; ++ks) { bf16x8 kf;
#pragma unroll
                for (int x = 0; x < 8; ++x) kf[x] = (short)Ks[(16 * jt + fr) * RS + 32 * ks + 8 * fg + x];
                acc = __builtin_amdgcn_mfma_f32_16x16x32_bf16(kf, qf[ks], acc, 0, 0, 0); }
            float pv[4];
#pragma unroll
            for (int r = 0; r < 4; ++r) { const int j = 16 * jt + 4 * fg + r; pv[r] = (il >= j) ? acc[r] * exp2f(l2g * (float)(il - j)) : 0.f; }
            LAS unsigned* pp = (LAS unsigned*)(Ps + il * RS + 16 * jt + 4 * fg); pp[0] = pk2(pv[0], pv[1]); pp[1] = pk2(pv[2], pv[3]);
        } else if (jt == w + 1 && (w & 1) == 0) { LAS unsigned* pp = (LAS unsigned*)(Ps + il * RS + 16 * jt + 4 * fg); pp[0] = 0u; pp[1] = 0u; }
    }
    __syncthreads();
    f32x4 accI[8], accC[8];
#pragma unroll
    for (int et = 0; et < 8; ++et) { accI[et] = (f32x4){0.f, 0.f, 0.f, 0.f}; accC[et] = (f32x4){0.f, 0.f, 0.f, 0.f}; }
    const int nks = (w >> 1) + 1;
    for (int ks = 0; ks < nks; ++ks) { bf16x8 pf;
#pragma unroll
        for (int x = 0; x < 8; ++x) pf[x] = (short)Ps[il * RS + 32 * ks + 8 * fg + x];
#pragma unroll
        for (int et = 0; et < 8; ++et) { const bf16x8 vf = lds_frag_col(Vs + (32 * ks + 8 * fg) * RS + 16 * et + fr, RS);
            accI[et] = __builtin_amdgcn_mfma_f32_16x16x32_bf16(vf, pf, accI[et], 0, 0, 0); } }
    { const bf16* rp = (const bf16*)(a.ws + WS_RT) + ((size_t)unit * 128 + fr) * 128 + 8 * fg;
#pragma unroll
      for (int et = 0; et < 8; ++et)
#pragma unroll
          for (int ks = 0; ks < 4; ++ks) { const bf16x8 rf = *(const bf16x8*)(rp + (size_t)(16 * et) * 128 + 32 * ks);
              accC[et] = __builtin_amdgcn_mfma_f32_16x16x32_bf16(rf, qf[ks], accC[et], 0, 0, 0); } }
    const float xi = exp2f(l2g * (float)(il + 1));
    float s = 0.f;
#pragma unroll
    for (int et = 0; et < 8; ++et) { accI[et] = accI[et] + accC[et] * xi; s += (accI[et][0] + accI[et][1]) + (accI[et][2] + accI[et][3]); }
    s += __shfl_xor(s, 16); s += __shfl_xor(s, 32);
    const float mu = s * (1.0f / 128.0f); float q2 = 0.f;
#pragma unroll
    for (int et = 0; et < 8; ++et) { accI[et] = accI[et] - mu; q2 += (accI[et][0] * accI[et][0] + accI[et][1] * accI[et][1]) + (accI[et][2] * accI[et][2] + accI[et][3] * accI[et][3]); }
    q2 += __shfl_xor(q2, 16); q2 += __shfl_xor(q2, 32);
    const float rstd = 1.0f / sqrtf(q2 * (1.0f / 128.0f) + 1e-6f);
    const size_t ob = (size_t)(t0 + il) * 1024 + h * 128 + 4 * fg;
    const bf16* gp = (const bf16*)(a.ws + WS_GS) + ob; bf16* yp = (bf16*)(a.ws + WS_YR) + ob;
#pragma unroll
    for (int et = 0; et < 8; ++et) { const v2u gw = *(const v2u*)(gp + 16 * et); v2u o;
        o.x = pk2(accI[et][0] * rstd * pg8::bf_lo(gw.x), accI[et][1] * rstd * pg8::bf_hi(gw.x)); o.y = pk2(accI[et][2] * rstd * pg8::bf_lo(gw.y), accI[et][3] * rstd * pg8::bf_hi(gw.y));
        *(v2u*)(yp + 16 * et) = o; }
    __syncthreads();
}

__device__ __forceinline__ void router_item(const Args& a, int item, LAS unsigned char* lds, int tid) {
    LAS float* rs = (LAS float*)lds;
    LAS float* part = rs + 64;
    LAS float* lg = part + 4 * 64 * 33;
    LAS int* hist = (LAS int*)(lg + 64 * 33);
    LAS int* base = hist + 32;
    const int lane = tid & 63, w = __builtin_amdgcn_readfirstlane(tid >> 6), tb = item * 64;
    const float* x2 = (const float*)(a.ws + WS_X2);
    if (tid < 32) hist[tid] = 0;
    for (int r = 0; r < 8; ++r) { const int t = tb + 8 * w + r; const float* xrow = x2 + (size_t)t * 2048;
        const f32x4* xr = (const f32x4*)xrow + lane; const f32x4* gr = (const f32x4*)a.norm2_g + lane;
        f32x4 v[8]; float s = 0.f;
#pragma unroll
        for (int j = 0; j < 8; ++j) { v[j] = xr[64 * j]; s += (v[j].x * v[j].x + v[j].y * v[j].y) + (v[j].z * v[j].z + v[j].w * v[j].w); }
        const float rstd = 1.0f / sqrtf(wave_sum(s) * (1.0f / 2048.0f) + 1e-6f);
        if (lane == 0) rs[8 * w + r] = rstd;
        v2u* o8 = (v2u*)((bf16*)(a.ws + WS_HB) + (size_t)t * 2048) + lane;
#pragma unroll
        for (int j = 0; j < 8; ++j) { const f32x4 g = gr[64 * j]; v2u o; o.x = pk2(v[j].x * rstd * g.x, v[j].y * rstd * g.y); o.y = pk2(v[j].z * rstd * g.z, v[j].w * rstd * g.w); o8[64 * j] = o; } }
    { const int tg = w & 1, kq = w >> 1, hl = lane >> 5, l31 = lane & 31;
      const float* xp = x2 + (size_t)(tb + 32 * tg + l31) * 2048 + 512 * kq + 4 * hl;
      const float* wp = (const float*)(a.ws + WS_WG) + (size_t)(512 * kq + 4 * hl) * 32 + l31;
      f32x16 acc;
#pragma unroll
      for (int x = 0; x < 16; ++x) acc[x] = 0.f;
#pragma unroll 4
      for (int kk = 0; kk < 64; ++kk) { const f32x4 av = *(const f32x4*)(xp + 8 * kk); const float* wq = wp + (size_t)(8 * kk) * 32;
          acc = __builtin_amdgcn_mfma_f32_32x32x2f32(av.x, wq[0], acc, 0, 0, 0); acc = __builtin_amdgcn_mfma_f32_32x32x2f32(av.y, wq[32], acc, 0, 0, 0);
          acc = __builtin_amdgcn_mfma_f32_32x32x2f32(av.z, wq[64], acc, 0, 0, 0); acc = __builtin_amdgcn_mfma_f32_32x32x2f32(av.w, wq[96], acc, 0, 0, 0); }
#pragma unroll
      for (int x = 0; x < 16; ++x) { const int tl = (x & 3) + 8 * (x >> 2) + 4 * hl; part[(kq * 64 + 32 * tg + tl) * 33 + l31] = acc[x]; } }
    __syncthreads();
    for (int e = tid; e < 64 * 32; e += 512) { const int tl = e >> 5, ex = e & 31;
        lg[tl * 33 + ex] = rs[tl] * ((part[(0 * 64 + tl) * 33 + ex] + part[(1 * 64 + tl) * 33 + ex]) + (part[(2 * 64 + tl) * 33 + ex] + part[(3 * 64 + tl) * 33 + ex])) + a.router_b[ex]; }
    __syncthreads();
    int e0 = 0, e1 = 0, e2 = 0, e3 = 0, r0 = 0, r1 = 0, r2 = 0, r3 = 0; float g0 = 0.f, g1 = 0.f, g2 = 0.f, g3 = 0.f;
    if (tid < 64) { const LAS float* L = lg + tid * 33; float v0 = -3.0e38f, v1 = -3.0e38f, v2 = -3.0e38f, v3 = -3.0e38f;
        for (int ex = 0; ex < 32; ++ex) { const float v = L[ex]; if (v > v0) { v0 = v; e0 = ex; } }
        for (int ex = 0; ex < 32; ++ex) { const float v = L[ex]; if (ex != e0 && v > v1) { v1 = v; e1 = ex; } }
        for (int ex = 0; ex < 32; ++ex) { const float v = L[ex]; if (ex != e0 && ex != e1 && v > v2) { v2 = v; e2 = ex; } }
        for (int ex = 0; ex < 32; ++ex) { const float v = L[ex]; if (ex != e0 && ex != e1 && ex != e2 && v > v3) { v3 = v; e3 = ex; } }
        const float p0 = 1.0f, p1 = expf(v1 - v0), p2 = expf(v2 - v0), p3 = expf(v3 - v0), inv = 1.0f / (p0 + p1 + p2 + p3);
        g0 = p0 * inv; g1 = p1 * inv; g2 = p2 * inv; g3 = p3 * inv;
        r0 = __hip_atomic_fetch_add(&hist[e0], 1, __ATOMIC_RELAXED, __HIP_MEMORY_SCOPE_WORKGROUP); r1 = __hip_atomic_fetch_add(&hist[e1], 1, __ATOMIC_RELAXED, __HIP_MEMORY_SCOPE_WORKGROUP);
        r2 = __hip_atomic_fetch_add(&hist[e2], 1, __ATOMIC_RELAXED, __HIP_MEMORY_SCOPE_WORKGROUP); r3 = __hip_atomic_fetch_add(&hist[e3], 1, __ATOMIC_RELAXED, __HIP_MEMORY_SCOPE_WORKGROUP); }
    __syncthreads();
    if (tid < 32) base[tid] = (int)__hip_atomic_fetch_add((unsigned*)(a.ws + WS_CTL) + CW_CNT + tid, (unsigned)hist[tid], RLX_AGENT);
    __syncthreads();
    if (tid < 64) { const int t = tb + tid; int* te = (int*)(a.ws + WS_TOKE) + t * 4; float* tg = (float*)(a.ws + WS_TOKG) + t * 4; int* tp = (int*)(a.ws + WS_TOKP) + t * 4;
        te[0] = e0; te[1] = e1; te[2] = e2; te[3] = e3; tg[0] = g0; tg[1] = g1; tg[2] = g2; tg[3] = g3;
        tp[0] = base[e0] + r0; tp[1] = base[e1] + r1; tp[2] = base[e2] + r2; tp[3] = base[e3] + r3; }
    __syncthreads();
}

constexpr int N_PHASES = 15;
__global__ void __launch_bounds__(NWAVES * 64, 2) mk_fwd(Args kargs) {
    extern __shared__ __attribute__((aligned(16))) unsigned char lds_raw[];
    LAS unsigned char* lds = (LAS unsigned char*)lds_raw;
    const int tid = threadIdx.x, lane = tid & 63, wave = __builtin_amdgcn_readfirstlane(tid >> 6);
    const int G = gridDim.x, bx = blockIdx.x, gw = bx * NWAVES + wave, NGW = G * NWAVES, gtid = bx * (NWAVES * 64) + tid, GT = G * NWAVES * 64;
    unsigned char* const ws = kargs.ws;
#define LOAD_ARGS() const __attribute__((address_space(4))) Args* ap_ = (const __attribute__((address_space(4))) Args*)__builtin_amdgcn_kernarg_segment_ptr(); asm volatile("" : "+s"(ap_)); Args a; { const __attribute__((address_space(4))) unsigned long long* q_ = (const __attribute__((address_space(4))) unsigned long long*)ap_; unsigned long long* d_ = (unsigned long long*)&a; _Pragma("unroll") for (int i_ = 0; i_ < (int)(sizeof(Args) / 8); ++i_) d_[i_] = q_[i_]; }
    for (int u = tid; u < (LDS_BYTES - LDSCTL_OFF) / 4; u += NWAVES * 64) ((LAS unsigned*)(lds + LDSCTL_OFF))[u] = 0u;
    __syncthreads();
    XcdBarrier bar = xcd_barrier_post((unsigned*)(ws + WS_CTL) + CW_BAR + kargs.li * XCD_BAR_WORDS, (volatile LAS unsigned*)(lds + LDSCTL_OFF) + 8);
    const int lo = kargs.ph_lo, hi = kargs.ph_hi;
#ifndef PH_MASK
#define PH_MASK 0x7fff
#endif
#define IN(k) (((PH_MASK >> (k)) & 1) && lo <= (k) && (k) < hi)
#define SEAM(k) do { if (IN(k) && IN((k) + 1)) xcd_barrier(bar); } while (0)
    bf16* const HB = (bf16*)(ws + WS_HB);

    if (IN(0)) { LOAD_ARGS();
        for (int g = bx; g < NG5; g += G) s5_tables(a, g, lds, tid);
        LAS float* scr = (LAS float*)(lds + wave * 16640);
#define TR(src, K_, N_, dst, mode, nmat, sstride, dstride) do { const int nbk = (N_) / 64, per = ((K_) / 64) * nbk; \
        for (int it = gw; it < (nmat) * per; it += NGW) { const int mat = it / per, r = it % per; \
            transpose_item((src) + (size_t)mat * (sstride), (K_), (N_), (dst) + (size_t)mat * (dstride), (mode), scr, r / nbk, r % nbk, lane); } } while (0)
        TR(a.w_in, 2048, INC, (bf16*)(ws + WS_BTIN), 1, 1, 0, 0);
        TR(a.w_pp, PLED, 2048, (bf16*)(ws + WS_BTPP), 0, 1, 0, 0);
        TR(a.w_glu, 1024, 1024, (bf16*)(ws + WS_BTGLU), 0, 1, 0, 0);
        TR(a.w_bs, 1024, 2048, (bf16*)(ws + WS_BTPS), 0, 1, 0, 0);
        TR(a.w_br, 1024, 2048, (bf16*)(ws + WS_BTPR), 0, 1, 0, 0);
        TR(a.w_out, 2048, 2048, (bf16*)(ws + WS_BTOUT), 0, 1, 0, 0);
        TR(a.w_pg, 2048, 2048, (bf16*)(ws + WS_BTPG), 0, 1, 0, 0);
        TR(a.w_gu, 2048, 4096, (bf16*)(ws + WS_BTGU), 2, NEXP, (size_t)2048 * 4096, (size_t)4096 * 2048);
        TR(a.w_dn, 2048, 2048, (bf16*)(ws + WS_BTDN), 0, NEXP, (size_t)2048 * 2048, (size_t)2048 * 2048);
#undef TR
        for (int t = gw; t < SEQ; t += NGW) rms_row_bf16(a.x + (size_t)t * 2048, a.norm1_g, HB + (size_t)t * 2048, lane);
        { float* cs = (float*)(ws + WS_CS); float* sn = (float*)(ws + WS_SN);
          for (int e = gtid; e < SEQ * 64; e += GT) { const int t = e >> 6, i = e & 63; const float inv = powf(10000.0f, -(float)i / 64.0f), ang = (float)a.pos[t] * inv; cs[e] = cosf(ang); sn[e] = sinf(ang); } }
        { float* wg = (float*)(ws + WS_WG); for (int e = gtid; e < 2048 * 32; e += GT) wg[e] = a.norm2_g[e >> 5] * a.router_w[e]; }
        { v2u* pb = (v2u*)(ws + WS_PBF); const f32x4* pf = (const f32x4*)a.p;
          for (int e = gtid; e < SEQ * PLED / 4; e += GT) { const f32x4 v = pf[e]; v2u o; o.x = pk2(v.x, v.y); o.y = pk2(v.z, v.w); pb[e] = o; } }
    }
    SEAM(0);
    if (IN(1)) { LOAD_ARGS();
#ifndef P1_MASK
#define P1_MASK 15
#endif
        if (P1_MASK & 1) { pg8::Gemm g{HB, (const bf16*)(ws + WS_BTIN), 2048, 2048, 2048}; pg8::StaticOrder S; S.init(SEQ, 1024, G, bx);
          pg8::EpiZU E{(bf16*)(ws + WS_XG5)};
          pg8::gemm_phase<pg8::EpiZU, pg8::StaticOrder, true, true>(lds + RING_OFF, g, S, E); }
        if (P1_MASK & 2) { pg8::Gemm g{HB, (const bf16*)(ws + WS_BTIN) + (size_t)1024 * 2048, 2048, 2048, 2048}; pg8::StaticOrder S; S.init(SEQ, 2048, G, bx);
          pg8::EpiZR E{(bf16*)(ws + WS_Q), (bf16*)(ws + WS_K), (const float*)(ws + WS_CS), (const float*)(ws + WS_SN)};
          pg8::gemm_phase<pg8::EpiZR, pg8::StaticOrder, true, true>(lds + RING_OFF, g, S, E); }
        if (P1_MASK & 4) { pg8::Gemm g{HB, (const bf16*)(ws + WS_BTIN) + (size_t)3072 * 2048, 2048, 2048, 2048}; pg8::StaticOrder S; S.init(SEQ, 6144, G, bx);
          pg8::EpiZA E{(bf16*)(ws + WS_V), (bf16*)(ws + WS_GS), (bf16*)(ws + WS_SGS), (bf16*)(ws + WS_SGR)};
          pg8::gemm_phase<pg8::EpiZA, pg8::StaticOrder, true, true>(lds + RING_OFF, g, S, E); }
        if (P1_MASK & 8) { pg8::Gemm g{(const bf16*)(ws + WS_PBF), (const bf16*)(ws + WS_BTPP), PLED, PLED, PLED}; pg8::StaticOrder S; S.init(SEQ, 2048, G, bx);
          pg8::EpiPlain E{(bf16*)(ws + WS_PP), 2048};
          pg8::gemm_phase<pg8::EpiPlain, pg8::StaticOrder, true, true>(lds + RING_OFF, g, S, E); }
    }
    SEAM(1);
    if (IN(2)) { LOAD_ARGS();
        { pg8::Gemm g{(const bf16*)(ws + WS_XG5), (const bf16*)(ws + WS_BTS1), K5, 512, 512}; pg8::OrderS1 S{G, bx}; pg8::EpiS1 E{(float*)(ws + WS_SLOC)};
          pg8::gemm_phase<pg8::EpiS1, pg8::OrderS1, false, true>(lds + RING_OFF, g, S, E); }
        __syncthreads();
        for (int u = bx; u < NRC * RH; u += G) ret_kv_unit(a, u, lds, tid);
    }
    SEAM(2);
    if (IN(3)) { LOAD_ARGS();
        for (int it = G - 1 - bx; it < 128; it += G) s5_scan_item(a, it, lds, tid);
        ret_state_scan(a, gtid, GT);
    }
    SEAM(3);
    if (IN(4)) { LOAD_ARGS();
        { pg8::Gemm g{(const bf16*)(ws + WS_XG5), (const bf16*)(ws + WS_BTS3), K5, K5, K5}; pg8::OrderS3 S{G, bx}; pg8::EpiS3 E{(bf16*)(ws + WS_YSP)};
          pg8::gemm_phase<pg8::EpiS3, pg8::OrderS3, false, true>(lds + RING_OFF, g, S, E); }
        __syncthreads();
        for (int u = bx; u < NRC * RH; u += G) ret_out_unit(a, u, lds, tid);
    }
    SEAM(4);
    if (IN(5)) { LOAD_ARGS();
        pg8::Gemm g{(const bf16*)(ws + WS_YSP), (const bf16*)(ws + WS_BTGLU), 1024, 1024, 1024}; pg8::StaticOrder S; S.init(SEQ, 1024, G, bx);
        pg8::EpiGLU E{(const bf16*)(ws + WS_YSP), a.b_glu, (bf16*)(ws + WS_YS)};
        pg8::gemm_phase<pg8::EpiGLU, pg8::StaticOrder, true, true>(lds + RING_OFF, g, S, E);
    }
    SEAM(5);
    if (IN(6)) { LOAD_ARGS();
        { pg8::Gemm g{(const bf16*)(ws + WS_YS), (const bf16*)(ws + WS_BTPS), 1024, 1024, 1024}; pg8::StaticOrder S; S.init(SEQ, 2048, G, bx);
          pg8::EpiM1 E{(const bf16*)(ws + WS_SGS), (float*)(ws + WS_TMP)};
          pg8::gemm_phase<pg8::EpiM1, pg8::StaticOrder, true, true>(lds + RING_OFF, g, S, E); }
        VM_WAIT(); __syncthreads();
        { pg8::Gemm g{(const bf16*)(ws + WS_YR), (const bf16*)(ws + WS_BTPR), 1024, 1024, 1024}; pg8::StaticOrder S; S.init(SEQ, 2048, G, bx);
          pg8::EpiM2 E{(const bf16*)(ws + WS_SGR), (const float*)(ws + WS_TMP), (bf16*)(ws + WS_MRG)};
          pg8::gemm_phase<pg8::EpiM2, pg8::StaticOrder, true, true>(lds + RING_OFF, g, S, E); }
    }
    SEAM(6);
    if (IN(7)) { LOAD_ARGS();
        pg8::Gemm g{(const bf16*)(ws + WS_MRG), (const bf16*)(ws + WS_BTOUT), 2048, 2048, 2048}; pg8::StaticOrder S; S.init(SEQ, 2048, G, bx);
        pg8::EpiRes E{a.x, (float*)(ws + WS_X2)};
        pg8::gemm_phase<pg8::EpiRes, pg8::StaticOrder, true, true>(lds + RING_OFF, g, S, E);
    }
    SEAM(7);
    if (IN(8)) { LOAD_ARGS(); for (int it = bx; it < SEQ / 64; it += G) router_item(a, it, lds, tid); }
    SEAM(8);
    if (IN(9)) { LOAD_ARGS();
        LAS int* ps = (LAS int*)lds;
        if (tid == 0) { int accp = 0; for (int e = 0; e < NEXP; ++e) { const int c = (int)__hip_atomic_load((unsigned*)(ws + WS_CTL) + CW_CNT + e, RLX_AGENT); ps[e] = accp; accp += (c + 255) / 256 * 256; } ps[NEXP] = accp; }
        __syncthreads();
        int* blke = (int*)(ws + WS_BLKE);
        if (bx == 0 && tid < NEXP) { for (int rt = ps[tid] >> 8; rt < (ps[tid + 1] >> 8); ++rt) blke[rt] = tid; }
        if (bx == 0 && tid == 0) blke[511] = ps[NEXP] >> 8;
        const int* toke = (const int*)(ws + WS_TOKE); const int* tokp = (const int*)(ws + WS_TOKP); const float* tokg = (const float*)(ws + WS_TOKG);
        float* rowg = (float*)(ws + WS_ROWG); int* arow = (int*)(ws + WS_AROW);
        for (int as = gw; as < SEQ * 4; as += NGW) { const int tok = as >> 2, row = ps[toke[as]] + tokp[as];
            const v4u* s = (const v4u*)(HB + (size_t)tok * 2048) + lane; v4u* d = (v4u*)((bf16*)(ws + WS_XG) + (size_t)row * 2048) + lane;
            const v4u v0 = s[0], v1 = s[64], v2 = s[128], v3 = s[192]; d[0] = v0; d[64] = v1; d[128] = v2; d[192] = v3;
            if (lane == 0) { rowg[row] = tokg[as]; arow[as] = row; } }
        __syncthreads();
    }
    SEAM(9);
    if (IN(10)) { LOAD_ARGS();
        const int* blke = (const int*)(ws + WS_BLKE); const int nrt = blke[511];
        pg8::Gemm g{(const bf16*)(ws + WS_XG), (const bf16*)(ws + WS_BTGU), 2048, 2048, 2048}; pg8::OrderMoe S; S.so.init(nrt * 256, 4096, G, bx); S.blk_e = blke; S.ntn = 16;
        pg8::EpiGU E{a.b_gu, (bf16*)(ws + WS_ACT)};
        pg8::gemm_phase<pg8::EpiGU, pg8::OrderMoe, true, true>(lds + RING_OFF, g, S, E);
    }
    SEAM(10);
    if (IN(11)) { LOAD_ARGS();
        const int* blke = (const int*)(ws + WS_BLKE); const int nrt = blke[511];
        pg8::Gemm g{(const bf16*)(ws + WS_ACT), (const bf16*)(ws + WS_BTDN), 2048, 2048, 2048}; pg8::OrderMoe S; S.so.init(nrt * 256, 2048, G, bx); S.blk_e = blke; S.ntn = 8;
        pg8::EpiDN E{a.b_dn, (const float*)(ws + WS_ROWG), (bf16*)(ws + WS_YB)};
        pg8::gemm_phase<pg8::EpiDN, pg8::OrderMoe, true, true>(lds + RING_OFF, g, S, E);
    }
    SEAM(11);
    if (IN(12)) { LOAD_ARGS();
        const int* arow = (const int*)(ws + WS_AROW); const bf16* yb = (const bf16*)(ws + WS_YB);
        for (int t = gw; t < SEQ; t += NGW) { f32x4* xr = (f32x4*)((float*)(ws + WS_X2) + (size_t)t * 2048) + lane;
            const int r0 = arow[t * 4], r1 = arow[t * 4 + 1], r2 = arow[t * 4 + 2], r3 = arow[t * 4 + 3];
            const v2u* y0 = (const v2u*)(yb + (size_t)r0 * 2048) + lane; const v2u* y1 = (const v2u*)(yb + (size_t)r1 * 2048) + lane;
            const v2u* y2 = (const v2u*)(yb + (size_t)r2 * 2048) + lane; const v2u* y3 = (const v2u*)(yb + (size_t)r3 * 2048) + lane;
            f32x4 v[8]; float s = 0.f;
#pragma unroll
            for (int j = 0; j < 8; ++j) { f32x4 x = xr[64 * j]; const v2u w0 = y0[64 * j], w1 = y1[64 * j], w2 = y2[64 * j], w3 = y3[64 * j];
                x.x += (pg8::bf_lo(w0.x) + pg8::bf_lo(w1.x)) + (pg8::bf_lo(w2.x) + pg8::bf_lo(w3.x)); x.y += (pg8::bf_hi(w0.x) + pg8::bf_hi(w1.x)) + (pg8::bf_hi(w2.x) + pg8::bf_hi(w3.x));
                x.z += (pg8::bf_lo(w0.y) + pg8::bf_lo(w1.y)) + (pg8::bf_lo(w2.y) + pg8::bf_lo(w3.y)); x.w += (pg8::bf_hi(w0.y) + pg8::bf_hi(w1.y)) + (pg8::bf_hi(w2.y) + pg8::bf_hi(w3.y));
                v[j] = x; xr[64 * j] = x; s += (x.x * x.x + x.y * x.y) + (x.z * x.z + x.w * x.w); }
            const float rstd = 1.0f / sqrtf(wave_sum(s) * (1.0f / 2048.0f) + 1e-6f);
            const f32x4* gr = (const f32x4*)a.norm3_g + lane; v2u* o8 = (v2u*)(HB + (size_t)t * 2048) + lane;
#pragma unroll
            for (int j = 0; j < 8; ++j) { const f32x4 g = gr[64 * j]; v2u o; o.x = pk2(v[j].x * rstd * g.x, v[j].y * rstd * g.y); o.y = pk2(v[j].z * rstd * g.z, v[j].w * rstd * g.w); o8[64 * j] = o; } }
    }
    SEAM(12);
    if (IN(13)) { LOAD_ARGS();
        pg8::Gemm g{HB, (const bf16*)(ws + WS_BTPG), 2048, 2048, 2048}; pg8::StaticOrder S; S.init(SEQ, 2048, G, bx);
        pg8::EpiPLE E{(const float*)(ws + WS_X2), (const bf16*)(ws + WS_PP), a.out};
        pg8::gemm_phase<pg8::EpiPLE, pg8::StaticOrder, true, true>(lds + RING_OFF, g, S, E);
    }
    SEAM(13);
    if (IN(14)) { LOAD_ARGS();
        for (int t = gw; t < SEQ; t += NGW) { f32x4* xr = (f32x4*)(a.out + (size_t)t * 2048) + lane; const f32x4* gr = (const f32x4*)a.fin_g + lane;
            f32x4 v[8]; float s = 0.f;
#pragma unroll
            for (int j = 0; j < 8; ++j) { v[j] = xr[64 * j]; s += (v[j].x * v[j].x + v[j].y * v[j].y) + (v[j].z * v[j].z + v[j].w * v[j].w); }
            const float rstd = 1.0f / sqrtf(wave_sum(s) * (1.0f / 2048.0f) + 1e-6f);
#pragma unroll
            for (int j = 0; j < 8; ++j) xr[64 * j] = v[j] * rstd * gr[64 * j]; }
    }
#undef IN
#undef SEAM
}

extern "C" void kernel_launch(void* const* d_in, const int* in_sizes, int n_in, void* d_out, int out_size, void* d_ws, size_t ws_size, hipStream_t stream) {
    static int grid = 0;
    if (grid == 0) {
        if (n_in != 29 || in_sizes[0] != SEQ * DM || out_size != SEQ * DM || ws_size < WS_END) { fprintf(stderr, "kernel_launch: unexpected shapes (n_in %d, ws %zu < %zu?)\n", n_in, ws_size, (size_t)WS_END); grid = -1; return; }
        int dev = 0, cus = 0, per_cu = 0;
        if (hipGetDevice(&dev) != hipSuccess || hipDeviceGetAttribute(&cus, hipDeviceAttributeMultiprocessorCount, dev) != hipSuccess) { grid = -1; return; }
        if (hipFuncSetAttribute((const void*)mk_fwd, hipFuncAttributeMaxDynamicSharedMemorySize, LDS_BYTES) != hipSuccess) { fprintf(stderr, "kernel_launch: hipFuncSetAttribute failed\n"); grid = -1; return; }
        if (hipOccupancyMaxActiveBlocksPerMultiprocessor(&per_cu, (const void*)mk_fwd, NWAVES * 64, LDS_BYTES) != hipSuccess || per_cu < 1) { fprintf(stderr, "kernel_launch: occupancy query says %d\n", per_cu); }
        (void)hipGetLastError();
        grid = cus;
    }
    if (grid < 0) return;
    if (hipMemsetAsync((char*)d_ws + WS_CTL, 0, CTL_ZERO_BYTES, stream) != hipSuccess) return;
    Args a{};
    a.x = (const float*)d_in[0]; a.p = (const float*)d_in[1]; a.pos = (const int*)d_in[2]; a.norm1_g = (const float*)d_in[3]; a.w_in = (const float*)d_in[4];
    a.lam_re = (const float*)d_in[5]; a.lam_im = (const float*)d_in[6]; a.log_dt = (const float*)d_in[7]; a.b_re = (const float*)d_in[8]; a.b_im = (const float*)d_in[9];
    a.c_re = (const float*)d_in[10]; a.c_im = (const float*)d_in[11]; a.d_skip = (const float*)d_in[12]; a.w_glu = (const float*)d_in[13]; a.b_glu = (const float*)d_in[14];
    a.w_bs = (const float*)d_in[15]; a.w_br = (const float*)d_in[16]; a.w_out = (const float*)d_in[17]; a.norm2_g = (const float*)d_in[18]; a.router_w = (const float*)d_in[19];
    a.router_b = (const float*)d_in[20]; a.w_gu = (const float*)d_in[21]; a.b_gu = (const float*)d_in[22]; a.w_dn = (const float*)d_in[23]; a.b_dn = (const float*)d_in[24];
    a.norm3_g = (const float*)d_in[25]; a.w_pg = (const float*)d_in[26]; a.w_pp = (const float*)d_in[27]; a.fin_g = (const float*)d_in[28];
    a.out = (float*)d_out; a.ws = (unsigned char*)d_ws;
#if defined(PROBE_LO)
    a.ph_lo = 0; a.ph_hi = PROBE_HI; hipLaunchKernelGGL(mk_fwd, dim3(grid), dim3(NWAVES * 64), LDS_BYTES, stream, a);
    a.ph_lo = PROBE_LO; a.ph_hi = N_PHASES; a.li = 1; hipLaunchKernelGGL(mk_fwd, dim3(grid), dim3(NWAVES * 64), LDS_BYTES, stream, a);
#elif MK_N_LAUNCHES == 1
    a.ph_lo = 0; a.ph_hi = N_PHASES;
    hipLaunchKernelGGL(mk_fwd, dim3(grid), dim3(NWAVES * 64), LDS_BYTES, stream, a);
#else
    for (int ph = 0; ph < N_PHASES; ++ph) { a.ph_lo = ph; a.ph_hi = ph + 1; hipLaunchKernelGGL(mk_fwd, dim3(grid), dim3(NWAVES * 64), LDS_BYTES, stream, a); }
#endif
    const hipError_t le = hipPeekAtLastError();
    if (le != hipSuccess) fprintf(stderr, "kernel_launch: launch failed: %s\n", hipGetErrorName(le));
}
```

```cpp
#include <hip/hip_runtime.h>
#include <cstdio>
#include <cstdint>

#ifndef MK_N_LAUNCHES
#define MK_N_LAUNCHES 1
#endif

constexpr int SEQ = 16384, DM = 2048, INC = 9216, NEXP = 32, FFN = 2048, PLED = 256;
constexpr int NG5 = 64, T5 = 32, NCH5 = SEQ / T5, K5 = 640;
constexpr int RCH = 128, NRC = SEQ / RCH, RH = 8;
constexpr int MAXROWS = SEQ * 4 + NEXP * 256;

namespace pg8 {
#define PG8_LAS __attribute__((address_space(3)))
typedef unsigned short bf16_t;
typedef short bf16x8 __attribute__((ext_vector_type(8)));
typedef float f32x4 __attribute__((ext_vector_type(4)));
typedef unsigned u32x4 __attribute__((ext_vector_type(4)));
typedef unsigned u32x2 __attribute__((ext_vector_type(2)));
constexpr int BM = 256, BK = 64, HALF = 128, HTB = HALF * BK * 2, STAGE_BYTES = 8 * HTB, NXCD = 8, WGM = 8;

__host__ __device__ __forceinline__ int lds_byte(int r, int c) { const int st = (r >> 4) * 2 + (c >> 5), rr = r & 15, cc = c & 31, ob = rr * 64 + cc * 2; return st * 1024 + (ob ^ (((ob >> 9) & 1) << 5)); }
__host__ __device__ __forceinline__ void stage_rc(int b, int& R, int& C) { const int st = b / 1024, sb = b % 1024, swz = sb ^ (((sb >> 9) & 1) << 5); R = (st >> 1) * 16 + swz / 64; C = (st & 1) * 32 + (swz % 64) / 2; }
__host__ __device__ __forceinline__ int perm32(int rho) { const int n = rho >> 4, i = rho & 15; return 8 * (i >> 2) + 4 * n + (i & 3); }

struct Unit { int pm, pn; };
struct Gemm { const bf16_t* A; const bf16_t* Bt; int lda, ldb, K; };

struct StaticOrder {
    int nM, nN, nwg, G, c;
    __host__ __device__ void init(int M, int N, int G_, int c_) { nM = M / BM; nN = N / BM; nwg = nM * nN; G = G_; c = c_; }
    __host__ __device__ bool next(int i, Unit& u) const {
        const long L = (long)i * G + c; if (L >= nwg) return false;
        int wgid = (int)L; { const int q = nwg / NXCD, r = nwg % NXCD, xcd = wgid % NXCD, off = wgid / NXCD; wgid = (xcd < r ? xcd * (q + 1) : r * (q + 1) + (xcd - r) * q) + off; }
        const int nig = WGM * nN, gid = wgid / nig, fm = gid * WGM, gsz = (nM - fm) < WGM ? (nM - fm) : WGM;
        u.pm = fm + ((wgid % nig) % gsz); u.pn = (wgid % nig) / gsz; return true;
    }
    __device__ __forceinline__ void a_ready(const Unit&) const {}
    __device__ __forceinline__ void done(const Unit&) const {}
};
struct OrderS3 {
    int G, c;
    __device__ bool next(int i, Unit& u) const { const int L = i * G + c; if (L >= 256) return false; const int g = L >> 2; u.pm = 2 * g + ((L >> 1) & 1); u.pn = 2 * g + (L & 1); return true; }
    __device__ __forceinline__ void a_ready(const Unit&) const {}
    __device__ __forceinline__ void done(const Unit&) const {}
};
struct OrderS1 {
    int G, c;
    __device__ bool next(int i, Unit& u) const { const int L = i * G + c; if (L >= 128) return false; u.pm = L; u.pn = L >> 1; return true; }
    __device__ __forceinline__ void a_ready(const Unit&) const {}
    __device__ __forceinline__ void done(const Unit&) const {}
};
struct OrderMoe {
    StaticOrder so; const int* blk_e; int ntn;
    __device__ bool next(int i, Unit& u) const { if (!so.next(i, u)) return false; u.pn = __builtin_amdgcn_readfirstlane(blk_e[u.pm]) * ntn + u.pn; return true; }
    __device__ __forceinline__ void a_ready(const Unit&) const {}
    __device__ __forceinline__ void done(const Unit&) const {}
};

__device__ __forceinline__ unsigned cvt_pk_bf16(float lo, float hi) { unsigned r; asm volatile("v_cvt_pk_bf16_f32 %0, %1, %2" : "=v"(r) : "v"(lo), "v"(hi)); return r; }
__device__ __forceinline__ u32x4 pack8(const f32x4& a, const f32x4& b) { u32x4 w; w.x = cvt_pk_bf16(a[0], a[1]); w.y = cvt_pk_bf16(a[2], a[3]); w.z = cvt_pk_bf16(b[0], b[1]); w.w = cvt_pk_bf16(b[2], b[3]); return w; }
__device__ __forceinline__ float bf_lo(unsigned w) { return __builtin_bit_cast(float, w << 16); }
__device__ __forceinline__ float bf_hi(unsigned w) { return __builtin_bit_cast(float, w & 0xffff0000u); }
__device__ __forceinline__ void unpack8(const u32x4& w, f32x4& a, f32x4& b) { a = (f32x4){bf_lo(w.x), bf_hi(w.x), bf_lo(w.y), bf_hi(w.y)}; b = (f32x4){bf_lo(w.z), bf_hi(w.z), bf_lo(w.w), bf_hi(w.w)}; }
__device__ __forceinline__ float sigm(float x) { return __builtin_amdgcn_rcpf(1.0f + __builtin_amdgcn_exp2f(-1.4426950408889634f * x)); }
__device__ __forceinline__ f32x4 sigm4(const f32x4& x) { return (f32x4){sigm(x[0]), sigm(x[1]), sigm(x[2]), sigm(x[3])}; }
__device__ __forceinline__ float gelu_t(float x) { return x * sigm(1.5957691216057308f * (x + 0.044715f * x * x * x)); }
__device__ __forceinline__ f32x4 gelu4(const f32x4& x) { return (f32x4){gelu_t(x[0]), gelu_t(x[1]), gelu_t(x[2]), gelu_t(x[3])}; }

#define EPI_LOOP_AM _Pragma("unroll") for (int ai = 0; ai < 2; ++ai) _Pragma("unroll") for (int m = 0; m < 4; ++m)
#define EPI_LOOP_BJ _Pragma("unroll") for (int bj = 0; bj < 2; ++bj)
typedef f32x4 AccT[2][2][4][2];
#ifndef EPIZ_MASK
#define EPIZ_MASK 31
#endif
#define EPIZ_EN(k) ((EPIZ_MASK >> (k)) & 1)

struct EpiZU {
    static constexpr bool PERM = true, AFTER_DRAIN = false;
    bf16_t* xg5;
    __device__ __forceinline__ void operator()(const AccT& acc, const Unit& u, int wr, int wc, int fr, int fq) const {
        const int row0 = u.pm * BM + wr * 64 + fr, tc = wc * 32 + 8 * fq, pn = u.pn;
        EPI_LOOP_AM { const int t = row0 + ai * HALF + m * 16, j = t >> 5, i = t & 31;
            EPI_LOOP_BJ { const int col = pn * BM + bj * HALF + tc, g = col >> 4, c0 = col & 15;
                *(u32x4*)(xg5 + ((size_t)(g * NCH5 + j) * K5 + i * 16 + c0)) = pack8(acc[ai][bj][m][0], acc[ai][bj][m][1]); } }
    }
};
struct EpiZR {
    static constexpr bool PERM = true, AFTER_DRAIN = false;
    bf16_t *q, *k; const float *cs, *sn;
    __device__ __forceinline__ void operator()(const AccT& acc, const Unit& u, int wr, int wc, int fr, int fq) const {
        const int row0 = u.pm * BM + wr * 64 + fr, pn = u.pn;
        const bool isk = pn >= 4; bf16_t* dst = isk ? k : q; const float sc = isk ? 0.08838834764831845f : 1.0f;
        const int head = 2 * (pn & 3) + (wc >> 1), dd = 32 * (wc & 1) + 8 * fq;
        EPI_LOOP_AM { const int t = row0 + ai * HALF + m * 16;
            const float* cp = cs + (size_t)t * 64 + dd; const float* sp = sn + (size_t)t * 64 + dd;
            const f32x4 c0 = *(const f32x4*)cp * sc, c1 = *(const f32x4*)(cp + 4) * sc, s0 = *(const f32x4*)sp * sc, s1 = *(const f32x4*)(sp + 4) * sc;
            const f32x4 x1a = acc[ai][0][m][0], x1b = acc[ai][0][m][1], x2a = acc[ai][1][m][0], x2b = acc[ai][1][m][1];
            bf16_t* o = dst + (size_t)t * 1024 + head * 128 + dd;
            *(u32x4*)o = pack8(x1a * c0 - x2a * s0, x1b * c1 - x2b * s1);
            *(u32x4*)(o + 64) = pack8(x1a * s0 + x2a * c0, x1b * s1 + x2b * c1); asm volatile("" ::: "memory"); }
    }
};
struct EpiZA {
    static constexpr bool PERM = true, AFTER_DRAIN = false;
    bf16_t *v, *gs, *sgs, *sgr;
    __device__ __forceinline__ void operator()(const AccT& acc, const Unit& u, int wr, int wc, int fr, int fq) const {
        const int row0 = u.pm * BM + wr * 64 + fr, tc = wc * 32 + 8 * fq, pn = u.pn;
        bf16_t* dst = pn < 4 ? v : (pn < 8 ? gs : (pn < 16 ? sgs : sgr));
        const int ldc = pn < 8 ? 1024 : 2048, cb = (pn < 8 ? (pn & 3) : (pn & 7)) * BM + tc;
        const float ka = pn < 4 ? 0.0f : 1.0f, kb = (pn >= 4 && pn < 8) ? 1.0f : 0.0f;
        EPI_LOOP_AM { const size_t off = (size_t)(row0 + ai * HALF + m * 16) * ldc + cb;
            EPI_LOOP_BJ { f32x4 r[2];
#pragma unroll
                for (int n = 0; n < 2; ++n) { const f32x4 x = acc[ai][bj][m][n], sg = sigm4(x); r[n] = x * (1.0f - ka) + sg * (ka - kb) + (x * sg) * kb; }
                *(u32x4*)(dst + off + bj * HALF) = pack8(r[0], r[1]); } }
    }
};
struct EpiS1 {
    static constexpr bool PERM = true, AFTER_DRAIN = false;
    float* sloc;
    __device__ __forceinline__ void operator()(const AccT& acc, const Unit& u, int wr, int wc, int fr, int fq) const {
        const int row0 = u.pm * BM + wr * 64 + fr, tc = wc * 32 + 8 * fq;
        EPI_LOOP_AM { float* o = sloc + (size_t)(row0 + ai * HALF + m * 16) * 128 + tc; *(f32x4*)o = acc[ai][0][m][0]; *(f32x4*)(o + 4) = acc[ai][0][m][1]; }
    }
};
struct EpiS3 {
    static constexpr bool PERM = true, AFTER_DRAIN = false;
    bf16_t* ysp;
    __device__ __forceinline__ void operator()(const AccT& acc, const Unit& u, int wr, int wc, int fr, int fq) const {
        const int g = u.pm >> 1, j0 = (u.pm & 1) * BM + wr * 64 + fr, cl0 = (u.pn & 1) * BM + wc * 32 + 8 * fq;
        EPI_LOOP_AM { const int j = j0 + ai * HALF + m * 16;
            EPI_LOOP_BJ { const int cl = cl0 + bj * HALF, i = cl >> 4, c0 = cl & 15;
                *(u32x4*)(ysp + (size_t)(j * T5 + i) * 1024 + g * 16 + c0) = pack8(gelu4(acc[ai][bj][m][0]), gelu4(acc[ai][bj][m][1])); } }
    }
};
struct EpiGLU {
    static constexpr bool PERM = true, AFTER_DRAIN = false;
    const bf16_t* ysp; const float* bias; bf16_t* ys;
    __device__ __forceinline__ void operator()(const AccT& acc, const Unit& u, int wr, int wc, int fr, int fq) const {
        const int row0 = u.pm * BM + wr * 64 + fr, col0 = u.pn * BM + wc * 32 + 8 * fq;
        f32x4 bv[2][2];
        EPI_LOOP_BJ { bv[bj][0] = *(const f32x4*)(bias + col0 + bj * HALF); bv[bj][1] = *(const f32x4*)(bias + col0 + bj * HALF + 4); }
        EPI_LOOP_AM { const size_t off = (size_t)(row0 + ai * HALF + m * 16) * 1024 + col0;
            EPI_LOOP_BJ { f32x4 ya, yb; unpack8(*(const u32x4*)(ysp + off + bj * HALF), ya, yb);
                *(u32x4*)(ys + off + bj * HALF) = pack8(ya * sigm4(acc[ai][bj][m][0] + bv[bj][0]), yb * sigm4(acc[ai][bj][m][1] + bv[bj][1])); } }
    }
};
struct EpiM1 {
    static constexpr bool PERM = true, AFTER_DRAIN = false;
    const bf16_t* sg; float* tmp;
    __device__ __forceinline__ void operator()(const AccT& acc, const Unit& u, int wr, int wc, int fr, int fq) const {
        const int row0 = u.pm * BM + wr * 64 + fr, col0 = u.pn * BM + wc * 32 + 8 * fq;
        EPI_LOOP_AM { const size_t off = (size_t)(row0 + ai * HALF + m * 16) * 2048 + col0;
            EPI_LOOP_BJ { f32x4 ga, gb; unpack8(*(const u32x4*)(sg + off + bj * HALF), ga, gb);
                *(f32x4*)(tmp + off + bj * HALF) = ga * acc[ai][bj][m][0]; *(f32x4*)(tmp + off + bj * HALF + 4) = gb * acc[ai][bj][m][1]; } }
    }
};
struct EpiM2 {
    static constexpr bool PERM = true, AFTER_DRAIN = false;
    const bf16_t* sg; const float* tmp; bf16_t* mrg;
    __device__ __forceinline__ void operator()(const AccT& acc, const Unit& u, int wr, int wc, int fr, int fq) const {
        const int row0 = u.pm * BM + wr * 64 + fr, col0 = u.pn * BM + wc * 32 + 8 * fq;
        EPI_LOOP_AM { const size_t off = (size_t)(row0 + ai * HALF + m * 16) * 2048 + col0;
            EPI_LOOP_BJ { f32x4 ga, gb; unpack8(*(const u32x4*)(sg + off + bj * HALF), ga, gb);
                const f32x4 ta = *(const f32x4*)(tmp + off + bj * HALF), tb = *(const f32x4*)(tmp + off + bj * HALF + 4);
                *(u32x4*)(mrg + off + bj * HALF) = pack8(ta + ga * acc[ai][bj][m][0], tb + gb * acc[ai][bj][m][1]); } }
    }
};
struct EpiRes {
    static constexpr bool PERM = true, AFTER_DRAIN = false;
    const float* x; float* o;
    __device__ __forceinline__ void operator()(const AccT& acc, const Unit& u, int wr, int wc, int fr, int fq) const {
        const int row0 = u.pm * BM + wr * 64 + fr, col0 = u.pn * BM + wc * 32 + 8 * fq;
        EPI_LOOP_AM { const size_t off = (size_t)(row0 + ai * HALF + m * 16) * 2048 + col0;
            EPI_LOOP_BJ { *(f32x4*)(o + off + bj * HALF) = *(const f32x4*)(x + off + bj * HALF) + acc[ai][bj][m][0];
                *(f32x4*)(o + off + bj * HALF + 4) = *(const f32x4*)(x + off + bj * HALF + 4) + acc[ai][bj][m][1]; } }
    }
};
struct EpiPlain {
    static constexpr bool PERM = true, AFTER_DRAIN = false;
    bf16_t* o; int ldc;
    __device__ __forceinline__ void operator()(const AccT& acc, const Unit& u, int wr, int wc, int fr, int fq) const {
        const int row0 = u.pm * BM + wr * 64 + fr, col0 = u.pn * BM + wc * 32 + 8 * fq;
        EPI_LOOP_AM { const size_t off = (size_t)(row0 + ai * HALF + m * 16) * ldc + col0;
            EPI_LOOP_BJ { *(u32x4*)(o + off + bj * HALF) = pack8(acc[ai][bj][m][0], acc[ai][bj][m][1]); } }
    }
};
__device__ __forceinline__ unsigned pk4_fp8(float a, float b, float c, float d) { int r = 0; r = __builtin_amdgcn_cvt_pk_fp8_f32(a, b, r, false); r = __builtin_amdgcn_cvt_pk_fp8_f32(c, d, r, true); return (unsigned)r; }
constexpr float W8_SCALE = 64.0f, W8_INV = 1.0f / 64.0f;
struct EpiGU {
    static constexpr bool PERM = true, AFTER_DRAIN = false;
    const float* bgu; unsigned char* act;
    __device__ __forceinline__ void operator()(const AccT& acc, const Unit& u, int wr, int wc, int fr, int fq) const {
        const int e = u.pn >> 4, ct = u.pn & 15, row0 = u.pm * BM + wr * 64 + fr, f0 = ct * HALF + wc * 32 + 8 * fq;
        const float* bp = bgu + (size_t)e * 4096 + 2 * f0;
        const f32x4 b0 = *(const f32x4*)bp, b1 = *(const f32x4*)(bp + 4), b2 = *(const f32x4*)(bp + 8), b3 = *(const f32x4*)(bp + 12);
        const f32x4 bg0 = (f32x4){b0[0], b0[2], b1[0], b1[2]}, bu0 = (f32x4){b0[1], b0[3], b1[1], b1[3]}, bg1 = (f32x4){b2[0], b2[2], b3[0], b3[2]}, bu1 = (f32x4){b2[1], b2[3], b3[1], b3[3]};
        EPI_LOOP_AM { const size_t off = (size_t)(row0 + ai * HALF + m * 16) * FFN + f0;
            f32x4 r[2];
#pragma unroll
            for (int n = 0; n < 2; ++n) { const f32x4 gv = acc[ai][0][m][n] * W8_INV + (n ? bg1 : bg0), uv = acc[ai][1][m][n] * W8_INV + (n ? bu1 : bu0);
#pragma unroll
                for (int x = 0; x < 4; ++x) { const float gg = fminf(gv[x], 7.0f), uu = fminf(fmaxf(uv[x], -7.0f), 7.0f); r[n][x] = gg * sigm(1.702f * gg) * (uu + 1.0f); } }
            u32x2 w; w.x = pk4_fp8(r[0][0], r[0][1], r[0][2], r[0][3]); w.y = pk4_fp8(r[1][0], r[1][1], r[1][2], r[1][3]);
            *(u32x2*)(act + off) = w; }
    }
};
struct EpiDN {
    static constexpr bool PERM = true, AFTER_DRAIN = false;
    const float* bdn; const float* rowg; bf16_t* yb;
    __device__ __forceinline__ void operator()(const AccT& acc, const Unit& u, int wr, int wc, int fr, int fq) const {
        const int e = u.pn >> 3, ct = u.pn & 7, row0 = u.pm * BM + wr * 64 + fr, col0 = ct * BM + wc * 32 + 8 * fq;
        f32x4 bv[2][2];
        EPI_LOOP_BJ { bv[bj][0] = *(const f32x4*)(bdn + (size_t)e * 2048 + col0 + bj * HALF); bv[bj][1] = *(const f32x4*)(bdn + (size_t)e * 2048 + col0 + bj * HALF + 4); }
        EPI_LOOP_AM { const int row = row0 + ai * HALF + m * 16; const float gt = rowg[row]; const size_t off = (size_t)row * 2048 + col0;
            EPI_LOOP_BJ { *(u32x4*)(yb + off + bj * HALF) = pack8((acc[ai][bj][m][0] * W8_INV + bv[bj][0]) * gt, (acc[ai][bj][m][1] * W8_INV + bv[bj][1]) * gt); } }
    }
};
struct EpiPLE {
    static constexpr bool PERM = true, AFTER_DRAIN = false;
    const float* x3; const bf16_t* pp; float* o;
    __device__ __forceinline__ void operator()(const AccT& acc, const Unit& u, int wr, int wc, int fr, int fq) const {
        const int row0 = u.pm * BM + wr * 64 + fr, col0 = u.pn * BM + wc * 32 + 8 * fq;
        EPI_LOOP_AM { const size_t off = (size_t)(row0 + ai * HALF + m * 16) * 2048 + col0;
            EPI_LOOP_BJ { f32x4 pa, pb; unpack8(*(const u32x4*)(pp + off + bj * HALF), pa, pb);
                *(f32x4*)(o + off + bj * HALF) = *(const f32x4*)(x3 + off + bj * HALF) + sigm4(acc[ai][bj][m][0]) * pa;
                *(f32x4*)(o + off + bj * HALF + 4) = *(const f32x4*)(x3 + off + bj * HALF + 4) + sigm4(acc[ai][bj][m][1]) * pb; } }
    }
};

typedef int v8i_t __attribute__((ext_vector_type(8)));
typedef int v4i_t __attribute__((ext_vector_type(4)));
__device__ __forceinline__ v8i_t cat8(const bf16x8& lo, const bf16x8& hi) { const v4i_t a = __builtin_bit_cast(v4i_t, lo), b = __builtin_bit_cast(v4i_t, hi); return (v8i_t){a[0], a[1], a[2], a[3], b[0], b[1], b[2], b[3]}; }
template <class Epi, class Sched, bool ALIGN_EPI = false, bool SP2 = false, bool F8 = false>
__device__ __forceinline__ void gemm_phase(PG8_LAS unsigned char* lds, const Gemm g, const Sched& S, const Epi& E) {
    const int tid = threadIdx.x, wid = __builtin_amdgcn_readfirstlane(tid >> 6), lane = tid & 63, wr = wid >> 2, wc = wid & 3, fr = lane & 15, fq = lane >> 4;
    const int K = g.K, nt = K / BK;
    unsigned voffA[2], voffB[2];
#pragma unroll
    for (int i = 0; i < 2; ++i) { int R, C; stage_rc(tid * 16 + i * 8192, R, C); const int Rb = Epi::PERM ? ((R & ~31) + perm32(R & 31)) : R;
        voffA[i] = (unsigned)(R * g.lda + C) * 2u; voffB[i] = (unsigned)(Rb * g.ldb + C) * 2u; }
    const size_t kstep = (size_t)(BK * 2);
    const size_t hstepA = (size_t)HALF * g.lda * 2, hstepB = (size_t)HALF * g.ldb * 2;
    const size_t tstepA = 2 * hstepA, tstepB = 2 * hstepB;
    const unsigned ldsw = (unsigned)wid * 1024u;
    const int aoff = lds_byte(wr * 64 + fr, fq * 8), boff = lds_byte(wc * 32 + fr, fq * 8);
#define PG8_SA(b, h) (((b) * 2 + (h)) * HTB)
#define PG8_SB(b, h) ((4 + (b) * 2 + (h)) * HTB)
#define PG8_STAGE(bufoff, gbase, voff) do { _Pragma("unroll") for (int _i = 0; _i < 2; ++_i) \
        __builtin_amdgcn_global_load_lds((const unsigned*)((const char*)(gbase) + (voff)[_i]), (PG8_LAS unsigned*)(lds + (bufoff) + ldsw + _i * 8192), 16, 0, 0); } while (0)
#define PG8_LD8(p_) __builtin_shufflevector(*(const PG8_LAS v4i_t*)(p_), *(const PG8_LAS v4i_t*)((p_) + 1024), 0, 1, 2, 3, 4, 5, 6, 7)
#define PG8_LDA(dst, b, h) do { if constexpr (F8) { _Pragma("unroll") for (int m = 0; m < 4; ++m) dst##8[m] = PG8_LD8(lds + PG8_SA(b, h) + aoff + m * 2048); } else { \
        _Pragma("unroll") for (int m = 0; m < 4; ++m) _Pragma("unroll") for (int k = 0; k < 2; ++k) dst[m][k] = *(const PG8_LAS bf16x8*)(lds + PG8_SA(b, h) + aoff + m * 2048 + k * 1024); } } while (0)
#define PG8_LDB(dst, b, h) do { if constexpr (F8) { _Pragma("unroll") for (int n = 0; n < 2; ++n) dst##8[n] = PG8_LD8(lds + PG8_SB(b, h) + boff + n * 2048); } else { \
        _Pragma("unroll") for (int n = 0; n < 2; ++n) _Pragma("unroll") for (int k = 0; k < 2; ++k) dst[n][k] = *(const PG8_LAS bf16x8*)(lds + PG8_SB(b, h) + boff + n * 2048 + k * 1024); } } while (0)
#define PG8_MMA(ai, bj, At, Bt) do { __builtin_amdgcn_s_setprio(1); if constexpr (F8) { _Pragma("unroll") for (int m = 0; m < 4; ++m) _Pragma("unroll") for (int n = 0; n < 2; ++n) \
        asm volatile("v_mfma_scale_f32_16x16x128_f8f6f4 %0, %1, %2, %0, %3, %3 op_sel_hi:[0,0,0]" : "+v"(acc[ai][bj][m][n]) : "v"(Bt##8[n]), "v"(At##8[m]), "v"(sc8)); } else { \
        _Pragma("unroll") for (int m = 0; m < 4; ++m) _Pragma("unroll") for (int n = 0; n < 2; ++n) _Pragma("unroll") for (int k = 0; k < 2; ++k) \
        acc[ai][bj][m][n] = __builtin_amdgcn_mfma_f32_16x16x32_bf16(Bt[n][k], At[m][k], acc[ai][bj][m][n], 0, 0, 0); } __builtin_amdgcn_s_setprio(0); } while (0)
#define PG8_WAIT_V(n) asm volatile("s_waitcnt vmcnt(" #n ")" ::: "memory")
#define PG8_WAIT_L(n) asm volatile("s_waitcnt lgkmcnt(" #n ")" ::: "memory")
#define PG8_BAR __builtin_amdgcn_s_barrier()
#define PG8_SCHED __builtin_amdgcn_sched_barrier(0)
    Unit cur, nxt; int ui = 0;
    if (!S.next(0, cur)) return;
    f32x4 acc[2][2][4][2];
#pragma unroll
    for (int a = 0; a < 2; ++a)
#pragma unroll
        for (int b = 0; b < 2; ++b)
#pragma unroll
            for (int m = 0; m < 4; ++m)
#pragma unroll
                for (int n = 0; n < 2; ++n) acc[a][b][m][n] = (f32x4){0.f, 0.f, 0.f, 0.f};
    bf16x8 At[4][2], B0[2][2], B1[2][2]; v8i_t At8[4], B08[2], B18[2]; const int sc8 = 0x7f7f7f7f;
    const char* cA = (const char*)g.A + (size_t)cur.pm * tstepA; const char* cB = (const char*)g.Bt + (size_t)cur.pn * tstepB;
    S.a_ready(cur);
    if constexpr (SP2) {
        PG8_STAGE(PG8_SB(0, 0), cB, voffB); PG8_STAGE(PG8_SB(0, 1), cB + hstepB, voffB); PG8_STAGE(PG8_SA(0, 0), cA, voffA); PG8_STAGE(PG8_SA(0, 1), cA + hstepA, voffA);
        if (wr == 1) PG8_BAR;
        PG8_WAIT_V(2); PG8_BAR;
        PG8_STAGE(PG8_SB(1, 0), cB + kstep, voffB); PG8_STAGE(PG8_SA(1, 0), cA + kstep, voffA); PG8_STAGE(PG8_SB(1, 1), cB + hstepB + kstep, voffB);
        PG8_WAIT_V(6); PG8_BAR;
    } else {
        PG8_STAGE(PG8_SB(0, 0), cB, voffB); PG8_STAGE(PG8_SA(0, 0), cA, voffA); PG8_STAGE(PG8_SB(0, 1), cB + hstepB, voffB); PG8_STAGE(PG8_SA(0, 1), cA + hstepA, voffA);
        if (wr == 1) PG8_BAR;
        PG8_WAIT_V(4); PG8_BAR;
        PG8_STAGE(PG8_SB(1, 0), cB + kstep, voffB); PG8_STAGE(PG8_SA(1, 0), cA + kstep, voffA); PG8_STAGE(PG8_SB(1, 1), cB + hstepB + kstep, voffB);
        PG8_WAIT_V(6); PG8_BAR;
    }
    for (;;) {
        const bool has_next = S.next(ui + 1, nxt);
        const char* nA = has_next ? (const char*)g.A + (size_t)nxt.pm * tstepA : cA; const char* nB = has_next ? (const char*)g.Bt + (size_t)nxt.pn * tstepB : cB;
#pragma nounroll
        for (int t = 0; t < nt; t += 2) {
            const bool last = (t == nt - 2);
            const char* a1 = cA + (size_t)(t + 1) * kstep;
            const char* a2 = last ? nA : cA + (size_t)(t + 2) * kstep; const char* b2 = last ? nB : cB + (size_t)(t + 2) * kstep;
            const char* a3 = a2 + kstep; const char* b3 = b2 + kstep;
            if (last && has_next) S.a_ready(nxt);
            if constexpr (SP2) {
            PG8_LDB(B0, 0, 0); PG8_LDB(B1, 0, 1); PG8_SCHED; PG8_LDA(At, 0, 0); PG8_STAGE(PG8_SA(1, 1), a1 + hstepA, voffA);
            PG8_WAIT_V(8); PG8_WAIT_L(0); PG8_BAR; PG8_MMA(0, 0, At, B0); PG8_MMA(0, 1, At, B1); PG8_BAR; PG8_SCHED;
            PG8_LDA(At, 0, 1); PG8_STAGE(PG8_SB(0, 0), b2, voffB); PG8_STAGE(PG8_SB(0, 1), b2 + hstepB, voffB); PG8_STAGE(PG8_SA(0, 0), a2, voffA);
            PG8_WAIT_V(8); PG8_WAIT_L(0); PG8_BAR; PG8_MMA(1, 0, At, B0); PG8_MMA(1, 1, At, B1); PG8_BAR; PG8_SCHED;
            PG8_LDB(B0, 1, 0); PG8_LDB(B1, 1, 1); PG8_SCHED; PG8_LDA(At, 1, 0); PG8_STAGE(PG8_SA(0, 1), a2 + hstepA, voffA);
            PG8_WAIT_V(8); PG8_WAIT_L(0); PG8_BAR; PG8_MMA(0, 0, At, B0); PG8_MMA(0, 1, At, B1); PG8_BAR; PG8_SCHED;
            PG8_LDA(At, 1, 1); PG8_STAGE(PG8_SB(1, 0), b3, voffB); PG8_STAGE(PG8_SB(1, 1), b3 + hstepB, voffB); PG8_STAGE(PG8_SA(1, 0), a3, voffA);
            PG8_WAIT_V(8); PG8_WAIT_L(0); PG8_BAR; PG8_MMA(1, 0, At, B0); PG8_MMA(1, 1, At, B1); PG8_BAR; PG8_SCHED;
            } else {
            PG8_LDB(B0, 0, 0); PG8_SCHED; PG8_LDA(At, 0, 0); PG8_STAGE(PG8_SA(1, 1), a1 + hstepA, voffA);
            PG8_WAIT_L(8); PG8_BAR; PG8_WAIT_L(0); PG8_MMA(0, 0, At, B0); PG8_BAR; PG8_SCHED;
            PG8_LDB(B1, 0, 1); PG8_STAGE(PG8_SB(0, 0), b2, voffB);
            PG8_BAR; PG8_WAIT_L(0); PG8_MMA(0, 1, At, B1); PG8_BAR;
            PG8_LDA(At, 0, 1); PG8_STAGE(PG8_SA(0, 0), a2, voffA);
            PG8_BAR; PG8_WAIT_L(0); PG8_MMA(1, 0, At, B0); PG8_BAR; PG8_SCHED;
            PG8_STAGE(PG8_SB(0, 1), b2 + hstepB, voffB);
            PG8_WAIT_V(6); PG8_BAR; PG8_MMA(1, 1, At, B1); PG8_BAR;
            PG8_LDB(B0, 1, 0); PG8_SCHED; PG8_LDA(At, 1, 0); PG8_STAGE(PG8_SA(0, 1), a2 + hstepA, voffA);
            PG8_WAIT_L(8); PG8_BAR; PG8_WAIT_L(0); PG8_MMA(0, 0, At, B0); PG8_BAR; PG8_SCHED;
            PG8_LDB(B1, 1, 1); PG8_STAGE(PG8_SB(1, 0), b3, voffB);
            PG8_BAR; PG8_WAIT_L(0); PG8_MMA(0, 1, At, B1); PG8_BAR;
            PG8_LDA(At, 1, 1); PG8_STAGE(PG8_SA(1, 0), a3, voffA);
            PG8_BAR; PG8_WAIT_L(0); PG8_MMA(1, 0, At, B0); PG8_BAR; PG8_SCHED;
            PG8_STAGE(PG8_SB(1, 1), b3 + hstepB, voffB);
            PG8_WAIT_V(6); PG8_BAR; PG8_MMA(1, 1, At, B1); PG8_BAR;
            }
        }
        if constexpr (ALIGN_EPI) { if (wr == 0) PG8_BAR; }
        if constexpr (F8) asm volatile("s_nop 15\n\ts_nop 15" ::: "memory");
        if constexpr (!Epi::AFTER_DRAIN) { E(acc, cur, wr, wc, fr, fq); S.done(cur); }
        if (!has_next) break;
#pragma unroll
        for (int a = 0; a < 2; ++a)
#pragma unroll
            for (int b = 0; b < 2; ++b)
#pragma unroll
                for (int m = 0; m < 4; ++m)
#pragma unroll
                    for (int n = 0; n < 2; ++n) acc[a][b][m][n] = (f32x4){0.f, 0.f, 0.f, 0.f};
        cur = nxt; cA = nA; cB = nB; ++ui;
        if constexpr (ALIGN_EPI) { if (wr == 1) PG8_BAR; }
    }
    PG8_WAIT_V(0);
    if constexpr (!ALIGN_EPI) { if (wr == 0) PG8_BAR; }
    PG8_BAR;
#undef PG8_SA
#undef PG8_SB
#undef PG8_STAGE
#undef PG8_LDA
#undef PG8_LD8
#undef PG8_LDB
#undef PG8_MMA
#undef PG8_WAIT_V
#undef PG8_WAIT_L
#undef PG8_BAR
#undef PG8_SCHED
}
}

constexpr size_t MiB = 1u << 20;
constexpr size_t WS_CTL = 0, CTL_ZERO_BYTES = 1 * MiB;
constexpr size_t WS_BTIN  = 1 * MiB;
constexpr size_t WS_BTGLU = WS_BTIN + 36 * MiB;
constexpr size_t WS_BTPS  = WS_BTGLU + 2 * MiB;
constexpr size_t WS_BTPR  = WS_BTPS + 4 * MiB;
constexpr size_t WS_BTOUT = WS_BTPR + 4 * MiB;
constexpr size_t WS_BTPG  = WS_BTOUT + 8 * MiB;
constexpr size_t WS_BTPP  = WS_BTPG + 8 * MiB;
constexpr size_t WS_BTGU  = WS_BTPP + 1 * MiB;
constexpr size_t WS_BTDN  = WS_BTGU + 512 * MiB;
constexpr size_t WS_BTS3  = WS_BTDN + 256 * MiB;
constexpr size_t WS_BTS1  = WS_BTS3 + 40 * MiB;
constexpr size_t WS_ATAB  = WS_BTS1 + 16 * MiB;
constexpr size_t WS_CS    = WS_ATAB + 1 * MiB;
constexpr size_t WS_SN    = WS_CS + 4 * MiB;
constexpr size_t WS_WG    = WS_SN + 4 * MiB;
constexpr size_t WS_PBF   = WS_WG + 1 * MiB;
constexpr size_t WS_HB    = WS_PBF + 8 * MiB;
constexpr size_t WS_XG5   = WS_HB + 64 * MiB;
constexpr size_t WS_Q     = WS_XG5 + 40 * MiB;
constexpr size_t WS_K     = WS_Q + 32 * MiB;
constexpr size_t WS_V     = WS_K + 32 * MiB;
constexpr size_t WS_GS    = WS_V + 32 * MiB;
constexpr size_t WS_SGS   = WS_GS + 32 * MiB;
constexpr size_t WS_SGR   = WS_SGS + 64 * MiB;
constexpr size_t WS_SLOC  = WS_SGR + 64 * MiB;
constexpr size_t WS_KVT   = WS_SLOC + 16 * MiB;
constexpr size_t WS_RT    = WS_KVT + 64 * MiB;
constexpr size_t WS_YSP   = WS_RT + 32 * MiB;
constexpr size_t WS_YS    = WS_YSP + 32 * MiB;
constexpr size_t WS_YR    = WS_YS + 32 * MiB;
constexpr size_t WS_TMP   = WS_YR + 32 * MiB;
constexpr size_t WS_MRG   = WS_TMP + 128 * MiB;
constexpr size_t WS_X2    = WS_MRG + 64 * MiB;
constexpr size_t WS_PP    = WS_X2 + 128 * MiB;
constexpr size_t WS_TOKE  = WS_PP + 64 * MiB;
constexpr size_t WS_TOKG  = WS_TOKE + 1 * MiB;
constexpr size_t WS_TOKP  = WS_TOKG + 1 * MiB;
constexpr size_t WS_ROWG  = WS_TOKP + 1 * MiB;
constexpr size_t WS_AROW  = WS_ROWG + 1 * MiB;
constexpr size_t WS_BLKE  = WS_AROW + 1 * MiB;
constexpr size_t WS_XG    = WS_BLKE + 1 * MiB;
constexpr size_t WS_ACT   = WS_XG + 288 * MiB;
constexpr size_t WS_YB    = WS_ACT + 288 * MiB;
constexpr size_t WS_END   = WS_YB + 288 * MiB;
constexpr int CW_CNT = 64;
constexpr int CW_BAR = 4096;

constexpr int RING_OFF = 0, RING_BYTES = 131072;
constexpr int LDS_BYTES = 159744;
constexpr int LDSCTL_OFF = LDS_BYTES - 256;
constexpr int NWAVES = 8;

#define GAS __attribute__((address_space(1)))
#define LAS __attribute__((address_space(3)))
typedef unsigned short bf16;
typedef unsigned v4u __attribute__((ext_vector_type(4)));
typedef unsigned v2u __attribute__((ext_vector_type(2)));
typedef float f32x4 __attribute__((ext_vector_type(4)));
typedef float f32x16 __attribute__((ext_vector_type(16)));
typedef short bf16x8 __attribute__((ext_vector_type(8)));
#define RLX_AGENT __ATOMIC_RELAXED, __HIP_MEMORY_SCOPE_AGENT
#define LDS_WAIT() asm volatile("s_waitcnt lgkmcnt(0)" ::: "memory")
#define VM_WAIT() asm volatile("s_waitcnt vmcnt(0)" ::: "memory")
__device__ __forceinline__ unsigned f2bf(float f) { unsigned u = __builtin_bit_cast(unsigned, f); return (u + 0x7fffu + ((u >> 16) & 1u)) >> 16; }
__device__ __forceinline__ unsigned pk2(float lo, float hi) { return f2bf(lo) | (f2bf(hi) << 16); }
__device__ __forceinline__ float bf2f(unsigned short b) { return __builtin_bit_cast(float, (unsigned)b << 16); }

#define XB_TMO      128
#define XB_XCNT(j)  (256  + 64 * (j))
#define XB_XSUB(j)  (1280 + 64 * (j))
#define XB_XGEN(j)  (2304 + 64 * (j))
#define XB_TOP      3328
#define XB_TOPGEN   3392
#define XCD_BAR_WORDS 3456
#define XB_SPIN_CAP (1u << 20)
__device__ __forceinline__ unsigned xb_ld(unsigned* p)              { return __hip_atomic_load(p, __ATOMIC_RELAXED, __HIP_MEMORY_SCOPE_AGENT); }
__device__ __forceinline__ unsigned xb_add(unsigned* p, unsigned v) { return __hip_atomic_fetch_add(p, v, __ATOMIC_RELAXED, __HIP_MEMORY_SCOPE_AGENT); }
__device__ __forceinline__ unsigned xb_xcc_id() { return (unsigned)__builtin_amdgcn_s_getreg((3 << 11) | 20) & 0xFu; }
#define XB_SPIN(cond, bar) do { unsigned _sp = 0; while (cond) { __builtin_amdgcn_s_sleep(1); \
    if ((++_sp & 255u) == 0u) { if (xb_ld(&(bar)[XB_TMO])) break; if (_sp > XB_SPIN_CAP) { atomicAdd(&(bar)[XB_TMO], 1u); break; } } } } while (0)
struct XcdBarrier { unsigned* bar; unsigned x; volatile LAS unsigned* st; };
__device__ __forceinline__ XcdBarrier xcd_barrier_post(unsigned* bar, volatile LAS unsigned* st) {
    XcdBarrier b; b.bar = bar; b.x = xb_xcc_id(); b.st = st;
    if (threadIdx.x == 0) (void)xb_add(&bar[XB_XCNT(b.x)], 1u);
    return b;
}
__device__ __forceinline__ void xcd_barrier_complete(unsigned* bar, unsigned x, unsigned& nloc, unsigned& nx) {
    const unsigned G = gridDim.x * gridDim.y * gridDim.z;
    unsigned sum, cnt, mine, sp = 0u;
    for (;;) {
        sum = 0u; cnt = 0u; mine = 0u;
#pragma unroll
        for (unsigned j = 0; j < 16; ++j) { const unsigned c = xb_ld(&bar[XB_XCNT(j)]); sum += c; cnt += (c > 0u) ? 1u : 0u; mine = (j == x) ? c : mine; }
        if (sum == G) break;
        __builtin_amdgcn_s_sleep(1);
        if ((++sp & 255u) == 0u) { if (xb_ld(&bar[XB_TMO])) break; if (sp > XB_SPIN_CAP) { atomicAdd(&bar[XB_TMO], 1u); break; } }
    }
    nloc = mine > 0u ? mine : 1u; nx = cnt > 0u ? cnt : 1u;
}
__device__ __forceinline__ void xcd_barrier(const XcdBarrier& b) {
    asm volatile("s_waitcnt vmcnt(0)" ::: "memory");
    __syncthreads();
    if (threadIdx.x == 0) {
        unsigned* bar = b.bar;
        __builtin_amdgcn_s_waitcnt(0);
        unsigned nloc = b.st[0], nx = b.st[1];
        if (nloc == 0u) { xcd_barrier_complete(bar, b.x, nloc, nx); b.st[0] = nloc; b.st[1] = nx; }
        const unsigned old = xb_add(&bar[XB_XSUB(b.x)], 1u);
        const unsigned gen = old / nloc;
        if (old + 1u == (gen + 1u) * nloc) {
            __builtin_amdgcn_fence(__ATOMIC_RELEASE, "agent");
            asm volatile("s_waitcnt vmcnt(0)" ::: "memory");
            const unsigned og = xb_add(&bar[XB_TOP], 1u);
            const unsigned tg = og / nx;
            if (og + 1u == (tg + 1u) * nx) xb_add(&bar[XB_TOPGEN], 1u);
            else XB_SPIN(xb_ld(&bar[XB_TOPGEN]) == tg, bar);
            __builtin_amdgcn_fence(__ATOMIC_ACQUIRE, "agent");
            xb_add(&bar[XB_XGEN(b.x)], 1u);
            asm volatile("s_waitcnt vmcnt(0)" ::: "memory");
        } else {
            XB_SPIN(xb_ld(&bar[XB_XGEN(b.x)]) == gen, bar);
            __builtin_amdgcn_fence(__ATOMIC_ACQUIRE, "agent");
            asm volatile("s_waitcnt vmcnt(0)" ::: "memory");
        }
    }
    __syncthreads();
}

__device__ __forceinline__ float wave_sum(float v) {
#pragma unroll
    for (int o = 1; o < 64; o <<= 1) v += __shfl_xor(v, o);
    return v;
}
__device__ __forceinline__ int rowmap(int mode, int n) {
    if (mode == 1) { if (n < 1024 || n >= 3072) return n; const int nn = n - 1024, r = nn >> 10, hn = nn & 1023, head = hn >> 7, half = (hn >> 6) & 1, dd = hn & 63;
        return 1024 + r * 1024 + (head >> 1) * 256 + half * 128 + (head & 1) * 64 + dd; }
    if (mode == 2) { const int f = n >> 1, s = n & 1; return (f >> 7) * 256 + (f & 127) + 128 * s; }
    return n;
}
__device__ __forceinline__ void transpose_item(const float* W, int K, int N, bf16* WT, int mode, LAS float* scr, int kb, int nb, int lane) {
    const int k0 = 64 * kb, n0 = 64 * nb;
    const GAS float* src = (const GAS float*)W + (size_t)k0 * N + n0 + lane;
#pragma unroll
    for (int kq = 0; kq < 2; ++kq) { float r[32];
#pragma unroll
        for (int i = 0; i < 32; ++i) r[i] = src[(size_t)(kq * 32 + i) * N];
#pragma unroll
        for (int i = 0; i < 32; ++i) scr[(kq * 32 + i) * 65 + lane] = r[i]; }
    LDS_WAIT(); asm volatile("" ::: "memory");
    const int c = lane & 7;
    GAS bf16* dst = (GAS bf16*)WT;
#pragma unroll
    for (int j = 0; j < 8; ++j) { const int n = (lane >> 3) + 8 * j; const LAS float* s = scr + (8 * c) * 65 + n;
        v4u o; o.x = pk2(s[0 * 65], s[1 * 65]); o.y = pk2(s[2 * 65], s[3 * 65]); o.z = pk2(s[4 * 65], s[5 * 65]); o.w = pk2(s[6 * 65], s[7 * 65]);
        *(GAS v4u*)(dst + (size_t)rowmap(mode, n0 + n) * K + k0 + 8 * c) = o; }
    LDS_WAIT(); asm volatile("" ::: "memory");
}
__device__ __forceinline__ void transpose_item8(const float* W, int K, int N, unsigned char* WT, int mode, LAS float* scr, int kb, int nb, int lane) {
    const int k0 = 64 * kb, n0 = 64 * nb;
    const GAS float* src = (const GAS float*)W + (size_t)k0 * N + n0 + lane;
#pragma unroll
    for (int kq = 0; kq < 2; ++kq) { float r[32];
#pragma unroll
        for (int i = 0; i < 32; ++i) r[i] = src[(size_t)(kq * 32 + i) * N];
#pragma unroll
        for (int i = 0; i < 32; ++i) scr[(kq * 32 + i) * 65 + lane] = r[i] * pg8::W8_SCALE; }
    LDS_WAIT(); asm volatile("" ::: "memory");
    const int c = lane & 3;
    GAS unsigned char* dst = (GAS unsigned char*)WT;
#pragma unroll
    for (int j = 0; j < 4; ++j) { const int n = (lane >> 2) + 16 * j; const LAS float* s = scr + (16 * c) * 65 + n;
        v4u o; o.x = pg8::pk4_fp8(s[0 * 65], s[1 * 65], s[2 * 65], s[3 * 65]); o.y = pg8::pk4_fp8(s[4 * 65], s[5 * 65], s[6 * 65], s[7 * 65]);
        o.z = pg8::pk4_fp8(s[8 * 65], s[9 * 65], s[10 * 65], s[11 * 65]); o.w = pg8::pk4_fp8(s[12 * 65], s[13 * 65], s[14 * 65], s[15 * 65]);
        *(GAS v4u*)(dst + (size_t)rowmap(mode, n0 + n) * K + k0 + 16 * c) = o; }
    LDS_WAIT(); asm volatile("" ::: "memory");
}
__device__ __forceinline__ void rms_row_bf16(const float* xrow, const float* gain, bf16* orow, int lane) {
    const f32x4* xr = (const f32x4*)xrow + lane; const f32x4* gr = (const f32x4*)gain + lane;
    f32x4 v[8]; float s = 0.f;
#pragma unroll
    for (int j = 0; j < 8; ++j) { v[j] = xr[64 * j]; s += (v[j].x * v[j].x + v[j].y * v[j].y) + (v[j].z * v[j].z + v[j].w * v[j].w); }
    const float rstd = 1.0f / sqrtf(wave_sum(s) * (1.0f / 2048.0f) + 1e-6f);
    v2u* o8 = (v2u*)orow + lane;
#pragma unroll
    for (int j = 0; j < 8; ++j) { const f32x4 g = gr[64 * j]; v2u w; w.x = pk2(v[j].x * rstd * g.x, v[j].y * rstd * g.y); w.y = pk2(v[j].z * rstd * g.z, v[j].w * rstd * g.w); o8[64 * j] = w; }
}

struct Args {
    const float* x; const float* p; const int* pos; const float* norm1_g; const float* w_in;
    const float* lam_re; const float* lam_im; const float* log_dt; const float* b_re; const float* b_im; const float* c_re; const float* c_im; const float* d_skip;
    const float* w_glu; const float* b_glu; const float* w_bs; const float* w_br; const float* w_out; const float* norm2_g; const float* router_w; const float* router_b;
    const float* w_gu; const float* b_gu; const float* w_dn; const float* b_dn; const float* norm3_g; const float* w_pg; const float* w_pp; const float* fin_g;
    float* out; unsigned char* ws; int ph_lo, ph_hi, li, pad;
};

__device__ __forceinline__ void s5_tables(const Args& a, int g, LAS unsigned char* lds, int tid) {
    LAS float* Pre = (LAS float*)lds;
    LAS float* Pim = Pre + 33 * 64;
    LAS float* Bre = Pim + 33 * 64;
    LAS float* Bim = Bre + 1024;
    LAS float* Cre = Bim + 1024;
    LAS float* Cim = Cre + 1024;
    LAS float* Kt  = Cim + 1024;
    const float dt = expf(a.log_dt[g]);
    for (int e = tid; e < 33 * 64; e += 512) { const int p = e >> 6, n = e & 63; const float lr = a.lam_re[g * 64 + n], li = a.lam_im[g * 64 + n];
        const float mag = expf(lr * dt * (float)p), ang = li * dt * (float)p; Pre[e] = mag * cosf(ang); Pim[e] = mag * sinf(ang); }
    for (int e = tid; e < 1024; e += 512) { const int n = e >> 4; const float lr = a.lam_re[g * 64 + n], li = a.lam_im[g * 64 + n];
        const float mag = expf(lr * dt), abr = mag * cosf(li * dt), abi = mag * sinf(li * dt);
        const float den = lr * lr + li * li, nr = abr - 1.0f, ni = abi, fre = (nr * lr + ni * li) / den, fim = (ni * lr - nr * li) / den;
        const float br = a.b_re[(size_t)g * 1024 + e], bi = a.b_im[(size_t)g * 1024 + e];
        Bre[e] = fre * br - fim * bi; Bim[e] = fre * bi + fim * br;
        Cre[e] = a.c_re[(size_t)g * 1024 + e]; Cim[e] = a.c_im[(size_t)g * 1024 + e]; }
    __syncthreads();
    for (int e = tid; e < 8192; e += 512) { const int tau = e >> 8, c = (e >> 4) & 15, cp = e & 15; float s = 0.f;
        for (int n = 0; n < 64; ++n) { const float pr = Pre[tau * 64 + n], pi = Pim[tau * 64 + n], br = Bre[n * 16 + cp], bi = Bim[n * 16 + cp];
            const float zr = pr * br - pi * bi, zi = pr * bi + pi * br; s += Cre[c * 64 + n] * zr - Cim[c * 64 + n] * zi; }
        if (tau == 0 && c == cp) s += a.d_skip[g * 16 + c];
        Kt[e] = s; }
    __syncthreads();
    bf16* bt3 = (bf16*)(a.ws + WS_BTS3) + (size_t)g * 512 * K5;
    for (int ch = tid; ch < 512 * 80; ch += 512) { const int row = ch / 80, cc = ch % 80, i = row >> 4, c = row & 15; float v[8];
        if (cc < 64) { const int ip = cc >> 1, c0 = (cc & 1) * 8;
#pragma unroll
            for (int x = 0; x < 8; ++x) v[x] = (i >= ip) ? Kt[(i - ip) * 256 + c * 16 + c0 + x] : 0.f;
        } else { const int m0 = (cc - 64) * 8;
#pragma unroll
            for (int x = 0; x < 8; ++x) { const int m = m0 + x, n = m & 63; const float cr = Cre[c * 64 + n], ci = Cim[c * 64 + n], pr = Pre[(i + 1) * 64 + n], pi = Pim[(i + 1) * 64 + n];
                v[x] = (m < 64) ? (cr * pr - ci * pi) : -(cr * pi + ci * pr); } }
        v4u o; o.x = pk2(v[0], v[1]); o.y = pk2(v[2], v[3]); o.z = pk2(v[4], v[5]); o.w = pk2(v[6], v[7]);
        *(v4u*)(bt3 + (size_t)row * K5 + cc * 8) = o; }
    bf16* bt1 = (bf16*)(a.ws + WS_BTS1) + (size_t)g * 256 * 512;
    for (int ch = tid; ch < 256 * 64; ch += 512) { const int row = ch >> 6, cc = ch & 63, ip = cc >> 1, c0 = (cc & 1) * 8; float v[8];
#pragma unroll
        for (int x = 0; x < 8; ++x) { if (row < 128) { const int n = row & 63; const float pr = Pre[(31 - ip) * 64 + n], pi = Pim[(31 - ip) * 64 + n], br = Bre[n * 16 + c0 + x], bi = Bim[n * 16 + c0 + x];
                v[x] = (row < 64) ? (pr * br - pi * bi) : (pr * bi + pi * br); } else v[x] = 0.f; }
        v4u o; o.x = pk2(v[0], v[1]); o.y = pk2(v[2], v[3]); o.z = pk2(v[4], v[5]); o.w = pk2(v[6], v[7]);
        *(v4u*)(bt1 + (size_t)row * 512 + cc * 8) = o; }
    float* at = (float*)(a.ws + WS_ATAB) + g * 128;
    if (tid < 64) { at[tid * 2] = Pre[32 * 64 + tid]; at[tid * 2 + 1] = Pim[32 * 64 + tid]; }
    __syncthreads();
}

__device__ __forceinline__ void s5_scan_item(const Args& a, int item, LAS unsigned char* lds, int tid) {
    LAS float* seg_re = (LAS float*)lds; LAS float* seg_im = seg_re + 512;
    const int sl = tid & 31, seg = tid >> 5, sidx = item * 32 + sl, g = sidx >> 6, n = sidx & 63;
    const float* at = (const float*)(a.ws + WS_ATAB) + g * 128 + n * 2; const float ar = at[0], ai = at[1];
    const float* sloc = (const float*)(a.ws + WS_SLOC) + ((size_t)g * NCH5 + seg * 32) * 128 + n;
    float er = 0.f, ei = 0.f;
#pragma unroll 8
    for (int j = 0; j < 32; ++j) { const float lr = sloc[j * 128], li = sloc[j * 128 + 64]; const float tr = ar * er - ai * ei + lr, ti = ar * ei + ai * er + li; er = tr; ei = ti; }
    seg_re[seg * 32 + sl] = er; seg_im[seg * 32 + sl] = ei;
    __syncthreads();
    float pr = ar, pi = ai;
#pragma unroll
    for (int q = 0; q < 5; ++q) { const float tr = pr * pr - pi * pi, ti = 2.f * pr * pi; pr = tr; pi = ti; }
    float sr = 0.f, si = 0.f;
    for (int s2 = 0; s2 < seg; ++s2) { const float tr = pr * sr - pi * si + seg_re[s2 * 32 + sl], ti = pr * si + pi * sr + seg_im[s2 * 32 + sl]; sr = tr; si = ti; }
    bf16* xg = (bf16*)(a.ws + WS_XG5) + ((size_t)g * NCH5 + seg * 32) * K5 + 512 + n;
#pragma unroll 8
    for (int j = 0; j < 32; ++j) { xg[(size_t)j * K5] = (bf16)f2bf(sr); xg[(size_t)j * K5 + 64] = (bf16)f2bf(si);
        const float lr = sloc[j * 128], li = sloc[j * 128 + 64]; const float tr = ar * sr - ai * si + lr, ti = ar * si + ai * sr + li; sr = tr; si = ti; }
    __syncthreads();
}

constexpr int RS = 130;
__device__ __forceinline__ float ret_l2g(int h) { return log2f(1.0f - exp2f(-5.0f - (float)h)); }
__device__ __forceinline__ bf16x8 lds_frag_col(const LAS bf16* base, int stride) {
    bf16x8 f;
#pragma unroll
    for (int x = 0; x < 8; ++x) f[x] = (short)base[x * stride];
    return f;
}
template <bool ZETA> __device__ __forceinline__ void ret_stage(const bf16* src_, LAS bf16* dst, int tid, float l2g) {
    const GAS bf16* src = (const GAS bf16*)src_; v4u wv[4];
#pragma unroll
    for (int q = 0; q < 4; ++q) { const int id = tid + 512 * q, row = id >> 4, c8 = id & 15; wv[q] = *(const GAS v4u*)(src + (size_t)row * 1024 + 8 * c8); }
#pragma unroll
    for (int q = 0; q < 4; ++q) { const int id = tid + 512 * q, row = id >> 4, c8 = id & 15; v4u w = wv[q];
        if (ZETA) { const float z = exp2f(l2g * (float)(127 - row));
            w.x = pk2(pg8::bf_lo(w.x) * z, pg8::bf_hi(w.x) * z); w.y = pk2(pg8::bf_lo(w.y) * z, pg8::bf_hi(w.y) * z); w.z = pk2(pg8::bf_lo(w.z) * z, pg8::bf_hi(w.z) * z); w.w = pk2(pg8::bf_lo(w.w) * z, pg8::bf_hi(w.w) * z); }
        LAS unsigned* d = (LAS unsigned*)(dst + row * RS + 8 * c8); d[0] = w.x; d[1] = w.y; d[2] = w.z; d[3] = w.w; }
}
__device__ __forceinline__ void ret_kv_unit(const Args& a, int unit, LAS unsigned char* lds, int tid) {
    const int n = unit >> 3, h = unit & 7, t0 = n * RCH, lane = tid & 63, w = __builtin_amdgcn_readfirstlane(tid >> 6), fr = lane & 15, fg = lane >> 4;
    LAS bf16* Ks = (LAS bf16*)lds; LAS bf16* Vs = Ks + 128 * RS;
    const float l2g = ret_l2g(h);
    ret_stage<true>((const bf16*)(a.ws + WS_K) + (size_t)t0 * 1024 + h * 128, Ks, tid, l2g);
    ret_stage<false>((const bf16*)(a.ws + WS_V) + (size_t)t0 * 1024 + h * 128, Vs, tid, l2g);
    __syncthreads();
    bf16x8 af[4];
#pragma unroll
    for (int ks = 0; ks < 4; ++ks) af[ks] = lds_frag_col(Vs + (32 * ks + 8 * fg) * RS + 16 * w + fr, RS);
    float* out = (float*)(a.ws + WS_KVT) + ((size_t)unit * 128 + 16 * w + 4 * fg) * 128 + fr;
#pragma unroll
    for (int dt = 0; dt < 8; ++dt) { f32x4 acc = (f32x4){0.f, 0.f, 0.f, 0.f};
#pragma unroll
        for (int ks = 0; ks < 4; ++ks) { const bf16x8 bfv = lds_frag_col(Ks + (32 * ks + 8 * fg) * RS + 16 * dt + fr, RS);
            acc = __builtin_amdgcn_mfma_f32_16x16x32_bf16(af[ks], bfv, acc, 0, 0, 0); }
#pragma unroll
        for (int r = 0; r < 4; ++r) out[(size_t)r * 128 + 16 * dt] = acc[r]; }
    __syncthreads();
}
__device__ __forceinline__ void ret_state_scan(const Args& a, int gtid, int gthreads) {
    const float* kvt = (const float*)(a.ws + WS_KVT); bf16* rt = (bf16*)(a.ws + WS_RT);
    for (int idx = gtid; idx < RH * 128 * 128; idx += gthreads) { const int h = idx >> 14; const float dec = exp2f(128.0f * ret_l2g(h)); float st = 0.f;
#pragma unroll 8
        for (int n = 0; n < NRC; ++n) { rt[(size_t)n * 131072 + idx] = (bf16)f2bf(st); st = st * dec + kvt[(size_t)n * 131072 + idx]; } }
}
__device__ __forceinline__ void ret_out_unit(const Args& a, int unit, LAS unsigned char* lds, int tid) {
    const int n = unit >> 3, h = unit & 7, t0 = n * RCH, lane = tid & 63, w = __builtin_amdgcn_readfirstlane(tid >> 6), fr = lane & 15, fg = lane >> 4;
    LAS bf16* Ks = (LAS bf16*)lds; LAS bf16* Vs = Ks + 128 * RS; LAS bf16* Ps = Vs + 128 * RS;
    const float l2g = ret_l2g(h);
    ret_stage<false>((const bf16*)(a.ws + WS_K) + (size_t)t0 * 1024 + h * 128, Ks, tid, l2g);
    ret_stage<false>((const bf16*)(a.ws + WS_V) + (size_t)t0 * 1024 + h * 128, Vs, tid, l2g);
    const int i0 = 16 * w, il = i0 + fr;
    bf16x8 qf[4];
    { const bf16* qp = (const bf16*)(a.ws + WS_Q) + (size_t)(t0 + il) * 1024 + h * 128 + 8 * fg;
#pragma unroll
      for (int ks = 0; ks < 4; ++ks) qf[ks] = *(const bf16x8*)(qp + 32 * ks); }
    __syncthreads();
#pragma unroll
    for (int jt = 0; jt < 8; ++jt) {
        if (jt <= w) { f32x4 acc = (f32x4){0.f, 0.f, 0.f, 0.f};
#pragma unroll
            for (int ks = 0; ks < 4; ++ks) { bf16x8 kf;
#pragma unroll
                for (int x = 0; x < 8; ++x) kf[x] = (short)Ks[(16 * jt + fr) * RS + 32 * ks + 8 * fg + x];
                acc = __builtin_amdgcn_mfma_f32_16x16x32_bf16(kf, qf[ks], acc, 0, 0, 0); }
            float pv[4];
#pragma unroll
            for (int r = 0; r < 4; ++r) { const int j = 16 * jt + 4 * fg + r; pv[r] = (il >= j) ? acc[r] * exp2f(l2g * (float)(il - j)) : 0.f; }
            LAS unsigned* pp = (LAS unsigned*)(Ps + il * RS + 16 * jt + 4 * fg); pp[0] = pk2(pv[0], pv[1]); pp[1] = pk2(pv[2], pv[3]);
        } else if (jt == w + 1 && (w & 1) == 0) { LAS unsigned* pp = (LAS unsigned*)(Ps + il * RS + 16 * jt + 4 * fg); pp[0] = 0u; pp[1] = 0u; }
    }
    __syncthreads();
    f32x4 accI[8], accC[8];
#pragma unroll
    for (int et = 0; et < 8; ++et) { accI[et] = (f32x4){0.f, 0.f, 0.f, 0.f}; accC[et] = (f32x4){0.f, 0.f, 0.f, 0.f}; }
    const int nks = (w >> 1) + 1;
    for (int ks = 0; ks < nks; ++ks) { bf16x8 pf;
#pragma unroll
        for (int x = 0; x < 8; ++x) pf[x] = (short)Ps[il * RS + 32 * ks + 8 * fg + x];
#pragma unroll
        for (int et = 0; et < 8; ++et) { const bf16x8 vf = lds_frag_col(Vs + (32 * ks + 8 * fg) * RS + 16 * et + fr, RS);
            accI[et] = __builtin_amdgcn_mfma_f32_16x16x32_bf16(vf, pf, accI[et], 0, 0, 0); } }
    { const bf16* rp = (const bf16*)(a.ws + WS_RT) + ((size_t)unit * 128 + fr) * 128 + 8 * fg;
#pragma unroll
      for (int et = 0; et < 8; ++et)
#pragma unroll
          for (int ks = 0; ks < 4; ++ks) { const bf16x8 rf = *(const bf16x8*)(rp + (size_t)(16 * et) * 128 + 32 * ks);
              accC[et] = __builtin_amdgcn_mfma_f32_16x16x32_bf16(rf, qf[ks], accC[et], 0, 0, 0); } }
    const float xi = exp2f(l2g * (float)(il + 1));
    float s = 0.f;
#pragma unroll
    for (int et = 0; et < 8; ++et) { accI[et] = accI[et] + accC[et] * xi; s += (accI[et][0] + accI[et][1]) + (accI[et][2] + accI[et][3]); }
    s += __shfl_xor(s, 16); s += __shfl_xor(s, 32);
    const float mu = s * (1.0f / 128.0f); float q2 = 0.f;
#pragma unroll
    for (int et = 0; et < 8; ++et) { accI[et] = accI[et] - mu; q2 += (accI[et][0] * accI[et][0] + accI[et][1] * accI[et][1]) + (accI[et][2] * accI[et][2] + accI[et][3] * accI[et][3]); }
    q2 += __shfl_xor(q2, 16); q2 += __shfl_xor(q2, 32);
    const float rstd = 1.0f / sqrtf(q2 * (1.0f / 128.0f) + 1e-6f);
    const size_t ob = (size_t)(t0 + il) * 1024 + h * 128 + 4 * fg;
    const bf16* gp = (const bf16*)(a.ws + WS_GS) + ob; bf16* yp = (bf16*)(a.ws + WS_YR) + ob;
#pragma unroll
    for (int et = 0; et < 8; ++et) { const v2u gw = *(const v2u*)(gp + 16 * et); v2u o;
        o.x = pk2(accI[et][0] * rstd * pg8::bf_lo(gw.x), accI[et][1] * rstd * pg8::bf_hi(gw.x)); o.y = pk2(accI[et][2] * rstd * pg8::bf_lo(gw.y), accI[et][3] * rstd * pg8::bf_hi(gw.y));
        *(v2u*)(yp + 16 * et) = o; }
    __syncthreads();
}

__device__ __forceinline__ void router_item(const Args& a, int item, LAS unsigned char* lds, int tid) {
    LAS float* rs = (LAS float*)lds;
    LAS float* part = rs + 64;
    LAS float* lg = part + 4 * 64 * 33;
    LAS int* hist = (LAS int*)(lg + 64 * 33);
    LAS int* base = hist + 32;
    const int lane = tid & 63, w = __builtin_amdgcn_readfirstlane(tid >> 6), tb = item * 64;
    const float* x2 = (const float*)(a.ws + WS_X2);
    if (tid < 32) hist[tid] = 0;
    for (int r = 0; r < 8; ++r) { const int t = tb + 8 * w + r; const float* xrow = x2 + (size_t)t * 2048;
        const f32x4* xr = (const f32x4*)xrow + lane; const f32x4* gr = (const f32x4*)a.norm2_g + lane;
        f32x4 v[8]; float s = 0.f;
#pragma unroll
        for (int j = 0; j < 8; ++j) { v[j] = xr[64 * j]; s += (v[j].x * v[j].x + v[j].y * v[j].y) + (v[j].z * v[j].z + v[j].w * v[j].w); }
        const float rstd = 1.0f / sqrtf(wave_sum(s) * (1.0f / 2048.0f) + 1e-6f);
        if (lane == 0) rs[8 * w + r] = rstd;
        v2u* o8 = (v2u*)((bf16*)(a.ws + WS_HB) + (size_t)t * 2048) + lane;
#pragma unroll
        for (int j = 0; j < 8; ++j) { const f32x4 g = gr[64 * j]; v2u o; o.x = pk2(v[j].x * rstd * g.x, v[j].y * rstd * g.y); o.y = pk2(v[j].z * rstd * g.z, v[j].w * rstd * g.w); o8[64 * j] = o; } }
    { const int tg = w & 1, kq = w >> 1, hl = lane >> 5, l31 = lane & 31;
      const float* xp = x2 + (size_t)(tb + 32 * tg + l31) * 2048 + 512 * kq + 4 * hl;
      const float* wp = (const float*)(a.ws + WS_WG) + (size_t)(512 * kq + 4 * hl) * 32 + l31;
      f32x16 acc;
#pragma unroll
      for (int x = 0; x < 16; ++x) acc[x] = 0.f;
#pragma unroll 4
      for (int kk = 0; kk < 64; ++kk) { const f32x4 av = *(const f32x4*)(xp + 8 * kk); const float* wq = wp + (size_t)(8 * kk) * 32;
          acc = __builtin_amdgcn_mfma_f32_32x32x2f32(av.x, wq[0], acc, 0, 0, 0); acc = __builtin_amdgcn_mfma_f32_32x32x2f32(av.y, wq[32], acc, 0, 0, 0);
          acc = __builtin_amdgcn_mfma_f32_32x32x2f32(av.z, wq[64], acc, 0, 0, 0); acc = __builtin_amdgcn_mfma_f32_32x32x2f32(av.w, wq[96], acc, 0, 0, 0); }
#pragma unroll
      for (int x = 0; x < 16; ++x) { const int tl = (x & 3) + 8 * (x >> 2) + 4 * hl; part[(kq * 64 + 32 * tg + tl) * 33 + l31] = acc[x]; } }
    __syncthreads();
    for (int e = tid; e < 64 * 32; e += 512) { const int tl = e >> 5, ex = e & 31;
        lg[tl * 33 + ex] = rs[tl] * ((part[(0 * 64 + tl) * 33 + ex] + part[(1 * 64 + tl) * 33 + ex]) + (part[(2 * 64 + tl) * 33 + ex] + part[(3 * 64 + tl) * 33 + ex])) + a.router_b[ex]; }
    __syncthreads();
    int e0 = 0, e1 = 0, e2 = 0, e3 = 0, r0 = 0, r1 = 0, r2 = 0, r3 = 0; float g0 = 0.f, g1 = 0.f, g2 = 0.f, g3 = 0.f;
    if (tid < 64) { const LAS float* L = lg + tid * 33; float v0 = -3.0e38f, v1 = -3.0e38f, v2 = -3.0e38f, v3 = -3.0e38f;
        for (int ex = 0; ex < 32; ++ex) { const float v = L[ex]; if (v > v0) { v0 = v; e0 = ex; } }
        for (int ex = 0; ex < 32; ++ex) { const float v = L[ex]; if (ex != e0 && v > v1) { v1 = v; e1 = ex; } }
        for (int ex = 0; ex < 32; ++ex) { const float v = L[ex]; if (ex != e0 && ex != e1 && v > v2) { v2 = v; e2 = ex; } }
        for (int ex = 0; ex < 32; ++ex) { const float v = L[ex]; if (ex != e0 && ex != e1 && ex != e2 && v > v3) { v3 = v; e3 = ex; } }
        const float p0 = 1.0f, p1 = expf(v1 - v0), p2 = expf(v2 - v0), p3 = expf(v3 - v0), inv = 1.0f / (p0 + p1 + p2 + p3);
        g0 = p0 * inv; g1 = p1 * inv; g2 = p2 * inv; g3 = p3 * inv;
        r0 = __hip_atomic_fetch_add(&hist[e0], 1, __ATOMIC_RELAXED, __HIP_MEMORY_SCOPE_WORKGROUP); r1 = __hip_atomic_fetch_add(&hist[e1], 1, __ATOMIC_RELAXED, __HIP_MEMORY_SCOPE_WORKGROUP);
        r2 = __hip_atomic_fetch_add(&hist[e2], 1, __ATOMIC_RELAXED, __HIP_MEMORY_SCOPE_WORKGROUP); r3 = __hip_atomic_fetch_add(&hist[e3], 1, __ATOMIC_RELAXED, __HIP_MEMORY_SCOPE_WORKGROUP); }
    __syncthreads();
    if (tid < 32) base[tid] = (int)__hip_atomic_fetch_add((unsigned*)(a.ws + WS_CTL) + CW_CNT + tid, (unsigned)hist[tid], RLX_AGENT);
    __syncthreads();
    if (tid < 64) { const int t = tb + tid; int* te = (int*)(a.ws + WS_TOKE) + t * 4; float* tg = (float*)(a.ws + WS_TOKG) + t * 4; int* tp = (int*)(a.ws + WS_TOKP) + t * 4;
        te[0] = e0; te[1] = e1; te[2] = e2; te[3] = e3; tg[0] = g0; tg[1] = g1; tg[2] = g2; tg[3] = g3;
        tp[0] = base[e0] + r0; tp[1] = base[e1] + r1; tp[2] = base[e2] + r2; tp[3] = base[e3] + r3; }
    __syncthreads();
}

constexpr int N_PHASES = 15;
__global__ void __launch_bounds__(NWAVES * 64, 2) mk_fwd(Args kargs) {
    extern __shared__ __attribute__((aligned(16))) unsigned char lds_raw[];
    LAS unsigned char* lds = (LAS unsigned char*)lds_raw;
    const int tid = threadIdx.x, lane = tid & 63, wave = __builtin_amdgcn_readfirstlane(tid >> 6);
    const int G = gridDim.x, bx = blockIdx.x, gw = bx * NWAVES + wave, NGW = G * NWAVES, gtid = bx * (NWAVES * 64) + tid, GT = G * NWAVES * 64;
    unsigned char* const ws = kargs.ws;
#define LOAD_ARGS() const __attribute__((address_space(4))) Args* ap_ = (const __attribute__((address_space(4))) Args*)__builtin_amdgcn_kernarg_segment_ptr(); asm volatile("" : "+s"(ap_)); Args a; { const __attribute__((address_space(4))) unsigned long long* q_ = (const __attribute__((address_space(4))) unsigned long long*)ap_; unsigned long long* d_ = (unsigned long long*)&a; _Pragma("unroll") for (int i_ = 0; i_ < (int)(sizeof(Args) / 8); ++i_) d_[i_] = q_[i_]; }
    for (int u = tid; u < (LDS_BYTES - LDSCTL_OFF) / 4; u += NWAVES * 64) ((LAS unsigned*)(lds + LDSCTL_OFF))[u] = 0u;
    __syncthreads();
    XcdBarrier bar = xcd_barrier_post((unsigned*)(ws + WS_CTL) + CW_BAR + kargs.li * XCD_BAR_WORDS, (volatile LAS unsigned*)(lds + LDSCTL_OFF) + 8);
    const int lo = kargs.ph_lo, hi = kargs.ph_hi;
#ifndef PH_MASK
#define PH_MASK 0x7fff
#endif
#define IN(k) (((PH_MASK >> (k)) & 1) && lo <= (k) && (k) < hi)
#define SEAM(k) do { if (IN(k) && IN((k) + 1)) xcd_barrier(bar); } while (0)
    bf16* const HB = (bf16*)(ws + WS_HB);

    if (IN(0)) { LOAD_ARGS();
        for (int g = bx; g < NG5; g += G) s5_tables(a, g, lds, tid);
        LAS float* scr = (LAS float*)(lds + wave * 16640);
#define TR(src, K_, N_, dst, mode, nmat, sstride, dstride) do { const int nbk = (N_) / 64, per = ((K_) / 64) * nbk; \
        for (int it = gw; it < (nmat) * per; it += NGW) { const int mat = it / per, r = it % per; \
            transpose_item((src) + (size_t)mat * (sstride), (K_), (N_), (dst) + (size_t)mat * (dstride), (mode), scr, r / nbk, r % nbk, lane); } } while (0)
        TR(a.w_in, 2048, INC, (bf16*)(ws + WS_BTIN), 1, 1, 0, 0);
        TR(a.w_pp, PLED, 2048, (bf16*)(ws + WS_BTPP), 0, 1, 0, 0);
        TR(a.w_glu, 1024, 1024, (bf16*)(ws + WS_BTGLU), 0, 1, 0, 0);
        TR(a.w_bs, 1024, 2048, (bf16*)(ws + WS_BTPS), 0, 1, 0, 0);
        TR(a.w_br, 1024, 2048, (bf16*)(ws + WS_BTPR), 0, 1, 0, 0);
        TR(a.w_out, 2048, 2048, (bf16*)(ws + WS_BTOUT), 0, 1, 0, 0);
        TR(a.w_pg, 2048, 2048, (bf16*)(ws + WS_BTPG), 0, 1, 0, 0);
#undef TR
#define TR8(src, K_, N_, dst, mode, nmat, sstride, dstride) do { const int nbk = (N_) / 64, per = ((K_) / 64) * nbk; \
        for (int it = gw; it < (nmat) * per; it += NGW) { const int mat = it / per, r = it % per; \
            transpose_item8((src) + (size_t)mat * (sstride), (K_), (N_), (dst) + (size_t)mat * (dstride), (mode), scr, r / nbk, r % nbk, lane); } } while (0)
        TR8(a.w_gu, 2048, 4096, ws + WS_BTGU, 2, NEXP, (size_t)2048 * 4096, (size_t)4096 * 2048);
        TR8(a.w_dn, 2048, 2048, ws + WS_BTDN, 0, NEXP, (size_t)2048 * 2048, (size_t)2048 * 2048);
#undef TR8
        for (int t = gw; t < SEQ; t += NGW) rms_row_bf16(a.x + (size_t)t * 2048, a.norm1_g, HB + (size_t)t * 2048, lane);
        { float* cs = (float*)(ws + WS_CS); float* sn = (float*)(ws + WS_SN);
          for (int e = gtid; e < SEQ * 64; e += GT) { const int t = e >> 6, i = e & 63; const float inv = powf(10000.0f, -(float)i / 64.0f), ang = (float)a.pos[t] * inv; cs[e] = cosf(ang); sn[e] = sinf(ang); } }
        { float* wg = (float*)(ws + WS_WG); for (int e = gtid; e < 2048 * 32; e += GT) wg[e] = a.norm2_g[e >> 5] * a.router_w[e]; }
        { v2u* pb = (v2u*)(ws + WS_PBF); const f32x4* pf = (const f32x4*)a.p;
          for (int e = gtid; e < SEQ * PLED / 4; e += GT) { const f32x4 v = pf[e]; v2u o; o.x = pk2(v.x, v.y); o.y = pk2(v.z, v.w); pb[e] = o; } }
    }
    SEAM(0);
    if (IN(1)) { LOAD_ARGS();
#ifndef P1_MASK
#define P1_MASK 15
#endif
        if (P1_MASK & 1) { pg8::Gemm g{HB, (const bf16*)(ws + WS_BTIN), 2048, 2048, 2048}; pg8::StaticOrder S; S.init(SEQ, 1024, G, bx);
          pg8::EpiZU E{(bf16*)(ws + WS_XG5)};
          pg8::gemm_phase<pg8::EpiZU, pg8::StaticOrder, true, true>(lds + RING_OFF, g, S, E); }
        if (P1_MASK & 2) { pg8::Gemm g{HB, (const bf16*)(ws + WS_BTIN) + (size_t)1024 * 2048, 2048, 2048, 2048}; pg8::StaticOrder S; S.init(SEQ, 2048, G, bx);
          pg8::EpiZR E{(bf16*)(ws + WS_Q), (bf16*)(ws + WS_K), (const float*)(ws + WS_CS), (const float*)(ws + WS_SN)};
          pg8::gemm_phase<pg8::EpiZR, pg8::StaticOrder, true, true>(lds + RING_OFF, g, S, E); }
        if (P1_MASK & 4) { pg8::Gemm g{HB, (const bf16*)(ws + WS_BTIN) + (size_t)3072 * 2048, 2048, 2048, 2048}; pg8::StaticOrder S; S.init(SEQ, 6144, G, bx);
          pg8::EpiZA E{(bf16*)(ws + WS_V), (bf16*)(ws + WS_GS), (bf16*)(ws + WS_SGS), (bf16*)(ws + WS_SGR)};
          pg8::gemm_phase<pg8::EpiZA, pg8::StaticOrder, true, true>(lds + RING_OFF, g, S, E); }
        if (P1_MASK & 8) { pg8::Gemm g{(const bf16*)(ws + WS_PBF), (const bf16*)(ws + WS_BTPP), PLED, PLED, PLED}; pg8::StaticOrder S; S.init(SEQ, 2048, G, bx);
          pg8::EpiPlain E{(bf16*)(ws + WS_PP), 2048};
          pg8::gemm_phase<pg8::EpiPlain, pg8::StaticOrder, true, true>(lds + RING_OFF, g, S, E); }
    }
    SEAM(1);
    if (IN(2)) { LOAD_ARGS();
        { pg8::Gemm g{(const bf16*)(ws + WS_XG5), (const bf16*)(ws + WS_BTS1), K5, 512, 512}; pg8::OrderS1 S{G, bx}; pg8::EpiS1 E{(float*)(ws + WS_SLOC)};
          pg8::gemm_phase<pg8::EpiS1, pg8::OrderS1, false, true>(lds + RING_OFF, g, S, E); }
        __syncthreads();
        for (int u = bx; u < NRC * RH; u += G) ret_kv_unit(a, u, lds, tid);
    }
    SEAM(2);
    if (IN(3)) { LOAD_ARGS();
        for (int it = G - 1 - bx; it < 128; it += G) s5_scan_item(a, it, lds, tid);
        ret_state_scan(a, gtid, GT);
    }
    SEAM(3);
    if (IN(4)) { LOAD_ARGS();
        { pg8::Gemm g{(const bf16*)(ws + WS_XG5), (const bf16*)(ws + WS_BTS3), K5, K5, K5}; pg8::OrderS3 S{G, bx}; pg8::EpiS3 E{(bf16*)(ws + WS_YSP)};
          pg8::gemm_phase<pg8::EpiS3, pg8::OrderS3, false, true>(lds + RING_OFF, g, S, E); }
        __syncthreads();
        for (int u = bx; u < NRC * RH; u += G) ret_out_unit(a, u, lds, tid);
    }
    SEAM(4);
    if (IN(5)) { LOAD_ARGS();
        pg8::Gemm g{(const bf16*)(ws + WS_YSP), (const bf16*)(ws + WS_BTGLU), 1024, 1024, 1024}; pg8::StaticOrder S; S.init(SEQ, 1024, G, bx);
        pg8::EpiGLU E{(const bf16*)(ws + WS_YSP), a.b_glu, (bf16*)(ws + WS_YS)};
        pg8::gemm_phase<pg8::EpiGLU, pg8::StaticOrder, true, true>(lds + RING_OFF, g, S, E);
    }
    SEAM(5);
#ifdef EXTRA_BAR
    for (int eb_ = 0; eb_ < EXTRA_BAR; ++eb_) xcd_barrier(bar);
#endif
    if (IN(6)) { LOAD_ARGS();
        { pg8::Gemm g{(const bf16*)(ws + WS_YS), (const bf16*)(ws + WS_BTPS), 1024, 1024, 1024}; pg8::StaticOrder S; S.init(SEQ, 2048, G, bx);
          pg8::EpiM1 E{(const bf16*)(ws + WS_SGS), (float*)(ws + WS_TMP)};
          pg8::gemm_phase<pg8::EpiM1, pg8::StaticOrder, true, true>(lds + RING_OFF, g, S, E); }
        VM_WAIT(); __syncthreads();
        { pg8::Gemm g{(const bf16*)(ws + WS_YR), (const bf16*)(ws + WS_BTPR), 1024, 1024, 1024}; pg8::StaticOrder S; S.init(SEQ, 2048, G, bx);
          pg8::EpiM2 E{(const bf16*)(ws + WS_SGR), (const float*)(ws + WS_TMP), (bf16*)(ws + WS_MRG)};
          pg8::gemm_phase<pg8::EpiM2, pg8::StaticOrder, true, true>(lds + RING_OFF, g, S, E); }
    }
    SEAM(6);
    if (IN(7)) { LOAD_ARGS();
        pg8::Gemm g{(const bf16*)(ws + WS_MRG), (const bf16*)(ws + WS_BTOUT), 2048, 2048, 2048}; pg8::StaticOrder S; S.init(SEQ, 2048, G, bx);
        pg8::EpiRes E{a.x, (float*)(ws + WS_X2)};
        pg8::gemm_phase<pg8::EpiRes, pg8::StaticOrder, true, true>(lds + RING_OFF, g, S, E);
    }
    SEAM(7);
    if (IN(8)) { LOAD_ARGS(); for (int it = bx; it < SEQ / 64; it += G) router_item(a, it, lds, tid); }
    SEAM(8);
    if (IN(9)) { LOAD_ARGS();
        LAS int* ps = (LAS int*)lds;
        if (tid == 0) { int accp = 0; for (int e = 0; e < NEXP; ++e) { const int c = (int)__hip_atomic_load((unsigned*)(ws + WS_CTL) + CW_CNT + e, RLX_AGENT); ps[e] = accp; accp += (c + 255) / 256 * 256; } ps[NEXP] = accp; }
        __syncthreads();
        int* blke = (int*)(ws + WS_BLKE);
        if (bx == 0 && tid < NEXP) { for (int rt = ps[tid] >> 8; rt < (ps[tid + 1] >> 8); ++rt) blke[rt] = tid; }
        if (bx == 0 && tid == 0) blke[511] = ps[NEXP] >> 8;
        const int* toke = (const int*)(ws + WS_TOKE); const int* tokp = (const int*)(ws + WS_TOKP); const float* tokg = (const float*)(ws + WS_TOKG);
        float* rowg = (float*)(ws + WS_ROWG); int* arow = (int*)(ws + WS_AROW);
        for (int as = gw; as < SEQ * 4; as += NGW) { const int tok = as >> 2, row = ps[toke[as]] + tokp[as];
            const v4u* s = (const v4u*)(HB + (size_t)tok * 2048) + 4 * lane; v4u* d = (v4u*)(ws + WS_XG + (size_t)row * 2048) + 2 * lane;
            const v4u v0 = s[0], v1 = s[1], v2 = s[2], v3 = s[3]; v4u o0, o1;
#define CV8(w0, w1) pg8::pk4_fp8(pg8::bf_lo(w0), pg8::bf_hi(w0), pg8::bf_lo(w1), pg8::bf_hi(w1))
            o0.x = CV8(v0.x, v0.y); o0.y = CV8(v0.z, v0.w); o0.z = CV8(v1.x, v1.y); o0.w = CV8(v1.z, v1.w);
            o1.x = CV8(v2.x, v2.y); o1.y = CV8(v2.z, v2.w); o1.z = CV8(v3.x, v3.y); o1.w = CV8(v3.z, v3.w);
#undef CV8
            d[0] = o0; d[1] = o1;
            if (lane == 0) { rowg[row] = tokg[as]; arow[as] = row; } }
        __syncthreads();
    }
    SEAM(9);
    if (IN(10)) { LOAD_ARGS();
        const int* blke = (const int*)(ws + WS_BLKE); const int nrt = __builtin_amdgcn_readfirstlane(blke[511]);
        pg8::Gemm g{(const bf16*)(ws + WS_XG), (const bf16*)(ws + WS_BTGU), 1024, 1024, 1024};     pg8::OrderMoe S; S.so.init(nrt * 256, 4096, G, bx); S.blk_e = blke; S.ntn = 16;
        pg8::EpiGU E{a.b_gu, ws + WS_ACT};
        pg8::gemm_phase<pg8::EpiGU, pg8::OrderMoe, true, true, true>(lds + RING_OFF, g, S, E);
    }
    SEAM(10);
    if (IN(11)) { LOAD_ARGS();
        const int* blke = (const int*)(ws + WS_BLKE); const int nrt = __builtin_amdgcn_readfirstlane(blke[511]);
        pg8::Gemm g{(const bf16*)(ws + WS_ACT), (const bf16*)(ws + WS_BTDN), 1024, 1024, 1024}; pg8::OrderMoe S; S.so.init(nrt * 256, 2048, G, bx); S.blk_e = blke; S.ntn = 8;
        pg8::EpiDN E{a.b_dn, (const float*)(ws + WS_ROWG), (bf16*)(ws + WS_YB)};
        pg8::gemm_phase<pg8::EpiDN, pg8::OrderMoe, true, true, true>(lds + RING_OFF, g, S, E);
    }
    SEAM(11);
    if (IN(12)) { LOAD_ARGS();
        const int* arow = (const int*)(ws + WS_AROW); const bf16* yb = (const bf16*)(ws + WS_YB);
        for (int t = gw; t < SEQ; t += NGW) { f32x4* xr = (f32x4*)((float*)(ws + WS_X2) + (size_t)t * 2048) + lane;
            const int r0 = arow[t * 4], r1 = arow[t * 4 + 1], r2 = arow[t * 4 + 2], r3 = arow[t * 4 + 3];
            const v2u* y0 = (const v2u*)(yb + (size_t)r0 * 2048) + lane; const v2u* y1 = (const v2u*)(yb + (size_t)r1 * 2048) + lane;
            const v2u* y2 = (const v2u*)(yb + (size_t)r2 * 2048) + lane; const v2u* y3 = (const v2u*)(yb + (size_t)r3 * 2048) + lane;
            f32x4 v[8]; float s = 0.f;
#pragma unroll
            for (int j = 0; j < 8; ++j) { f32x4 x = xr[64 * j]; const v2u w0 = y0[64 * j], w1 = y1[64 * j], w2 = y2[64 * j], w3 = y3[64 * j];
                x.x += (pg8::bf_lo(w0.x) + pg8::bf_lo(w1.x)) + (pg8::bf_lo(w2.x) + pg8::bf_lo(w3.x)); x.y += (pg8::bf_hi(w0.x) + pg8::bf_hi(w1.x)) + (pg8::bf_hi(w2.x) + pg8::bf_hi(w3.x));
                x.z += (pg8::bf_lo(w0.y) + pg8::bf_lo(w1.y)) + (pg8::bf_lo(w2.y) + pg8::bf_lo(w3.y)); x.w += (pg8::bf_hi(w0.y) + pg8::bf_hi(w1.y)) + (pg8::bf_hi(w2.y) + pg8::bf_hi(w3.y));
                v[j] = x; xr[64 * j] = x; s += (x.x * x.x + x.y * x.y) + (x.z * x.z + x.w * x.w); }
            const float rstd = 1.0f / sqrtf(wave_sum(s) * (1.0f / 2048.0f) + 1e-6f);
            const f32x4* gr = (const f32x4*)a.norm3_g + lane; v2u* o8 = (v2u*)(HB + (size_t)t * 2048) + lane;
#pragma unroll
            for (int j = 0; j < 8; ++j) { const f32x4 g = gr[64 * j]; v2u o; o.x = pk2(v[j].x * rstd * g.x, v[j].y * rstd * g.y); o.y = pk2(v[j].z * rstd * g.z, v[j].w * rstd * g.w); o8[64 * j] = o; } }
    }
    SEAM(12);
    if (IN(13)) { LOAD_ARGS();
        pg8::Gemm g{HB, (const bf16*)(ws + WS_BTPG), 2048, 2048, 2048}; pg8::StaticOrder S; S.init(SEQ, 2048, G, bx);
        pg8::EpiPLE E{(const float*)(ws + WS_X2), (const bf16*)(ws + WS_PP), a.out};
        pg8::gemm_phase<pg8::EpiPLE, pg8::StaticOrder, true, true>(lds + RING_OFF, g, S, E);
    }
    SEAM(13);
    if (IN(14)) { LOAD_ARGS();
        for (int t = gw; t < SEQ; t += NGW) { f32x4* xr = (f32x4*)(a.out + (size_t)t * 2048) + lane; const f32x4* gr = (const f32x4*)a.fin_g + lane;
            f32x4 v[8]; float s = 0.f;
#pragma unroll
            for (int j = 0; j < 8; ++j) { v[j] = xr[64 * j]; s += (v[j].x * v[j].x + v[j].y * v[j].y) + (v[j].z * v[j].z + v[j].w * v[j].w); }
            const float rstd = 1.0f / sqrtf(wave_sum(s) * (1.0f / 2048.0f) + 1e-6f);
#pragma unroll
            for (int j = 0; j < 8; ++j) xr[64 * j] = v[j] * rstd * gr[64 * j]; }
    }
#undef IN
#undef SEAM
}

extern "C" void kernel_launch(void* const* d_in, const int* in_sizes, int n_in, void* d_out, int out_size, void* d_ws, size_t ws_size, hipStream_t stream) {
    static int grid = 0;
    if (grid == 0) {
        if (n_in != 29 || in_sizes[0] != SEQ * DM || out_size != SEQ * DM || ws_size < WS_END) { fprintf(stderr, "kernel_launch: unexpected shapes (n_in %d, ws %zu < %zu?)\n", n_in, ws_size, (size_t)WS_END); grid = -1; return; }
        int dev = 0, cus = 0, per_cu = 0;
        if (hipGetDevice(&dev) != hipSuccess || hipDeviceGetAttribute(&cus, hipDeviceAttributeMultiprocessorCount, dev) != hipSuccess) { grid = -1; return; }
        if (hipFuncSetAttribute((const void*)mk_fwd, hipFuncAttributeMaxDynamicSharedMemorySize, LDS_BYTES) != hipSuccess) { fprintf(stderr, "kernel_launch: hipFuncSetAttribute failed\n"); grid = -1; return; }
        if (hipOccupancyMaxActiveBlocksPerMultiprocessor(&per_cu, (const void*)mk_fwd, NWAVES * 64, LDS_BYTES) != hipSuccess || per_cu < 1) { fprintf(stderr, "kernel_launch: occupancy query says %d\n", per_cu); }
        (void)hipGetLastError();
        grid = cus;
    }
    if (grid < 0) return;
    if (hipMemsetAsync((char*)d_ws + WS_CTL, 0, CTL_ZERO_BYTES, stream) != hipSuccess) return;
    Args a{};
    a.x = (const float*)d_in[0]; a.p = (const float*)d_in[1]; a.pos = (const int*)d_in[2]; a.norm1_g = (const float*)d_in[3]; a.w_in = (const float*)d_in[4];
    a.lam_re = (const float*)d_in[5]; a.lam_im = (const float*)d_in[6]; a.log_dt = (const float*)d_in[7]; a.b_re = (const float*)d_in[8]; a.b_im = (const float*)d_in[9];
    a.c_re = (const float*)d_in[10]; a.c_im = (const float*)d_in[11]; a.d_skip = (const float*)d_in[12]; a.w_glu = (const float*)d_in[13]; a.b_glu = (const float*)d_in[14];
    a.w_bs = (const float*)d_in[15]; a.w_br = (const float*)d_in[16]; a.w_out = (const float*)d_in[17]; a.norm2_g = (const float*)d_in[18]; a.router_w = (const float*)d_in[19];
    a.router_b = (const float*)d_in[20]; a.w_gu = (const float*)d_in[21]; a.b_gu = (const float*)d_in[22]; a.w_dn = (const float*)d_in[23]; a.b_dn = (const float*)d_in[24];
    a.norm3_g = (const float*)d_in[25]; a.w_pg = (const float*)d_in[26]; a.w_pp = (const float*)d_in[27]; a.fin_g = (const float*)d_in[28];
    a.out = (float*)d_out; a.ws = (unsigned char*)d_ws;
#if defined(PROBE_LO)
    a.ph_lo = 0; a.ph_hi = PROBE_HI; hipLaunchKernelGGL(mk_fwd, dim3(grid), dim3(NWAVES * 64), LDS_BYTES, stream, a);
    a.ph_lo = PROBE_LO; a.ph_hi = N_PHASES; a.li = 1; hipLaunchKernelGGL(mk_fwd, dim3(grid), dim3(NWAVES * 64), LDS_BYTES, stream, a);
#elif MK_N_LAUNCHES == 1
    a.ph_lo = 0; a.ph_hi = N_PHASES;
    hipLaunchKernelGGL(mk_fwd, dim3(grid), dim3(NWAVES * 64), LDS_BYTES, stream, a);
#else
    for (int ph = 0; ph < N_PHASES; ++ph) { a.ph_lo = ph; a.ph_hi = ph + 1; hipLaunchKernelGGL(mk_fwd, dim3(grid), dim3(NWAVES * 64), LDS_BYTES, stream, a); }
#endif
    const hipError_t le = hipPeekAtLastError();
    if (le != hipSuccess) fprintf(stderr, "kernel_launch: launch failed: %s\n", hipGetErrorName(le));
}
```

```cpp
#include <hip/hip_runtime.h>
#include <cstdio>
#include <cstdint>

#ifndef MK_N_LAUNCHES
#define MK_N_LAUNCHES 1
#endif

constexpr int SEQ = 16384, DM = 2048, INC = 9216, NEXP = 32, FFN = 2048, PLED = 256;
constexpr int NG5 = 64, T5 = 32, NCH5 = SEQ / T5, K5 = 640;
constexpr int RCH = 128, NRC = SEQ / RCH, RH = 8;
constexpr int MAXROWS = SEQ * 4 + NEXP * 256;

namespace pg8 {
#define PG8_LAS __attribute__((address_space(3)))
typedef unsigned short bf16_t;
typedef short bf16x8 __attribute__((ext_vector_type(8)));
typedef float f32x4 __attribute__((ext_vector_type(4)));
typedef unsigned u32x4 __attribute__((ext_vector_type(4)));
typedef unsigned u32x2 __attribute__((ext_vector_type(2)));
constexpr int BM = 256, BK = 64, HALF = 128, HTB = HALF * BK * 2, STAGE_BYTES = 8 * HTB, NXCD = 8, WGM = 8;

__host__ __device__ __forceinline__ int lds_byte(int r, int c) { const int st = (r >> 4) * 2 + (c >> 5), rr = r & 15, cc = c & 31, ob = rr * 64 + cc * 2; return st * 1024 + (ob ^ (((ob >> 9) & 1) << 5)); }
__host__ __device__ __forceinline__ void stage_rc(int b, int& R, int& C) { const int st = b / 1024, sb = b % 1024, swz = sb ^ (((sb >> 9) & 1) << 5); R = (st >> 1) * 16 + swz / 64; C = (st & 1) * 32 + (swz % 64) / 2; }
__host__ __device__ __forceinline__ int perm32(int rho) { const int n = rho >> 4, i = rho & 15; return 8 * (i >> 2) + 4 * n + (i & 3); }

struct Unit { int pm, pn, pa; };
struct Gemm { const bf16_t* A; const bf16_t* Bt; int lda, ldb, K; };

struct StaticOrder {
    int nM, nN, nwg, G, c;
    __host__ __device__ void init(int M, int N, int G_, int c_) { nM = M / BM; nN = N / BM; nwg = nM * nN; G = G_; c = c_; }
    __host__ __device__ bool next(int i, Unit& u) const {
        const long L = (long)i * G + c; if (L >= nwg) return false;
        int wgid = (int)L; { const int q = nwg / NXCD, r = nwg % NXCD, xcd = wgid % NXCD, off = wgid / NXCD; wgid = (xcd < r ? xcd * (q + 1) : r * (q + 1) + (xcd - r) * q) + off; }
        const int nig = WGM * nN, gid = wgid / nig, fm = gid * WGM, gsz = (nM - fm) < WGM ? (nM - fm) : WGM;
        u.pm = fm + ((wgid % nig) % gsz); u.pn = (wgid % nig) / gsz; u.pa = u.pm; return true;
    }
    __device__ __forceinline__ void a_ready(const Unit&) const {}
    __device__ __forceinline__ void done(const Unit&) const {}
};
struct OrderS3 {
    int G, c;
    __device__ bool next(int i, Unit& u) const { const int L = i * G + c; if (L >= 256) return false; const int g = L >> 2; u.pm = 2 * g + ((L >> 1) & 1); u.pn = 2 * g + (L & 1); u.pa = u.pm; return true; }
    __device__ __forceinline__ void a_ready(const Unit&) const {}
    __device__ __forceinline__ void done(const Unit&) const {}
};
struct OrderS1 {
    int G, c;
    __device__ bool next(int i, Unit& u) const { const int L = i * G + c; if (L >= 128) return false; u.pm = L; u.pn = L >> 1; u.pa = L; return true; }
    __device__ __forceinline__ void a_ready(const Unit&) const {}
    __device__ __forceinline__ void done(const Unit&) const {}
};
struct OrderMoe {
    StaticOrder so; const PG8_LAS int* tab; int ntn; bool gather_a;
    __device__ bool next(int i, Unit& u) const { if (!so.next(i, u)) return false;
        const int e = __builtin_amdgcn_readfirstlane(tab[33 + u.pm]), t0 = __builtin_amdgcn_readfirstlane(tab[e]);
        u.pn = e * ntn + u.pn; u.pa = gather_a ? e * 64 + (u.pm - t0) : u.pm; return true; }
    __device__ __forceinline__ void a_ready(const Unit&) const {}
    __device__ __forceinline__ void done(const Unit&) const {}
};

__device__ __forceinline__ unsigned cvt_pk_bf16(float lo, float hi) { unsigned r; asm volatile("v_cvt_pk_bf16_f32 %0, %1, %2" : "=v"(r) : "v"(lo), "v"(hi)); return r; }
__device__ __forceinline__ u32x4 pack8(const f32x4& a, const f32x4& b) { u32x4 w; w.x = cvt_pk_bf16(a[0], a[1]); w.y = cvt_pk_bf16(a[2], a[3]); w.z = cvt_pk_bf16(b[0], b[1]); w.w = cvt_pk_bf16(b[2], b[3]); return w; }
__device__ __forceinline__ float bf_lo(unsigned w) { return __builtin_bit_cast(float, w << 16); }
__device__ __forceinline__ float bf_hi(unsigned w) { return __builtin_bit_cast(float, w & 0xffff0000u); }
__device__ __forceinline__ void unpack8(const u32x4& w, f32x4& a, f32x4& b) { a = (f32x4){bf_lo(w.x), bf_hi(w.x), bf_lo(w.y), bf_hi(w.y)}; b = (f32x4){bf_lo(w.z), bf_hi(w.z), bf_lo(w.w), bf_hi(w.w)}; }
typedef float f32x2 __attribute__((ext_vector_type(2)));
__device__ __forceinline__ float sigm(float x) { return __builtin_amdgcn_rcpf(1.0f + __builtin_amdgcn_exp2f(-1.4426950408889634f * x)); }
__device__ __forceinline__ f32x2 sigm2(f32x2 x) { const f32x2 t = x * (-1.4426950408889634f); f32x2 e; e.x = __builtin_amdgcn_exp2f(t.x); e.y = __builtin_amdgcn_exp2f(t.y);
    const f32x2 d = e + 1.0f; f32x2 r; r.x = __builtin_amdgcn_rcpf(d.x); r.y = __builtin_amdgcn_rcpf(d.y); return r; }
__device__ __forceinline__ f32x4 sigm4(const f32x4& x) { const f32x2 a = sigm2((f32x2){x[0], x[1]}), b = sigm2((f32x2){x[2], x[3]}); return (f32x4){a.x, a.y, b.x, b.y}; }
__device__ __forceinline__ float gelu_t(float x) { return x * sigm(1.5957691216057308f * (x + 0.044715f * x * x * x)); }
__device__ __forceinline__ f32x2 gelu2(f32x2 x) { const f32x2 u = x * x, w = (u * 0.044715f + 1.0f) * x; return x * sigm2(w * 1.5957691216057308f); }
__device__ __forceinline__ f32x4 gelu4(const f32x4& x) { const f32x2 a = gelu2((f32x2){x[0], x[1]}), b = gelu2((f32x2){x[2], x[3]}); return (f32x4){a.x, a.y, b.x, b.y}; }

#define EPI_LOOP_AM _Pragma("unroll") for (int ai = 0; ai < 2; ++ai) _Pragma("unroll") for (int m = 0; m < 4; ++m)
#define EPI_LOOP_BJ _Pragma("unroll") for (int bj = 0; bj < 2; ++bj)
typedef f32x4 AccT[2][2][4][2];
#ifndef EPIZ_MASK
#define EPIZ_MASK 31
#endif
#define EPIZ_EN(k) ((EPIZ_MASK >> (k)) & 1)

struct EpiZU {
    static constexpr bool PERM = true, AFTER_DRAIN = false; static constexpr int NSTORE = 16;
    bf16_t* xg5;
    __device__ __forceinline__ void operator()(const AccT& acc, const Unit& u, int wr, int wc, int fr, int fq) const {
        const int row0 = u.pm * BM + wr * 64 + fr, tc = wc * 32 + 8 * fq, pn = u.pn;
        EPI_LOOP_AM { const int t = row0 + ai * HALF + m * 16, j = t >> 5, i = t & 31;
            EPI_LOOP_BJ { const int col = pn * BM + bj * HALF + tc, g = col >> 4, c0 = col & 15;
                *(u32x4*)(xg5 + ((size_t)(g * NCH5 + j) * K5 + i * 16 + c0)) = pack8(acc[ai][bj][m][0], acc[ai][bj][m][1]); } }
    }
};
struct EpiZR {
    static constexpr bool PERM = true, AFTER_DRAIN = false; static constexpr int NSTORE = 16;
    bf16_t *q, *k; const float *cs, *sn;
    __device__ __forceinline__ void operator()(const AccT& acc, const Unit& u, int wr, int wc, int fr, int fq) const {
        const int row0 = u.pm * BM + wr * 64 + fr, pn = u.pn;
        const bool isk = pn >= 4; bf16_t* dst = isk ? k : q; const float sc = isk ? 0.08838834764831845f : 1.0f;
        const int head = 2 * (pn & 3) + (wc >> 1), dd = 32 * (wc & 1) + 8 * fq;
        EPI_LOOP_AM { const int t = row0 + ai * HALF + m * 16;
            const float* cp = cs + (size_t)t * 64 + dd; const float* sp = sn + (size_t)t * 64 + dd;
            const f32x4 c0 = *(const f32x4*)cp * sc, c1 = *(const f32x4*)(cp + 4) * sc, s0 = *(const f32x4*)sp * sc, s1 = *(const f32x4*)(sp + 4) * sc;
            const f32x4 x1a = acc[ai][0][m][0], x1b = acc[ai][0][m][1], x2a = acc[ai][1][m][0], x2b = acc[ai][1][m][1];
            bf16_t* o = dst + (size_t)t * 1024 + head * 128 + dd;
            *(u32x4*)o = pack8(x1a * c0 - x2a * s0, x1b * c1 - x2b * s1);
            *(u32x4*)(o + 64) = pack8(x1a * s0 + x2a * c0, x1b * s1 + x2b * c1); asm volatile("" ::: "memory"); }
    }
};
struct EpiZA {
    static constexpr bool PERM = true, AFTER_DRAIN = false; static constexpr int NSTORE = 16;
    bf16_t *v, *gs, *sgs, *sgr; int pn0; float sc;
    __device__ __forceinline__ void operator()(const AccT& acc, const Unit& u, int wr, int wc, int fr, int fq) const {
        const int row0 = u.pm * BM + wr * 64 + fr, tc = wc * 32 + 8 * fq, pn = u.pn + pn0;
        bf16_t* dst = pn < 4 ? v : (pn < 8 ? gs : (pn < 16 ? sgs : sgr));
        const int ldc = pn < 8 ? 1024 : 2048, cb = (pn < 8 ? (pn & 3) : (pn & 7)) * BM + tc;
        if (pn < 4) {
            EPI_LOOP_AM { const size_t off = (size_t)(row0 + ai * HALF + m * 16) * ldc + cb;
                EPI_LOOP_BJ { *(u32x4*)(dst + off + bj * HALF) = pack8(acc[ai][bj][m][0] * sc, acc[ai][bj][m][1] * sc); } }
        } else {
            const float kb = pn < 8 ? 1.0f : 0.0f;
            EPI_LOOP_AM { const size_t off = (size_t)(row0 + ai * HALF + m * 16) * ldc + cb;
                EPI_LOOP_BJ { f32x4 r[2];
#pragma unroll
                    for (int n = 0; n < 2; ++n) { const f32x4 x = acc[ai][bj][m][n] * sc, sg = sigm4(x); r[n] = sg * (1.0f - kb) + (x * sg) * kb; }
                    *(u32x4*)(dst + off + bj * HALF) = pack8(r[0], r[1]); } }
        }
    }
};
struct EpiS1 {
    static constexpr bool PERM = true, AFTER_DRAIN = false; static constexpr int NSTORE = 16;
    float* sloc;
    __device__ __forceinline__ void operator()(const AccT& acc, const Unit& u, int wr, int wc, int fr, int fq) const {
        const int row0 = u.pm * BM + wr * 64 + fr, tc = wc * 32 + 8 * fq;
        EPI_LOOP_AM { float* o = sloc + (size_t)(row0 + ai * HALF + m * 16) * 128 + tc; *(f32x4*)o = acc[ai][0][m][0]; *(f32x4*)(o + 4) = acc[ai][0][m][1]; }
    }
};
struct EpiS3 {
    static constexpr bool PERM = true, AFTER_DRAIN = false; static constexpr int NSTORE = 16;
    bf16_t* ysp;
    __device__ __forceinline__ void operator()(const AccT& acc, const Unit& u, int wr, int wc, int fr, int fq) const {
        const int g = u.pm >> 1, j0 = (u.pm & 1) * BM + wr * 64 + fr, cl0 = (u.pn & 1) * BM + wc * 32 + 8 * fq;
        EPI_LOOP_AM { const int j = j0 + ai * HALF + m * 16;
            EPI_LOOP_BJ { const int cl = cl0 + bj * HALF, i = cl >> 4, c0 = cl & 15;
                *(u32x4*)(ysp + (size_t)(j * T5 + i) * 1024 + g * 16 + c0) = pack8(gelu4(acc[ai][bj][m][0]), gelu4(acc[ai][bj][m][1])); } }
    }
};
struct EpiGLU {
    static constexpr bool PERM = true, AFTER_DRAIN = false; static constexpr int NSTORE = 16;
    const bf16_t* ysp; const float* bias; bf16_t* ys;
    __device__ __forceinline__ void operator()(const AccT& acc, const Unit& u, int wr, int wc, int fr, int fq) const {
        const int row0 = u.pm * BM + wr * 64 + fr, col0 = u.pn * BM + wc * 32 + 8 * fq;
        f32x4 bv[2][2];
        EPI_LOOP_BJ { bv[bj][0] = *(const f32x4*)(bias + col0 + bj * HALF); bv[bj][1] = *(const f32x4*)(bias + col0 + bj * HALF + 4); }
        EPI_LOOP_AM { const size_t off = (size_t)(row0 + ai * HALF + m * 16) * 1024 + col0;
            EPI_LOOP_BJ { f32x4 ya, yb; unpack8(*(const u32x4*)(ysp + off + bj * HALF), ya, yb);
                *(u32x4*)(ys + off + bj * HALF) = pack8(ya * sigm4(acc[ai][bj][m][0] + bv[bj][0]), yb * sigm4(acc[ai][bj][m][1] + bv[bj][1])); } }
    }
};
struct EpiM1 {
    static constexpr bool PERM = true, AFTER_DRAIN = false; static constexpr int NSTORE = 16;
    const bf16_t* sg; bf16_t* tmp;
    __device__ __forceinline__ void operator()(const AccT& acc, const Unit& u, int wr, int wc, int fr, int fq) const {
        const int row0 = u.pm * BM + wr * 64 + fr, col0 = u.pn * BM + wc * 32 + 8 * fq;
        EPI_LOOP_AM { const size_t off = (size_t)(row0 + ai * HALF + m * 16) * 2048 + col0;
            EPI_LOOP_BJ { f32x4 ga, gb; unpack8(*(const u32x4*)(sg + off + bj * HALF), ga, gb);
                *(u32x4*)(tmp + off + bj * HALF) = pack8(ga * acc[ai][bj][m][0], gb * acc[ai][bj][m][1]); } }
    }
};
struct EpiM2 {
    static constexpr bool PERM = true, AFTER_DRAIN = false; static constexpr int NSTORE = 16;
    const bf16_t* sg; const bf16_t* tmp; bf16_t* mrg;
    __device__ __forceinline__ void operator()(const AccT& acc, const Unit& u, int wr, int wc, int fr, int fq) const {
        const int row0 = u.pm * BM + wr * 64 + fr, col0 = u.pn * BM + wc * 32 + 8 * fq;
        EPI_LOOP_AM { const size_t off = (size_t)(row0 + ai * HALF + m * 16) * 2048 + col0;
            EPI_LOOP_BJ { f32x4 ga, gb, ta, tb; unpack8(*(const u32x4*)(sg + off + bj * HALF), ga, gb); unpack8(*(const u32x4*)(tmp + off + bj * HALF), ta, tb);
                *(u32x4*)(mrg + off + bj * HALF) = pack8(ta + ga * acc[ai][bj][m][0], tb + gb * acc[ai][bj][m][1]); } }
    }
};
struct EpiRes {
    static constexpr bool PERM = true, AFTER_DRAIN = false; static constexpr int NSTORE = 32;
    const float* x; float* o;
    __device__ __forceinline__ void operator()(const AccT& acc, const Unit& u, int wr, int wc, int fr, int fq) const {
        const int row0 = u.pm * BM + wr * 64 + fr, col0 = u.pn * BM + wc * 32 + 8 * fq;
        EPI_LOOP_AM { const size_t off = (size_t)(row0 + ai * HALF + m * 16) * 2048 + col0;
            EPI_LOOP_BJ { *(f32x4*)(o + off + bj * HALF) = *(const f32x4*)(x + off + bj * HALF) + acc[ai][bj][m][0];
                *(f32x4*)(o + off + bj * HALF + 4) = *(const f32x4*)(x + off + bj * HALF + 4) + acc[ai][bj][m][1]; } }
    }
};
struct EpiPlain {
    static constexpr bool PERM = true, AFTER_DRAIN = false; static constexpr int NSTORE = 16;
    bf16_t* o; int ldc;
    __device__ __forceinline__ void operator()(const AccT& acc, const Unit& u, int wr, int wc, int fr, int fq) const {
        const int row0 = u.pm * BM + wr * 64 + fr, col0 = u.pn * BM + wc * 32 + 8 * fq;
        EPI_LOOP_AM { const size_t off = (size_t)(row0 + ai * HALF + m * 16) * ldc + col0;
            EPI_LOOP_BJ { *(u32x4*)(o + off + bj * HALF) = pack8(acc[ai][bj][m][0], acc[ai][bj][m][1]); } }
    }
};
__device__ __forceinline__ unsigned pk4_fp8(float a, float b, float c, float d) { int r = 0; r = __builtin_amdgcn_cvt_pk_fp8_f32(a, b, r, false); r = __builtin_amdgcn_cvt_pk_fp8_f32(c, d, r, true); return (unsigned)r; }
constexpr float W8_SCALE = 64.0f, W8_INV = 1.0f / 64.0f;
struct EpiGU {
    static constexpr bool PERM = true, AFTER_DRAIN = false; static constexpr int NSTORE = 8;
    const float* bgu; unsigned char* act;
    __device__ __forceinline__ void operator()(const AccT& acc, const Unit& u, int wr, int wc, int fr, int fq) const {
        const int e = u.pn >> 4, ct = u.pn & 15, row0 = u.pm * BM + wr * 64 + fr, f0 = ct * HALF + wc * 32 + 8 * fq;
        const float* bp = bgu + (size_t)e * 4096 + 2 * f0;
        const f32x4 b0 = *(const f32x4*)bp, b1 = *(const f32x4*)(bp + 4), b2 = *(const f32x4*)(bp + 8), b3 = *(const f32x4*)(bp + 12);
        const f32x4 bg0 = (f32x4){b0[0], b0[2], b1[0], b1[2]}, bu0 = (f32x4){b0[1], b0[3], b1[1], b1[3]}, bg1 = (f32x4){b2[0], b2[2], b3[0], b3[2]}, bu1 = (f32x4){b2[1], b2[3], b3[1], b3[3]};
        const f32x4 bu0p = bu0 + 1.0f, bu1p = bu1 + 1.0f;
        EPI_LOOP_AM { const size_t off = (size_t)(row0 + ai * HALF + m * 16) * FFN + f0;
            f32x4 r[2];
#pragma unroll
            for (int n = 0; n < 2; ++n) { const f32x4 gv = acc[ai][0][m][n] * W8_INV + (n ? bg1 : bg0), uv = acc[ai][1][m][n] * W8_INV + (n ? bu1p : bu0p);
#pragma unroll
                for (int x = 0; x < 4; x += 2) { const f32x2 gg = (f32x2){fminf(gv[x], 7.0f), fminf(gv[x + 1], 7.0f)};
                    const f32x2 uu = (f32x2){__builtin_amdgcn_fmed3f(uv[x], -6.0f, 8.0f), __builtin_amdgcn_fmed3f(uv[x + 1], -6.0f, 8.0f)};
                    const f32x2 o = (gg * sigm2(gg * 1.702f)) * uu; r[n][x] = o.x; r[n][x + 1] = o.y; } }
            u32x2 w; w.x = pk4_fp8(r[0][0], r[0][1], r[0][2], r[0][3]); w.y = pk4_fp8(r[1][0], r[1][1], r[1][2], r[1][3]);
            *(u32x2*)(act + off) = w; }
    }
};
constexpr float YB_SCALE = 16.0f, YB_INV = 1.0f / 16.0f;
struct EpiDN {
    static constexpr bool PERM = true, AFTER_DRAIN = false; static constexpr int NSTORE = 16;
    const float* bdn; unsigned char* yb;
    __device__ __forceinline__ void operator()(const AccT& acc, const Unit& u, int wr, int wc, int fr, int fq) const {
        const int e = u.pn >> 3, ct = u.pn & 7, row0 = u.pm * BM + wr * 64 + fr, col0 = ct * BM + wc * 32 + 8 * fq;
        f32x4 bv[2][2];
        EPI_LOOP_BJ { bv[bj][0] = *(const f32x4*)(bdn + (size_t)e * 2048 + col0 + bj * HALF); bv[bj][1] = *(const f32x4*)(bdn + (size_t)e * 2048 + col0 + bj * HALF + 4); }
        EPI_LOOP_AM { const int row = row0 + ai * HALF + m * 16; const float gt = YB_SCALE; const size_t off = (size_t)row * 2048 + col0;
            EPI_LOOP_BJ { const f32x4 a = (acc[ai][bj][m][0] * W8_INV + bv[bj][0]) * gt, b = (acc[ai][bj][m][1] * W8_INV + bv[bj][1]) * gt;
                u32x2 w; w.x = pk4_fp8(a[0], a[1], a[2], a[3]); w.y = pk4_fp8(b[0], b[1], b[2], b[3]); *(u32x2*)(yb + off + bj * HALF) = w; } }
    }
};
struct EpiPLE {
    static constexpr bool PERM = true, AFTER_DRAIN = false; static constexpr int NSTORE = 16;
    const bf16_t* x3; const bf16_t* pp; bf16_t* o; float sc;
    __device__ __forceinline__ void operator()(const AccT& acc, const Unit& u, int wr, int wc, int fr, int fq) const {
        const int row0 = u.pm * BM + wr * 64 + fr, col0 = u.pn * BM + wc * 32 + 8 * fq;
        EPI_LOOP_AM { const size_t off = (size_t)(row0 + ai * HALF + m * 16) * 2048 + col0;
            EPI_LOOP_BJ { f32x4 pa, pb; unpack8(*(const u32x4*)(pp + off + bj * HALF), pa, pb);
                f32x4 xa, xb; unpack8(*(const u32x4*)(x3 + off + bj * HALF), xa, xb);
                *(u32x4*)(o + off + bj * HALF) = pack8(xa + sigm4(acc[ai][bj][m][0] * sc) * pa, xb + sigm4(acc[ai][bj][m][1] * sc) * pb); } }
    }
};

typedef int v8i_t __attribute__((ext_vector_type(8)));
typedef int v4i_t __attribute__((ext_vector_type(4)));
__device__ __forceinline__ v8i_t cat8(const bf16x8& lo, const bf16x8& hi) { const v4i_t a = __builtin_bit_cast(v4i_t, lo), b = __builtin_bit_cast(v4i_t, hi); return (v8i_t){a[0], a[1], a[2], a[3], b[0], b[1], b[2], b[3]}; }
template <class Epi, class Sched, bool ALIGN_EPI = false, bool SP2 = false, bool F8 = false>
__device__ __forceinline__ void gemm_phase(PG8_LAS unsigned char* lds, const Gemm g, const Sched& S, const Epi& E) {
    const int tid = threadIdx.x, wid = __builtin_amdgcn_readfirstlane(tid >> 6), lane = tid & 63, wr = wid >> 2, wc = wid & 3, fr = lane & 15, fq = lane >> 4;
    const int K = g.K, nt = K / BK;
    unsigned voffA[2], voffB[2];
#pragma unroll
    for (int i = 0; i < 2; ++i) { int R, C; stage_rc(tid * 16 + i * 8192, R, C); const int Rb = Epi::PERM ? ((R & ~31) + perm32(R & 31)) : R;
        voffA[i] = (unsigned)(R * g.lda + C) * 2u; voffB[i] = (unsigned)(Rb * g.ldb + C) * 2u; }
    const size_t kstep = (size_t)(BK * 2);
    const size_t hstepA = (size_t)HALF * g.lda * 2, hstepB = (size_t)HALF * g.ldb * 2;
    const size_t tstepA = 2 * hstepA, tstepB = 2 * hstepB;
    const unsigned ldsw = (unsigned)wid * 1024u;
    const int aoff = lds_byte(wr * 64 + fr, fq * 8), boff = lds_byte(wc * 32 + fr, fq * 8);
#define PG8_SA(b, h) (((b) * 2 + (h)) * HTB)
#define PG8_SB(b, h) ((4 + (b) * 2 + (h)) * HTB)
#define PG8_STAGE(bufoff, gbase, voff) do { _Pragma("unroll") for (int _i = 0; _i < 2; ++_i) \
        __builtin_amdgcn_global_load_lds((const unsigned*)((const char*)(gbase) + (voff)[_i]), (PG8_LAS unsigned*)(lds + (bufoff) + ldsw + _i * 8192), 16, 0, 0); } while (0)
#define PG8_LD8(p_) __builtin_shufflevector(*(const PG8_LAS v4i_t*)(p_), *(const PG8_LAS v4i_t*)((p_) + 1024), 0, 1, 2, 3, 4, 5, 6, 7)
#define PG8_LDA(dst, b, h) do { if constexpr (F8) { _Pragma("unroll") for (int m = 0; m < 4; ++m) dst##8[m] = PG8_LD8(lds + PG8_SA(b, h) + aoff + m * 2048); } else { \
        _Pragma("unroll") for (int m = 0; m < 4; ++m) _Pragma("unroll") for (int k = 0; k < 2; ++k) dst[m][k] = *(const PG8_LAS bf16x8*)(lds + PG8_SA(b, h) + aoff + m * 2048 + k * 1024); } } while (0)
#define PG8_LDB(dst, b, h) do { if constexpr (F8) { _Pragma("unroll") for (int n = 0; n < 2; ++n) dst##8[n] = PG8_LD8(lds + PG8_SB(b, h) + boff + n * 2048); } else { \
        _Pragma("unroll") for (int n = 0; n < 2; ++n) _Pragma("unroll") for (int k = 0; k < 2; ++k) dst[n][k] = *(const PG8_LAS bf16x8*)(lds + PG8_SB(b, h) + boff + n * 2048 + k * 1024); } } while (0)
#define PG8_MMA(ai, bj, At, Bt) do { __builtin_amdgcn_s_setprio(1); if constexpr (F8) { _Pragma("unroll") for (int m = 0; m < 4; ++m) _Pragma("unroll") for (int n = 0; n < 2; ++n) \
        asm volatile("v_mfma_scale_f32_16x16x128_f8f6f4 %0, %1, %2, %0, %3, %3 op_sel_hi:[0,0,0]" : "+v"(acc[ai][bj][m][n]) : "v"(Bt##8[n]), "v"(At##8[m]), "v"(sc8)); } else { \
        _Pragma("unroll") for (int m = 0; m < 4; ++m) _Pragma("unroll") for (int n = 0; n < 2; ++n) _Pragma("unroll") for (int k = 0; k < 2; ++k) \
        acc[ai][bj][m][n] = __builtin_amdgcn_mfma_f32_16x16x32_bf16(Bt[n][k], At[m][k], acc[ai][bj][m][n], 0, 0, 0); } __builtin_amdgcn_s_setprio(0); } while (0)
#define PG8_WAIT_V(n) asm volatile("s_waitcnt vmcnt(" #n ")" ::: "memory")
#define PG8_WAIT_V8R() do { if (fresh) asm volatile("s_waitcnt vmcnt(%0)" :: "n"(8 + Epi::NSTORE) : "memory"); else asm volatile("s_waitcnt vmcnt(8)" ::: "memory"); } while (0)
#define PG8_WAIT_L(n) asm volatile("s_waitcnt lgkmcnt(" #n ")" ::: "memory")
#define PG8_BAR __builtin_amdgcn_s_barrier()
#define PG8_SCHED __builtin_amdgcn_sched_barrier(0)
    Unit cur, nxt; int ui = 0;
    if (!S.next(0, cur)) return;
    f32x4 acc[2][2][4][2];
#pragma unroll
    for (int a = 0; a < 2; ++a)
#pragma unroll
        for (int b = 0; b < 2; ++b)
#pragma unroll
            for (int m = 0; m < 4; ++m)
#pragma unroll
                for (int n = 0; n < 2; ++n) acc[a][b][m][n] = (f32x4){0.f, 0.f, 0.f, 0.f};
    bf16x8 At[4][2], B0[2][2], B1[2][2]; v8i_t At8[4], B08[2], B18[2]; const int sc8 = 0x7f7f7f7f;
    const char* cA = (const char*)g.A + (size_t)cur.pa * tstepA; const char* cB = (const char*)g.Bt + (size_t)cur.pn * tstepB;
    S.a_ready(cur);
    if constexpr (SP2) {
        PG8_STAGE(PG8_SB(0, 0), cB, voffB); PG8_STAGE(PG8_SB(0, 1), cB + hstepB, voffB); PG8_STAGE(PG8_SA(0, 0), cA, voffA); PG8_STAGE(PG8_SA(0, 1), cA + hstepA, voffA);
        if (wr == 1) PG8_BAR;
        PG8_WAIT_V(2); PG8_BAR;
        PG8_STAGE(PG8_SB(1, 0), cB + kstep, voffB); PG8_STAGE(PG8_SA(1, 0), cA + kstep, voffA); PG8_STAGE(PG8_SB(1, 1), cB + hstepB + kstep, voffB);
        PG8_WAIT_V(6); PG8_BAR;
    } else {
        PG8_STAGE(PG8_SB(0, 0), cB, voffB); PG8_STAGE(PG8_SA(0, 0), cA, voffA); PG8_STAGE(PG8_SB(0, 1), cB + hstepB, voffB); PG8_STAGE(PG8_SA(0, 1), cA + hstepA, voffA);
        if (wr == 1) PG8_BAR;
        PG8_WAIT_V(4); PG8_BAR;
        PG8_STAGE(PG8_SB(1, 0), cB + kstep, voffB); PG8_STAGE(PG8_SA(1, 0), cA + kstep, voffA); PG8_STAGE(PG8_SB(1, 1), cB + hstepB + kstep, voffB);
        PG8_WAIT_V(6); PG8_BAR;
    }
    for (;;) {
        const bool has_next = S.next(ui + 1, nxt);
        const char* nA = has_next ? (const char*)g.A + (size_t)nxt.pa * tstepA : cA; const char* nB = has_next ? (const char*)g.Bt + (size_t)nxt.pn * tstepB : cB;
#pragma nounroll
        for (int t = 0; t < nt; t += 2) {
            const bool last = (t == nt - 2);
            const char* a1 = cA + (size_t)(t + 1) * kstep;
            const char* a2 = last ? nA : cA + (size_t)(t + 2) * kstep; const char* b2 = last ? nB : cB + (size_t)(t + 2) * kstep;
            const char* a3 = a2 + kstep; const char* b3 = b2 + kstep;
            if (last && has_next) S.a_ready(nxt);
            if constexpr (SP2) {
            const bool fresh = (t == 0) && (ui > 0);
            PG8_LDB(B0, 0, 0); PG8_LDB(B1, 0, 1); PG8_SCHED; PG8_LDA(At, 0, 0); PG8_STAGE(PG8_SA(1, 1), a1 + hstepA, voffA);
            PG8_WAIT_V8R(); PG8_WAIT_L(0); PG8_BAR; PG8_MMA(0, 0, At, B0); PG8_MMA(0, 1, At, B1); PG8_BAR; PG8_SCHED;
            PG8_LDA(At, 0, 1); PG8_STAGE(PG8_SB(0, 0), b2, voffB); PG8_STAGE(PG8_SB(0, 1), b2 + hstepB, voffB); PG8_STAGE(PG8_SA(0, 0), a2, voffA);
            PG8_WAIT_V8R(); PG8_WAIT_L(0); PG8_BAR; PG8_MMA(1, 0, At, B0); PG8_MMA(1, 1, At, B1); PG8_BAR; PG8_SCHED;
            PG8_LDB(B0, 1, 0); PG8_LDB(B1, 1, 1); PG8_SCHED; PG8_LDA(At, 1, 0); PG8_STAGE(PG8_SA(0, 1), a2 + hstepA, voffA);
            PG8_WAIT_V(8); PG8_WAIT_L(0); PG8_BAR; PG8_MMA(0, 0, At, B0); PG8_MMA(0, 1, At, B1); PG8_BAR; PG8_SCHED;
            PG8_LDA(At, 1, 1); PG8_STAGE(PG8_SB(1, 0), b3, voffB); PG8_STAGE(PG8_SB(1, 1), b3 + hstepB, voffB); PG8_STAGE(PG8_SA(1, 0), a3, voffA);
            PG8_WAIT_V(8); PG8_WAIT_L(0); PG8_BAR; PG8_MMA(1, 0, At, B0); PG8_MMA(1, 1, At, B1); PG8_BAR; PG8_SCHED;
            } else {
            PG8_LDB(B0, 0, 0); PG8_SCHED; PG8_LDA(At, 0, 0); PG8_STAGE(PG8_SA(1, 1), a1 + hstepA, voffA);
            PG8_WAIT_L(8); PG8_BAR; PG8_WAIT_L(0); PG8_MMA(0, 0, At, B0); PG8_BAR; PG8_SCHED;
            PG8_LDB(B1, 0, 1); PG8_STAGE(PG8_SB(0, 0), b2, voffB);
            PG8_BAR; PG8_WAIT_L(0); PG8_MMA(0, 1, At, B1); PG8_BAR;
            PG8_LDA(At, 0, 1); PG8_STAGE(PG8_SA(0, 0), a2, voffA);
            PG8_BAR; PG8_WAIT_L(0); PG8_MMA(1, 0, At, B0); PG8_BAR; PG8_SCHED;
            PG8_STAGE(PG8_SB(0, 1), b2 + hstepB, voffB);
            PG8_WAIT_V(6); PG8_BAR; PG8_MMA(1, 1, At, B1); PG8_BAR;
            PG8_LDB(B0, 1, 0); PG8_SCHED; PG8_LDA(At, 1, 0); PG8_STAGE(PG8_SA(0, 1), a2 + hstepA, voffA);
            PG8_WAIT_L(8); PG8_BAR; PG8_WAIT_L(0); PG8_MMA(0, 0, At, B0); PG8_BAR; PG8_SCHED;
            PG8_LDB(B1, 1, 1); PG8_STAGE(PG8_SB(1, 0), b3, voffB);
            PG8_BAR; PG8_WAIT_L(0); PG8_MMA(0, 1, At, B1); PG8_BAR;
            PG8_LDA(At, 1, 1); PG8_STAGE(PG8_SA(1, 0), a3, voffA);
            PG8_BAR; PG8_WAIT_L(0); PG8_MMA(1, 0, At, B0); PG8_BAR; PG8_SCHED;
            PG8_STAGE(PG8_SB(1, 1), b3 + hstepB, voffB);
            PG8_WAIT_V(6); PG8_BAR; PG8_MMA(1, 1, At, B1); PG8_BAR;
            }
        }
        if constexpr (ALIGN_EPI) { if (wr == 0) PG8_BAR; }
        if constexpr (F8) asm volatile("s_nop 15\n\ts_nop 15" ::: "memory");
        if constexpr (!Epi::AFTER_DRAIN) { E(acc, cur, wr, wc, fr, fq); S.done(cur); }
        if (!has_next) break;
#pragma unroll
        for (int a = 0; a < 2; ++a)
#pragma unroll
            for (int b = 0; b < 2; ++b)
#pragma unroll
                for (int m = 0; m < 4; ++m)
#pragma unroll
                    for (int n = 0; n < 2; ++n) acc[a][b][m][n] = (f32x4){0.f, 0.f, 0.f, 0.f};
        cur = nxt; cA = nA; cB = nB; ++ui;
        if constexpr (ALIGN_EPI) { if (wr == 1) PG8_BAR; }
    }
    PG8_WAIT_V(0);
    if constexpr (!ALIGN_EPI) { if (wr == 0) PG8_BAR; }
    PG8_BAR;
#undef PG8_SA
#undef PG8_SB
#undef PG8_STAGE
#undef PG8_LDA
#undef PG8_LD8
#undef PG8_LDB
#undef PG8_MMA
#undef PG8_WAIT_V
#undef PG8_WAIT_V8R
#undef PG8_WAIT_L
#undef PG8_BAR
#undef PG8_SCHED
}
}

constexpr size_t MiB = 1u << 20;
constexpr size_t WS_CTL = 0, CTL_ZERO_BYTES = 1 * MiB;
constexpr size_t WS_BTIN  = 1 * MiB;
constexpr size_t WS_BTGLU = WS_BTIN + 36 * MiB;
constexpr size_t WS_BTPS  = WS_BTGLU + 2 * MiB;
constexpr size_t WS_BTPR  = WS_BTPS + 4 * MiB;
constexpr size_t WS_BTOUT = WS_BTPR + 4 * MiB;
constexpr size_t WS_BTPG  = WS_BTOUT + 8 * MiB;
constexpr size_t WS_BTPP  = WS_BTPG + 8 * MiB;
constexpr size_t WS_BTGU  = WS_BTPP + 1 * MiB;
constexpr size_t WS_BTDN  = WS_BTGU + 512 * MiB;
constexpr size_t WS_BTS3  = WS_BTDN + 256 * MiB;
constexpr size_t WS_BTS1  = WS_BTS3 + 40 * MiB;
constexpr size_t WS_ATAB  = WS_BTS1 + 16 * MiB;
constexpr size_t WS_CS    = WS_ATAB + 1 * MiB;
constexpr size_t WS_SN    = WS_CS + 4 * MiB;
constexpr size_t WS_WG    = WS_SN + 4 * MiB;
constexpr size_t WS_PBF   = WS_WG + 1 * MiB;
constexpr size_t WS_HB    = WS_PBF + 8 * MiB;
constexpr size_t WS_XG5   = WS_HB + 64 * MiB;
constexpr size_t WS_Q     = WS_XG5 + 40 * MiB;
constexpr size_t WS_K     = WS_Q + 32 * MiB;
constexpr size_t WS_V     = WS_K + 32 * MiB;
constexpr size_t WS_GS    = WS_V + 32 * MiB;
constexpr size_t WS_SGS   = WS_GS + 32 * MiB;
constexpr size_t WS_SGR   = WS_SGS + 64 * MiB;
constexpr size_t WS_SLOC  = WS_SGR + 64 * MiB;
constexpr size_t WS_KVT   = WS_SLOC + 16 * MiB;
constexpr size_t WS_RT    = WS_KVT + 64 * MiB;
constexpr size_t WS_YSP   = WS_RT + 32 * MiB;
constexpr size_t WS_YS    = WS_YSP + 32 * MiB;
constexpr size_t WS_YR    = WS_YS + 32 * MiB;
constexpr size_t WS_TMP   = WS_YR + 32 * MiB;
constexpr size_t WS_MRG   = WS_TMP + 128 * MiB;
constexpr size_t WS_X2    = WS_MRG + 64 * MiB;
constexpr size_t WS_PP    = WS_X2 + 128 * MiB;
constexpr size_t WS_TOKE  = WS_PP + 64 * MiB;
constexpr size_t WS_TOKG  = WS_TOKE + 1 * MiB;
constexpr size_t WS_TOKP  = WS_TOKG + 1 * MiB;
constexpr size_t WS_ROWG  = WS_TOKP + 1 * MiB;
constexpr size_t WS_AROW  = WS_ROWG + 1 * MiB;
constexpr size_t WS_BLKE  = WS_AROW + 1 * MiB;
constexpr size_t WS_XG    = WS_BLKE + 1 * MiB;
constexpr size_t WS_ACT   = WS_XG + 1024 * MiB;
constexpr size_t WS_YB    = WS_ACT + 288 * MiB;
constexpr size_t WS_BTIN8 = WS_YB + 288 * MiB;
constexpr size_t WS_END   = WS_BTIN8 + 8 * MiB;
constexpr size_t WS_H8    = WS_YB;
constexpr int CW_CNT = 64;
constexpr int CW_BAR = 4096;

constexpr int RING_OFF = 0, RING_BYTES = 131072;
constexpr int LDS_BYTES = 159744;
constexpr int LDSCTL_OFF = LDS_BYTES - 256;
constexpr int MOETAB_OFF = RING_BYTES;
constexpr int NWAVES = 8;

#define GAS __attribute__((address_space(1)))
#define LAS __attribute__((address_space(3)))
typedef unsigned short bf16;
typedef unsigned v4u __attribute__((ext_vector_type(4)));
typedef unsigned v2u __attribute__((ext_vector_type(2)));
typedef float f32x4 __attribute__((ext_vector_type(4)));
typedef float f32x16 __attribute__((ext_vector_type(16)));
typedef short bf16x8 __attribute__((ext_vector_type(8)));
#define RLX_AGENT __ATOMIC_RELAXED, __HIP_MEMORY_SCOPE_AGENT
#define LDS_WAIT() asm volatile("s_waitcnt lgkmcnt(0)" ::: "memory")
#define VM_WAIT() asm volatile("s_waitcnt vmcnt(0)" ::: "memory")
__device__ __forceinline__ unsigned f2bf(float f) { unsigned u = __builtin_bit_cast(unsigned, f); return (u + 0x7fffu + ((u >> 16) & 1u)) >> 16; }
__device__ __forceinline__ unsigned pk2(float lo, float hi) { return f2bf(lo) | (f2bf(hi) << 16); }
__device__ __forceinline__ float bf2f(unsigned short b) { return __builtin_bit_cast(float, (unsigned)b << 16); }

#define XB_TMO      128
#define XB_XCNT(j)  (256  + 64 * (j))
#define XB_XSUB(j)  (1280 + 64 * (j))
#define XB_XGEN(j)  (2304 + 64 * (j))
#define XB_TOP      3328
#define XB_TOPGEN   3392
#define XCD_BAR_WORDS 3456
#define XB_SPIN_CAP (1u << 20)
__device__ __forceinline__ unsigned xb_ld(unsigned* p)              { return __hip_atomic_load(p, __ATOMIC_RELAXED, __HIP_MEMORY_SCOPE_AGENT); }
__device__ __forceinline__ unsigned xb_add(unsigned* p, unsigned v) { return __hip_atomic_fetch_add(p, v, __ATOMIC_RELAXED, __HIP_MEMORY_SCOPE_AGENT); }
__device__ __forceinline__ unsigned xb_xcc_id() { return (unsigned)__builtin_amdgcn_s_getreg((3 << 11) | 20) & 0xFu; }
#define XB_SPIN(cond, bar) do { unsigned _sp = 0; while (cond) { __builtin_amdgcn_s_sleep(1); \
    if ((++_sp & 255u) == 0u) { if (xb_ld(&(bar)[XB_TMO])) break; if (_sp > XB_SPIN_CAP) { atomicAdd(&(bar)[XB_TMO], 1u); break; } } } } while (0)
struct XcdBarrier { unsigned* bar; unsigned x; volatile LAS unsigned* st; };
__device__ __forceinline__ XcdBarrier xcd_barrier_post(unsigned* bar, volatile LAS unsigned* st) {
    XcdBarrier b; b.bar = bar; b.x = xb_xcc_id(); b.st = st;
    if (threadIdx.x == 0) (void)xb_add(&bar[XB_XCNT(b.x)], 1u);
    return b;
}
__device__ __forceinline__ void xcd_barrier_complete(unsigned* bar, unsigned x, unsigned& nloc, unsigned& nx) {
    const unsigned G = gridDim.x * gridDim.y * gridDim.z;
    unsigned sum, cnt, mine, sp = 0u;
    for (;;) {
        sum = 0u; cnt = 0u; mine = 0u;
#pragma unroll
        for (unsigned j = 0; j < 16; ++j) { const unsigned c = xb_ld(&bar[XB_XCNT(j)]); sum += c; cnt += (c > 0u) ? 1u : 0u; mine = (j == x) ? c : mine; }
        if (sum == G) break;
        __builtin_amdgcn_s_sleep(1);
        if ((++sp & 255u) == 0u) { if (xb_ld(&bar[XB_TMO])) break; if (sp > XB_SPIN_CAP) { atomicAdd(&bar[XB_TMO], 1u); break; } }
    }
    nloc = mine > 0u ? mine : 1u; nx = cnt > 0u ? cnt : 1u;
}
__device__ __forceinline__ void xcd_barrier(const XcdBarrier& b) {
    asm volatile("s_waitcnt vmcnt(0)" ::: "memory");
    __syncthreads();
    if (threadIdx.x == 0) {
        unsigned* bar = b.bar;
        __builtin_amdgcn_s_waitcnt(0);
        unsigned nloc = b.st[0], nx = b.st[1];
        if (nloc == 0u) { xcd_barrier_complete(bar, b.x, nloc, nx); b.st[0] = nloc; b.st[1] = nx; }
        const unsigned old = xb_add(&bar[XB_XSUB(b.x)], 1u);
        const unsigned gen = old / nloc;
        if (old + 1u == (gen + 1u) * nloc) {
            __builtin_amdgcn_fence(__ATOMIC_RELEASE, "agent");
            asm volatile("s_waitcnt vmcnt(0)" ::: "memory");
            const unsigned og = xb_add(&bar[XB_TOP], 1u);
            const unsigned tg = og / nx;
            if (og + 1u == (tg + 1u) * nx) xb_add(&bar[XB_TOPGEN], 1u);
            else XB_SPIN(xb_ld(&bar[XB_TOPGEN]) == tg, bar);
            __builtin_amdgcn_fence(__ATOMIC_ACQUIRE, "agent");
            xb_add(&bar[XB_XGEN(b.x)], 1u);
            asm volatile("s_waitcnt vmcnt(0)" ::: "memory");
        } else {
            XB_SPIN(xb_ld(&bar[XB_XGEN(b.x)]) == gen, bar);
            __builtin_amdgcn_fence(__ATOMIC_ACQUIRE, "agent");
            asm volatile("s_waitcnt vmcnt(0)" ::: "memory");
        }
    }
    __syncthreads();
}

__device__ __forceinline__ float wave_sum(float v) {
#pragma unroll
    for (int o = 1; o < 64; o <<= 1) v += __shfl_xor(v, o);
    return v;
}
__device__ __forceinline__ int rowmap(int mode, int n) {
    if (mode == 1) { if (n < 1024 || n >= 3072) return n; const int nn = n - 1024, r = nn >> 10, hn = nn & 1023, head = hn >> 7, half = (hn >> 6) & 1, dd = hn & 63;
        return 1024 + r * 1024 + (head >> 1) * 256 + half * 128 + (head & 1) * 64 + dd; }
    if (mode == 2) { const int f = n >> 1, s = n & 1; return (f >> 7) * 256 + (f & 127) + 128 * s; }
    return n;
}
template <bool F8> __device__ __forceinline__ void transpose_run(const float* W, int K, int N, int ldw, void* WT, int mode, int nmat, size_t sstride, size_t dstride, LAS float* scr, int gw, int NGW, int lane) {
    const int nbk = N / 64, per = (K / 64) * nbk, total = nmat * per;
    int it = gw; if (it >= total) return;
    float r[64];
#define TR_SRC(it_) ((const GAS float*)W + (size_t)((it_) / per) * sstride + (size_t)(64 * (((it_) % per) / nbk)) * ldw + 64 * (((it_) % per) % nbk) + lane)
    { const GAS float* src = TR_SRC(it);
#pragma unroll
      for (int i = 0; i < 64; ++i) r[i] = src[(size_t)i * ldw]; }
    for (;;) {
#pragma unroll
        for (int i = 0; i < 64; ++i) scr[i * 65 + lane] = F8 ? r[i] * 64.0f : r[i];
        LDS_WAIT(); asm volatile("" ::: "memory");
        const int mat = it / per, rr = it % per, k0 = 64 * (rr / nbk), n0 = 64 * (rr % nbk);
        const int nit = it + NGW; const bool hn = nit < total;
        if (hn) { const GAS float* src = TR_SRC(nit);
#pragma unroll
            for (int i = 0; i < 64; ++i) r[i] = src[(size_t)i * ldw]; }
        if constexpr (F8) { const int c = lane & 3; GAS unsigned char* dst = (GAS unsigned char*)WT + (size_t)mat * dstride;
#pragma unroll
            for (int j = 0; j < 4; ++j) { const int n = (lane >> 2) + 16 * j; const LAS float* s = scr + (16 * c) * 65 + n;
                v4u o; o.x = pg8::pk4_fp8(s[0 * 65], s[1 * 65], s[2 * 65], s[3 * 65]); o.y = pg8::pk4_fp8(s[4 * 65], s[5 * 65], s[6 * 65], s[7 * 65]);
                o.z = pg8::pk4_fp8(s[8 * 65], s[9 * 65], s[10 * 65], s[11 * 65]); o.w = pg8::pk4_fp8(s[12 * 65], s[13 * 65], s[14 * 65], s[15 * 65]);
                *(GAS v4u*)(dst + (size_t)rowmap(mode, n0 + n) * K + k0 + 16 * c) = o; }
        } else { const int c = lane & 7; GAS bf16* dst = (GAS bf16*)WT + (size_t)mat * dstride;
#pragma unroll
            for (int j = 0; j < 8; ++j) { const int n = (lane >> 3) + 8 * j; const LAS float* s = scr + (8 * c) * 65 + n;
                v4u o; o.x = pk2(s[0 * 65], s[1 * 65]); o.y = pk2(s[2 * 65], s[3 * 65]); o.z = pk2(s[4 * 65], s[5 * 65]); o.w = pk2(s[6 * 65], s[7 * 65]);
                *(GAS v4u*)(dst + (size_t)rowmap(mode, n0 + n) * K + k0 + 8 * c) = o; } }
        LDS_WAIT(); asm volatile("" ::: "memory");
        if (!hn) break;
        it = nit;
    }
#undef TR_SRC
}
#ifndef TR8_NT
#define TR8_NT 0
#endif
__device__ __forceinline__ void transpose_run8(const float* W, int K, int N, int ldw, unsigned char* WT, int mode, int nmat, size_t sstride, size_t dstride, LAS unsigned* scr, int gw, int NGW, int lane) {
    const int nkb = K / 256, per = nkb * (N / 64), total = nmat * per, nkh = nkb / 2;
#define TR_KB(it_) (2 * ((((it_) % per) >> 3) % nkh) + ((((it_) % per) >> 2) & 1))
#define TR_NB(it_) (4 * ((((it_) % per) >> 3) / nkh) + (((it_) % per) & 3))
    int it = gw; if (it >= total) return;
    const int kr = lane >> 4, nc = 4 * (lane & 15);
    f32x4 ra[16], rb[16];
#define TR_SRC(it_, q_) ((const GAS float*)W + (size_t)((it_) / per) * sstride + (size_t)(256 * TR_KB(it_) + 64 * (q_) + 16 * kr) * ldw + 64 * TR_NB(it_) + nc)
#define TR_LOAD(r_, it_, q_) do { const GAS float* src_ = TR_SRC(it_, q_); _Pragma("unroll") for (int i = 0; i < 16; ++i) r_[i] = TR8_NT ? __builtin_nontemporal_load((const GAS f32x4*)(src_ + (size_t)i * ldw)) : *(const GAS f32x4*)(src_ + (size_t)i * ldw); } while (0)
#define TR_PACK(r_, q_) do { _Pragma("unroll") for (int m = 0; m < 4; ++m) _Pragma("unroll") for (int c = 0; c < 4; ++c) \
        scr[(nc + c) * 65 + (q_) * 16 + 4 * kr + m] = pg8::pk4_fp8(r_[4 * m][c] * 64.0f, r_[4 * m + 1][c] * 64.0f, r_[4 * m + 2][c] * 64.0f, r_[4 * m + 3][c] * 64.0f); } while (0)
    TR_LOAD(ra, it, 0); TR_LOAD(rb, it, 1);
    for (;;) {
        const int nit = it + NGW; const bool hn = nit < total;
        TR_PACK(ra, 0); TR_LOAD(ra, it, 2);
        TR_PACK(rb, 1); TR_LOAD(rb, it, 3);
        TR_PACK(ra, 2); if (hn) TR_LOAD(ra, nit, 0);
        TR_PACK(rb, 3); if (hn) TR_LOAD(rb, nit, 1);
        LDS_WAIT(); asm volatile("" ::: "memory");
        const int mat = it / per, k0 = 256 * TR_KB(it), n0 = 64 * TR_NB(it), c16 = lane & 15;
        GAS unsigned char* dst = (GAS unsigned char*)WT + (size_t)mat * dstride;
#pragma unroll
        for (int j = 0; j < 16; ++j) { const int n = (lane >> 4) + 4 * j; const LAS unsigned* sp = scr + n * 65 + 4 * c16;
            v4u o; o.x = sp[0]; o.y = sp[1]; o.z = sp[2]; o.w = sp[3];
            if (TR8_NT) __builtin_nontemporal_store(o, (GAS v4u*)(dst + (size_t)rowmap(mode, n0 + n) * K + k0 + 16 * c16)); else *(GAS v4u*)(dst + (size_t)rowmap(mode, n0 + n) * K + k0 + 16 * c16) = o; }
        LDS_WAIT(); asm volatile("" ::: "memory");
        if (!hn) break;
        it = nit;
    }
#undef TR_SRC
#undef TR_LOAD
#undef TR_PACK
#undef TR_KB
#undef TR_NB
}
__device__ __forceinline__ void rms_row_bf16(const float* xrow, const float* gain, bf16* orow, unsigned char* orow8, int lane) {
    const f32x4* xr = (const f32x4*)xrow + lane; const f32x4* gr = (const f32x4*)gain + lane;
    f32x4 v[8]; float s = 0.f;
#pragma unroll
    for (int j = 0; j < 8; ++j) { v[j] = xr[64 * j]; s += (v[j].x * v[j].x + v[j].y * v[j].y) + (v[j].z * v[j].z + v[j].w * v[j].w); }
    const float rstd = 1.0f / sqrtf(wave_sum(s) * (1.0f / 2048.0f) + 1e-6f);
    v2u* o8 = (v2u*)orow + lane;
#pragma unroll
    for (int j = 0; j < 8; ++j) { const f32x4 g = gr[64 * j]; const f32x4 y = v[j] * rstd * g; v2u w; w.x = pk2(y.x, y.y); w.y = pk2(y.z, y.w); o8[64 * j] = w;
        ((unsigned*)orow8)[lane + 64 * j] = pg8::pk4_fp8(y.x, y.y, y.z, y.w); }
}

struct Args {
    const float* x; const float* p; const int* pos; const float* norm1_g; const float* w_in;
    const float* lam_re; const float* lam_im; const float* log_dt; const float* b_re; const float* b_im; const float* c_re; const float* c_im; const float* d_skip;
    const float* w_glu; const float* b_glu; const float* w_bs; const float* w_br; const float* w_out; const float* norm2_g; const float* router_w; const float* router_b;
    const float* w_gu; const float* b_gu; const float* w_dn; const float* b_dn; const float* norm3_g; const float* w_pg; const float* w_pp; const float* fin_g;
    float* out; unsigned char* ws; int ph_lo, ph_hi, li, pad;
};

__device__ __forceinline__ void s5_tables(const Args& a, int g, LAS unsigned char* lds, int tid) {
    LAS float* Pre = (LAS float*)lds;
    LAS float* Pim = Pre + 33 * 64;
    LAS float* Bre = Pim + 33 * 64;
    LAS float* Bim = Bre + 1024;
    LAS float* Cre = Bim + 1024;
    LAS float* Cim = Cre + 1024;
    LAS float* Kt  = Cim + 1024;
    const float dt = expf(a.log_dt[g]);
    for (int e = tid; e < 33 * 64; e += 512) { const int p = e >> 6, n = e & 63; const float lr = a.lam_re[g * 64 + n], li = a.lam_im[g * 64 + n];
        const float mag = expf(lr * dt * (float)p), ang = li * dt * (float)p; Pre[e] = mag * cosf(ang); Pim[e] = mag * sinf(ang); }
    for (int e = tid; e < 1024; e += 512) { const int n = e >> 4; const float lr = a.lam_re[g * 64 + n], li = a.lam_im[g * 64 + n];
        const float mag = expf(lr * dt), abr = mag * cosf(li * dt), abi = mag * sinf(li * dt);
        const float den = lr * lr + li * li, nr = abr - 1.0f, ni = abi, fre = (nr * lr + ni * li) / den, fim = (ni * lr - nr * li) / den;
        const float br = a.b_re[(size_t)g * 1024 + e], bi = a.b_im[(size_t)g * 1024 + e];
        Bre[e] = fre * br - fim * bi; Bim[e] = fre * bi + fim * br;
        Cre[e] = a.c_re[(size_t)g * 1024 + e]; Cim[e] = a.c_im[(size_t)g * 1024 + e]; }
    __syncthreads();
    { const int tau = tid >> 4, cp = tid & 15; float kacc[16];
#pragma unroll
      for (int c = 0; c < 16; ++c) kacc[c] = 0.f;
      for (int n = 0; n < 64; ++n) { const float pr = Pre[tau * 64 + n], pi = Pim[tau * 64 + n], br = Bre[n * 16 + cp], bi = Bim[n * 16 + cp];
          const float zr = pr * br - pi * bi, zi = pr * bi + pi * br;
#pragma unroll
          for (int c = 0; c < 16; ++c) kacc[c] += Cre[c * 64 + n] * zr - Cim[c * 64 + n] * zi; }
#pragma unroll
      for (int c = 0; c < 16; ++c) Kt[tau * 256 + c * 16 + cp] = kacc[c] + ((tau == 0 && c == cp) ? a.d_skip[g * 16 + c] : 0.f); }
    __syncthreads();
    bf16* bt3 = (bf16*)(a.ws + WS_BTS3) + (size_t)g * 512 * K5;
    for (int ch = tid; ch < 512 * 80; ch += 512) { const int row = ch / 80, cc = ch % 80, i = row >> 4, c = row & 15; float v[8];
        if (cc < 64) { const int ip = cc >> 1, c0 = (cc & 1) * 8;
#pragma unroll
            for (int x = 0; x < 8; ++x) v[x] = (i >= ip) ? Kt[(i - ip) * 256 + c * 16 + c0 + x] : 0.f;
        } else { const int m0 = (cc - 64) * 8;
#pragma unroll
            for (int x = 0; x < 8; ++x) { const int m = m0 + x, n = m & 63; const float cr = Cre[c * 64 + n], ci = Cim[c * 64 + n], pr = Pre[(i + 1) * 64 + n], pi = Pim[(i + 1) * 64 + n];
                v[x] = (m < 64) ? (cr * pr - ci * pi) : -(cr * pi + ci * pr); } }
        v4u o; o.x = pk2(v[0], v[1]); o.y = pk2(v[2], v[3]); o.z = pk2(v[4], v[5]); o.w = pk2(v[6], v[7]);
        *(v4u*)(bt3 + (size_t)row * K5 + cc * 8) = o; }
    bf16* bt1 = (bf16*)(a.ws + WS_BTS1) + (size_t)g * 256 * 512;
    for (int ch = tid; ch < 256 * 64; ch += 512) { const int row = ch >> 6, cc = ch & 63, ip = cc >> 1, c0 = (cc & 1) * 8; float v[8];
#pragma unroll
        for (int x = 0; x < 8; ++x) { if (row < 128) { const int n = row & 63; const float pr = Pre[(31 - ip) * 64 + n], pi = Pim[(31 - ip) * 64 + n], br = Bre[n * 16 + c0 + x], bi = Bim[n * 16 + c0 + x];
                v[x] = (row < 64) ? (pr * br - pi * bi) : (pr * bi + pi * br); } else v[x] = 0.f; }
        v4u o; o.x = pk2(v[0], v[1]); o.y = pk2(v[2], v[3]); o.z = pk2(v[4], v[5]); o.w = pk2(v[6], v[7]);
        *(v4u*)(bt1 + (size_t)row * 512 + cc * 8) = o; }
    float* at = (float*)(a.ws + WS_ATAB) + g * 128;
    if (tid < 64) { at[tid * 2] = Pre[32 * 64 + tid]; at[tid * 2 + 1] = Pim[32 * 64 + tid]; }
    __syncthreads();
}

__device__ __forceinline__ void s5_scan_item(const Args& a, int item, LAS unsigned char* lds, int tid) {
    LAS float* seg_re = (LAS float*)lds; LAS float* seg_im = seg_re + 512;
    const int sl = tid & 31, seg = tid >> 5, sidx = item * 32 + sl, g = sidx >> 6, n = sidx & 63;
    const float* at = (const float*)(a.ws + WS_ATAB) + g * 128 + n * 2; const float ar = at[0], ai = at[1];
    const float* sloc = (const float*)(a.ws + WS_SLOC) + ((size_t)g * NCH5 + seg * 32) * 128 + n;
    float er = 0.f, ei = 0.f;
#pragma unroll 8
    for (int j = 0; j < 32; ++j) { const float lr = sloc[j * 128], li = sloc[j * 128 + 64]; const float tr = ar * er - ai * ei + lr, ti = ar * ei + ai * er + li; er = tr; ei = ti; }
    seg_re[seg * 32 + sl] = er; seg_im[seg * 32 + sl] = ei;
    __syncthreads();
    float pr = ar, pi = ai;
#pragma unroll
    for (int q = 0; q < 5; ++q) { const float tr = pr * pr - pi * pi, ti = 2.f * pr * pi; pr = tr; pi = ti; }
    float sr = 0.f, si = 0.f;
    for (int s2 = 0; s2 < seg; ++s2) { const float tr = pr * sr - pi * si + seg_re[s2 * 32 + sl], ti = pr * si + pi * sr + seg_im[s2 * 32 + sl]; sr = tr; si = ti; }
    bf16* xg = (bf16*)(a.ws + WS_XG5) + ((size_t)g * NCH5 + seg * 32) * K5 + 512 + n;
#pragma unroll 8
    for (int j = 0; j < 32; ++j) { xg[(size_t)j * K5] = (bf16)f2bf(sr); xg[(size_t)j * K5 + 64] = (bf16)f2bf(si);
        const float lr = sloc[j * 128], li = sloc[j * 128 + 64]; const float tr = ar * sr - ai * si + lr, ti = ar * si + ai * sr + li; sr = tr; si = ti; }
    __syncthreads();
}

constexpr int RS = 136;
__device__ __forceinline__ float ret_l2g(int h) { return log2f(1.0f - exp2f(-5.0f - (float)h)); }
__device__ __forceinline__ v4u ret_scale8(v4u w, float z) {
    w.x = pk2(pg8::bf_lo(w.x) * z, pg8::bf_hi(w.x) * z); w.y = pk2(pg8::bf_lo(w.y) * z, pg8::bf_hi(w.y) * z); w.z = pk2(pg8::bf_lo(w.z) * z, pg8::bf_hi(w.z) * z); w.w = pk2(pg8::bf_lo(w.w) * z, pg8::bf_hi(w.w) * z); return w; }
__device__ __forceinline__ void ret_stage_rm(const bf16* src_, LAS bf16* dst, int tid) {
    const GAS bf16* src = (const GAS bf16*)src_; v4u wv[4];
#pragma unroll
    for (int q = 0; q < 4; ++q) { const int id = tid + 512 * q, row = id >> 4, c8 = id & 15; wv[q] = *(const GAS v4u*)(src + (size_t)row * 1024 + 8 * c8); }
#pragma unroll
    for (int q = 0; q < 4; ++q) { const int id = tid + 512 * q, row = id >> 4, c8 = id & 15; *(LAS v4u*)(dst + row * RS + 8 * c8) = wv[q]; }
}
template <bool ZETA> __device__ __forceinline__ void ret_stage_tr(const bf16* src_, LAS bf16* dst, int tid, float l2g) {
    const GAS bf16* src = (const GAS bf16*)src_; v4u wv[4];
#pragma unroll
    for (int q = 0; q < 4; ++q) { const int id = tid + 512 * q, row = id & 127, c8 = id >> 7; wv[q] = *(const GAS v4u*)(src + (size_t)row * 1024 + 8 * c8); }
#pragma unroll
    for (int q = 0; q < 4; ++q) { const int id = tid + 512 * q, row = id & 127, c8 = id >> 7; v4u w = wv[q];
        if (ZETA) w = ret_scale8(w, exp2f(l2g * (float)(127 - row)));
        LAS bf16* d = dst + (8 * c8) * RS + row;
        d[0 * RS] = (bf16)(w.x & 0xffffu); d[1 * RS] = (bf16)(w.x >> 16); d[2 * RS] = (bf16)(w.y & 0xffffu); d[3 * RS] = (bf16)(w.y >> 16);
        d[4 * RS] = (bf16)(w.z & 0xffffu); d[5 * RS] = (bf16)(w.z >> 16); d[6 * RS] = (bf16)(w.w & 0xffffu); d[7 * RS] = (bf16)(w.w >> 16); }
}
__device__ __forceinline__ void ret_kv_unit(const Args& a, int unit, LAS unsigned char* lds, int tid) {
    const int n = unit >> 3, h = unit & 7, t0 = n * RCH, lane = tid & 63, w = __builtin_amdgcn_readfirstlane(tid >> 6), fr = lane & 15, fg = lane >> 4;
    LAS bf16* Kt = (LAS bf16*)lds; LAS bf16* Vt = Kt + 128 * RS;
    const float l2g = ret_l2g(h);
    ret_stage_tr<true>((const bf16*)(a.ws + WS_K) + (size_t)t0 * 1024 + h * 128, Kt, tid, l2g);
    ret_stage_tr<false>((const bf16*)(a.ws + WS_V) + (size_t)t0 * 1024 + h * 128, Vt, tid, l2g);
    __syncthreads();
    bf16x8 af[4];
#pragma unroll
    for (int ks = 0; ks < 4; ++ks) af[ks] = *(const LAS bf16x8*)(Vt + (16 * w + fr) * RS + 32 * ks + 8 * fg);
    float* out = (float*)(a.ws + WS_KVT) + ((size_t)unit * 128 + 16 * w + 4 * fg) * 128 + fr;
#pragma unroll
    for (int dt = 0; dt < 8; ++dt) { f32x4 acc = (f32x4){0.f, 0.f, 0.f, 0.f};
#pragma unroll
        for (int ks = 0; ks < 4; ++ks) { const bf16x8 bfv = *(const LAS bf16x8*)(Kt + (16 * dt + fr) * RS + 32 * ks + 8 * fg);
            acc = __builtin_amdgcn_mfma_f32_16x16x32_bf16(af[ks], bfv, acc, 0, 0, 0); }
#pragma unroll
        for (int r = 0; r < 4; ++r) out[(size_t)r * 128 + 16 * dt] = acc[r]; }
    __syncthreads();
}
__device__ __forceinline__ void ret_state_scan(const Args& a, int gtid, int gthreads) {
    const float* kvt = (const float*)(a.ws + WS_KVT); bf16* rt = (bf16*)(a.ws + WS_RT);
    for (int idx = gtid; idx < RH * 128 * 128; idx += gthreads) { const int h = idx >> 14; const float dec = exp2f(128.0f * ret_l2g(h)); float st = 0.f;
#pragma unroll 8
        for (int n = 0; n < NRC; ++n) { rt[(size_t)n * 131072 + idx] = (bf16)f2bf(st); st = st * dec + kvt[(size_t)n * 131072 + idx]; } }
}
struct RetPre { v4u k[4], v[4]; bf16x8 q[4]; };
__device__ __forceinline__ void ret_out_load(const Args& a, int unit, int tid, RetPre& P) {
    const int n = unit >> 3, h = unit & 7, t0 = n * RCH, lane = tid & 63, w = tid >> 6, fr = lane & 15, fg = lane >> 4, il = 16 * w + fr;
    const GAS bf16* ks = (const GAS bf16*)(a.ws + WS_K) + (size_t)t0 * 1024 + h * 128; const GAS bf16* vs = (const GAS bf16*)(a.ws + WS_V) + (size_t)t0 * 1024 + h * 128;
#pragma unroll
    for (int q = 0; q < 4; ++q) { const int id = tid + 512 * q;
        P.k[q] = *(const GAS v4u*)(ks + (size_t)(id >> 4) * 1024 + 8 * (id & 15));
        P.v[q] = *(const GAS v4u*)(vs + (size_t)(id & 127) * 1024 + 8 * (id >> 7)); }
    const GAS bf16* qp = (const GAS bf16*)(a.ws + WS_Q) + (size_t)(t0 + il) * 1024 + h * 128 + 8 * fg;
#pragma unroll
    for (int ks2 = 0; ks2 < 4; ++ks2) P.q[ks2] = *(const GAS bf16x8*)(qp + 32 * ks2);
}
__device__ __forceinline__ void ret_out_units(const Args& a, int u0, int ustride, int uend, LAS unsigned char* lds, int tid) {
    if (u0 >= uend) return;
    const int lane = tid & 63, w = __builtin_amdgcn_readfirstlane(tid >> 6), fr = lane & 15, fg = lane >> 4, i0 = 16 * w, il = i0 + fr;
    LAS bf16* Ks = (LAS bf16*)lds; LAS bf16* Vt = Ks + 128 * RS; LAS bf16* Ps = Vt + 128 * RS; LAS bf16* Rs = Ps + 128 * RS;
    RetPre P; ret_out_load(a, u0, tid, P);
    for (int unit = u0; unit < uend; unit += ustride) {
        const int n = unit >> 3, h = unit & 7, t0 = n * RCH; const float l2g = ret_l2g(h);
#pragma unroll
        for (int q = 0; q < 4; ++q) { const int id = tid + 512 * q;
            *(LAS v4u*)(Ks + (id >> 4) * RS + 8 * (id & 15)) = P.k[q];
            const v4u wv = P.v[q]; LAS bf16* d = Vt + (8 * (id >> 7)) * RS + (id & 127);
            d[0 * RS] = (bf16)(wv.x & 0xffffu); d[1 * RS] = (bf16)(wv.x >> 16); d[2 * RS] = (bf16)(wv.y & 0xffffu); d[3 * RS] = (bf16)(wv.y >> 16);
            d[4 * RS] = (bf16)(wv.z & 0xffffu); d[5 * RS] = (bf16)(wv.z >> 16); d[6 * RS] = (bf16)(wv.w & 0xffffu); d[7 * RS] = (bf16)(wv.w >> 16); }
        bf16x8 qf[4]; v2u gt[8];
#pragma unroll
        for (int ks = 0; ks < 4; ++ks) qf[ks] = P.q[ks];
        __syncthreads();
        { const GAS bf16* gp = (const GAS bf16*)(a.ws + WS_GS) + (size_t)(t0 + il) * 1024 + h * 128 + 4 * fg;
#pragma unroll
          for (int et = 0; et < 8; ++et) gt[et] = *(const GAS v2u*)(gp + 16 * et); }
        v4u rv[4];
        { const GAS bf16* rs = (const GAS bf16*)(a.ws + WS_RT) + (size_t)unit * 16384;
#pragma unroll
          for (int q = 0; q < 4; ++q) { const int id = tid + 512 * q; rv[q] = *(const GAS v4u*)(rs + (size_t)(id >> 4) * 128 + 8 * (id & 15)); } }
        if (unit + ustride < uend) ret_out_load(a, unit + ustride, tid, P);
#pragma unroll
        for (int jt = 0; jt < 8; ++jt) {
            if (jt <= w) { f32x4 acc = (f32x4){0.f, 0.f, 0.f, 0.f};
#pragma unroll
                for (int ks = 0; ks < 4; ++ks) { const bf16x8 kf = *(const LAS bf16x8*)(Ks + (16 * jt + fr) * RS + 32 * ks + 8 * fg);
                    acc = __builtin_amdgcn_mfma_f32_16x16x32_bf16(kf, qf[ks], acc, 0, 0, 0); }
                float pv[4];
#pragma unroll
                for (int r = 0; r < 4; ++r) { const int j = 16 * jt + 4 * fg + r; pv[r] = (il >= j) ? acc[r] * exp2f(l2g * (float)(il - j)) : 0.f; }
                LAS unsigned* pp = (LAS unsigned*)(Ps + il * RS + 16 * jt + 4 * fg); pp[0] = pk2(pv[0], pv[1]); pp[1] = pk2(pv[2], pv[3]);
            } else if (jt == w + 1 && (w & 1) == 0) { LAS unsigned* pp = (LAS unsigned*)(Ps + il * RS + 16 * jt + 4 * fg); pp[0] = 0u; pp[1] = 0u; }
        }
#pragma unroll
        for (int q = 0; q < 4; ++q) { const int id = tid + 512 * q; *(LAS v4u*)(Rs + (id >> 4) * RS + 8 * (id & 15)) = rv[q]; }
        __syncthreads();
        f32x4 accI[8], accC[8];
#pragma unroll
        for (int et = 0; et < 8; ++et) { accI[et] = (f32x4){0.f, 0.f, 0.f, 0.f}; accC[et] = (f32x4){0.f, 0.f, 0.f, 0.f}; }
        const int nks = (w >> 1) + 1;
        for (int ks = 0; ks < nks; ++ks) { const bf16x8 pf = *(const LAS bf16x8*)(Ps + il * RS + 32 * ks + 8 * fg);
#pragma unroll
            for (int et = 0; et < 8; ++et) { const bf16x8 vf = *(const LAS bf16x8*)(Vt + (16 * et + fr) * RS + 32 * ks + 8 * fg);
                accI[et] = __builtin_amdgcn_mfma_f32_16x16x32_bf16(vf, pf, accI[et], 0, 0, 0); }
            __builtin_amdgcn_sched_barrier(0); }
#pragma unroll
        for (int ks = 0; ks < 4; ++ks) {
#pragma unroll
            for (int et = 0; et < 8; ++et) { const bf16x8 rf = *(const LAS bf16x8*)(Rs + (16 * et + fr) * RS + 32 * ks + 8 * fg);
                accC[et] = __builtin_amdgcn_mfma_f32_16x16x32_bf16(rf, qf[ks], accC[et], 0, 0, 0); }
            __builtin_amdgcn_sched_barrier(0); }
        const float xi = exp2f(l2g * (float)(il + 1));
        float s = 0.f;
#pragma unroll
        for (int et = 0; et < 8; ++et) { accI[et] = accI[et] + accC[et] * xi; s += (accI[et][0] + accI[et][1]) + (accI[et][2] + accI[et][3]); }
        s += __shfl_xor(s, 16); s += __shfl_xor(s, 32);
        const float mu = s * (1.0f / 128.0f); float q2 = 0.f;
#pragma unroll
        for (int et = 0; et < 8; ++et) { accI[et] = accI[et] - mu; q2 += (accI[et][0] * accI[et][0] + accI[et][1] * accI[et][1]) + (accI[et][2] * accI[et][2] + accI[et][3] * accI[et][3]); }
        q2 += __shfl_xor(q2, 16); q2 += __shfl_xor(q2, 32);
        const float rstd = 1.0f / sqrtf(q2 * (1.0f / 128.0f) + 1e-6f);
        GAS bf16* yp = (GAS bf16*)(a.ws + WS_YR) + (size_t)(t0 + il) * 1024 + h * 128 + 4 * fg;
#pragma unroll
        for (int et = 0; et < 8; ++et) { const v2u gw = gt[et]; v2u o;
            o.x = pk2(accI[et][0] * rstd * pg8::bf_lo(gw.x), accI[et][1] * rstd * pg8::bf_hi(gw.x)); o.y = pk2(accI[et][2] * rstd * pg8::bf_lo(gw.y), accI[et][3] * rstd * pg8::bf_hi(gw.y));
            *(GAS v2u*)(yp + 16 * et) = o; }
        __syncthreads();
    }
}

__device__ __forceinline__ void router_item(const Args& a, int item, LAS unsigned char* lds, int tid) {
    LAS float* rs = (LAS float*)lds;
    LAS float* part = rs + 64;
    LAS float* lg = part + 4 * 64 * 33;
    LAS int* hist = (LAS int*)(lg + 64 * 33);
    LAS int* base = hist + 32;
    LAS int* slot = base + 32;
    const int lane = tid & 63, w = __builtin_amdgcn_readfirstlane(tid >> 6), tb = item * 64;
    const float* x2 = (const float*)(a.ws + WS_X2);
    if (tid < 32) hist[tid] = 0;
    { f32x4 va[8], vb[8];
#define P8_LOAD(V_, r_) do { const GAS f32x4* xr_ = (const GAS f32x4*)(x2 + (size_t)(tb + 8 * w + (r_)) * 2048) + lane; _Pragma("unroll") for (int j = 0; j < 8; ++j) V_[j] = xr_[64 * j]; } while (0)
#define P8_PROC(V_, r_) do { float s_ = 0.f; _Pragma("unroll") for (int j = 0; j < 8; ++j) s_ += (V_[j].x * V_[j].x + V_[j].y * V_[j].y) + (V_[j].z * V_[j].z + V_[j].w * V_[j].w); \
          const float rstd_ = 1.0f / sqrtf(wave_sum(s_) * (1.0f / 2048.0f) + 1e-6f); if (lane == 0) rs[8 * w + (r_)] = rstd_; } while (0)
      P8_LOAD(va, 0);
#pragma unroll
      for (int rp = 0; rp < 4; ++rp) { P8_LOAD(vb, 2 * rp + 1); P8_PROC(va, 2 * rp); if (rp < 3) P8_LOAD(va, 2 * rp + 2); P8_PROC(vb, 2 * rp + 1); }
#undef P8_LOAD
#undef P8_PROC
    }
    { const int tg = w & 1, kq = w >> 1, hl = lane >> 5, l31 = lane & 31;
      const GAS float* xp = (const GAS float*)x2 + (size_t)(tb + 32 * tg + l31) * 2048 + 512 * kq + 4 * hl;
      const GAS float* wp = (const GAS float*)(a.ws + WS_WG) + (size_t)(512 * kq + 4 * hl) * 32 + l31;
      f32x16 acc;
#pragma unroll
      for (int x = 0; x < 16; ++x) acc[x] = 0.f;
#pragma unroll 4
      for (int kk = 0; kk < 64; ++kk) { const f32x4 av = *(const GAS f32x4*)(xp + 8 * kk); const GAS float* wq = wp + (size_t)(8 * kk) * 32;
          acc = __builtin_amdgcn_mfma_f32_32x32x2f32(av.x, wq[0], acc, 0, 0, 0); acc = __builtin_amdgcn_mfma_f32_32x32x2f32(av.y, wq[32], acc, 0, 0, 0);
          acc = __builtin_amdgcn_mfma_f32_32x32x2f32(av.z, wq[64], acc, 0, 0, 0); acc = __builtin_amdgcn_mfma_f32_32x32x2f32(av.w, wq[96], acc, 0, 0, 0); }
#pragma unroll
      for (int x = 0; x < 16; ++x) { const int tl = (x & 3) + 8 * (x >> 2) + 4 * hl; part[(kq * 64 + 32 * tg + tl) * 33 + l31] = acc[x]; } }
    __syncthreads();
    for (int e = tid; e < 64 * 32; e += 512) { const int tl = e >> 5, ex = e & 31;
        lg[tl * 33 + ex] = rs[tl] * ((part[(0 * 64 + tl) * 33 + ex] + part[(1 * 64 + tl) * 33 + ex]) + (part[(2 * 64 + tl) * 33 + ex] + part[(3 * 64 + tl) * 33 + ex])) + a.router_b[ex]; }
    __syncthreads();
    int e0 = 0, e1 = 0, e2 = 0, e3 = 0, r0 = 0, r1 = 0, r2 = 0, r3 = 0; float g0 = 0.f, g1 = 0.f, g2 = 0.f, g3 = 0.f;
    if (tid < 64) { const LAS float* L = lg + tid * 33; float v0 = -3.0e38f, v1 = -3.0e38f, v2 = -3.0e38f, v3 = -3.0e38f;
        for (int ex = 0; ex < 32; ++ex) { const float v = L[ex]; if (v > v0) { v0 = v; e0 = ex; } }
        for (int ex = 0; ex < 32; ++ex) { const float v = L[ex]; if (ex != e0 && v > v1) { v1 = v; e1 = ex; } }
        for (int ex = 0; ex < 32; ++ex) { const float v = L[ex]; if (ex != e0 && ex != e1 && v > v2) { v2 = v; e2 = ex; } }
        for (int ex = 0; ex < 32; ++ex) { const float v = L[ex]; if (ex != e0 && ex != e1 && ex != e2 && v > v3) { v3 = v; e3 = ex; } }
        const float p0 = 1.0f, p1 = expf(v1 - v0), p2 = expf(v2 - v0), p3 = expf(v3 - v0), inv = 1.0f / (p0 + p1 + p2 + p3);
        g0 = p0 * inv; g1 = p1 * inv; g2 = p2 * inv; g3 = p3 * inv;
        r0 = __hip_atomic_fetch_add(&hist[e0], 1, __ATOMIC_RELAXED, __HIP_MEMORY_SCOPE_WORKGROUP); r1 = __hip_atomic_fetch_add(&hist[e1], 1, __ATOMIC_RELAXED, __HIP_MEMORY_SCOPE_WORKGROUP);
        r2 = __hip_atomic_fetch_add(&hist[e2], 1, __ATOMIC_RELAXED, __HIP_MEMORY_SCOPE_WORKGROUP); r3 = __hip_atomic_fetch_add(&hist[e3], 1, __ATOMIC_RELAXED, __HIP_MEMORY_SCOPE_WORKGROUP); }
    __syncthreads();
    if (tid < 32) base[tid] = (int)__hip_atomic_fetch_add((unsigned*)(a.ws + WS_CTL) + CW_CNT + tid, (unsigned)hist[tid], RLX_AGENT);
    __syncthreads();
    if (tid < 64) { const int t = tb + tid; int* te = (int*)(a.ws + WS_TOKE) + t * 4; float* tg = (float*)(a.ws + WS_TOKG) + t * 4; int* tp = (int*)(a.ws + WS_TOKP) + t * 4;
        const int q0 = base[e0] + r0, q1 = base[e1] + r1, q2 = base[e2] + r2, q3 = base[e3] + r3;
        te[0] = e0; te[1] = e1; te[2] = e2; te[3] = e3; tg[0] = g0; tg[1] = g1; tg[2] = g2; tg[3] = g3; tp[0] = q0; tp[1] = q1; tp[2] = q2; tp[3] = q3;
        slot[tid * 4] = e0 * 16384 + q0; slot[tid * 4 + 1] = e1 * 16384 + q1; slot[tid * 4 + 2] = e2 * 16384 + q2; slot[tid * 4 + 3] = e3 * 16384 + q3; }
    __syncthreads();
    { const GAS f32x4* gr = (const GAS f32x4*)a.norm2_g + lane; GAS unsigned char* xg = (GAS unsigned char*)(a.ws + WS_XG); f32x4 va[8], vb[8];
#define P8_LOAD(V_, r_) do { const GAS f32x4* xr_ = (const GAS f32x4*)(x2 + (size_t)(tb + 8 * w + (r_)) * 2048) + lane; _Pragma("unroll") for (int j = 0; j < 8; ++j) V_[j] = xr_[64 * j]; } while (0)
#define P8_PROC(V_, r_) do { const int tl_ = 8 * w + (r_); const float rstd_ = rs[tl_]; const int s0 = slot[tl_ * 4], s1 = slot[tl_ * 4 + 1], s2 = slot[tl_ * 4 + 2], s3 = slot[tl_ * 4 + 3]; \
          GAS unsigned* d0 = (GAS unsigned*)(xg + (size_t)s0 * 2048) + lane; GAS unsigned* d1 = (GAS unsigned*)(xg + (size_t)s1 * 2048) + lane; \
          GAS unsigned* d2 = (GAS unsigned*)(xg + (size_t)s2 * 2048) + lane; GAS unsigned* d3 = (GAS unsigned*)(xg + (size_t)s3 * 2048) + lane; \
          _Pragma("unroll") for (int j = 0; j < 8; ++j) { const f32x4 v = V_[j], g = gr[64 * j]; const unsigned dw = pg8::pk4_fp8(v.x * rstd_ * g.x, v.y * rstd_ * g.y, v.z * rstd_ * g.z, v.w * rstd_ * g.w); \
              d0[64 * j] = dw; d1[64 * j] = dw; d2[64 * j] = dw; d3[64 * j] = dw; } } while (0)
      P8_LOAD(va, 0);
#pragma unroll
      for (int rp = 0; rp < 4; ++rp) { P8_LOAD(vb, 2 * rp + 1); P8_PROC(va, 2 * rp); if (rp < 3) P8_LOAD(va, 2 * rp + 2); P8_PROC(vb, 2 * rp + 1); }
#undef P8_LOAD
#undef P8_PROC
    }
    __syncthreads();
}
__device__ __forceinline__ int moe_table(const Args& a, LAS unsigned char* lds, int tid) {
    LAS int* tab = (LAS int*)(lds + MOETAB_OFF);
    if (tid < 64) {
        const int e = tid, c = (e < NEXP) ? (int)__hip_atomic_load((unsigned*)(a.ws + WS_CTL) + CW_CNT + e, RLX_AGENT) : 0, nt = (c + 255) >> 8;
        int incl = nt;
#pragma unroll
        for (int o = 1; o < 64; o <<= 1) { const int v = __shfl_up(incl, o); if (tid >= o) incl += v; }
        const int start = incl - nt;
        if (e <= NEXP) tab[e] = start;
        for (int j = 0; j < nt; ++j) tab[33 + start + j] = e; }
    __syncthreads();
    return __builtin_amdgcn_readfirstlane(tab[NEXP]);
}

constexpr int N_PHASES = 15;
__global__ void __launch_bounds__(NWAVES * 64, 2) mk_fwd(Args kargs) {
    extern __shared__ __attribute__((aligned(16))) unsigned char lds_raw[];
    LAS unsigned char* lds = (LAS unsigned char*)lds_raw;
    const int tid = threadIdx.x, lane = tid & 63, wave = __builtin_amdgcn_readfirstlane(tid >> 6);
    const int G = gridDim.x, bx = blockIdx.x, gw = bx * NWAVES + wave, NGW = G * NWAVES, gtid = bx * (NWAVES * 64) + tid, GT = G * NWAVES * 64;
    unsigned char* const ws = kargs.ws;
#define LOAD_ARGS() const __attribute__((address_space(4))) Args* ap_ = (const __attribute__((address_space(4))) Args*)__builtin_amdgcn_kernarg_segment_ptr(); asm volatile("" : "+s"(ap_)); Args a; { const __attribute__((address_space(4))) unsigned long long* q_ = (const __attribute__((address_space(4))) unsigned long long*)ap_; unsigned long long* d_ = (unsigned long long*)&a; _Pragma("unroll") for (int i_ = 0; i_ < (int)(sizeof(Args) / 8); ++i_) d_[i_] = q_[i_]; }
    for (int u = tid; u < (LDS_BYTES - LDSCTL_OFF) / 4; u += NWAVES * 64) ((LAS unsigned*)(lds + LDSCTL_OFF))[u] = 0u;
    __syncthreads();
    XcdBarrier bar = xcd_barrier_post((unsigned*)(ws + WS_CTL) + CW_BAR + kargs.li * XCD_BAR_WORDS, (volatile LAS unsigned*)(lds + LDSCTL_OFF) + 8);
    const int lo = kargs.ph_lo, hi = kargs.ph_hi;
#ifndef PH_MASK
#define PH_MASK 0x7fff
#endif
#define IN(k) (((PH_MASK >> (k)) & 1) && lo <= (k) && (k) < hi)
#define SEAM(k) do { if (IN(k) && IN((k) + 1)) xcd_barrier(bar); } while (0)
    bf16* const HB = (bf16*)(ws + WS_HB);
#ifndef STAG_US
#define STAG_US 0
#endif
#define STAGGER(us) do { if ((us) > 0 && (bx & 1)) { const unsigned long long t0_ = __builtin_amdgcn_s_memrealtime(); while (__builtin_amdgcn_s_memrealtime() - t0_ < (unsigned long long)(us) * 100ull) __builtin_amdgcn_s_sleep(32); } } while (0)

#ifndef MK_SPLIT
#define MK_SPLIT 0
#endif
    const bool split = MK_SPLIT && (G == 256);
    const bool is_conv = !split || (((bx >> 3) & 3) == 3);
    const bool is_gemm = !split || !is_conv;
    const int convG = split ? 64 : G, convRank = split ? ((bx >> 5) * 8 + (bx & 7)) : bx;
    const int gemmG = split ? 192 : G, gemmRank = split ? ((bx >> 5) * 24 + (bx & 31)) : bx;
    if (IN(0)) { LOAD_ARGS();
        const int nsk = (G > 2 * NG5) ? NG5 : 0;
        if (bx < nsk || nsk == 0) for (int g = bx; g < NG5; g += G) s5_tables(a, g, lds, tid);
        if (bx >= nsk) { LAS float* scr = (LAS float*)(lds + wave * 16640);
            const int gw2 = (bx - nsk) * NWAVES + wave, NGW2 = (G - nsk) * NWAVES, gt2 = (bx - nsk) * (NWAVES * 64) + tid, GT2 = (G - nsk) * NWAVES * 64;
            transpose_run<false>(a.w_in, 2048, 5120, INC, ws + WS_BTIN, 1, 1, 0, 0, scr, gw2, NGW2, lane);
            transpose_run8(a.w_in + 5120, 2048, 4096, INC, ws + WS_BTIN8, 0, 1, 0, 0, (LAS unsigned*)scr, gw2, NGW2, lane);
            transpose_run<false>(a.w_pp, PLED, 2048, 2048, ws + WS_BTPP, 0, 1, 0, 0, scr, gw2, NGW2, lane);
            for (int t = gw2; t < SEQ; t += NGW2) rms_row_bf16(a.x + (size_t)t * 2048, a.norm1_g, HB + (size_t)t * 2048, ws + WS_H8 + (size_t)t * 2048, lane);
            { float* cs = (float*)(ws + WS_CS); float* sn = (float*)(ws + WS_SN);
              for (int e = gt2; e < SEQ * 64; e += GT2) { const int t = e >> 6, i = e & 63; const float inv = powf(10000.0f, -(float)i / 64.0f), ang = (float)a.pos[t] * inv; cs[e] = cosf(ang); sn[e] = sinf(ang); } }
            { float* wg = (float*)(ws + WS_WG); for (int e = gt2; e < 2048 * 32; e += GT2) wg[e] = a.norm2_g[e >> 5] * a.router_w[e]; }
            { v2u* pb = (v2u*)(ws + WS_PBF); const f32x4* pf = (const f32x4*)a.p;
              for (int e = gt2; e < SEQ * PLED / 4; e += GT2) { const f32x4 v = pf[e]; v2u o; o.x = pk2(v.x, v.y); o.y = pk2(v.z, v.w); pb[e] = o; } } }
    }
    SEAM(0);
    if (IN(1)) { LOAD_ARGS();
#ifndef MK_INTERLEAVE
#define MK_INTERLEAVE 0
#endif
        const bool gemm_first = MK_INTERLEAVE && !split && (((bx >> 3) & 1) != 0);
#define P1_CONV() do { LAS float* scr = (LAS float*)(lds + wave * 16640); const int cw = convRank * NWAVES + wave, NCW = convG * NWAVES; \
            transpose_run<false>(a.w_glu, 1024, 1024, 1024, ws + WS_BTGLU, 0, 1, 0, 0, scr, cw, NCW, lane); \
            transpose_run<false>(a.w_bs, 1024, 2048, 2048, ws + WS_BTPS, 0, 1, 0, 0, scr, cw, NCW, lane); \
            transpose_run<false>(a.w_br, 1024, 2048, 2048, ws + WS_BTPR, 0, 1, 0, 0, scr, cw, NCW, lane); \
            transpose_run<false>(a.w_out, 2048, 2048, 2048, ws + WS_BTOUT, 0, 1, 0, 0, scr, cw, NCW, lane); \
            transpose_run<true>(a.w_pg, 2048, 2048, 2048, ws + WS_BTPG, 0, 1, 0, 0, scr, cw, NCW, lane); \
            transpose_run8(a.w_gu, 2048, 4096, 4096, ws + WS_BTGU, 2, NEXP, (size_t)2048 * 4096, (size_t)4096 * 2048, (LAS unsigned*)scr, cw, NCW, lane); \
            transpose_run8(a.w_dn, 2048, 2048, 2048, ws + WS_BTDN, 0, NEXP, (size_t)2048 * 2048, (size_t)2048 * 2048, (LAS unsigned*)scr, cw, NCW, lane); \
            __syncthreads(); } while (0)
#define P1_GEMMS() do { \
        { pg8::Gemm g{HB, (const bf16*)(ws + WS_BTIN), 2048, 2048, 2048}; pg8::StaticOrder S; S.init(SEQ, 1024, gemmG, gemmRank); \
          pg8::EpiZU E{(bf16*)(ws + WS_XG5)}; \
          pg8::gemm_phase<pg8::EpiZU, pg8::StaticOrder, true, true>(lds + RING_OFF, g, S, E); } \
        { pg8::Gemm g{HB, (const bf16*)(ws + WS_BTIN) + (size_t)1024 * 2048, 2048, 2048, 2048}; pg8::StaticOrder S; S.init(SEQ, 2048, gemmG, gemmRank); \
          pg8::EpiZR E{(bf16*)(ws + WS_Q), (bf16*)(ws + WS_K), (const float*)(ws + WS_CS), (const float*)(ws + WS_SN)}; \
          pg8::gemm_phase<pg8::EpiZR, pg8::StaticOrder, true, true>(lds + RING_OFF, g, S, E); } \
        { pg8::Gemm g{HB, (const bf16*)(ws + WS_BTIN) + (size_t)3072 * 2048, 2048, 2048, 2048}; pg8::StaticOrder S; S.init(SEQ, 2048, gemmG, gemmRank); \
          pg8::EpiZA E{(bf16*)(ws + WS_V), (bf16*)(ws + WS_GS), (bf16*)(ws + WS_SGS), (bf16*)(ws + WS_SGR), 0, 1.0f}; \
          pg8::gemm_phase<pg8::EpiZA, pg8::StaticOrder, true, true>(lds + RING_OFF, g, S, E); } \
        { pg8::Gemm g{(const bf16*)(ws + WS_H8), (const bf16*)(ws + WS_BTIN8), 1024, 1024, 1024}; pg8::StaticOrder S; S.init(SEQ, 4096, gemmG, gemmRank);     \
          pg8::EpiZA E{(bf16*)(ws + WS_V), (bf16*)(ws + WS_GS), (bf16*)(ws + WS_SGS), (bf16*)(ws + WS_SGR), 8, pg8::W8_INV}; \
          pg8::gemm_phase<pg8::EpiZA, pg8::StaticOrder, true, true, true>(lds + RING_OFF, g, S, E); } \
        __syncthreads(); } while (0)
        if (gemm_first) { P1_GEMMS(); P1_CONV(); }
        else { if (is_conv) P1_CONV(); if (is_gemm) P1_GEMMS(); }
#undef P1_CONV
#undef P1_GEMMS
        if (is_conv) { pg8::Gemm g{(const bf16*)(ws + WS_PBF), (const bf16*)(ws + WS_BTPP), PLED, PLED, PLED}; pg8::StaticOrder S; S.init(SEQ, 2048, convG, convRank);
          pg8::EpiPlain E{(bf16*)(ws + WS_PP), 2048};
          pg8::gemm_phase<pg8::EpiPlain, pg8::StaticOrder, true, true>(lds + RING_OFF, g, S, E); }
    }
    SEAM(1);
    if (IN(2)) { LOAD_ARGS();
        { pg8::Gemm g{(const bf16*)(ws + WS_XG5), (const bf16*)(ws + WS_BTS1), K5, 512, 512}; pg8::OrderS1 S{G, bx}; pg8::EpiS1 E{(float*)(ws + WS_SLOC)};
          pg8::gemm_phase<pg8::EpiS1, pg8::OrderS1, false, true>(lds + RING_OFF, g, S, E); }
        __syncthreads();
        for (int u = bx; u < NRC * RH; u += G) ret_kv_unit(a, u, lds, tid);
    }
    SEAM(2);
    if (IN(3)) { LOAD_ARGS();
        for (int it = G - 1 - bx; it < 128; it += G) s5_scan_item(a, it, lds, tid);
        ret_state_scan(a, gtid, GT);
    }
    SEAM(3);
    if (IN(4)) { LOAD_ARGS();
#if defined(P4_SKIP_GEMM)
        if (kargs.li == 0)
#endif
        { pg8::Gemm g{(const bf16*)(ws + WS_XG5), (const bf16*)(ws + WS_BTS3), K5, K5, K5}; pg8::OrderS3 S{G, bx}; pg8::EpiS3 E{(bf16*)(ws + WS_YSP)};
          pg8::gemm_phase<pg8::EpiS3, pg8::OrderS3, false, true>(lds + RING_OFF, g, S, E); }
        __syncthreads();
#if defined(P4_SKIP_RET)
        if (kargs.li == 0)
#endif
        ret_out_units(a, bx, G, NRC * RH, lds, tid);
    }
    SEAM(4);
    if (IN(5)) { LOAD_ARGS();
        pg8::Gemm g{(const bf16*)(ws + WS_YSP), (const bf16*)(ws + WS_BTGLU), 1024, 1024, 1024}; pg8::StaticOrder S; S.init(SEQ, 1024, G, bx);
        pg8::EpiGLU E{(const bf16*)(ws + WS_YSP), a.b_glu, (bf16*)(ws + WS_YS)};
        pg8::gemm_phase<pg8::EpiGLU, pg8::StaticOrder, true, true>(lds + RING_OFF, g, S, E);
    }
    SEAM(5);
#ifdef EXTRA_BAR
    for (int eb_ = 0; eb_ < EXTRA_BAR; ++eb_) xcd_barrier(bar);
#endif
    if (IN(6)) { LOAD_ARGS(); STAGGER(STAG_US);
        { pg8::Gemm g{(const bf16*)(ws + WS_YS), (const bf16*)(ws + WS_BTPS), 1024, 1024, 1024}; pg8::StaticOrder S; S.init(SEQ, 2048, G, bx);
          pg8::EpiM1 E{(const bf16*)(ws + WS_SGS), (bf16*)(ws + WS_TMP)};
          pg8::gemm_phase<pg8::EpiM1, pg8::StaticOrder, true, true>(lds + RING_OFF, g, S, E); }
        VM_WAIT(); __syncthreads();
        { pg8::Gemm g{(const bf16*)(ws + WS_YR), (const bf16*)(ws + WS_BTPR), 1024, 1024, 1024}; pg8::StaticOrder S; S.init(SEQ, 2048, G, bx);
          pg8::EpiM2 E{(const bf16*)(ws + WS_SGR), (const bf16*)(ws + WS_TMP), (bf16*)(ws + WS_MRG)};
          pg8::gemm_phase<pg8::EpiM2, pg8::StaticOrder, true, true>(lds + RING_OFF, g, S, E); }
    }
    SEAM(6);
    if (IN(7)) { LOAD_ARGS(); STAGGER(STAG_US);
        pg8::Gemm g{(const bf16*)(ws + WS_MRG), (const bf16*)(ws + WS_BTOUT), 2048, 2048, 2048}; pg8::StaticOrder S; S.init(SEQ, 2048, G, bx);
        pg8::EpiRes E{a.x, (float*)(ws + WS_X2)};
        pg8::gemm_phase<pg8::EpiRes, pg8::StaticOrder, true, true>(lds + RING_OFF, g, S, E);
    }
    SEAM(7);
    if (IN(8)) { LOAD_ARGS(); for (int it = bx; it < SEQ / 64; it += G) router_item(a, it, lds, tid); }
    do { if (IN(8) && IN(10)) xcd_barrier(bar); } while (0);
    if (IN(10)) { LOAD_ARGS();
        const int nrt = moe_table(a, lds, tid);
        pg8::Gemm g{(const bf16*)(ws + WS_XG), (const bf16*)(ws + WS_BTGU), 1024, 1024, 1024};     pg8::OrderMoe S; S.so.init(nrt * 256, 4096, G, bx); S.tab = (const LAS int*)(lds + MOETAB_OFF); S.ntn = 16; S.gather_a = true;
        pg8::EpiGU E{a.b_gu, ws + WS_ACT};
        pg8::gemm_phase<pg8::EpiGU, pg8::OrderMoe, true, true, true>(lds + RING_OFF, g, S, E);
    }
    SEAM(10);
    if (IN(11)) { LOAD_ARGS();
        const int nrt = moe_table(a, lds, tid);
        pg8::Gemm g{(const bf16*)(ws + WS_ACT), (const bf16*)(ws + WS_BTDN), 1024, 1024, 1024}; pg8::OrderMoe S; S.so.init(nrt * 256, 2048, G, bx); S.tab = (const LAS int*)(lds + MOETAB_OFF); S.ntn = 8; S.gather_a = false;
        pg8::EpiDN E{a.b_dn, ws + WS_YB};
        pg8::gemm_phase<pg8::EpiDN, pg8::OrderMoe, true, true, true>(lds + RING_OFF, g, S, E);
    }
    SEAM(11);
    if (IN(12)) { LOAD_ARGS();
        (void)moe_table(a, lds, tid); const LAS int* tab = (const LAS int*)(lds + MOETAB_OFF);
        const GAS int* toke = (const GAS int*)(ws + WS_TOKE); const GAS int* tokp = (const GAS int*)(ws + WS_TOKP); const GAS float* tokg = (const GAS float*)(ws + WS_TOKG);
        const GAS unsigned char* yb = (const GAS unsigned char*)(ws + WS_YB); const GAS float* x2 = (const GAS float*)(ws + WS_X2);
        GAS bf16* x3b = (GAS bf16*)(ws + WS_TMP + 64 * MiB); GAS unsigned char* h3b = (GAS unsigned char*)HB; const GAS f32x4* gr = (const GAS f32x4*)a.norm3_g + lane;
        typedef float f32x2_ __attribute__((ext_vector_type(2)));
        for (int tb = gw * 8; tb < SEQ; tb += NGW * 8) {
            int rowv = 0; float gv = 0.f;
            if (lane < 32) { const int as = tb * 4 + lane; rowv = tab[toke[as]] * 256 + tokp[as]; gv = tokg[as] * pg8::YB_INV; }
            f32x4 xa[8], xb[8]; unsigned ya[32], yc[32];
#define P12_LOAD(X_, Y_, tk_) do { const GAS f32x4* xr_ = (const GAS f32x4*)(x2 + (size_t)(tb + (tk_)) * 2048) + lane; \
                _Pragma("unroll") for (int j = 0; j < 8; ++j) X_[j] = xr_[64 * j]; \
                _Pragma("unroll") for (int k = 0; k < 4; ++k) { const int r_ = __shfl(rowv, (tk_) * 4 + k); const GAS unsigned* yp_ = (const GAS unsigned*)(yb + (size_t)r_ * 2048) + lane; \
                    _Pragma("unroll") for (int j = 0; j < 8; ++j) Y_[k * 8 + j] = yp_[64 * j]; } } while (0)
#define P12_PROC(X_, Y_, tk_) do { const float q0 = __shfl(gv, (tk_) * 4), q1 = __shfl(gv, (tk_) * 4 + 1), q2 = __shfl(gv, (tk_) * 4 + 2), q3 = __shfl(gv, (tk_) * 4 + 3); float s_ = 0.f; \
                GAS v2u* x3o = (GAS v2u*)(x3b + (size_t)(tb + (tk_)) * 2048) + lane; GAS unsigned* o4 = (GAS unsigned*)(h3b + (size_t)(tb + (tk_)) * 2048) + lane; \
                _Pragma("unroll") for (int j = 0; j < 8; ++j) { f32x4 x = X_[j]; const unsigned w0 = Y_[j], w1 = Y_[8 + j], w2 = Y_[16 + j], w3 = Y_[24 + j]; \
                    const f32x2_ a0 = __builtin_amdgcn_cvt_pk_f32_fp8(w0, false), b0 = __builtin_amdgcn_cvt_pk_f32_fp8(w0, true), a1 = __builtin_amdgcn_cvt_pk_f32_fp8(w1, false), b1 = __builtin_amdgcn_cvt_pk_f32_fp8(w1, true); \
                    const f32x2_ a2 = __builtin_amdgcn_cvt_pk_f32_fp8(w2, false), b2 = __builtin_amdgcn_cvt_pk_f32_fp8(w2, true), a3 = __builtin_amdgcn_cvt_pk_f32_fp8(w3, false), b3 = __builtin_amdgcn_cvt_pk_f32_fp8(w3, true); \
                    x.x += (a0.x * q0 + a1.x * q1) + (a2.x * q2 + a3.x * q3); x.y += (a0.y * q0 + a1.y * q1) + (a2.y * q2 + a3.y * q3); \
                    x.z += (b0.x * q0 + b1.x * q1) + (b2.x * q2 + b3.x * q3); x.w += (b0.y * q0 + b1.y * q1) + (b2.y * q2 + b3.y * q3); \
                    X_[j] = x; v2u xo; xo.x = pk2(x.x, x.y); xo.y = pk2(x.z, x.w); x3o[64 * j] = xo; s_ += (x.x * x.x + x.y * x.y) + (x.z * x.z + x.w * x.w); __builtin_amdgcn_sched_barrier(0); } \
                const float rstd_ = 1.0f / sqrtf(wave_sum(s_) * (1.0f / 2048.0f) + 1e-6f); \
                _Pragma("unroll") for (int j = 0; j < 8; ++j) { const f32x4 g = gr[64 * j]; o4[64 * j] = pg8::pk4_fp8(X_[j].x * rstd_ * g.x, X_[j].y * rstd_ * g.y, X_[j].z * rstd_ * g.z, X_[j].w * rstd_ * g.w); } } while (0)
            P12_LOAD(xa, ya, 0);
#pragma unroll
            for (int tp = 0; tp < 4; ++tp) { P12_LOAD(xb, yc, 2 * tp + 1); P12_PROC(xa, ya, 2 * tp); if (tp < 3) P12_LOAD(xa, ya, 2 * tp + 2); P12_PROC(xb, yc, 2 * tp + 1); }
#undef P12_LOAD
#undef P12_PROC
        }
    }
    SEAM(12);
    if (IN(13)) { LOAD_ARGS(); STAGGER(STAG_US);
        pg8::Gemm g{HB, (const bf16*)(ws + WS_BTPG), 1024, 1024, 1024}; pg8::StaticOrder S; S.init(SEQ, 2048, G, bx);
        pg8::EpiPLE E{(const bf16*)(ws + WS_TMP + 64 * MiB), (const bf16*)(ws + WS_PP), (bf16*)(ws + WS_MRG), pg8::W8_INV};
        pg8::gemm_phase<pg8::EpiPLE, pg8::StaticOrder, true, true, true>(lds + RING_OFF, g, S, E);
    }
    SEAM(13);
    if (IN(14)) { LOAD_ARGS();
        const GAS f32x4* gr = (const GAS f32x4*)a.fin_g + lane; const GAS bf16* x4 = (const GAS bf16*)(ws + WS_MRG); GAS float* outp = (GAS float*)a.out;
        for (int tb = gw * 8; tb < SEQ; tb += NGW * 8) { v2u wa[8], wb[8];
#define P14_LOAD(W_, tk_) do { const GAS v2u* xb_ = (const GAS v2u*)(x4 + (size_t)(tb + (tk_)) * 2048) + lane; _Pragma("unroll") for (int j = 0; j < 8; ++j) W_[j] = xb_[64 * j]; } while (0)
#define P14_PROC(W_, tk_) do { f32x4 v_[8]; float s_ = 0.f; \
                _Pragma("unroll") for (int j = 0; j < 8; ++j) { const v2u w = W_[j]; v_[j] = (f32x4){pg8::bf_lo(w.x), pg8::bf_hi(w.x), pg8::bf_lo(w.y), pg8::bf_hi(w.y)}; s_ += (v_[j].x * v_[j].x + v_[j].y * v_[j].y) + (v_[j].z * v_[j].z + v_[j].w * v_[j].w); } \
                const float rstd_ = 1.0f / sqrtf(wave_sum(s_) * (1.0f / 2048.0f) + 1e-6f); GAS f32x4* xr_ = (GAS f32x4*)(outp + (size_t)(tb + (tk_)) * 2048) + lane; \
                _Pragma("unroll") for (int j = 0; j < 8; ++j) xr_[64 * j] = v_[j] * rstd_ * gr[64 * j]; } while (0)
            P14_LOAD(wa, 0);
#pragma unroll
            for (int tp = 0; tp < 4; ++tp) { P14_LOAD(wb, 2 * tp + 1); P14_PROC(wa, 2 * tp); if (tp < 3) P14_LOAD(wa, 2 * tp + 2); P14_PROC(wb, 2 * tp + 1); }
#undef P14_LOAD
#undef P14_PROC
        }
    }
#undef IN
#undef SEAM
}

extern "C" void kernel_launch(void* const* d_in, const int* in_sizes, int n_in, void* d_out, int out_size, void* d_ws, size_t ws_size, hipStream_t stream) {
    static int grid = 0;
    if (grid == 0) {
        if (n_in != 29 || in_sizes[0] != SEQ * DM || out_size != SEQ * DM || ws_size < WS_END) { fprintf(stderr, "kernel_launch: unexpected shapes (n_in %d, ws %zu < %zu?)\n", n_in, ws_size, (size_t)WS_END); grid = -1; return; }
        int dev = 0, cus = 0, per_cu = 0;
        if (hipGetDevice(&dev) != hipSuccess || hipDeviceGetAttribute(&cus, hipDeviceAttributeMultiprocessorCount, dev) != hipSuccess) { grid = -1; return; }
        if (hipFuncSetAttribute((const void*)mk_fwd, hipFuncAttributeMaxDynamicSharedMemorySize, LDS_BYTES) != hipSuccess) { fprintf(stderr, "kernel_launch: hipFuncSetAttribute failed\n"); grid = -1; return; }
        if (hipOccupancyMaxActiveBlocksPerMultiprocessor(&per_cu, (const void*)mk_fwd, NWAVES * 64, LDS_BYTES) != hipSuccess || per_cu < 1) { fprintf(stderr, "kernel_launch: occupancy query says %d\n", per_cu); }
        (void)hipGetLastError();
        grid = cus;
    }
    if (grid < 0) return;
    if (hipMemsetAsync((char*)d_ws + WS_CTL, 0, CTL_ZERO_BYTES, stream) != hipSuccess) return;
    Args a{};
    a.x = (const float*)d_in[0]; a.p = (const float*)d_in[1]; a.pos = (const int*)d_in[2]; a.norm1_g = (const float*)d_in[3]; a.w_in = (const float*)d_in[4];
    a.lam_re = (const float*)d_in[5]; a.lam_im = (const float*)d_in[6]; a.log_dt = (const float*)d_in[7]; a.b_re = (const float*)d_in[8]; a.b_im = (const float*)d_in[9];
    a.c_re = (const float*)d_in[10]; a.c_im = (const float*)d_in[11]; a.d_skip = (const float*)d_in[12]; a.w_glu = (const float*)d_in[13]; a.b_glu = (const float*)d_in[14];
    a.w_bs = (const float*)d_in[15]; a.w_br = (const float*)d_in[16]; a.w_out = (const float*)d_in[17]; a.norm2_g = (const float*)d_in[18]; a.router_w = (const float*)d_in[19];
    a.router_b = (const float*)d_in[20]; a.w_gu = (const float*)d_in[21]; a.b_gu = (const float*)d_in[22]; a.w_dn = (const float*)d_in[23]; a.b_dn = (const float*)d_in[24];
    a.norm3_g = (const float*)d_in[25]; a.w_pg = (const float*)d_in[26]; a.w_pp = (const float*)d_in[27]; a.fin_g = (const float*)d_in[28];
    a.out = (float*)d_out; a.ws = (unsigned char*)d_ws;
#if defined(PROBE_LO)
#ifndef PROBE_REP
#define PROBE_REP 1
#endif
    a.ph_lo = 0; a.ph_hi = PROBE_HI; a.li = 0; hipLaunchKernelGGL(mk_fwd, dim3(grid), dim3(NWAVES * 64), LDS_BYTES, stream, a);
    for (int rep = 0; rep < PROBE_REP; ++rep) { a.ph_lo = PROBE_LO; a.ph_hi = (rep == PROBE_REP - 1) ? N_PHASES : PROBE_HI; a.li = 1 + rep; hipLaunchKernelGGL(mk_fwd, dim3(grid), dim3(NWAVES * 64), LDS_BYTES, stream, a); }
#elif MK_N_LAUNCHES == 1
    a.ph_lo = 0; a.ph_hi = N_PHASES;
    hipLaunchKernelGGL(mk_fwd, dim3(grid), dim3(NWAVES * 64), LDS_BYTES, stream, a);
#else
    for (int ph = 0; ph < N_PHASES; ++ph) { a.ph_lo = ph; a.ph_hi = ph + 1; hipLaunchKernelGGL(mk_fwd, dim3(grid), dim3(NWAVES * 64), LDS_BYTES, stream, a); }
#endif
    const hipError_t le = hipPeekAtLastError();
    if (le != hipSuccess) fprintf(stderr, "kernel_launch: launch failed: %s\n", hipGetErrorName(le));
}
```

```cpp
#include <hip/hip_runtime.h>
#include <cstdio>
#include <cstdint>

#ifndef MK_N_LAUNCHES
#define MK_N_LAUNCHES 1
#endif

constexpr int SEQ = 16384, DM = 2048, INC = 9216, NEXP = 32, FFN = 2048, PLED = 256;
constexpr int NG5 = 64, T5 = 32, NCH5 = SEQ / T5, K5 = 640;
constexpr int RCH = 128, NRC = SEQ / RCH, RH = 8;
constexpr int MAXROWS = SEQ * 4 + NEXP * 256;

namespace pg8 {
#define PG8_LAS __attribute__((address_space(3)))
typedef unsigned short bf16_t;
typedef short bf16x8 __attribute__((ext_vector_type(8)));
typedef float f32x4 __attribute__((ext_vector_type(4)));
typedef unsigned u32x4 __attribute__((ext_vector_type(4)));
typedef unsigned u32x2 __attribute__((ext_vector_type(2)));
constexpr int BM = 256, BK = 64, HALF = 128, HTB = HALF * BK * 2, STAGE_BYTES = 8 * HTB, NXCD = 8, WGM = 4;

__host__ __device__ __forceinline__ int lds_byte(int r, int c) { const int st = (r >> 4) * 2 + (c >> 5), rr = r & 15, cc = c & 31, ob = rr * 64 + cc * 2; return st * 1024 + (ob ^ (((ob >> 9) & 1) << 5)); }
__host__ __device__ __forceinline__ void stage_rc(int b, int& R, int& C) { const int st = b / 1024, sb = b % 1024, swz = sb ^ (((sb >> 9) & 1) << 5); R = (st >> 1) * 16 + swz / 64; C = (st & 1) * 32 + (swz % 64) / 2; }
__host__ __device__ __forceinline__ int perm32(int rho) { const int n = rho >> 4, i = rho & 15; return 8 * (i >> 2) + 4 * n + (i & 3); }

struct Unit { int pm, pn, pa; };
struct Gemm { const bf16_t* A; const bf16_t* Bt; int lda, ldb, K; };

struct StaticOrder {
    int nM, nN, nwg, G, c;
    __host__ __device__ void init(int M, int N, int G_, int c_) { nM = M / BM; nN = N / BM; nwg = nM * nN; G = G_; c = c_; }
    __host__ __device__ bool next(int i, Unit& u) const {
        const long L = (long)i * G + c; if (L >= nwg) return false;
        int wgid = (int)L; { const int q = nwg / NXCD, r = nwg % NXCD, xcd = wgid % NXCD, off = wgid / NXCD; wgid = (xcd < r ? xcd * (q + 1) : r * (q + 1) + (xcd - r) * q) + off; }
        const int nig = WGM * nN, gid = wgid / nig, fm = gid * WGM, gsz = (nM - fm) < WGM ? (nM - fm) : WGM;
        u.pm = fm + ((wgid % nig) % gsz); u.pn = (wgid % nig) / gsz; u.pa = u.pm; return true;
    }
    __device__ __forceinline__ void a_ready(const Unit&) const {}
    __device__ __forceinline__ void done(const Unit&) const {}
};
struct OrderS3 {
    int G, c;
    __device__ bool next(int i, Unit& u) const { const int L = i * G + c; if (L >= 256) return false; const int g = L >> 2; u.pm = 2 * g + ((L >> 1) & 1); u.pn = 2 * g + (L & 1); u.pa = u.pm; return true; }
    __device__ __forceinline__ void a_ready(const Unit&) const {}
    __device__ __forceinline__ void done(const Unit&) const {}
};
struct OrderS1 {
    int G, c;
    __device__ bool next(int i, Unit& u) const { const int L = i * G + c; if (L >= 128) return false; u.pm = L; u.pn = L >> 1; u.pa = L; return true; }
    __device__ __forceinline__ void a_ready(const Unit&) const {}
    __device__ __forceinline__ void done(const Unit&) const {}
};
struct OrderMoe {
    StaticOrder so; const PG8_LAS int* tab; int ntn; bool gather_a;
    __device__ bool next(int i, Unit& u) const { if (!so.next(i, u)) return false;
        const int e = __builtin_amdgcn_readfirstlane(tab[33 + u.pm]), t0 = __builtin_amdgcn_readfirstlane(tab[e]);
        u.pn = e * ntn + u.pn; u.pa = gather_a ? e * 64 + (u.pm - t0) : u.pm; return true; }
    __device__ __forceinline__ void a_ready(const Unit&) const {}
    __device__ __forceinline__ void done(const Unit&) const {}
};

__device__ __forceinline__ unsigned cvt_pk_bf16(float lo, float hi) { unsigned r; asm volatile("v_cvt_pk_bf16_f32 %0, %1, %2" : "=v"(r) : "v"(lo), "v"(hi)); return r; }
__device__ __forceinline__ u32x4 pack8(const f32x4& a, const f32x4& b) { u32x4 w; w.x = cvt_pk_bf16(a[0], a[1]); w.y = cvt_pk_bf16(a[2], a[3]); w.z = cvt_pk_bf16(b[0], b[1]); w.w = cvt_pk_bf16(b[2], b[3]); return w; }
__device__ __forceinline__ float bf_lo(unsigned w) { return __builtin_bit_cast(float, w << 16); }
__device__ __forceinline__ float bf_hi(unsigned w) { return __builtin_bit_cast(float, w & 0xffff0000u); }
__device__ __forceinline__ void unpack8(const u32x4& w, f32x4& a, f32x4& b) { a = (f32x4){bf_lo(w.x), bf_hi(w.x), bf_lo(w.y), bf_hi(w.y)}; b = (f32x4){bf_lo(w.z), bf_hi(w.z), bf_lo(w.w), bf_hi(w.w)}; }
typedef float f32x2 __attribute__((ext_vector_type(2)));
__device__ __forceinline__ float sigm(float x) { return __builtin_amdgcn_rcpf(1.0f + __builtin_amdgcn_exp2f(-1.4426950408889634f * x)); }
__device__ __forceinline__ f32x2 sigm2(f32x2 x) { const f32x2 t = x * (-1.4426950408889634f); f32x2 e; e.x = __builtin_amdgcn_exp2f(t.x); e.y = __builtin_amdgcn_exp2f(t.y);
    const f32x2 d = e + 1.0f; f32x2 r; r.x = __builtin_amdgcn_rcpf(d.x); r.y = __builtin_amdgcn_rcpf(d.y); return r; }
__device__ __forceinline__ f32x4 sigm4(const f32x4& x) { const f32x2 a = sigm2((f32x2){x[0], x[1]}), b = sigm2((f32x2){x[2], x[3]}); return (f32x4){a.x, a.y, b.x, b.y}; }
__device__ __forceinline__ float gelu_t(float x) { return x * sigm(1.5957691216057308f * (x + 0.044715f * x * x * x)); }
__device__ __forceinline__ f32x2 gelu2(f32x2 x) { const f32x2 u = x * x, w = (u * 0.044715f + 1.0f) * x; return x * sigm2(w * 1.5957691216057308f); }
__device__ __forceinline__ f32x4 gelu4(const f32x4& x) { const f32x2 a = gelu2((f32x2){x[0], x[1]}), b = gelu2((f32x2){x[2], x[3]}); return (f32x4){a.x, a.y, b.x, b.y}; }

#define EPI_LOOP_AM _Pragma("unroll") for (int ai = 0; ai < 2; ++ai) _Pragma("unroll") for (int m = 0; m < 4; ++m)
#define EPI_LOOP_BJ _Pragma("unroll") for (int bj = 0; bj < 2; ++bj)
typedef f32x4 AccT[2][2][4][2];
#ifndef EPIZ_MASK
#define EPIZ_MASK 31
#endif
#define EPIZ_EN(k) ((EPIZ_MASK >> (k)) & 1)

struct EpiZU {
    static constexpr bool PERM = true, AFTER_DRAIN = false; static constexpr int NSTORE = 16;
    bf16_t* xg5;
    __device__ __forceinline__ void operator()(const AccT& acc, const Unit& u, int wr, int wc, int fr, int fq) const {
        const int row0 = u.pm * BM + wr * 64 + fr, tc = wc * 32 + 8 * fq, pn = u.pn;
        EPI_LOOP_AM { const int t = row0 + ai * HALF + m * 16, j = t >> 5, i = t & 31;
            EPI_LOOP_BJ { const int col = pn * BM + bj * HALF + tc, g = col >> 4, c0 = col & 15;
                *(u32x4*)(xg5 + ((size_t)(g * NCH5 + j) * K5 + i * 16 + c0)) = pack8(acc[ai][bj][m][0], acc[ai][bj][m][1]); } }
    }
};
struct EpiZR {
    static constexpr bool PERM = true, AFTER_DRAIN = false; static constexpr int NSTORE = 16;
    bf16_t *q, *k; const float *cs, *sn;
    __device__ __forceinline__ void operator()(const AccT& acc, const Unit& u, int wr, int wc, int fr, int fq) const {
        const int row0 = u.pm * BM + wr * 64 + fr, pn = u.pn;
        const bool isk = pn >= 4; bf16_t* dst = isk ? k : q; const float sc = isk ? 0.08838834764831845f : 1.0f;
        const int head = 2 * (pn & 3) + (wc >> 1), dd = 32 * (wc & 1) + 8 * fq;
        EPI_LOOP_AM { const int t = row0 + ai * HALF + m * 16;
            const float* cp = cs + (size_t)t * 64 + dd; const float* sp = sn + (size_t)t * 64 + dd;
            const f32x4 c0 = *(const f32x4*)cp * sc, c1 = *(const f32x4*)(cp + 4) * sc, s0 = *(const f32x4*)sp * sc, s1 = *(const f32x4*)(sp + 4) * sc;
            const f32x4 x1a = acc[ai][0][m][0], x1b = acc[ai][0][m][1], x2a = acc[ai][1][m][0], x2b = acc[ai][1][m][1];
            bf16_t* o = dst + (size_t)t * 1024 + head * 128 + dd;
            *(u32x4*)o = pack8(x1a * c0 - x2a * s0, x1b * c1 - x2b * s1);
            *(u32x4*)(o + 64) = pack8(x1a * s0 + x2a * c0, x1b * s1 + x2b * c1); asm volatile("" ::: "memory"); }
    }
};
struct EpiZA {
    static constexpr bool PERM = true, AFTER_DRAIN = false; static constexpr int NSTORE = 16;
    bf16_t *v, *gs, *sgs, *sgr; int pn0; float sc;
    __device__ __forceinline__ void operator()(const AccT& acc, const Unit& u, int wr, int wc, int fr, int fq) const {
        const int row0 = u.pm * BM + wr * 64 + fr, tc = wc * 32 + 8 * fq, pn = u.pn + pn0;
        bf16_t* dst = pn < 4 ? v : (pn < 8 ? gs : (pn < 16 ? sgs : sgr));
        const int ldc = pn < 8 ? 1024 : 2048, cb = (pn < 8 ? (pn & 3) : (pn & 7)) * BM + tc;
        if (pn < 4) {
            EPI_LOOP_AM { const size_t off = (size_t)(row0 + ai * HALF + m * 16) * ldc + cb;
                EPI_LOOP_BJ { *(u32x4*)(dst + off + bj * HALF) = pack8(acc[ai][bj][m][0] * sc, acc[ai][bj][m][1] * sc); } }
        } else {
            const float kb = pn < 8 ? 1.0f : 0.0f;
            EPI_LOOP_AM { const size_t off = (size_t)(row0 + ai * HALF + m * 16) * ldc + cb;
                EPI_LOOP_BJ { f32x4 r[2];
#pragma unroll
                    for (int n = 0; n < 2; ++n) { const f32x4 x = acc[ai][bj][m][n] * sc, sg = sigm4(x); r[n] = sg * (1.0f - kb) + (x * sg) * kb; }
                    *(u32x4*)(dst + off + bj * HALF) = pack8(r[0], r[1]); } }
        }
    }
};
struct EpiS1 {
    static constexpr bool PERM = true, AFTER_DRAIN = false; static constexpr int NSTORE = 16;
    float* sloc;
    __device__ __forceinline__ void operator()(const AccT& acc, const Unit& u, int wr, int wc, int fr, int fq) const {
        const int row0 = u.pm * BM + wr * 64 + fr, tc = wc * 32 + 8 * fq;
        EPI_LOOP_AM { float* o = sloc + (size_t)(row0 + ai * HALF + m * 16) * 128 + tc; *(f32x4*)o = acc[ai][0][m][0]; *(f32x4*)(o + 4) = acc[ai][0][m][1]; }
    }
};
struct EpiS3 {
    static constexpr bool PERM = true, AFTER_DRAIN = false; static constexpr int NSTORE = 16;
    bf16_t* ysp;
    __device__ __forceinline__ void operator()(const AccT& acc, const Unit& u, int wr, int wc, int fr, int fq) const {
        const int g = u.pm >> 1, j0 = (u.pm & 1) * BM + wr * 64 + fr, cl0 = (u.pn & 1) * BM + wc * 32 + 8 * fq;
        EPI_LOOP_AM { const int j = j0 + ai * HALF + m * 16;
            EPI_LOOP_BJ { const int cl = cl0 + bj * HALF, i = cl >> 4, c0 = cl & 15;
                *(u32x4*)(ysp + (size_t)(j * T5 + i) * 1024 + g * 16 + c0) = pack8(gelu4(acc[ai][bj][m][0]), gelu4(acc[ai][bj][m][1])); } }
    }
};
struct EpiGLU {
    static constexpr bool PERM = true, AFTER_DRAIN = false; static constexpr int NSTORE = 16;
    const bf16_t* ysp; const float* bias; bf16_t* ys;
    __device__ __forceinline__ void operator()(const AccT& acc, const Unit& u, int wr, int wc, int fr, int fq) const {
        const int row0 = u.pm * BM + wr * 64 + fr, col0 = u.pn * BM + wc * 32 + 8 * fq;
        f32x4 bv[2][2];
        EPI_LOOP_BJ { bv[bj][0] = *(const f32x4*)(bias + col0 + bj * HALF); bv[bj][1] = *(const f32x4*)(bias + col0 + bj * HALF + 4); }
        EPI_LOOP_AM { const size_t off = (size_t)(row0 + ai * HALF + m * 16) * 1024 + col0;
            EPI_LOOP_BJ { f32x4 ya, yb; unpack8(*(const u32x4*)(ysp + off + bj * HALF), ya, yb);
                *(u32x4*)(ys + off + bj * HALF) = pack8(ya * sigm4(acc[ai][bj][m][0] + bv[bj][0]), yb * sigm4(acc[ai][bj][m][1] + bv[bj][1])); } }
    }
};
struct EpiM1 {
    static constexpr bool PERM = true, AFTER_DRAIN = false; static constexpr int NSTORE = 16;
    const bf16_t* sg; bf16_t* tmp;
    __device__ __forceinline__ void operator()(const AccT& acc, const Unit& u, int wr, int wc, int fr, int fq) const {
        const int row0 = u.pm * BM + wr * 64 + fr, col0 = u.pn * BM + wc * 32 + 8 * fq;
        EPI_LOOP_AM { const size_t off = (size_t)(row0 + ai * HALF + m * 16) * 2048 + col0;
            EPI_LOOP_BJ { f32x4 ga, gb; unpack8(*(const u32x4*)(sg + off + bj * HALF), ga, gb);
                *(u32x4*)(tmp + off + bj * HALF) = pack8(ga * acc[ai][bj][m][0], gb * acc[ai][bj][m][1]); } }
    }
};
struct EpiM2 {
    static constexpr bool PERM = true, AFTER_DRAIN = false; static constexpr int NSTORE = 16;
    const bf16_t* sg; const bf16_t* tmp; bf16_t* mrg;
    __device__ __forceinline__ void operator()(const AccT& acc, const Unit& u, int wr, int wc, int fr, int fq) const {
        const int row0 = u.pm * BM + wr * 64 + fr, col0 = u.pn * BM + wc * 32 + 8 * fq;
        EPI_LOOP_AM { const size_t off = (size_t)(row0 + ai * HALF + m * 16) * 2048 + col0;
            EPI_LOOP_BJ { f32x4 ga, gb, ta, tb; unpack8(*(const u32x4*)(sg + off + bj * HALF), ga, gb); unpack8(*(const u32x4*)(tmp + off + bj * HALF), ta, tb);
                *(u32x4*)(mrg + off + bj * HALF) = pack8(ta + ga * acc[ai][bj][m][0], tb + gb * acc[ai][bj][m][1]); } }
    }
};
struct EpiRes {
    static constexpr bool PERM = true, AFTER_DRAIN = false; static constexpr int NSTORE = 32;
    const float* x; float* o;
    __device__ __forceinline__ void operator()(const AccT& acc, const Unit& u, int wr, int wc, int fr, int fq) const {
        const int row0 = u.pm * BM + wr * 64 + fr, col0 = u.pn * BM + wc * 32 + 8 * fq;
        EPI_LOOP_AM { const size_t off = (size_t)(row0 + ai * HALF + m * 16) * 2048 + col0;
            EPI_LOOP_BJ { *(f32x4*)(o + off + bj * HALF) = *(const f32x4*)(x + off + bj * HALF) + acc[ai][bj][m][0];
                *(f32x4*)(o + off + bj * HALF + 4) = *(const f32x4*)(x + off + bj * HALF + 4) + acc[ai][bj][m][1]; } }
    }
};
struct EpiPlain {
    static constexpr bool PERM = true, AFTER_DRAIN = false; static constexpr int NSTORE = 16;
    bf16_t* o; int ldc;
    __device__ __forceinline__ void operator()(const AccT& acc, const Unit& u, int wr, int wc, int fr, int fq) const {
        const int row0 = u.pm * BM + wr * 64 + fr, col0 = u.pn * BM + wc * 32 + 8 * fq;
        EPI_LOOP_AM { const size_t off = (size_t)(row0 + ai * HALF + m * 16) * ldc + col0;
            EPI_LOOP_BJ { *(u32x4*)(o + off + bj * HALF) = pack8(acc[ai][bj][m][0], acc[ai][bj][m][1]); } }
    }
};
__device__ __forceinline__ unsigned pk4_fp8(float a, float b, float c, float d) { int r = 0; r = __builtin_amdgcn_cvt_pk_fp8_f32(a, b, r, false); r = __builtin_amdgcn_cvt_pk_fp8_f32(c, d, r, true); return (unsigned)r; }
constexpr float W8_SCALE = 64.0f, W8_INV = 1.0f / 64.0f;
struct EpiGU {
    static constexpr bool PERM = true, AFTER_DRAIN = false; static constexpr int NSTORE = 8;
    const float* bgu; unsigned char* act;
    __device__ __forceinline__ void operator()(const AccT& acc, const Unit& u, int wr, int wc, int fr, int fq) const {
        const int e = u.pn >> 4, ct = u.pn & 15, row0 = u.pm * BM + wr * 64 + fr, f0 = ct * HALF + wc * 32 + 8 * fq;
        const float* bp = bgu + (size_t)e * 4096 + 2 * f0;
        const f32x4 b0 = *(const f32x4*)bp, b1 = *(const f32x4*)(bp + 4), b2 = *(const f32x4*)(bp + 8), b3 = *(const f32x4*)(bp + 12);
        const f32x4 bg0 = (f32x4){b0[0], b0[2], b1[0], b1[2]}, bu0 = (f32x4){b0[1], b0[3], b1[1], b1[3]}, bg1 = (f32x4){b2[0], b2[2], b3[0], b3[2]}, bu1 = (f32x4){b2[1], b2[3], b3[1], b3[3]};
        const f32x4 bu0p = bu0 + 1.0f, bu1p = bu1 + 1.0f;
        EPI_LOOP_AM { const size_t off = (size_t)(row0 + ai * HALF + m * 16) * FFN + f0;
            f32x4 r[2];
#pragma unroll
            for (int n = 0; n < 2; ++n) { const f32x4 gv = acc[ai][0][m][n] * W8_INV + (n ? bg1 : bg0), uv = acc[ai][1][m][n] * W8_INV + (n ? bu1p : bu0p);
#pragma unroll
                for (int x = 0; x < 4; x += 2) { const f32x2 gg = (f32x2){fminf(gv[x], 7.0f), fminf(gv[x + 1], 7.0f)};
                    const f32x2 uu = (f32x2){__builtin_amdgcn_fmed3f(uv[x], -6.0f, 8.0f), __builtin_amdgcn_fmed3f(uv[x + 1], -6.0f, 8.0f)};
                    const f32x2 o = (gg * sigm2(gg * 1.702f)) * uu; r[n][x] = o.x; r[n][x + 1] = o.y; } }
            u32x2 w; w.x = pk4_fp8(r[0][0], r[0][1], r[0][2], r[0][3]); w.y = pk4_fp8(r[1][0], r[1][1], r[1][2], r[1][3]);
            *(u32x2*)(act + off) = w; }
    }
};
constexpr float YB_SCALE = 16.0f, YB_INV = 1.0f / 16.0f;
struct EpiDN {
    static constexpr bool PERM = true, AFTER_DRAIN = false; static constexpr int NSTORE = 16;
    const float* bdn; unsigned char* yb;
    __device__ __forceinline__ void operator()(const AccT& acc, const Unit& u, int wr, int wc, int fr, int fq) const {
        const int e = u.pn >> 3, ct = u.pn & 7, row0 = u.pm * BM + wr * 64 + fr, col0 = ct * BM + wc * 32 + 8 * fq;
        f32x4 bv[2][2];
        EPI_LOOP_BJ { bv[bj][0] = *(const f32x4*)(bdn + (size_t)e * 2048 + col0 + bj * HALF); bv[bj][1] = *(const f32x4*)(bdn + (size_t)e * 2048 + col0 + bj * HALF + 4); }
        EPI_LOOP_AM { const int row = row0 + ai * HALF + m * 16; const float gt = YB_SCALE; const size_t off = (size_t)row * 2048 + col0;
            EPI_LOOP_BJ { const f32x4 a = (acc[ai][bj][m][0] * W8_INV + bv[bj][0]) * gt, b = (acc[ai][bj][m][1] * W8_INV + bv[bj][1]) * gt;
                u32x2 w; w.x = pk4_fp8(a[0], a[1], a[2], a[3]); w.y = pk4_fp8(b[0], b[1], b[2], b[3]); *(u32x2*)(yb + off + bj * HALF) = w; } }
    }
};
struct EpiPLE {
    static constexpr bool PERM = true, AFTER_DRAIN = false; static constexpr int NSTORE = 16;
    const bf16_t* x3; const bf16_t* pp; bf16_t* o; float sc;
    __device__ __forceinline__ void operator()(const AccT& acc, const Unit& u, int wr, int wc, int fr, int fq) const {
        const int row0 = u.pm * BM + wr * 64 + fr, col0 = u.pn * BM + wc * 32 + 8 * fq;
        EPI_LOOP_AM { const size_t off = (size_t)(row0 + ai * HALF + m * 16) * 2048 + col0;
            EPI_LOOP_BJ { f32x4 pa, pb; unpack8(*(const u32x4*)(pp + off + bj * HALF), pa, pb);
                f32x4 xa, xb; unpack8(*(const u32x4*)(x3 + off + bj * HALF), xa, xb);
                *(u32x4*)(o + off + bj * HALF) = pack8(xa + sigm4(acc[ai][bj][m][0] * sc) * pa, xb + sigm4(acc[ai][bj][m][1] * sc) * pb); } }
    }
};

typedef int v8i_t __attribute__((ext_vector_type(8)));
typedef int v4i_t __attribute__((ext_vector_type(4)));
__device__ __forceinline__ v8i_t cat8(const bf16x8& lo, const bf16x8& hi) { const v4i_t a = __builtin_bit_cast(v4i_t, lo), b = __builtin_bit_cast(v4i_t, hi); return (v8i_t){a[0], a[1], a[2], a[3], b[0], b[1], b[2], b[3]}; }
template <class Epi, class Sched, bool ALIGN_EPI = false, bool SP2 = false, bool F8 = false>
__device__ __forceinline__ void gemm_phase(PG8_LAS unsigned char* lds, const Gemm g, const Sched& S, const Epi& E) {
    const int tid = threadIdx.x, wid = __builtin_amdgcn_readfirstlane(tid >> 6), lane = tid & 63, wr = wid >> 2, wc = wid & 3, fr = lane & 15, fq = lane >> 4;
    const int K = g.K, nt = K / BK;
    unsigned voffA[2], voffB[2];
#pragma unroll
    for (int i = 0; i < 2; ++i) { int R, C; stage_rc(tid * 16 + i * 8192, R, C); const int Rb = Epi::PERM ? ((R & ~31) + perm32(R & 31)) : R;
        voffA[i] = (unsigned)(R * g.lda + C) * 2u; voffB[i] = (unsigned)(Rb * g.ldb + C) * 2u; }
    const size_t kstep = (size_t)(BK * 2);
    const size_t hstepA = (size_t)HALF * g.lda * 2, hstepB = (size_t)HALF * g.ldb * 2;
    const size_t tstepA = 2 * hstepA, tstepB = 2 * hstepB;
    const unsigned ldsw = (unsigned)wid * 1024u;
    const int aoff = lds_byte(wr * 64 + fr, fq * 8), boff = lds_byte(wc * 32 + fr, fq * 8);
#define PG8_SA(b, h) (((b) * 2 + (h)) * HTB)
#define PG8_SB(b, h) ((4 + (b) * 2 + (h)) * HTB)
#define PG8_STAGE(bufoff, gbase, voff) do { _Pragma("unroll") for (int _i = 0; _i < 2; ++_i) \
        __builtin_amdgcn_global_load_lds((const unsigned*)((const char*)(gbase) + (voff)[_i]), (PG8_LAS unsigned*)(lds + (bufoff) + ldsw + _i * 8192), 16, 0, 0); } while (0)
#define PG8_LD8(p_) __builtin_shufflevector(*(const PG8_LAS v4i_t*)(p_), *(const PG8_LAS v4i_t*)((p_) + 1024), 0, 1, 2, 3, 4, 5, 6, 7)
#define PG8_LDA(dst, b, h) do { if constexpr (F8) { _Pragma("unroll") for (int m = 0; m < 4; ++m) dst##8[m] = PG8_LD8(lds + PG8_SA(b, h) + aoff + m * 2048); } else { \
        _Pragma("unroll") for (int m = 0; m < 4; ++m) _Pragma("unroll") for (int k = 0; k < 2; ++k) dst[m][k] = *(const PG8_LAS bf16x8*)(lds + PG8_SA(b, h) + aoff + m * 2048 + k * 1024); } } while (0)
#define PG8_LDB(dst, b, h) do { if constexpr (F8) { _Pragma("unroll") for (int n = 0; n < 2; ++n) dst##8[n] = PG8_LD8(lds + PG8_SB(b, h) + boff + n * 2048); } else { \
        _Pragma("unroll") for (int n = 0; n < 2; ++n) _Pragma("unroll") for (int k = 0; k < 2; ++k) dst[n][k] = *(const PG8_LAS bf16x8*)(lds + PG8_SB(b, h) + boff + n * 2048 + k * 1024); } } while (0)
#define PG8_MMA(ai, bj, At, Bt) do { __builtin_amdgcn_s_setprio(1); if constexpr (F8) { _Pragma("unroll") for (int m = 0; m < 4; ++m) _Pragma("unroll") for (int n = 0; n < 2; ++n) \
        asm volatile("v_mfma_scale_f32_16x16x128_f8f6f4 %0, %1, %2, %0, %3, %3 op_sel_hi:[0,0,0]" : "+v"(acc[ai][bj][m][n]) : "v"(Bt##8[n]), "v"(At##8[m]), "v"(sc8)); } else { \
        _Pragma("unroll") for (int m = 0; m < 4; ++m) _Pragma("unroll") for (int n = 0; n < 2; ++n) _Pragma("unroll") for (int k = 0; k < 2; ++k) \
        acc[ai][bj][m][n] = __builtin_amdgcn_mfma_f32_16x16x32_bf16(Bt[n][k], At[m][k], acc[ai][bj][m][n], 0, 0, 0); } __builtin_amdgcn_s_setprio(0); } while (0)
#define PG8_WAIT_V(n) asm volatile("s_waitcnt vmcnt(" #n ")" ::: "memory")
#define PG8_WAIT_V8R() do { if (fresh) asm volatile("s_waitcnt vmcnt(%0)" :: "n"(8 + Epi::NSTORE) : "memory"); else asm volatile("s_waitcnt vmcnt(8)" ::: "memory"); } while (0)
#define PG8_WAIT_L(n) asm volatile("s_waitcnt lgkmcnt(" #n ")" ::: "memory")
#define PG8_BAR __builtin_amdgcn_s_barrier()
#define PG8_SCHED __builtin_amdgcn_sched_barrier(0)
    Unit cur, nxt; int ui = 0;
    if (!S.next(0, cur)) return;
    f32x4 acc[2][2][4][2];
#pragma unroll
    for (int a = 0; a < 2; ++a)
#pragma unroll
        for (int b = 0; b < 2; ++b)
#pragma unroll
            for (int m = 0; m < 4; ++m)
#pragma unroll
                for (int n = 0; n < 2; ++n) acc[a][b][m][n] = (f32x4){0.f, 0.f, 0.f, 0.f};
    bf16x8 At[4][2], B0[2][2], B1[2][2]; v8i_t At8[4], B08[2], B18[2]; const int sc8 = 0x7f7f7f7f;
    const char* cA = (const char*)g.A + (size_t)cur.pa * tstepA; const char* cB = (const char*)g.Bt + (size_t)cur.pn * tstepB;
    S.a_ready(cur);
    if constexpr (SP2) {
        PG8_STAGE(PG8_SB(0, 0), cB, voffB); PG8_STAGE(PG8_SB(0, 1), cB + hstepB, voffB); PG8_STAGE(PG8_SA(0, 0), cA, voffA); PG8_STAGE(PG8_SA(0, 1), cA + hstepA, voffA);
        if (wr == 1) PG8_BAR;
        PG8_WAIT_V(2); PG8_BAR;
        PG8_STAGE(PG8_SB(1, 0), cB + kstep, voffB); PG8_STAGE(PG8_SA(1, 0), cA + kstep, voffA); PG8_STAGE(PG8_SB(1, 1), cB + hstepB + kstep, voffB);
        PG8_WAIT_V(6); PG8_BAR;
    } else {
        PG8_STAGE(PG8_SB(0, 0), cB, voffB); PG8_STAGE(PG8_SA(0, 0), cA, voffA); PG8_STAGE(PG8_SB(0, 1), cB + hstepB, voffB); PG8_STAGE(PG8_SA(0, 1), cA + hstepA, voffA);
        if (wr == 1) PG8_BAR;
        PG8_WAIT_V(4); PG8_BAR;
        PG8_STAGE(PG8_SB(1, 0), cB + kstep, voffB); PG8_STAGE(PG8_SA(1, 0), cA + kstep, voffA); PG8_STAGE(PG8_SB(1, 1), cB + hstepB + kstep, voffB);
        PG8_WAIT_V(6); PG8_BAR;
    }
    for (;;) {
        const bool has_next = S.next(ui + 1, nxt);
        const char* nA = has_next ? (const char*)g.A + (size_t)nxt.pa * tstepA : cA; const char* nB = has_next ? (const char*)g.Bt + (size_t)nxt.pn * tstepB : cB;
#pragma nounroll
        for (int t = 0; t < nt; t += 2) {
            const bool last = (t == nt - 2);
            const char* a1 = cA + (size_t)(t + 1) * kstep;
            const char* a2 = last ? nA : cA + (size_t)(t + 2) * kstep; const char* b2 = last ? nB : cB + (size_t)(t + 2) * kstep;
            const char* a3 = a2 + kstep; const char* b3 = b2 + kstep;
            if (last && has_next) S.a_ready(nxt);
            if constexpr (SP2) {
            const bool fresh = (t == 0) && (ui > 0);
            PG8_LDB(B0, 0, 0); PG8_LDB(B1, 0, 1); PG8_SCHED; PG8_LDA(At, 0, 0); PG8_STAGE(PG8_SA(1, 1), a1 + hstepA, voffA);
            PG8_WAIT_V8R(); PG8_WAIT_L(0); PG8_BAR; PG8_MMA(0, 0, At, B0); PG8_MMA(0, 1, At, B1); PG8_BAR; PG8_SCHED;
            PG8_LDA(At, 0, 1); PG8_STAGE(PG8_SB(0, 0), b2, voffB); PG8_STAGE(PG8_SB(0, 1), b2 + hstepB, voffB); PG8_STAGE(PG8_SA(0, 0), a2, voffA);
            PG8_WAIT_V8R(); PG8_WAIT_L(0); PG8_BAR; PG8_MMA(1, 0, At, B0); PG8_MMA(1, 1, At, B1); PG8_BAR; PG8_SCHED;
            PG8_LDB(B0, 1, 0); PG8_LDB(B1, 1, 1); PG8_SCHED; PG8_LDA(At, 1, 0); PG8_STAGE(PG8_SA(0, 1), a2 + hstepA, voffA);
            PG8_WAIT_V(8); PG8_WAIT_L(0); PG8_BAR; PG8_MMA(0, 0, At, B0); PG8_MMA(0, 1, At, B1); PG8_BAR; PG8_SCHED;
            PG8_LDA(At, 1, 1); PG8_STAGE(PG8_SB(1, 0), b3, voffB); PG8_STAGE(PG8_SB(1, 1), b3 + hstepB, voffB); PG8_STAGE(PG8_SA(1, 0), a3, voffA);
            PG8_WAIT_V(8); PG8_WAIT_L(0); PG8_BAR; PG8_MMA(1, 0, At, B0); PG8_MMA(1, 1, At, B1); PG8_BAR; PG8_SCHED;
            } else {
            PG8_LDB(B0, 0, 0); PG8_SCHED; PG8_LDA(At, 0, 0); PG8_STAGE(PG8_SA(1, 1), a1 + hstepA, voffA);
            PG8_WAIT_L(8); PG8_BAR; PG8_WAIT_L(0); PG8_MMA(0, 0, At, B0); PG8_BAR; PG8_SCHED;
            PG8_LDB(B1, 0, 1); PG8_STAGE(PG8_SB(0, 0), b2, voffB);
            PG8_BAR; PG8_WAIT_L(0); PG8_MMA(0, 1, At, B1); PG8_BAR;
            PG8_LDA(At, 0, 1); PG8_STAGE(PG8_SA(0, 0), a2, voffA);
            PG8_BAR; PG8_WAIT_L(0); PG8_MMA(1, 0, At, B0); PG8_BAR; PG8_SCHED;
            PG8_STAGE(PG8_SB(0, 1), b2 + hstepB, voffB);
            PG8_WAIT_V(6); PG8_BAR; PG8_MMA(1, 1, At, B1); PG8_BAR;
            PG8_LDB(B0, 1, 0); PG8_SCHED; PG8_LDA(At, 1, 0); PG8_STAGE(PG8_SA(0, 1), a2 + hstepA, voffA);
            PG8_WAIT_L(8); PG8_BAR; PG8_WAIT_L(0); PG8_MMA(0, 0, At, B0); PG8_BAR; PG8_SCHED;
            PG8_LDB(B1, 1, 1); PG8_STAGE(PG8_SB(1, 0), b3, voffB);
            PG8_BAR; PG8_WAIT_L(0); PG8_MMA(0, 1, At, B1); PG8_BAR;
            PG8_LDA(At, 1, 1); PG8_STAGE(PG8_SA(1, 0), a3, voffA);
            PG8_BAR; PG8_WAIT_L(0); PG8_MMA(1, 0, At, B0); PG8_BAR; PG8_SCHED;
            PG8_STAGE(PG8_SB(1, 1), b3 + hstepB, voffB);
            PG8_WAIT_V(6); PG8_BAR; PG8_MMA(1, 1, At, B1); PG8_BAR;
            }
        }
        if constexpr (ALIGN_EPI) { if (wr == 0) PG8_BAR; }
        if constexpr (F8) asm volatile("s_nop 15\n\ts_nop 15" ::: "memory");
        if constexpr (!Epi::AFTER_DRAIN) { E(acc, cur, wr, wc, fr, fq); S.done(cur); }
        if (!has_next) break;
#pragma unroll
        for (int a = 0; a < 2; ++a)
#pragma unroll
            for (int b = 0; b < 2; ++b)
#pragma unroll
                for (int m = 0; m < 4; ++m)
#pragma unroll
                    for (int n = 0; n < 2; ++n) acc[a][b][m][n] = (f32x4){0.f, 0.f, 0.f, 0.f};
        cur = nxt; cA = nA; cB = nB; ++ui;
        if constexpr (ALIGN_EPI) { if (wr == 1) PG8_BAR; }
    }
    PG8_WAIT_V(0);
    if constexpr (!ALIGN_EPI) { if (wr == 0) PG8_BAR; }
    PG8_BAR;
#undef PG8_SA
#undef PG8_SB
#undef PG8_STAGE
#undef PG8_LDA
#undef PG8_LD8
#undef PG8_LDB
#undef PG8_MMA
#undef PG8_WAIT_V
#undef PG8_WAIT_V8R
#undef PG8_WAIT_L
#undef PG8_BAR
#undef PG8_SCHED
}
}

constexpr size_t MiB = 1u << 20;
constexpr size_t WS_CTL = 0, CTL_ZERO_BYTES = 1 * MiB;
constexpr size_t WS_BTIN  = 1 * MiB;
constexpr size_t WS_BTGLU = WS_BTIN + 36 * MiB;
constexpr size_t WS_BTPS  = WS_BTGLU + 2 * MiB;
constexpr size_t WS_BTPR  = WS_BTPS + 4 * MiB;
constexpr size_t WS_BTOUT = WS_BTPR + 4 * MiB;
constexpr size_t WS_BTPG  = WS_BTOUT + 8 * MiB;
constexpr size_t WS_BTPP  = WS_BTPG + 8 * MiB;
constexpr size_t WS_BTGU  = WS_BTPP + 1 * MiB;
constexpr size_t WS_BTDN  = WS_BTGU + 512 * MiB;
constexpr size_t WS_BTS3  = WS_BTDN + 256 * MiB;
constexpr size_t WS_BTS1  = WS_BTS3 + 40 * MiB;
constexpr size_t WS_ATAB  = WS_BTS1 + 16 * MiB;
constexpr size_t WS_CS    = WS_ATAB + 1 * MiB;
constexpr size_t WS_SN    = WS_CS + 4 * MiB;
constexpr size_t WS_WG    = WS_SN + 4 * MiB;
constexpr size_t WS_PBF   = WS_WG + 1 * MiB;
constexpr size_t WS_HB    = WS_PBF + 8 * MiB;
constexpr size_t WS_XG5   = WS_HB + 64 * MiB;
constexpr size_t WS_Q     = WS_XG5 + 40 * MiB;
constexpr size_t WS_K     = WS_Q + 32 * MiB;
constexpr size_t WS_V     = WS_K + 32 * MiB;
constexpr size_t WS_GS    = WS_V + 32 * MiB;
constexpr size_t WS_SGS   = WS_GS + 32 * MiB;
constexpr size_t WS_SGR   = WS_SGS + 64 * MiB;
constexpr size_t WS_SLOC  = WS_SGR + 64 * MiB;
constexpr size_t WS_KVT   = WS_SLOC + 16 * MiB;
constexpr size_t WS_RT    = WS_KVT + 64 * MiB;
constexpr size_t WS_YSP   = WS_RT + 32 * MiB;
constexpr size_t WS_YS    = WS_YSP + 32 * MiB;
constexpr size_t WS_YR    = WS_YS + 32 * MiB;
constexpr size_t WS_TMP   = WS_YR + 32 * MiB;
constexpr size_t WS_MRG   = WS_TMP + 128 * MiB;
constexpr size_t WS_X2    = WS_MRG + 64 * MiB;
constexpr size_t WS_PP    = WS_X2 + 128 * MiB;
constexpr size_t WS_TOKE  = WS_PP + 64 * MiB;
constexpr size_t WS_TOKG  = WS_TOKE + 1 * MiB;
constexpr size_t WS_TOKP  = WS_TOKG + 1 * MiB;
constexpr size_t WS_ROWG  = WS_TOKP + 1 * MiB;
constexpr size_t WS_AROW  = WS_ROWG + 1 * MiB;
constexpr size_t WS_BLKE  = WS_AROW + 1 * MiB;
constexpr size_t WS_XG    = WS_BLKE + 1 * MiB;
constexpr size_t WS_ACT   = WS_XG + 1024 * MiB;
constexpr size_t WS_YB    = WS_ACT + 288 * MiB;
constexpr size_t WS_BTIN8 = WS_YB + 288 * MiB;
constexpr size_t WS_END   = WS_BTIN8 + 8 * MiB;
constexpr size_t WS_H8    = WS_YB;
constexpr int CW_CNT = 64;
constexpr int CW_BAR = 4096;

constexpr int RING_OFF = 0, RING_BYTES = 131072;
constexpr int LDS_BYTES = 159744;
constexpr int LDSCTL_OFF = LDS_BYTES - 256;
constexpr int MOETAB_OFF = RING_BYTES;
constexpr int NWAVES = 8;

#define GAS __attribute__((address_space(1)))
#define LAS __attribute__((address_space(3)))
typedef unsigned short bf16;
typedef unsigned v4u __attribute__((ext_vector_type(4)));
typedef unsigned v2u __attribute__((ext_vector_type(2)));
typedef float f32x4 __attribute__((ext_vector_type(4)));
typedef float f32x16 __attribute__((ext_vector_type(16)));
typedef short bf16x8 __attribute__((ext_vector_type(8)));
#define RLX_AGENT __ATOMIC_RELAXED, __HIP_MEMORY_SCOPE_AGENT
#define LDS_WAIT() asm volatile("s_waitcnt lgkmcnt(0)" ::: "memory")
#define VM_WAIT() asm volatile("s_waitcnt vmcnt(0)" ::: "memory")
__device__ __forceinline__ unsigned f2bf(float f) { unsigned u = __builtin_bit_cast(unsigned, f); return (u + 0x7fffu + ((u >> 16) & 1u)) >> 16; }
__device__ __forceinline__ unsigned pk2(float lo, float hi) { return f2bf(lo) | (f2bf(hi) << 16); }
__device__ __forceinline__ float bf2f(unsigned short b) { return __builtin_bit_cast(float, (unsigned)b << 16); }

#define XB_TMO      128
#define XB_XCNT(j)  (256  + 64 * (j))
#define XB_XSUB(j)  (1280 + 64 * (j))
#define XB_XGEN(j)  (2304 + 64 * (j))
#define XB_TOP      3328
#define XB_TOPGEN   3392
#define XCD_BAR_WORDS 3456
#define XB_SPIN_CAP (1u << 20)
__device__ __forceinline__ unsigned xb_ld(unsigned* p)              { return __hip_atomic_load(p, __ATOMIC_RELAXED, __HIP_MEMORY_SCOPE_AGENT); }
__device__ __forceinline__ unsigned xb_add(unsigned* p, unsigned v) { return __hip_atomic_fetch_add(p, v, __ATOMIC_RELAXED, __HIP_MEMORY_SCOPE_AGENT); }
__device__ __forceinline__ unsigned xb_xcc_id() { return (unsigned)__builtin_amdgcn_s_getreg((3 << 11) | 20) & 0xFu; }
#define XB_SPIN(cond, bar) do { unsigned _sp = 0; while (cond) { __builtin_amdgcn_s_sleep(1); \
    if ((++_sp & 255u) == 0u) { if (xb_ld(&(bar)[XB_TMO])) break; if (_sp > XB_SPIN_CAP) { atomicAdd(&(bar)[XB_TMO], 1u); break; } } } } while (0)
struct XcdBarrier { unsigned* bar; unsigned x; volatile LAS unsigned* st; };
__device__ __forceinline__ XcdBarrier xcd_barrier_post(unsigned* bar, volatile LAS unsigned* st) {
    XcdBarrier b; b.bar = bar; b.x = xb_xcc_id(); b.st = st;
    if (threadIdx.x == 0) (void)xb_add(&bar[XB_XCNT(b.x)], 1u);
    return b;
}
__device__ __forceinline__ void xcd_barrier_complete(unsigned* bar, unsigned x, unsigned& nloc, unsigned& nx) {
    const unsigned G = gridDim.x * gridDim.y * gridDim.z;
    unsigned sum, cnt, mine, sp = 0u;
    for (;;) {
        sum = 0u; cnt = 0u; mine = 0u;
#pragma unroll
        for (unsigned j = 0; j < 16; ++j) { const unsigned c = xb_ld(&bar[XB_XCNT(j)]); sum += c; cnt += (c > 0u) ? 1u : 0u; mine = (j == x) ? c : mine; }
        if (sum == G) break;
        __builtin_amdgcn_s_sleep(1);
        if ((++sp & 255u) == 0u) { if (xb_ld(&bar[XB_TMO])) break; if (sp > XB_SPIN_CAP) { atomicAdd(&bar[XB_TMO], 1u); break; } }
    }
    nloc = mine > 0u ? mine : 1u; nx = cnt > 0u ? cnt : 1u;
}
__device__ __forceinline__ void xcd_barrier(const XcdBarrier& b) {
    asm volatile("s_waitcnt vmcnt(0)" ::: "memory");
    __syncthreads();
    if (threadIdx.x == 0) {
        unsigned* bar = b.bar;
        __builtin_amdgcn_s_waitcnt(0);
        unsigned nloc = b.st[0], nx = b.st[1];
        if (nloc == 0u) { xcd_barrier_complete(bar, b.x, nloc, nx); b.st[0] = nloc; b.st[1] = nx; }
        const unsigned old = xb_add(&bar[XB_XSUB(b.x)], 1u);
        const unsigned gen = old / nloc;
        if (old + 1u == (gen + 1u) * nloc) {
            __builtin_amdgcn_fence(__ATOMIC_RELEASE, "agent");
            asm volatile("s_waitcnt vmcnt(0)" ::: "memory");
            const unsigned og = xb_add(&bar[XB_TOP], 1u);
            const unsigned tg = og / nx;
            if (og + 1u == (tg + 1u) * nx) xb_add(&bar[XB_TOPGEN], 1u);
            else XB_SPIN(xb_ld(&bar[XB_TOPGEN]) == tg, bar);
            __builtin_amdgcn_fence(__ATOMIC_ACQUIRE, "agent");
            xb_add(&bar[XB_XGEN(b.x)], 1u);
            asm volatile("s_waitcnt vmcnt(0)" ::: "memory");
        } else {
            XB_SPIN(xb_ld(&bar[XB_XGEN(b.x)]) == gen, bar);
            __builtin_amdgcn_fence(__ATOMIC_ACQUIRE, "agent");
            asm volatile("s_waitcnt vmcnt(0)" ::: "memory");
        }
    }
    __syncthreads();
}

__device__ __forceinline__ float wave_sum(float v) {
#pragma unroll
    for (int o = 1; o < 64; o <<= 1) v += __shfl_xor(v, o);
    return v;
}
__device__ __forceinline__ int rowmap(int mode, int n) {
    if (mode == 1) { if (n < 1024 || n >= 3072) return n; const int nn = n - 1024, r = nn >> 10, hn = nn & 1023, head = hn >> 7, half = (hn >> 6) & 1, dd = hn & 63;
        return 1024 + r * 1024 + (head >> 1) * 256 + half * 128 + (head & 1) * 64 + dd; }
    if (mode == 2) { const int f = n >> 1, s = n & 1; return (f >> 7) * 256 + (f & 127) + 128 * s; }
    return n;
}
template <bool F8> __device__ __forceinline__ void transpose_run(const float* W, int K, int N, int ldw, void* WT, int mode, int nmat, size_t sstride, size_t dstride, LAS float* scr, int gw, int NGW, int lane) {
    const int nbk = N / 64, per = (K / 64) * nbk, total = nmat * per;
    int it = gw; if (it >= total) return;
    float r[64];
#define TR_SRC(it_) ((const GAS float*)W + (size_t)((it_) / per) * sstride + (size_t)(64 * (((it_) % per) / nbk)) * ldw + 64 * (((it_) % per) % nbk) + lane)
    { const GAS float* src = TR_SRC(it);
#pragma unroll
      for (int i = 0; i < 64; ++i) r[i] = src[(size_t)i * ldw]; }
    for (;;) {
#pragma unroll
        for (int i = 0; i < 64; ++i) scr[i * 65 + lane] = F8 ? r[i] * 64.0f : r[i];
        LDS_WAIT(); asm volatile("" ::: "memory");
        const int mat = it / per, rr = it % per, k0 = 64 * (rr / nbk), n0 = 64 * (rr % nbk);
        const int nit = it + NGW; const bool hn = nit < total;
        if (hn) { const GAS float* src = TR_SRC(nit);
#pragma unroll
            for (int i = 0; i < 64; ++i) r[i] = src[(size_t)i * ldw]; }
        if constexpr (F8) { const int c = lane & 3; GAS unsigned char* dst = (GAS unsigned char*)WT + (size_t)mat * dstride;
#pragma unroll
            for (int j = 0; j < 4; ++j) { const int n = (lane >> 2) + 16 * j; const LAS float* s = scr + (16 * c) * 65 + n;
                v4u o; o.x = pg8::pk4_fp8(s[0 * 65], s[1 * 65], s[2 * 65], s[3 * 65]); o.y = pg8::pk4_fp8(s[4 * 65], s[5 * 65], s[6 * 65], s[7 * 65]);
                o.z = pg8::pk4_fp8(s[8 * 65], s[9 * 65], s[10 * 65], s[11 * 65]); o.w = pg8::pk4_fp8(s[12 * 65], s[13 * 65], s[14 * 65], s[15 * 65]);
                *(GAS v4u*)(dst + (size_t)rowmap(mode, n0 + n) * K + k0 + 16 * c) = o; }
        } else { const int c = lane & 7; GAS bf16* dst = (GAS bf16*)WT + (size_t)mat * dstride;
#pragma unroll
            for (int j = 0; j < 8; ++j) { const int n = (lane >> 3) + 8 * j; const LAS float* s = scr + (8 * c) * 65 + n;
                v4u o; o.x = pk2(s[0 * 65], s[1 * 65]); o.y = pk2(s[2 * 65], s[3 * 65]); o.z = pk2(s[4 * 65], s[5 * 65]); o.w = pk2(s[6 * 65], s[7 * 65]);
                *(GAS v4u*)(dst + (size_t)rowmap(mode, n0 + n) * K + k0 + 8 * c) = o; } }
        LDS_WAIT(); asm volatile("" ::: "memory");
        if (!hn) break;
        it = nit;
    }
#undef TR_SRC
}
#ifndef TR8_NT
#define TR8_NT 0
#endif
__device__ __forceinline__ void transpose_run8(const float* W, int K, int N, int ldw, unsigned char* WT, int mode, int nmat, size_t sstride, size_t dstride, LAS unsigned* scr, int gw, int NGW, int lane) {
    const int nkb = K / 256, per = nkb * (N / 64), total = nmat * per, nkh = nkb / 2;
#define TR_KB(it_) (2 * ((((it_) % per) >> 3) % nkh) + ((((it_) % per) >> 2) & 1))
#define TR_NB(it_) (4 * ((((it_) % per) >> 3) / nkh) + (((it_) % per) & 3))
    int it = gw; if (it >= total) return;
    const int kr = lane >> 4, nc = 4 * (lane & 15);
    f32x4 ra[16], rb[16];
#define TR_SRC(it_, q_) ((const GAS float*)W + (size_t)((it_) / per) * sstride + (size_t)(256 * TR_KB(it_) + 64 * (q_) + 16 * kr) * ldw + 64 * TR_NB(it_) + nc)
#define TR_LOAD(r_, it_, q_) do { const GAS float* src_ = TR_SRC(it_, q_); _Pragma("unroll") for (int i = 0; i < 16; ++i) r_[i] = TR8_NT ? __builtin_nontemporal_load((const GAS f32x4*)(src_ + (size_t)i * ldw)) : *(const GAS f32x4*)(src_ + (size_t)i * ldw); } while (0)
#define TR_PACK(r_, q_) do { _Pragma("unroll") for (int m = 0; m < 4; ++m) _Pragma("unroll") for (int c = 0; c < 4; ++c) \
        scr[(nc + c) * 65 + (q_) * 16 + 4 * kr + m] = pg8::pk4_fp8(r_[4 * m][c] * 64.0f, r_[4 * m + 1][c] * 64.0f, r_[4 * m + 2][c] * 64.0f, r_[4 * m + 3][c] * 64.0f); } while (0)
    TR_LOAD(ra, it, 0); TR_LOAD(rb, it, 1);
    for (;;) {
        const int nit = it + NGW; const bool hn = nit < total;
        TR_PACK(ra, 0); TR_LOAD(ra, it, 2);
        TR_PACK(rb, 1); TR_LOAD(rb, it, 3);
        TR_PACK(ra, 2); if (hn) TR_LOAD(ra, nit, 0);
        TR_PACK(rb, 3); if (hn) TR_LOAD(rb, nit, 1);
        LDS_WAIT(); asm volatile("" ::: "memory");
        const int mat = it / per, k0 = 256 * TR_KB(it), n0 = 64 * TR_NB(it), c16 = lane & 15;
        GAS unsigned char* dst = (GAS unsigned char*)WT + (size_t)mat * dstride;
#pragma unroll
        for (int j = 0; j < 16; ++j) { const int n = (lane >> 4) + 4 * j; const LAS unsigned* sp = scr + n * 65 + 4 * c16;
            v4u o; o.x = sp[0]; o.y = sp[1]; o.z = sp[2]; o.w = sp[3];
            if (TR8_NT) __builtin_nontemporal_store(o, (GAS v4u*)(dst + (size_t)rowmap(mode, n0 + n) * K + k0 + 16 * c16)); else *(GAS v4u*)(dst + (size_t)rowmap(mode, n0 + n) * K + k0 + 16 * c16) = o; }
        LDS_WAIT(); asm volatile("" ::: "memory");
        if (!hn) break;
        it = nit;
    }
#undef TR_SRC
#undef TR_LOAD
#undef TR_PACK
#undef TR_KB
#undef TR_NB
}
__device__ __forceinline__ void rms_row_bf16(const float* xrow, const float* gain, bf16* orow, unsigned char* orow8, int lane) {
    const f32x4* xr = (const f32x4*)xrow + lane; const f32x4* gr = (const f32x4*)gain + lane;
    f32x4 v[8]; float s = 0.f;
#pragma unroll
    for (int j = 0; j < 8; ++j) { v[j] = xr[64 * j]; s += (v[j].x * v[j].x + v[j].y * v[j].y) + (v[j].z * v[j].z + v[j].w * v[j].w); }
    const float rstd = 1.0f / sqrtf(wave_sum(s) * (1.0f / 2048.0f) + 1e-6f);
    v2u* o8 = (v2u*)orow + lane;
#pragma unroll
    for (int j = 0; j < 8; ++j) { const f32x4 g = gr[64 * j]; const f32x4 y = v[j] * rstd * g; v2u w; w.x = pk2(y.x, y.y); w.y = pk2(y.z, y.w); o8[64 * j] = w;
        ((unsigned*)orow8)[lane + 64 * j] = pg8::pk4_fp8(y.x, y.y, y.z, y.w); }
}

struct Args {
    const float* x; const float* p; const int* pos; const float* norm1_g; const float* w_in;
    const float* lam_re; const float* lam_im; const float* log_dt; const float* b_re; const float* b_im; const float* c_re; const float* c_im; const float* d_skip;
    const float* w_glu; const float* b_glu; const float* w_bs; const float* w_br; const float* w_out; const float* norm2_g; const float* router_w; const float* router_b;
    const float* w_gu; const float* b_gu; const float* w_dn; const float* b_dn; const float* norm3_g; const float* w_pg; const float* w_pp; const float* fin_g;
    float* out; unsigned char* ws; int ph_lo, ph_hi, li, pad;
};

__device__ __forceinline__ void s5_tables(const Args& a, int g, LAS unsigned char* lds, int tid) {
    LAS float* Pre = (LAS float*)lds;
    LAS float* Pim = Pre + 33 * 64;
    LAS float* Bre = Pim + 33 * 64;
    LAS float* Bim = Bre + 1024;
    LAS float* Cre = Bim + 1024;
    LAS float* Cim = Cre + 1024;
    LAS float* Kt  = Cim + 1024;
    const float dt = expf(a.log_dt[g]);
    for (int e = tid; e < 33 * 64; e += 512) { const int p = e >> 6, n = e & 63; const float lr = a.lam_re[g * 64 + n], li = a.lam_im[g * 64 + n];
        const float mag = expf(lr * dt * (float)p), ang = li * dt * (float)p; Pre[e] = mag * cosf(ang); Pim[e] = mag * sinf(ang); }
    for (int e = tid; e < 1024; e += 512) { const int n = e >> 4; const float lr = a.lam_re[g * 64 + n], li = a.lam_im[g * 64 + n];
        const float mag = expf(lr * dt), abr = mag * cosf(li * dt), abi = mag * sinf(li * dt);
        const float den = lr * lr + li * li, nr = abr - 1.0f, ni = abi, fre = (nr * lr + ni * li) / den, fim = (ni * lr - nr * li) / den;
        const float br = a.b_re[(size_t)g * 1024 + e], bi = a.b_im[(size_t)g * 1024 + e];
        Bre[e] = fre * br - fim * bi; Bim[e] = fre * bi + fim * br;
        Cre[e] = a.c_re[(size_t)g * 1024 + e]; Cim[e] = a.c_im[(size_t)g * 1024 + e]; }
    __syncthreads();
    { const int tau = tid >> 4, cp = tid & 15; float kacc[16];
#pragma unroll
      for (int c = 0; c < 16; ++c) kacc[c] = 0.f;
      for (int n = 0; n < 64; ++n) { const float pr = Pre[tau * 64 + n], pi = Pim[tau * 64 + n], br = Bre[n * 16 + cp], bi = Bim[n * 16 + cp];
          const float zr = pr * br - pi * bi, zi = pr * bi + pi * br;
#pragma unroll
          for (int c = 0; c < 16; ++c) kacc[c] += Cre[c * 64 + n] * zr - Cim[c * 64 + n] * zi; }
#pragma unroll
      for (int c = 0; c < 16; ++c) Kt[tau * 256 + c * 16 + cp] = kacc[c] + ((tau == 0 && c == cp) ? a.d_skip[g * 16 + c] : 0.f); }
    __syncthreads();
    bf16* bt3 = (bf16*)(a.ws + WS_BTS3) + (size_t)g * 512 * K5;
    for (int ch = tid; ch < 512 * 80; ch += 512) { const int row = ch / 80, cc = ch % 80, i = row >> 4, c = row & 15; float v[8];
        if (cc < 64) { const int ip = cc >> 1, c0 = (cc & 1) * 8;
#pragma unroll
            for (int x = 0; x < 8; ++x) v[x] = (i >= ip) ? Kt[(i - ip) * 256 + c * 16 + c0 + x] : 0.f;
        } else { const int m0 = (cc - 64) * 8;
#pragma unroll
            for (int x = 0; x < 8; ++x) { const int m = m0 + x, n = m & 63; const float cr = Cre[c * 64 + n], ci = Cim[c * 64 + n], pr = Pre[(i + 1) * 64 + n], pi = Pim[(i + 1) * 64 + n];
                v[x] = (m < 64) ? (cr * pr - ci * pi) : -(cr * pi + ci * pr); } }
        v4u o; o.x = pk2(v[0], v[1]); o.y = pk2(v[2], v[3]); o.z = pk2(v[4], v[5]); o.w = pk2(v[6], v[7]);
        *(v4u*)(bt3 + (size_t)row * K5 + cc * 8) = o; }
    bf16* bt1 = (bf16*)(a.ws + WS_BTS1) + (size_t)g * 256 * 512;
    for (int ch = tid; ch < 256 * 64; ch += 512) { const int row = ch >> 6, cc = ch & 63, ip = cc >> 1, c0 = (cc & 1) * 8; float v[8];
#pragma unroll
        for (int x = 0; x < 8; ++x) { if (row < 128) { const int n = row & 63; const float pr = Pre[(31 - ip) * 64 + n], pi = Pim[(31 - ip) * 64 + n], br = Bre[n * 16 + c0 + x], bi = Bim[n * 16 + c0 + x];
                v[x] = (row < 64) ? (pr * br - pi * bi) : (pr * bi + pi * br); } else v[x] = 0.f; }
        v4u o; o.x = pk2(v[0], v[1]); o.y = pk2(v[2], v[3]); o.z = pk2(v[4], v[5]); o.w = pk2(v[6], v[7]);
        *(v4u*)(bt1 + (size_t)row * 512 + cc * 8) = o; }
    float* at = (float*)(a.ws + WS_ATAB) + g * 128;
    if (tid < 64) { at[tid * 2] = Pre[32 * 64 + tid]; at[tid * 2 + 1] = Pim[32 * 64 + tid]; }
    __syncthreads();
}

__device__ __forceinline__ void s5_scan_item(const Args& a, int item, LAS unsigned char* lds, int tid) {
    LAS float* seg_re = (LAS float*)lds; LAS float* seg_im = seg_re + 512;
    const int sl = tid & 31, seg = tid >> 5, sidx = item * 32 + sl, g = sidx >> 6, n = sidx & 63;
    const float* at = (const float*)(a.ws + WS_ATAB) + g * 128 + n * 2; const float ar = at[0], ai = at[1];
    const float* sloc = (const float*)(a.ws + WS_SLOC) + ((size_t)g * NCH5 + seg * 32) * 128 + n;
    float er = 0.f, ei = 0.f;
#pragma unroll 8
    for (int j = 0; j < 32; ++j) { const float lr = sloc[j * 128], li = sloc[j * 128 + 64]; const float tr = ar * er - ai * ei + lr, ti = ar * ei + ai * er + li; er = tr; ei = ti; }
    seg_re[seg * 32 + sl] = er; seg_im[seg * 32 + sl] = ei;
    __syncthreads();
    float pr = ar, pi = ai;
#pragma unroll
    for (int q = 0; q < 5; ++q) { const float tr = pr * pr - pi * pi, ti = 2.f * pr * pi; pr = tr; pi = ti; }
    float sr = 0.f, si = 0.f;
    for (int s2 = 0; s2 < seg; ++s2) { const float tr = pr * sr - pi * si + seg_re[s2 * 32 + sl], ti = pr * si + pi * sr + seg_im[s2 * 32 + sl]; sr = tr; si = ti; }
    bf16* xg = (bf16*)(a.ws + WS_XG5) + ((size_t)g * NCH5 + seg * 32) * K5 + 512 + n;
#pragma unroll 8
    for (int j = 0; j < 32; ++j) { xg[(size_t)j * K5] = (bf16)f2bf(sr); xg[(size_t)j * K5 + 64] = (bf16)f2bf(si);
        const float lr = sloc[j * 128], li = sloc[j * 128 + 64]; const float tr = ar * sr - ai * si + lr, ti = ar * si + ai * sr + li; sr = tr; si = ti; }
    __syncthreads();
}

constexpr int RS = 136;
__device__ __forceinline__ float ret_l2g(int h) { return log2f(1.0f - exp2f(-5.0f - (float)h)); }
__device__ __forceinline__ v4u ret_scale8(v4u w, float z) {
    w.x = pk2(pg8::bf_lo(w.x) * z, pg8::bf_hi(w.x) * z); w.y = pk2(pg8::bf_lo(w.y) * z, pg8::bf_hi(w.y) * z); w.z = pk2(pg8::bf_lo(w.z) * z, pg8::bf_hi(w.z) * z); w.w = pk2(pg8::bf_lo(w.w) * z, pg8::bf_hi(w.w) * z); return w; }
__device__ __forceinline__ void ret_stage_rm(const bf16* src_, LAS bf16* dst, int tid) {
    const GAS bf16* src = (const GAS bf16*)src_; v4u wv[4];
#pragma unroll
    for (int q = 0; q < 4; ++q) { const int id = tid + 512 * q, row = id >> 4, c8 = id & 15; wv[q] = *(const GAS v4u*)(src + (size_t)row * 1024 + 8 * c8); }
#pragma unroll
    for (int q = 0; q < 4; ++q) { const int id = tid + 512 * q, row = id >> 4, c8 = id & 15; *(LAS v4u*)(dst + row * RS + 8 * c8) = wv[q]; }
}
template <bool ZETA> __device__ __forceinline__ void ret_stage_tr(const bf16* src_, LAS bf16* dst, int tid, float l2g) {
    const GAS bf16* src = (const GAS bf16*)src_; v4u wv[4];
#pragma unroll
    for (int q = 0; q < 4; ++q) { const int id = tid + 512 * q, row = id & 127, c8 = id >> 7; wv[q] = *(const GAS v4u*)(src + (size_t)row * 1024 + 8 * c8); }
#pragma unroll
    for (int q = 0; q < 4; ++q) { const int id = tid + 512 * q, row = id & 127, c8 = id >> 7; v4u w = wv[q];
        if (ZETA) w = ret_scale8(w, exp2f(l2g * (float)(127 - row)));
        LAS bf16* d = dst + (8 * c8) * RS + row;
        d[0 * RS] = (bf16)(w.x & 0xffffu); d[1 * RS] = (bf16)(w.x >> 16); d[2 * RS] = (bf16)(w.y & 0xffffu); d[3 * RS] = (bf16)(w.y >> 16);
        d[4 * RS] = (bf16)(w.z & 0xffffu); d[5 * RS] = (bf16)(w.z >> 16); d[6 * RS] = (bf16)(w.w & 0xffffu); d[7 * RS] = (bf16)(w.w >> 16); }
}
__device__ __forceinline__ void ret_kv_unit(const Args& a, int unit, LAS unsigned char* lds, int tid) {
    const int n = unit >> 3, h = unit & 7, t0 = n * RCH, lane = tid & 63, w = __builtin_amdgcn_readfirstlane(tid >> 6), fr = lane & 15, fg = lane >> 4;
    LAS bf16* Kt = (LAS bf16*)lds; LAS bf16* Vt = Kt + 128 * RS;
    const float l2g = ret_l2g(h);
    ret_stage_tr<true>((const bf16*)(a.ws + WS_K) + (size_t)t0 * 1024 + h * 128, Kt, tid, l2g);
    ret_stage_tr<false>((const bf16*)(a.ws + WS_V) + (size_t)t0 * 1024 + h * 128, Vt, tid, l2g);
    __syncthreads();
    bf16x8 af[4];
#pragma unroll
    for (int ks = 0; ks < 4; ++ks) af[ks] = *(const LAS bf16x8*)(Vt + (16 * w + fr) * RS + 32 * ks + 8 * fg);
    float* out = (float*)(a.ws + WS_KVT) + ((size_t)unit * 128 + 16 * w + 4 * fg) * 128 + fr;
#pragma unroll
    for (int dt = 0; dt < 8; ++dt) { f32x4 acc = (f32x4){0.f, 0.f, 0.f, 0.f};
#pragma unroll
        for (int ks = 0; ks < 4; ++ks) { const bf16x8 bfv = *(const LAS bf16x8*)(Kt + (16 * dt + fr) * RS + 32 * ks + 8 * fg);
            acc = __builtin_amdgcn_mfma_f32_16x16x32_bf16(af[ks], bfv, acc, 0, 0, 0); }
#pragma unroll
        for (int r = 0; r < 4; ++r) out[(size_t)r * 128 + 16 * dt] = acc[r]; }
    __syncthreads();
}
__device__ __forceinline__ void ret_state_scan(const Args& a, int gtid, int gthreads) {
    const float* kvt = (const float*)(a.ws + WS_KVT); bf16* rt = (bf16*)(a.ws + WS_RT);
    for (int idx = gtid; idx < RH * 128 * 128; idx += gthreads) { const int h = idx >> 14; const float dec = exp2f(128.0f * ret_l2g(h)); float st = 0.f;
#pragma unroll 8
        for (int n = 0; n < NRC; ++n) { rt[(size_t)n * 131072 + idx] = (bf16)f2bf(st); st = st * dec + kvt[(size_t)n * 131072 + idx]; } }
}
struct RetPre { v4u k[4], v[4]; bf16x8 q[4]; };
__device__ __forceinline__ void ret_out_load(const Args& a, int unit, int tid, RetPre& P) {
    const int n = unit >> 3, h = unit & 7, t0 = n * RCH, lane = tid & 63, w = tid >> 6, fr = lane & 15, fg = lane >> 4, il = 16 * w + fr;
    const GAS bf16* ks = (const GAS bf16*)(a.ws + WS_K) + (size_t)t0 * 1024 + h * 128; const GAS bf16* vs = (const GAS bf16*)(a.ws + WS_V) + (size_t)t0 * 1024 + h * 128;
#pragma unroll
    for (int q = 0; q < 4; ++q) { const int id = tid + 512 * q;
        P.k[q] = *(const GAS v4u*)(ks + (size_t)(id >> 4) * 1024 + 8 * (id & 15));
        P.v[q] = *(const GAS v4u*)(vs + (size_t)(id & 127) * 1024 + 8 * (id >> 7)); }
    const GAS bf16* qp = (const GAS bf16*)(a.ws + WS_Q) + (size_t)(t0 + il) * 1024 + h * 128 + 8 * fg;
#pragma unroll
    for (int ks2 = 0; ks2 < 4; ++ks2) P.q[ks2] = *(const GAS bf16x8*)(qp + 32 * ks2);
}
__device__ __forceinline__ void ret_out_units(const Args& a, int u0, int ustride, int uend, LAS unsigned char* lds, int tid) {
    if (u0 >= uend) return;
    const int lane = tid & 63, w = __builtin_amdgcn_readfirstlane(tid >> 6), fr = lane & 15, fg = lane >> 4, i0 = 16 * w, il = i0 + fr;
    LAS bf16* Ks = (LAS bf16*)lds; LAS bf16* Vt = Ks + 128 * RS; LAS bf16* Ps = Vt + 128 * RS; LAS bf16* Rs = Ps + 128 * RS;
    RetPre P; ret_out_load(a, u0, tid, P);
    for (int unit = u0; unit < uend; unit += ustride) {
        const int n = unit >> 3, h = unit & 7, t0 = n * RCH; const float l2g = ret_l2g(h);
#pragma unroll
        for (int q = 0; q < 4; ++q) { const int id = tid + 512 * q;
            *(LAS v4u*)(Ks + (id >> 4) * RS + 8 * (id & 15)) = P.k[q];
            const v4u wv = P.v[q]; LAS bf16* d = Vt + (8 * (id >> 7)) * RS + (id & 127);
            d[0 * RS] = (bf16)(wv.x & 0xffffu); d[1 * RS] = (bf16)(wv.x >> 16); d[2 * RS] = (bf16)(wv.y & 0xffffu); d[3 * RS] = (bf16)(wv.y >> 16);
            d[4 * RS] = (bf16)(wv.z & 0xffffu); d[5 * RS] = (bf16)(wv.z >> 16); d[6 * RS] = (bf16)(wv.w & 0xffffu); d[7 * RS] = (bf16)(wv.w >> 16); }
        bf16x8 qf[4]; v2u gt[8];
#pragma unroll
        for (int ks = 0; ks < 4; ++ks) qf[ks] = P.q[ks];
        __syncthreads();
        { const GAS bf16* gp = (const GAS bf16*)(a.ws + WS_GS) + (size_t)(t0 + il) * 1024 + h * 128 + 4 * fg;
#pragma unroll
          for (int et = 0; et < 8; ++et) gt[et] = *(const GAS v2u*)(gp + 16 * et); }
        v4u rv[4];
        { const GAS bf16* rs = (const GAS bf16*)(a.ws + WS_RT) + (size_t)unit * 16384;
#pragma unroll
          for (int q = 0; q < 4; ++q) { const int id = tid + 512 * q; rv[q] = *(const GAS v4u*)(rs + (size_t)(id >> 4) * 128 + 8 * (id & 15)); } }
        if (unit + ustride < uend) ret_out_load(a, unit + ustride, tid, P);
#pragma unroll
        for (int jt = 0; jt < 8; ++jt) {
            if (jt <= w) { f32x4 acc = (f32x4){0.f, 0.f, 0.f, 0.f};
#pragma unroll
                for (int ks = 0; ks < 4; ++ks) { const bf16x8 kf = *(const LAS bf16x8*)(Ks + (16 * jt + fr) * RS + 32 * ks + 8 * fg);
                    acc = __builtin_amdgcn_mfma_f32_16x16x32_bf16(kf, qf[ks], acc, 0, 0, 0); }
                float pv[4];
#pragma unroll
                for (int r = 0; r < 4; ++r) { const int j = 16 * jt + 4 * fg + r; pv[r] = (il >= j) ? acc[r] * exp2f(l2g * (float)(il - j)) : 0.f; }
                LAS unsigned* pp = (LAS unsigned*)(Ps + il * RS + 16 * jt + 4 * fg); pp[0] = pk2(pv[0], pv[1]); pp[1] = pk2(pv[2], pv[3]);
            } else if (jt == w + 1 && (w & 1) == 0) { LAS unsigned* pp = (LAS unsigned*)(Ps + il * RS + 16 * jt + 4 * fg); pp[0] = 0u; pp[1] = 0u; }
        }
#pragma unroll
        for (int q = 0; q < 4; ++q) { const int id = tid + 512 * q; *(LAS v4u*)(Rs + (id >> 4) * RS + 8 * (id & 15)) = rv[q]; }
        __syncthreads();
        f32x4 accI[8], accC[8];
#pragma unroll
        for (int et = 0; et < 8; ++et) { accI[et] = (f32x4){0.f, 0.f, 0.f, 0.f}; accC[et] = (f32x4){0.f, 0.f, 0.f, 0.f}; }
        const int nks = (w >> 1) + 1;
        for (int ks = 0; ks < nks; ++ks) { const bf16x8 pf = *(const LAS bf16x8*)(Ps + il * RS + 32 * ks + 8 * fg);
#pragma unroll
            for (int et = 0; et < 8; ++et) { const bf16x8 vf = *(const LAS bf16x8*)(Vt + (16 * et + fr) * RS + 32 * ks + 8 * fg);
                accI[et] = __builtin_amdgcn_mfma_f32_16x16x32_bf16(vf, pf, accI[et], 0, 0, 0); }
            __builtin_amdgcn_sched_barrier(0); }
#pragma unroll
        for (int ks = 0; ks < 4; ++ks) {
#pragma unroll
            for (int et = 0; et < 8; ++et) { const bf16x8 rf = *(const LAS bf16x8*)(Rs + (16 * et + fr) * RS + 32 * ks + 8 * fg);
                accC[et] = __builtin_amdgcn_mfma_f32_16x16x32_bf16(rf, qf[ks], accC[et], 0, 0, 0); }
            __builtin_amdgcn_sched_barrier(0); }
        const float xi = exp2f(l2g * (float)(il + 1));
        float s = 0.f;
#pragma unroll
        for (int et = 0; et < 8; ++et) { accI[et] = accI[et] + accC[et] * xi; s += (accI[et][0] + accI[et][1]) + (accI[et][2] + accI[et][3]); }
        s += __shfl_xor(s, 16); s += __shfl_xor(s, 32);
        const float mu = s * (1.0f / 128.0f); float q2 = 0.f;
#pragma unroll
        for (int et = 0; et < 8; ++et) { accI[et] = accI[et] - mu; q2 += (accI[et][0] * accI[et][0] + accI[et][1] * accI[et][1]) + (accI[et][2] * accI[et][2] + accI[et][3] * accI[et][3]); }
        q2 += __shfl_xor(q2, 16); q2 += __shfl_xor(q2, 32);
        const float rstd = 1.0f / sqrtf(q2 * (1.0f / 128.0f) + 1e-6f);
        GAS bf16* yp = (GAS bf16*)(a.ws + WS_YR) + (size_t)(t0 + il) * 1024 + h * 128 + 4 * fg;
#pragma unroll
        for (int et = 0; et < 8; ++et) { const v2u gw = gt[et]; v2u o;
            o.x = pk2(accI[et][0] * rstd * pg8::bf_lo(gw.x), accI[et][1] * rstd * pg8::bf_hi(gw.x)); o.y = pk2(accI[et][2] * rstd * pg8::bf_lo(gw.y), accI[et][3] * rstd * pg8::bf_hi(gw.y));
            *(GAS v2u*)(yp + 16 * et) = o; }
        __syncthreads();
    }
}

__device__ __forceinline__ void router_item(const Args& a, int item, LAS unsigned char* lds, int tid) {
    LAS float* rs = (LAS float*)lds;
    LAS float* part = rs + 64;
    LAS float* lg = part + 4 * 64 * 33;
    LAS int* hist = (LAS int*)(lg + 64 * 33);
    LAS int* base = hist + 32;
    LAS int* slot = base + 32;
    const int lane = tid & 63, w = __builtin_amdgcn_readfirstlane(tid >> 6), tb = item * 64;
    const float* x2 = (const float*)(a.ws + WS_X2);
    if (tid < 32) hist[tid] = 0;
    { f32x4 va[8], vb[8];
#define P8_LOAD(V_, r_) do { const GAS f32x4* xr_ = (const GAS f32x4*)(x2 + (size_t)(tb + 8 * w + (r_)) * 2048) + lane; _Pragma("unroll") for (int j = 0; j < 8; ++j) V_[j] = xr_[64 * j]; } while (0)
#define P8_PROC(V_, r_) do { float s_ = 0.f; _Pragma("unroll") for (int j = 0; j < 8; ++j) s_ += (V_[j].x * V_[j].x + V_[j].y * V_[j].y) + (V_[j].z * V_[j].z + V_[j].w * V_[j].w); \
          const float rstd_ = 1.0f / sqrtf(wave_sum(s_) * (1.0f / 2048.0f) + 1e-6f); if (lane == 0) rs[8 * w + (r_)] = rstd_; } while (0)
      P8_LOAD(va, 0);
#pragma unroll
      for (int rp = 0; rp < 4; ++rp) { P8_LOAD(vb, 2 * rp + 1); P8_PROC(va, 2 * rp); if (rp < 3) P8_LOAD(va, 2 * rp + 2); P8_PROC(vb, 2 * rp + 1); }
#undef P8_LOAD
#undef P8_PROC
    }
    { const int tg = w & 1, kq = w >> 1, hl = lane >> 5, l31 = lane & 31;
      const GAS float* xp = (const GAS float*)x2 + (size_t)(tb + 32 * tg + l31) * 2048 + 512 * kq + 4 * hl;
      const GAS float* wp = (const GAS float*)(a.ws + WS_WG) + (size_t)(512 * kq + 4 * hl) * 32 + l31;
      f32x16 acc;
#pragma unroll
      for (int x = 0; x < 16; ++x) acc[x] = 0.f;
#pragma unroll 4
      for (int kk = 0; kk < 64; ++kk) { const f32x4 av = *(const GAS f32x4*)(xp + 8 * kk); const GAS float* wq = wp + (size_t)(8 * kk) * 32;
          acc = __builtin_amdgcn_mfma_f32_32x32x2f32(av.x, wq[0], acc, 0, 0, 0); acc = __builtin_amdgcn_mfma_f32_32x32x2f32(av.y, wq[32], acc, 0, 0, 0);
          acc = __builtin_amdgcn_mfma_f32_32x32x2f32(av.z, wq[64], acc, 0, 0, 0); acc = __builtin_amdgcn_mfma_f32_32x32x2f32(av.w, wq[96], acc, 0, 0, 0); }
#pragma unroll
      for (int x = 0; x < 16; ++x) { const int tl = (x & 3) + 8 * (x >> 2) + 4 * hl; part[(kq * 64 + 32 * tg + tl) * 33 + l31] = acc[x]; } }
    __syncthreads();
    for (int e = tid; e < 64 * 32; e += 512) { const int tl = e >> 5, ex = e & 31;
        lg[tl * 33 + ex] = rs[tl] * ((part[(0 * 64 + tl) * 33 + ex] + part[(1 * 64 + tl) * 33 + ex]) + (part[(2 * 64 + tl) * 33 + ex] + part[(3 * 64 + tl) * 33 + ex])) + a.router_b[ex]; }
    __syncthreads();
    int e0 = 0, e1 = 0, e2 = 0, e3 = 0, r0 = 0, r1 = 0, r2 = 0, r3 = 0; float g0 = 0.f, g1 = 0.f, g2 = 0.f, g3 = 0.f;
    if (tid < 64) { const LAS float* L = lg + tid * 33; float v0 = -3.0e38f, v1 = -3.0e38f, v2 = -3.0e38f, v3 = -3.0e38f;
        for (int ex = 0; ex < 32; ++ex) { const float v = L[ex]; if (v > v0) { v0 = v; e0 = ex; } }
        for (int ex = 0; ex < 32; ++ex) { const float v = L[ex]; if (ex != e0 && v > v1) { v1 = v; e1 = ex; } }
        for (int ex = 0; ex < 32; ++ex) { const float v = L[ex]; if (ex != e0 && ex != e1 && v > v2) { v2 = v; e2 = ex; } }
        for (int ex = 0; ex < 32; ++ex) { const float v = L[ex]; if (ex != e0 && ex != e1 && ex != e2 && v > v3) { v3 = v; e3 = ex; } }
        const float p0 = 1.0f, p1 = expf(v1 - v0), p2 = expf(v2 - v0), p3 = expf(v3 - v0), inv = 1.0f / (p0 + p1 + p2 + p3);
        g0 = p0 * inv; g1 = p1 * inv; g2 = p2 * inv; g3 = p3 * inv;
        r0 = __hip_atomic_fetch_add(&hist[e0], 1, __ATOMIC_RELAXED, __HIP_MEMORY_SCOPE_WORKGROUP); r1 = __hip_atomic_fetch_add(&hist[e1], 1, __ATOMIC_RELAXED, __HIP_MEMORY_SCOPE_WORKGROUP);
        r2 = __hip_atomic_fetch_add(&hist[e2], 1, __ATOMIC_RELAXED, __HIP_MEMORY_SCOPE_WORKGROUP); r3 = __hip_atomic_fetch_add(&hist[e3], 1, __ATOMIC_RELAXED, __HIP_MEMORY_SCOPE_WORKGROUP); }
    __syncthreads();
    if (tid < 32) base[tid] = (int)__hip_atomic_fetch_add((unsigned*)(a.ws + WS_CTL) + CW_CNT + tid, (unsigned)hist[tid], RLX_AGENT);
    __syncthreads();
    if (tid < 64) { const int t = tb + tid; int* te = (int*)(a.ws + WS_TOKE) + t * 4; float* tg = (float*)(a.ws + WS_TOKG) + t * 4; int* tp = (int*)(a.ws + WS_TOKP) + t * 4;
        const int q0 = base[e0] + r0, q1 = base[e1] + r1, q2 = base[e2] + r2, q3 = base[e3] + r3;
        te[0] = e0; te[1] = e1; te[2] = e2; te[3] = e3; tg[0] = g0; tg[1] = g1; tg[2] = g2; tg[3] = g3; tp[0] = q0; tp[1] = q1; tp[2] = q2; tp[3] = q3;
        slot[tid * 4] = e0 * 16384 + q0; slot[tid * 4 + 1] = e1 * 16384 + q1; slot[tid * 4 + 2] = e2 * 16384 + q2; slot[tid * 4 + 3] = e3 * 16384 + q3; }
    __syncthreads();
    { const GAS f32x4* gr = (const GAS f32x4*)a.norm2_g + lane; GAS unsigned char* xg = (GAS unsigned char*)(a.ws + WS_XG); f32x4 va[8], vb[8];
#define P8_LOAD(V_, r_) do { const GAS f32x4* xr_ = (const GAS f32x4*)(x2 + (size_t)(tb + 8 * w + (r_)) * 2048) + lane; _Pragma("unroll") for (int j = 0; j < 8; ++j) V_[j] = xr_[64 * j]; } while (0)
#define P8_PROC(V_, r_) do { const int tl_ = 8 * w + (r_); const float rstd_ = rs[tl_]; const int s0 = slot[tl_ * 4], s1 = slot[tl_ * 4 + 1], s2 = slot[tl_ * 4 + 2], s3 = slot[tl_ * 4 + 3]; \
          GAS unsigned* d0 = (GAS unsigned*)(xg + (size_t)s0 * 2048) + lane; GAS unsigned* d1 = (GAS unsigned*)(xg + (size_t)s1 * 2048) + lane; \
          GAS unsigned* d2 = (GAS unsigned*)(xg + (size_t)s2 * 2048) + lane; GAS unsigned* d3 = (GAS unsigned*)(xg + (size_t)s3 * 2048) + lane; \
          _Pragma("unroll") for (int j = 0; j < 8; ++j) { const f32x4 v = V_[j], g = gr[64 * j]; const unsigned dw = pg8::pk4_fp8(v.x * rstd_ * g.x, v.y * rstd_ * g.y, v.z * rstd_ * g.z, v.w * rstd_ * g.w); \
              d0[64 * j] = dw; d1[64 * j] = dw; d2[64 * j] = dw; d3[64 * j] = dw; } } while (0)
      P8_LOAD(va, 0);
#pragma unroll
      for (int rp = 0; rp < 4; ++rp) { P8_LOAD(vb, 2 * rp + 1); P8_PROC(va, 2 * rp); if (rp < 3) P8_LOAD(va, 2 * rp + 2); P8_PROC(vb, 2 * rp + 1); }
#undef P8_LOAD
#undef P8_PROC
    }
    __syncthreads();
}
__device__ __forceinline__ int moe_table(const Args& a, LAS unsigned char* lds, int tid) {
    LAS int* tab = (LAS int*)(lds + MOETAB_OFF);
    if (tid < 64) {
        const int e = tid, c = (e < NEXP) ? (int)__hip_atomic_load((unsigned*)(a.ws + WS_CTL) + CW_CNT + e, RLX_AGENT) : 0, nt = (c + 255) >> 8;
        int incl = nt;
#pragma unroll
        for (int o = 1; o < 64; o <<= 1) { const int v = __shfl_up(incl, o); if (tid >= o) incl += v; }
        const int start = incl - nt;
        if (e <= NEXP) tab[e] = start;
        for (int j = 0; j < nt; ++j) tab[33 + start + j] = e; }
    __syncthreads();
    return __builtin_amdgcn_readfirstlane(tab[NEXP]);
}

constexpr int N_PHASES = 15;
__global__ void __launch_bounds__(NWAVES * 64, 2) mk_fwd(Args kargs) {
    extern __shared__ __attribute__((aligned(16))) unsigned char lds_raw[];
    LAS unsigned char* lds = (LAS unsigned char*)lds_raw;
    const int tid = threadIdx.x, lane = tid & 63, wave = __builtin_amdgcn_readfirstlane(tid >> 6);
    const int G = gridDim.x, bx = blockIdx.x, gw = bx * NWAVES + wave, NGW = G * NWAVES, gtid = bx * (NWAVES * 64) + tid, GT = G * NWAVES * 64;
    unsigned char* const ws = kargs.ws;
#define LOAD_ARGS() const __attribute__((address_space(4))) Args* ap_ = (const __attribute__((address_space(4))) Args*)__builtin_amdgcn_kernarg_segment_ptr(); asm volatile("" : "+s"(ap_)); Args a; { const __attribute__((address_space(4))) unsigned long long* q_ = (const __attribute__((address_space(4))) unsigned long long*)ap_; unsigned long long* d_ = (unsigned long long*)&a; _Pragma("unroll") for (int i_ = 0; i_ < (int)(sizeof(Args) / 8); ++i_) d_[i_] = q_[i_]; }
    for (int u = tid; u < (LDS_BYTES - LDSCTL_OFF) / 4; u += NWAVES * 64) ((LAS unsigned*)(lds + LDSCTL_OFF))[u] = 0u;
    __syncthreads();
    XcdBarrier bar = xcd_barrier_post((unsigned*)(ws + WS_CTL) + CW_BAR + kargs.li * XCD_BAR_WORDS, (volatile LAS unsigned*)(lds + LDSCTL_OFF) + 8);
    const int lo = kargs.ph_lo, hi = kargs.ph_hi;
#ifndef PH_MASK
#define PH_MASK 0x7fff
#endif
#define IN(k) (((PH_MASK >> (k)) & 1) && lo <= (k) && (k) < hi)
#define SEAM(k) do { if (IN(k) && IN((k) + 1)) xcd_barrier(bar); } while (0)
    bf16* const HB = (bf16*)(ws + WS_HB);
#ifndef STAG_US
#define STAG_US 0
#endif
#define STAGGER(us) do { if ((us) > 0 && (bx & 1)) { const unsigned long long t0_ = __builtin_amdgcn_s_memrealtime(); while (__builtin_amdgcn_s_memrealtime() - t0_ < (unsigned long long)(us) * 100ull) __builtin_amdgcn_s_sleep(32); } } while (0)

#ifndef MK_SPLIT
#define MK_SPLIT 0
#endif
    const bool split = MK_SPLIT && (G == 256);
    const bool is_conv = !split || (((bx >> 3) & 3) == 3);
    const bool is_gemm = !split || !is_conv;
    const int convG = split ? 64 : G, convRank = split ? ((bx >> 5) * 8 + (bx & 7)) : bx;
    const int gemmG = split ? 192 : G, gemmRank = split ? ((bx >> 5) * 24 + (bx & 31)) : bx;
    if (IN(0)) { LOAD_ARGS();
        const int nsk = (G > 2 * NG5) ? NG5 : 0;
        if (bx < nsk || nsk == 0) for (int g = bx; g < NG5; g += G) s5_tables(a, g, lds, tid);
        if (bx >= nsk) { LAS float* scr = (LAS float*)(lds + wave * 16640);
            const int gw2 = (bx - nsk) * NWAVES + wave, NGW2 = (G - nsk) * NWAVES, gt2 = (bx - nsk) * (NWAVES * 64) + tid, GT2 = (G - nsk) * NWAVES * 64;
            transpose_run<false>(a.w_in, 2048, 5120, INC, ws + WS_BTIN, 1, 1, 0, 0, scr, gw2, NGW2, lane);
            transpose_run8(a.w_in + 5120, 2048, 4096, INC, ws + WS_BTIN8, 0, 1, 0, 0, (LAS unsigned*)scr, gw2, NGW2, lane);
            transpose_run<false>(a.w_pp, PLED, 2048, 2048, ws + WS_BTPP, 0, 1, 0, 0, scr, gw2, NGW2, lane);
            for (int t = gw2; t < SEQ; t += NGW2) rms_row_bf16(a.x + (size_t)t * 2048, a.norm1_g, HB + (size_t)t * 2048, ws + WS_H8 + (size_t)t * 2048, lane);
            { float* cs = (float*)(ws + WS_CS); float* sn = (float*)(ws + WS_SN);
              for (int e = gt2; e < SEQ * 64; e += GT2) { const int t = e >> 6, i = e & 63; const float inv = powf(10000.0f, -(float)i / 64.0f), ang = (float)a.pos[t] * inv; cs[e] = cosf(ang); sn[e] = sinf(ang); } }
            { float* wg = (float*)(ws + WS_WG); for (int e = gt2; e < 2048 * 32; e += GT2) wg[e] = a.norm2_g[e >> 5] * a.router_w[e]; }
            { v2u* pb = (v2u*)(ws + WS_PBF); const f32x4* pf = (const f32x4*)a.p;
              for (int e = gt2; e < SEQ * PLED / 4; e += GT2) { const f32x4 v = pf[e]; v2u o; o.x = pk2(v.x, v.y); o.y = pk2(v.z, v.w); pb[e] = o; } } }
    }
    SEAM(0);
    if (IN(1)) { LOAD_ARGS();
#ifndef MK_INTERLEAVE
#define MK_INTERLEAVE 0
#endif
        const bool gemm_first = MK_INTERLEAVE && !split && (((bx >> 3) & 1) != 0);
#define P1_CONV() do { LAS float* scr = (LAS float*)(lds + wave * 16640); const int cw = convRank * NWAVES + wave, NCW = convG * NWAVES; \
            transpose_run<false>(a.w_glu, 1024, 1024, 1024, ws + WS_BTGLU, 0, 1, 0, 0, scr, cw, NCW, lane); \
            transpose_run<false>(a.w_bs, 1024, 2048, 2048, ws + WS_BTPS, 0, 1, 0, 0, scr, cw, NCW, lane); \
            transpose_run<false>(a.w_br, 1024, 2048, 2048, ws + WS_BTPR, 0, 1, 0, 0, scr, cw, NCW, lane); \
            transpose_run<false>(a.w_out, 2048, 2048, 2048, ws + WS_BTOUT, 0, 1, 0, 0, scr, cw, NCW, lane); \
            transpose_run<true>(a.w_pg, 2048, 2048, 2048, ws + WS_BTPG, 0, 1, 0, 0, scr, cw, NCW, lane); \
            transpose_run8(a.w_gu, 2048, 4096, 4096, ws + WS_BTGU, 2, NEXP, (size_t)2048 * 4096, (size_t)4096 * 2048, (LAS unsigned*)scr, cw, NCW, lane); \
            transpose_run8(a.w_dn, 2048, 2048, 2048, ws + WS_BTDN, 0, NEXP, (size_t)2048 * 2048, (size_t)2048 * 2048, (LAS unsigned*)scr, cw, NCW, lane); \
            __syncthreads(); } while (0)
#define P1_GEMMS() do { \
        { pg8::Gemm g{HB, (const bf16*)(ws + WS_BTIN), 2048, 2048, 2048}; pg8::StaticOrder S; S.init(SEQ, 1024, gemmG, gemmRank); \
          pg8::EpiZU E{(bf16*)(ws + WS_XG5)}; \
          pg8::gemm_phase<pg8::EpiZU, pg8::StaticOrder, true, true>(lds + RING_OFF, g, S, E); } \
        { pg8::Gemm g{HB, (const bf16*)(ws + WS_BTIN) + (size_t)1024 * 2048, 2048, 2048, 2048}; pg8::StaticOrder S; S.init(SEQ, 2048, gemmG, gemmRank); \
          pg8::EpiZR E{(bf16*)(ws + WS_Q), (bf16*)(ws + WS_K), (const float*)(ws + WS_CS), (const float*)(ws + WS_SN)}; \
          pg8::gemm_phase<pg8::EpiZR, pg8::StaticOrder, true, true>(lds + RING_OFF, g, S, E); } \
        { pg8::Gemm g{HB, (const bf16*)(ws + WS_BTIN) + (size_t)3072 * 2048, 2048, 2048, 2048}; pg8::StaticOrder S; S.init(SEQ, 2048, gemmG, gemmRank); \
          pg8::EpiZA E{(bf16*)(ws + WS_V), (bf16*)(ws + WS_GS), (bf16*)(ws + WS_SGS), (bf16*)(ws + WS_SGR), 0, 1.0f}; \
          pg8::gemm_phase<pg8::EpiZA, pg8::StaticOrder, true, true>(lds + RING_OFF, g, S, E); } \
        { pg8::Gemm g{(const bf16*)(ws + WS_H8), (const bf16*)(ws + WS_BTIN8), 1024, 1024, 1024}; pg8::StaticOrder S; S.init(SEQ, 4096, gemmG, gemmRank);     \
          pg8::EpiZA E{(bf16*)(ws + WS_V), (bf16*)(ws + WS_GS), (bf16*)(ws + WS_SGS), (bf16*)(ws + WS_SGR), 8, pg8::W8_INV}; \
          pg8::gemm_phase<pg8::EpiZA, pg8::StaticOrder, true, true, true>(lds + RING_OFF, g, S, E); } \
        __syncthreads(); } while (0)
        if (gemm_first) { P1_GEMMS(); P1_CONV(); }
        else { if (is_conv) P1_CONV(); if (is_gemm) P1_GEMMS(); }
#undef P1_CONV
#undef P1_GEMMS
        if (is_conv) { pg8::Gemm g{(const bf16*)(ws + WS_PBF), (const bf16*)(ws + WS_BTPP), PLED, PLED, PLED}; pg8::StaticOrder S; S.init(SEQ, 2048, convG, convRank);
          pg8::EpiPlain E{(bf16*)(ws + WS_PP), 2048};
          pg8::gemm_phase<pg8::EpiPlain, pg8::StaticOrder, true, true>(lds + RING_OFF, g, S, E); }
    }
    SEAM(1);
    if (IN(2)) { LOAD_ARGS();
        { pg8::Gemm g{(const bf16*)(ws + WS_XG5), (const bf16*)(ws + WS_BTS1), K5, 512, 512}; pg8::OrderS1 S{G, bx}; pg8::EpiS1 E{(float*)(ws + WS_SLOC)};
          pg8::gemm_phase<pg8::EpiS1, pg8::OrderS1, false, true>(lds + RING_OFF, g, S, E); }
        __syncthreads();
        for (int u = bx; u < NRC * RH; u += G) ret_kv_unit(a, u, lds, tid);
    }
    SEAM(2);
    if (IN(3)) { LOAD_ARGS();
        for (int it = G - 1 - bx; it < 128; it += G) s5_scan_item(a, it, lds, tid);
        ret_state_scan(a, gtid, GT);
    }
    SEAM(3);
    if (IN(4)) { LOAD_ARGS();
#if defined(P4_SKIP_GEMM)
        if (kargs.li == 0)
#endif
        { pg8::Gemm g{(const bf16*)(ws + WS_XG5), (const bf16*)(ws + WS_BTS3), K5, K5, K5}; pg8::OrderS3 S{G, bx}; pg8::EpiS3 E{(bf16*)(ws + WS_YSP)};
          pg8::gemm_phase<pg8::EpiS3, pg8::OrderS3, false, true>(lds + RING_OFF, g, S, E); }
        __syncthreads();
#if defined(P4_SKIP_RET)
        if (kargs.li == 0)
#endif
        ret_out_units(a, bx, G, NRC * RH, lds, tid);
    }
    SEAM(4);
    if (IN(5)) { LOAD_ARGS();
        pg8::Gemm g{(const bf16*)(ws + WS_YSP), (const bf16*)(ws + WS_BTGLU), 1024, 1024, 1024}; pg8::StaticOrder S; S.init(SEQ, 1024, G, bx);
        pg8::EpiGLU E{(const bf16*)(ws + WS_YSP), a.b_glu, (bf16*)(ws + WS_YS)};
        pg8::gemm_phase<pg8::EpiGLU, pg8::StaticOrder, true, true>(lds + RING_OFF, g, S, E);
    }
    SEAM(5);
#ifdef EXTRA_BAR
    for (int eb_ = 0; eb_ < EXTRA_BAR; ++eb_) xcd_barrier(bar);
#endif
    if (IN(6)) { LOAD_ARGS(); STAGGER(STAG_US);
        { pg8::Gemm g{(const bf16*)(ws + WS_YS), (const bf16*)(ws + WS_BTPS), 1024, 1024, 1024}; pg8::StaticOrder S; S.init(SEQ, 2048, G, bx);
          pg8::EpiM1 E{(const bf16*)(ws + WS_SGS), (bf16*)(ws + WS_TMP)};
          pg8::gemm_phase<pg8::EpiM1, pg8::StaticOrder, true, true>(lds + RING_OFF, g, S, E); }
        VM_WAIT(); __syncthreads();
        { pg8::Gemm g{(const bf16*)(ws + WS_YR), (const bf16*)(ws + WS_BTPR), 1024, 1024, 1024}; pg8::StaticOrder S; S.init(SEQ, 2048, G, bx);
          pg8::EpiM2 E{(const bf16*)(ws + WS_SGR), (const bf16*)(ws + WS_TMP), (bf16*)(ws + WS_MRG)};
          pg8::gemm_phase<pg8::EpiM2, pg8::StaticOrder, true, true>(lds + RING_OFF, g, S, E); }
    }
    SEAM(6);
    if (IN(7)) { LOAD_ARGS(); STAGGER(STAG_US);
        pg8::Gemm g{(const bf16*)(ws + WS_MRG), (const bf16*)(ws + WS_BTOUT), 2048, 2048, 2048}; pg8::StaticOrder S; S.init(SEQ, 2048, G, bx);
        pg8::EpiRes E{a.x, (float*)(ws + WS_X2)};
        pg8::gemm_phase<pg8::EpiRes, pg8::StaticOrder, true, true>(lds + RING_OFF, g, S, E);
    }
    SEAM(7);
    if (IN(8)) { LOAD_ARGS(); for (int it = bx; it < SEQ / 64; it += G) router_item(a, it, lds, tid); }
    do { if (IN(8) && IN(10)) xcd_barrier(bar); } while (0);
    if (IN(10)) { LOAD_ARGS();
        const int nrt = moe_table(a, lds, tid);
        pg8::Gemm g{(const bf16*)(ws + WS_XG), (const bf16*)(ws + WS_BTGU), 1024, 1024, 1024};     pg8::OrderMoe S; S.so.init(nrt * 256, 4096, G, bx); S.tab = (const LAS int*)(lds + MOETAB_OFF); S.ntn = 16; S.gather_a = true;
        pg8::EpiGU E{a.b_gu, ws + WS_ACT};
        pg8::gemm_phase<pg8::EpiGU, pg8::OrderMoe, true, true, true>(lds + RING_OFF, g, S, E);
    }
    SEAM(10);
    if (IN(11)) { LOAD_ARGS();
        const int nrt = moe_table(a, lds, tid);
        pg8::Gemm g{(const bf16*)(ws + WS_ACT), (const bf16*)(ws + WS_BTDN), 1024, 1024, 1024}; pg8::OrderMoe S; S.so.init(nrt * 256, 2048, G, bx); S.tab = (const LAS int*)(lds + MOETAB_OFF); S.ntn = 8; S.gather_a = false;
        pg8::EpiDN E{a.b_dn, ws + WS_YB};
        pg8::gemm_phase<pg8::EpiDN, pg8::OrderMoe, true, true, true>(lds + RING_OFF, g, S, E);
    }
    SEAM(11);
    if (IN(12)) { LOAD_ARGS();
        (void)moe_table(a, lds, tid); const LAS int* tab = (const LAS int*)(lds + MOETAB_OFF);
        const GAS int* toke = (const GAS int*)(ws + WS_TOKE); const GAS int* tokp = (const GAS int*)(ws + WS_TOKP); const GAS float* tokg = (const GAS float*)(ws + WS_TOKG);
        const GAS unsigned char* yb = (const GAS unsigned char*)(ws + WS_YB); const GAS float* x2 = (const GAS float*)(ws + WS_X2);
        GAS bf16* x3b = (GAS bf16*)(ws + WS_TMP + 64 * MiB); GAS unsigned char* h3b = (GAS unsigned char*)HB; const GAS f32x4* gr = (const GAS f32x4*)a.norm3_g + lane;
        typedef float f32x2_ __attribute__((ext_vector_type(2)));
        for (int tb = gw * 8; tb < SEQ; tb += NGW * 8) {
            int rowv = 0; float gv = 0.f;
            if (lane < 32) { const int as = tb * 4 + lane; rowv = tab[toke[as]] * 256 + tokp[as]; gv = tokg[as] * pg8::YB_INV; }
            f32x4 xa[8], xb[8]; unsigned ya[32], yc[32];
#define P12_LOAD(X_, Y_, tk_) do { const GAS f32x4* xr_ = (const GAS f32x4*)(x2 + (size_t)(tb + (tk_)) * 2048) + lane; \
                _Pragma("unroll") for (int j = 0; j < 8; ++j) X_[j] = xr_[64 * j]; \
                _Pragma("unroll") for (int k = 0; k < 4; ++k) { const int r_ = __shfl(rowv, (tk_) * 4 + k); const GAS unsigned* yp_ = (const GAS unsigned*)(yb + (size_t)r_ * 2048) + lane; \
                    _Pragma("unroll") for (int j = 0; j < 8; ++j) Y_[k * 8 + j] = yp_[64 * j]; } } while (0)
#define P12_PROC(X_, Y_, tk_) do { const float q0 = __shfl(gv, (tk_) * 4), q1 = __shfl(gv, (tk_) * 4 + 1), q2 = __shfl(gv, (tk_) * 4 + 2), q3 = __shfl(gv, (tk_) * 4 + 3); float s_ = 0.f; \
                GAS v2u* x3o = (GAS v2u*)(x3b + (size_t)(tb + (tk_)) * 2048) + lane; GAS unsigned* o4 = (GAS unsigned*)(h3b + (size_t)(tb + (tk_)) * 2048) + lane; \
                _Pragma("unroll") for (int j = 0; j < 8; ++j) { f32x4 x = X_[j]; const unsigned w0 = Y_[j], w1 = Y_[8 + j], w2 = Y_[16 + j], w3 = Y_[24 + j]; \
                    const f32x2_ a0 = __builtin_amdgcn_cvt_pk_f32_fp8(w0, false), b0 = __builtin_amdgcn_cvt_pk_f32_fp8(w0, true), a1 = __builtin_amdgcn_cvt_pk_f32_fp8(w1, false), b1 = __builtin_amdgcn_cvt_pk_f32_fp8(w1, true); \
                    const f32x2_ a2 = __builtin_amdgcn_cvt_pk_f32_fp8(w2, false), b2 = __builtin_amdgcn_cvt_pk_f32_fp8(w2, true), a3 = __builtin_amdgcn_cvt_pk_f32_fp8(w3, false), b3 = __builtin_amdgcn_cvt_pk_f32_fp8(w3, true); \
                    x.x += (a0.x * q0 + a1.x * q1) + (a2.x * q2 + a3.x * q3); x.y += (a0.y * q0 + a1.y * q1) + (a2.y * q2 + a3.y * q3); \
                    x.z += (b0.x * q0 + b1.x * q1) + (b2.x * q2 + b3.x * q3); x.w += (b0.y * q0 + b1.y * q1) + (b2.y * q2 + b3.y * q3); \
                    X_[j] = x; v2u xo; xo.x = pk2(x.x, x.y); xo.y = pk2(x.z, x.w); x3o[64 * j] = xo; s_ += (x.x * x.x + x.y * x.y) + (x.z * x.z + x.w * x.w); __builtin_amdgcn_sched_barrier(0); } \
                const float rstd_ = 1.0f / sqrtf(wave_sum(s_) * (1.0f / 2048.0f) + 1e-6f); \
                _Pragma("unroll") for (int j = 0; j < 8; ++j) { const f32x4 g = gr[64 * j]; o4[64 * j] = pg8::pk4_fp8(X_[j].x * rstd_ * g.x, X_[j].y * rstd_ * g.y, X_[j].z * rstd_ * g.z, X_[j].w * rstd_ * g.w); } } while (0)
            P12_LOAD(xa, ya, 0);
#pragma unroll
            for (int tp = 0; tp < 4; ++tp) { P12_LOAD(xb, yc, 2 * tp + 1); P12_PROC(xa, ya, 2 * tp); if (tp < 3) P12_LOAD(xa, ya, 2 * tp + 2); P12_PROC(xb, yc, 2 * tp + 1); }
#undef P12_LOAD
#undef P12_PROC
        }
    }
    SEAM(12);
    if (IN(13)) { LOAD_ARGS(); STAGGER(STAG_US);
        pg8::Gemm g{HB, (const bf16*)(ws + WS_BTPG), 1024, 1024, 1024}; pg8::StaticOrder S; S.init(SEQ, 2048, G, bx);
        pg8::EpiPLE E{(const bf16*)(ws + WS_TMP + 64 * MiB), (const bf16*)(ws + WS_PP), (bf16*)(ws + WS_MRG), pg8::W8_INV};
        pg8::gemm_phase<pg8::EpiPLE, pg8::StaticOrder, true, true, true>(lds + RING_OFF, g, S, E);
    }
    SEAM(13);
    if (IN(14)) { LOAD_ARGS();
        const GAS f32x4* gr = (const GAS f32x4*)a.fin_g + lane; const GAS bf16* x4 = (const GAS bf16*)(ws + WS_MRG); GAS float* outp = (GAS float*)a.out;
        for (int tb = gw * 8; tb < SEQ; tb += NGW * 8) { v2u wa[8], wb[8];
#define P14_LOAD(W_, tk_) do { const GAS v2u* xb_ = (const GAS v2u*)(x4 + (size_t)(tb + (tk_)) * 2048) + lane; _Pragma("unroll") for (int j = 0; j < 8; ++j) W_[j] = xb_[64 * j]; } while (0)
#define P14_PROC(W_, tk_) do { f32x4 v_[8]; float s_ = 0.f; \
                _Pragma("unroll") for (int j = 0; j < 8; ++j) { const v2u w = W_[j]; v_[j] = (f32x4){pg8::bf_lo(w.x), pg8::bf_hi(w.x), pg8::bf_lo(w.y), pg8::bf_hi(w.y)}; s_ += (v_[j].x * v_[j].x + v_[j].y * v_[j].y) + (v_[j].z * v_[j].z + v_[j].w * v_[j].w); } \
                const float rstd_ = 1.0f / sqrtf(wave_sum(s_) * (1.0f / 2048.0f) + 1e-6f); GAS f32x4* xr_ = (GAS f32x4*)(outp + (size_t)(tb + (tk_)) * 2048) + lane; \
                _Pragma("unroll") for (int j = 0; j < 8; ++j) xr_[64 * j] = v_[j] * rstd_ * gr[64 * j]; } while (0)
            P14_LOAD(wa, 0);
#pragma unroll
            for (int tp = 0; tp < 4; ++tp) { P14_LOAD(wb, 2 * tp + 1); P14_PROC(wa, 2 * tp); if (tp < 3) P14_LOAD(wa, 2 * tp + 2); P14_PROC(wb, 2 * tp + 1); }
#undef P14_LOAD
#undef P14_PROC
        }
    }
#undef IN
#undef SEAM
}

extern "C" void kernel_launch(void* const* d_in, const int* in_sizes, int n_in, void* d_out, int out_size, void* d_ws, size_t ws_size, hipStream_t stream) {
    static int grid = 0;
    if (grid == 0) {
        if (n_in != 29 || in_sizes[0] != SEQ * DM || out_size != SEQ * DM || ws_size < WS_END) { fprintf(stderr, "kernel_launch: unexpected shapes (n_in %d, ws %zu < %zu?)\n", n_in, ws_size, (size_t)WS_END); grid = -1; return; }
        int dev = 0, cus = 0, per_cu = 0;
        if (hipGetDevice(&dev) != hipSuccess || hipDeviceGetAttribute(&cus, hipDeviceAttributeMultiprocessorCount, dev) != hipSuccess) { grid = -1; return; }
        if (hipFuncSetAttribute((const void*)mk_fwd, hipFuncAttributeMaxDynamicSharedMemorySize, LDS_BYTES) != hipSuccess) { fprintf(stderr, "kernel_launch: hipFuncSetAttribute failed\n"); grid = -1; return; }
        if (hipOccupancyMaxActiveBlocksPerMultiprocessor(&per_cu, (const void*)mk_fwd, NWAVES * 64, LDS_BYTES) != hipSuccess || per_cu < 1) { fprintf(stderr, "kernel_launch: occupancy query says %d\n", per_cu); }
        (void)hipGetLastError();
        grid = cus;
    }
    if (grid < 0) return;
    if (hipMemsetAsync((char*)d_ws + WS_CTL, 0, CTL_ZERO_BYTES, stream) != hipSuccess) return;
    Args a{};
    a.x = (const float*)d_in[0]; a.p = (const float*)d_in[1]; a.pos = (const int*)d_in[2]; a.norm1_g = (const float*)d_in[3]; a.w_in = (const float*)d_in[4];
    a.lam_re = (const float*)d_in[5]; a.lam_im = (const float*)d_in[6]; a.log_dt = (const float*)d_in[7]; a.b_re = (const float*)d_in[8]; a.b_im = (const float*)d_in[9];
    a.c_re = (const float*)d_in[10]; a.c_im = (const float*)d_in[11]; a.d_skip = (const float*)d_in[12]; a.w_glu = (const float*)d_in[13]; a.b_glu = (const float*)d_in[14];
    a.w_bs = (const float*)d_in[15]; a.w_br = (const float*)d_in[16]; a.w_out = (const float*)d_in[17]; a.norm2_g = (const float*)d_in[18]; a.router_w = (const float*)d_in[19];
    a.router_b = (const float*)d_in[20]; a.w_gu = (const float*)d_in[21]; a.b_gu = (const float*)d_in[22]; a.w_dn = (const float*)d_in[23]; a.b_dn = (const float*)d_in[24];
    a.norm3_g = (const float*)d_in[25]; a.w_pg = (const float*)d_in[26]; a.w_pp = (const float*)d_in[27]; a.fin_g = (const float*)d_in[28];
    a.out = (float*)d_out; a.ws = (unsigned char*)d_ws;
#if defined(PROBE_LO)
#ifndef PROBE_REP
#define PROBE_REP 1
#endif
    a.ph_lo = 0; a.ph_hi = PROBE_HI; a.li = 0; hipLaunchKernelGGL(mk_fwd, dim3(grid), dim3(NWAVES * 64), LDS_BYTES, stream, a);
    for (int rep = 0; rep < PROBE_REP; ++rep) { a.ph_lo = PROBE_LO; a.ph_hi = (rep == PROBE_REP - 1) ? N_PHASES : PROBE_HI; a.li = 1 + rep; hipLaunchKernelGGL(mk_fwd, dim3(grid), dim3(NWAVES * 64), LDS_BYTES, stream, a); }
#elif MK_N_LAUNCHES == 1
    a.ph_lo = 0; a.ph_hi = N_PHASES;
    hipLaunchKernelGGL(mk_fwd, dim3(grid), dim3(NWAVES * 64), LDS_BYTES, stream, a);
#else
    for (int ph = 0; ph < N_PHASES; ++ph) { a.ph_lo = ph; a.ph_hi = ph + 1; hipLaunchKernelGGL(mk_fwd, dim3(grid), dim3(NWAVES * 64), LDS_BYTES, stream, a); }
#endif
    const hipError_t le = hipPeekAtLastError();
    if (le != hipSuccess) fprintf(stderr, "kernel_launch: launch failed: %s\n", hipGetErrorName(le));
}
```

```cpp
#include <hip/hip_runtime.h>
#include <cstdio>
#include <cstdint>

#ifndef MK_N_LAUNCHES
#define MK_N_LAUNCHES 1
#endif

constexpr int SEQ = 16384, DM = 2048, INC = 9216, NEXP = 32, FFN = 2048, PLED = 256;
constexpr int NG5 = 64, T5 = 32, NCH5 = SEQ / T5, K5 = 640;
constexpr int RCH = 128, NRC = SEQ / RCH, RH = 8;
constexpr int MAXROWS = SEQ * 4 + NEXP * 256;

namespace pg8 {
#define PG8_LAS __attribute__((address_space(3)))
typedef unsigned short bf16_t;
typedef short bf16x8 __attribute__((ext_vector_type(8)));
typedef float f32x4 __attribute__((ext_vector_type(4)));
typedef unsigned u32x4 __attribute__((ext_vector_type(4)));
typedef unsigned u32x2 __attribute__((ext_vector_type(2)));
constexpr int BM = 256, BK = 64, HALF = 128, HTB = HALF * BK * 2, STAGE_BYTES = 8 * HTB, NXCD = 8, WGM = 4;

__host__ __device__ __forceinline__ int lds_byte(int r, int c) { const int st = (r >> 4) * 2 + (c >> 5), rr = r & 15, cc = c & 31, ob = rr * 64 + cc * 2; return st * 1024 + (ob ^ (((ob >> 9) & 1) << 5)); }
__host__ __device__ __forceinline__ void stage_rc(int b, int& R, int& C) { const int st = b / 1024, sb = b % 1024, swz = sb ^ (((sb >> 9) & 1) << 5); R = (st >> 1) * 16 + swz / 64; C = (st & 1) * 32 + (swz % 64) / 2; }
__host__ __device__ __forceinline__ int perm32(int rho) { const int n = rho >> 4, i = rho & 15; return 8 * (i >> 2) + 4 * n + (i & 3); }

struct Unit { int pm, pn, pa; };
struct Gemm { const bf16_t* A; const bf16_t* Bt; int lda, ldb, K; };

struct StaticOrder {
    int nM, nN, nwg, G, c;
    __host__ __device__ void init(int M, int N, int G_, int c_) { nM = M / BM; nN = N / BM; nwg = nM * nN; G = G_; c = c_; }
    __host__ __device__ bool next(int i, Unit& u) const {
        const long L = (long)i * G + c; if (L >= nwg) return false;
        int wgid = (int)L; { const int q = nwg / NXCD, r = nwg % NXCD, xcd = wgid % NXCD, off = wgid / NXCD; wgid = (xcd < r ? xcd * (q + 1) : r * (q + 1) + (xcd - r) * q) + off; }
        const int nig = WGM * nN, gid = wgid / nig, fm = gid * WGM, gsz = (nM - fm) < WGM ? (nM - fm) : WGM;
        u.pm = fm + ((wgid % nig) % gsz); u.pn = (wgid % nig) / gsz; u.pa = u.pm; return true;
    }
    __device__ __forceinline__ void a_ready(const Unit&) const {}
    __device__ __forceinline__ void done(const Unit&) const {}
};
struct OrderS3 {
    int G, c;
    __device__ bool next(int i, Unit& u) const { const int L = i * G + c; if (L >= 256) return false; const int g = L >> 2; u.pm = 2 * g + ((L >> 1) & 1); u.pn = 2 * g + (L & 1); u.pa = u.pm; return true; }
    __device__ __forceinline__ void a_ready(const Unit&) const {}
    __device__ __forceinline__ void done(const Unit&) const {}
};
struct OrderS1 {
    int G, c;
    __device__ bool next(int i, Unit& u) const { const int L = i * G + c; if (L >= 128) return false; u.pm = L; u.pn = L >> 1; u.pa = L; return true; }
    __device__ __forceinline__ void a_ready(const Unit&) const {}
    __device__ __forceinline__ void done(const Unit&) const {}
};
struct OrderMoe {
    StaticOrder so; const PG8_LAS int* tab; int ntn; bool gather_a;
    __device__ bool next(int i, Unit& u) const { if (!so.next(i, u)) return false;
        const int e = __builtin_amdgcn_readfirstlane(tab[33 + u.pm]), t0 = __builtin_amdgcn_readfirstlane(tab[e]);
        u.pn = e * ntn + u.pn; u.pa = gather_a ? e * 64 + (u.pm - t0) : u.pm; return true; }
    __device__ __forceinline__ void a_ready(const Unit&) const {}
    __device__ __forceinline__ void done(const Unit&) const {}
};

__device__ __forceinline__ unsigned cvt_pk_bf16(float lo, float hi) { unsigned r; asm volatile("v_cvt_pk_bf16_f32 %0, %1, %2" : "=v"(r) : "v"(lo), "v"(hi)); return r; }
__device__ __forceinline__ u32x4 pack8(const f32x4& a, const f32x4& b) { u32x4 w; w.x = cvt_pk_bf16(a[0], a[1]); w.y = cvt_pk_bf16(a[2], a[3]); w.z = cvt_pk_bf16(b[0], b[1]); w.w = cvt_pk_bf16(b[2], b[3]); return w; }
__device__ __forceinline__ float bf_lo(unsigned w) { return __builtin_bit_cast(float, w << 16); }
__device__ __forceinline__ float bf_hi(unsigned w) { return __builtin_bit_cast(float, w & 0xffff0000u); }
__device__ __forceinline__ void unpack8(const u32x4& w, f32x4& a, f32x4& b) { a = (f32x4){bf_lo(w.x), bf_hi(w.x), bf_lo(w.y), bf_hi(w.y)}; b = (f32x4){bf_lo(w.z), bf_hi(w.z), bf_lo(w.w), bf_hi(w.w)}; }
typedef float f32x2 __attribute__((ext_vector_type(2)));
__device__ __forceinline__ float sigm(float x) { return __builtin_amdgcn_rcpf(1.0f + __builtin_amdgcn_exp2f(-1.4426950408889634f * x)); }
__device__ __forceinline__ f32x2 sigm2(f32x2 x) { const f32x2 t = x * (-1.4426950408889634f); f32x2 e; e.x = __builtin_amdgcn_exp2f(t.x); e.y = __builtin_amdgcn_exp2f(t.y);
    const f32x2 d = e + 1.0f; f32x2 r; r.x = __builtin_amdgcn_rcpf(d.x); r.y = __builtin_amdgcn_rcpf(d.y); return r; }
__device__ __forceinline__ f32x4 sigm4(const f32x4& x) { const f32x2 a = sigm2((f32x2){x[0], x[1]}), b = sigm2((f32x2){x[2], x[3]}); return (f32x4){a.x, a.y, b.x, b.y}; }
__device__ __forceinline__ float gelu_t(float x) { return x * sigm(1.5957691216057308f * (x + 0.044715f * x * x * x)); }
__device__ __forceinline__ f32x2 gelu2(f32x2 x) { const f32x2 u = x * x, w = (u * 0.044715f + 1.0f) * x; return x * sigm2(w * 1.5957691216057308f); }
__device__ __forceinline__ f32x4 gelu4(const f32x4& x) { const f32x2 a = gelu2((f32x2){x[0], x[1]}), b = gelu2((f32x2){x[2], x[3]}); return (f32x4){a.x, a.y, b.x, b.y}; }

#define EPI_LOOP_AM _Pragma("unroll") for (int ai = 0; ai < 2; ++ai) _Pragma("unroll") for (int m = 0; m < 4; ++m)
#define EPI_LOOP_BJ _Pragma("unroll") for (int bj = 0; bj < 2; ++bj)
typedef f32x4 AccT[2][2][4][2];
#ifndef EPIZ_MASK
#define EPIZ_MASK 31
#endif
#define EPIZ_EN(k) ((EPIZ_MASK >> (k)) & 1)

struct EpiZU {
    static constexpr bool PERM = true, AFTER_DRAIN = false; static constexpr int NSTORE = 16; static constexpr bool HAS_MID = false;
    bf16_t* xg5;
    __device__ __forceinline__ void operator()(const AccT& acc, const Unit& u, int wr, int wc, int fr, int fq) const {
        const int row0 = u.pm * BM + wr * 64 + fr, tc = wc * 32 + 8 * fq, pn = u.pn;
        EPI_LOOP_AM { const int t = row0 + ai * HALF + m * 16, j = t >> 5, i = t & 31;
            EPI_LOOP_BJ { const int col = pn * BM + bj * HALF + tc, g = col >> 4, c0 = col & 15;
                *(u32x4*)(xg5 + ((size_t)(g * NCH5 + j) * K5 + i * 16 + c0)) = pack8(acc[ai][bj][m][0], acc[ai][bj][m][1]); } }
    }
};
struct EpiZR {
    static constexpr bool PERM = true, AFTER_DRAIN = false; static constexpr int NSTORE = 16; static constexpr bool HAS_MID = false;
    bf16_t *q, *k; const float *cs, *sn;
    __device__ __forceinline__ void operator()(const AccT& acc, const Unit& u, int wr, int wc, int fr, int fq) const {
        const int row0 = u.pm * BM + wr * 64 + fr, pn = u.pn;
        const bool isk = pn >= 4; bf16_t* dst = isk ? k : q; const float sc = isk ? 0.08838834764831845f : 1.0f;
        const int head = 2 * (pn & 3) + (wc >> 1), dd = 32 * (wc & 1) + 8 * fq;
        EPI_LOOP_AM { const int t = row0 + ai * HALF + m * 16;
            const float* cp = cs + (size_t)t * 64 + dd; const float* sp = sn + (size_t)t * 64 + dd;
            const f32x4 c0 = *(const f32x4*)cp * sc, c1 = *(const f32x4*)(cp + 4) * sc, s0 = *(const f32x4*)sp * sc, s1 = *(const f32x4*)(sp + 4) * sc;
            const f32x4 x1a = acc[ai][0][m][0], x1b = acc[ai][0][m][1], x2a = acc[ai][1][m][0], x2b = acc[ai][1][m][1];
            bf16_t* o = dst + (size_t)t * 1024 + head * 128 + dd;
            *(u32x4*)o = pack8(x1a * c0 - x2a * s0, x1b * c1 - x2b * s1);
            *(u32x4*)(o + 64) = pack8(x1a * s0 + x2a * c0, x1b * s1 + x2b * c1); asm volatile("" ::: "memory"); }
    }
};
struct EpiZA {
    static constexpr bool PERM = true, AFTER_DRAIN = false; static constexpr int NSTORE = 16; static constexpr bool HAS_MID = false;
    bf16_t *v, *gs, *sgs, *sgr; int pn0; float sc;
    __device__ __forceinline__ void operator()(const AccT& acc, const Unit& u, int wr, int wc, int fr, int fq) const {
        const int row0 = u.pm * BM + wr * 64 + fr, tc = wc * 32 + 8 * fq, pn = u.pn + pn0;
        bf16_t* dst = pn < 4 ? v : (pn < 8 ? gs : (pn < 16 ? sgs : sgr));
        const int ldc = pn < 8 ? 1024 : 2048, cb = (pn < 8 ? (pn & 3) : (pn & 7)) * BM + tc;
        if (pn < 4) {
            EPI_LOOP_AM { const size_t off = (size_t)(row0 + ai * HALF + m * 16) * ldc + cb;
                EPI_LOOP_BJ { *(u32x4*)(dst + off + bj * HALF) = pack8(acc[ai][bj][m][0] * sc, acc[ai][bj][m][1] * sc); } }
        } else {
            const float kb = pn < 8 ? 1.0f : 0.0f;
            EPI_LOOP_AM { const size_t off = (size_t)(row0 + ai * HALF + m * 16) * ldc + cb;
                EPI_LOOP_BJ { f32x4 r[2];
#pragma unroll
                    for (int n = 0; n < 2; ++n) { const f32x4 x = acc[ai][bj][m][n] * sc, sg = sigm4(x); r[n] = sg * (1.0f - kb) + (x * sg) * kb; }
                    *(u32x4*)(dst + off + bj * HALF) = pack8(r[0], r[1]); } }
        }
    }
};
struct EpiS1 {
    static constexpr bool PERM = true, AFTER_DRAIN = false; static constexpr int NSTORE = 16; static constexpr bool HAS_MID = false;
    float* sloc;
    __device__ __forceinline__ void operator()(const AccT& acc, const Unit& u, int wr, int wc, int fr, int fq) const {
        const int row0 = u.pm * BM + wr * 64 + fr, tc = wc * 32 + 8 * fq;
        EPI_LOOP_AM { float* o = sloc + (size_t)(row0 + ai * HALF + m * 16) * 128 + tc; *(f32x4*)o = acc[ai][0][m][0]; *(f32x4*)(o + 4) = acc[ai][0][m][1]; }
    }
};
struct EpiS3 {
    static constexpr bool PERM = true, AFTER_DRAIN = false; static constexpr int NSTORE = 16; static constexpr bool HAS_MID = false;
    bf16_t* ysp;
    __device__ __forceinline__ void operator()(const AccT& acc, const Unit& u, int wr, int wc, int fr, int fq) const {
        const int g = u.pm >> 1, j0 = (u.pm & 1) * BM + wr * 64 + fr, cl0 = (u.pn & 1) * BM + wc * 32 + 8 * fq;
        EPI_LOOP_AM { const int j = j0 + ai * HALF + m * 16;
            EPI_LOOP_BJ { const int cl = cl0 + bj * HALF, i = cl >> 4, c0 = cl & 15;
                *(u32x4*)(ysp + (size_t)(j * T5 + i) * 1024 + g * 16 + c0) = pack8(gelu4(acc[ai][bj][m][0]), gelu4(acc[ai][bj][m][1])); } }
    }
};
struct EpiGLU {
    static constexpr bool PERM = true, AFTER_DRAIN = false; static constexpr int NSTORE = 16; static constexpr bool HAS_MID = false;
    const bf16_t* ysp; const float* bias; bf16_t* ys; int ldy;
    __device__ __forceinline__ void operator()(const AccT& acc, const Unit& u, int wr, int wc, int fr, int fq) const {
        const int row0 = u.pm * BM + wr * 64 + fr, col0 = u.pn * BM + wc * 32 + 8 * fq;
        f32x4 bv[2][2];
        EPI_LOOP_BJ { bv[bj][0] = *(const f32x4*)(bias + col0 + bj * HALF); bv[bj][1] = *(const f32x4*)(bias + col0 + bj * HALF + 4); }
        EPI_LOOP_AM { const size_t off = (size_t)(row0 + ai * HALF + m * 16) * 1024 + col0, offy = (size_t)(row0 + ai * HALF + m * 16) * ldy + col0;
            EPI_LOOP_BJ { f32x4 ya, yb; unpack8(*(const u32x4*)(ysp + off + bj * HALF), ya, yb);
                *(u32x4*)(ys + offy + bj * HALF) = pack8(ya * sigm4(acc[ai][bj][m][0] + bv[bj][0]), yb * sigm4(acc[ai][bj][m][1] + bv[bj][1])); } }
    }
};
struct EpiZG {
    static constexpr bool PERM = true, AFTER_DRAIN = false; static constexpr int NSTORE = 16; static constexpr bool HAS_MID = false;
    bf16_t *rat, *sgr; float sc;
    __device__ __forceinline__ void operator()(const AccT& acc, const Unit& u, int wr, int wc, int fr, int fq) const {
        const int row0 = u.pm * BM + wr * 64 + fr, col0 = u.pn * HALF + wc * 32 + 8 * fq; const float k2 = -1.4426950408889634f * sc;
        EPI_LOOP_AM { const size_t off = (size_t)(row0 + ai * HALF + m * 16) * 2048 + col0; f32x4 rr[2], sr[2];
#pragma unroll
            for (int n = 0; n < 2; ++n) { const f32x4 ts = acc[ai][0][m][n] * k2, tr = acc[ai][1][m][n] * k2;
#pragma unroll
                for (int x = 0; x < 4; ++x) { const float ds = 1.0f + __builtin_amdgcn_exp2f(ts[x]), dr = 1.0f + __builtin_amdgcn_exp2f(tr[x]); rr[n][x] = dr * __builtin_amdgcn_rcpf(ds); sr[n][x] = __builtin_amdgcn_rcpf(dr); } }
            *(u32x4*)(rat + off) = pack8(rr[0], rr[1]); *(u32x4*)(sgr + off) = pack8(sr[0], sr[1]); }
    }
};
struct EpiMF {
    static constexpr bool PERM = true, AFTER_DRAIN = false; static constexpr int NSTORE = 16; static constexpr bool HAS_MID = true;
    const bf16_t *rat, *sgr; bf16_t* mrg;
    __device__ __forceinline__ void mid(AccT& acc, const Unit& u, int wr, int wc, int fr, int fq) const {
        int row0 = u.pm * BM + wr * 64 + fr, col0 = u.pn * BM + wc * 32 + 8 * fq; asm volatile("" : "+v"(row0), "+v"(col0));
#pragma unroll
        for (int ai = 0; ai < 2; ++ai) { u32x4 rv[4][2];
#pragma unroll
            for (int m = 0; m < 4; ++m) { const size_t off = (size_t)(row0 + ai * HALF + m * 16) * 2048 + col0; EPI_LOOP_BJ rv[m][bj] = *(const u32x4*)(rat + off + bj * HALF); }
#pragma unroll
            for (int m = 0; m < 4; ++m) EPI_LOOP_BJ { f32x4 ra, rb; unpack8(rv[m][bj], ra, rb); acc[ai][bj][m][0] = acc[ai][bj][m][0] * ra; acc[ai][bj][m][1] = acc[ai][bj][m][1] * rb; }
            asm volatile("" ::: "memory"); }
    }
    __device__ __forceinline__ void operator()(const AccT& acc, const Unit& u, int wr, int wc, int fr, int fq) const {
        const int row0 = u.pm * BM + wr * 64 + fr, col0 = u.pn * BM + wc * 32 + 8 * fq;
        EPI_LOOP_AM { const size_t off = (size_t)(row0 + ai * HALF + m * 16) * 2048 + col0;
            EPI_LOOP_BJ { f32x4 ga, gb; unpack8(*(const u32x4*)(sgr + off + bj * HALF), ga, gb);
                *(u32x4*)(mrg + off + bj * HALF) = pack8(ga * acc[ai][bj][m][0], gb * acc[ai][bj][m][1]); } }
    }
};
struct EpiRes {
    static constexpr bool PERM = true, AFTER_DRAIN = false; static constexpr int NSTORE = 32; static constexpr bool HAS_MID = false;
    const float* x; float* o;
    __device__ __forceinline__ void operator()(const AccT& acc, const Unit& u, int wr, int wc, int fr, int fq) const {
        const int row0 = u.pm * BM + wr * 64 + fr, col0 = u.pn * BM + wc * 32 + 8 * fq;
        EPI_LOOP_AM { const size_t off = (size_t)(row0 + ai * HALF + m * 16) * 2048 + col0;
            EPI_LOOP_BJ { *(f32x4*)(o + off + bj * HALF) = *(const f32x4*)(x + off + bj * HALF) + acc[ai][bj][m][0];
                *(f32x4*)(o + off + bj * HALF + 4) = *(const f32x4*)(x + off + bj * HALF + 4) + acc[ai][bj][m][1]; } }
    }
};
struct EpiPlain {
    static constexpr bool PERM = true, AFTER_DRAIN = false; static constexpr int NSTORE = 16; static constexpr bool HAS_MID = false;
    bf16_t* o; int ldc;
    __device__ __forceinline__ void operator()(const AccT& acc, const Unit& u, int wr, int wc, int fr, int fq) const {
        const int row0 = u.pm * BM + wr * 64 + fr, col0 = u.pn * BM + wc * 32 + 8 * fq;
        EPI_LOOP_AM { const size_t off = (size_t)(row0 + ai * HALF + m * 16) * ldc + col0;
            EPI_LOOP_BJ { *(u32x4*)(o + off + bj * HALF) = pack8(acc[ai][bj][m][0], acc[ai][bj][m][1]); } }
    }
};
__device__ __forceinline__ unsigned pk4_fp8(float a, float b, float c, float d) { int r = 0; r = __builtin_amdgcn_cvt_pk_fp8_f32(a, b, r, false); r = __builtin_amdgcn_cvt_pk_fp8_f32(c, d, r, true); return (unsigned)r; }
constexpr float W8_SCALE = 64.0f, W8_INV = 1.0f / 64.0f;
struct EpiGU {
    static constexpr bool PERM = true, AFTER_DRAIN = false; static constexpr int NSTORE = 8; static constexpr bool HAS_MID = false;
    const float* bgu; unsigned char* act;
    __device__ __forceinline__ void operator()(const AccT& acc, const Unit& u, int wr, int wc, int fr, int fq) const {
        const int e = u.pn >> 4, ct = u.pn & 15, row0 = u.pm * BM + wr * 64 + fr, f0 = ct * HALF + wc * 32 + 8 * fq;
        const float* bp = bgu + (size_t)e * 4096 + 2 * f0;
        const f32x4 b0 = *(const f32x4*)bp, b1 = *(const f32x4*)(bp + 4), b2 = *(const f32x4*)(bp + 8), b3 = *(const f32x4*)(bp + 12);
        const f32x4 bg0 = (f32x4){b0[0], b0[2], b1[0], b1[2]}, bu0 = (f32x4){b0[1], b0[3], b1[1], b1[3]}, bg1 = (f32x4){b2[0], b2[2], b3[0], b3[2]}, bu1 = (f32x4){b2[1], b2[3], b3[1], b3[3]};
        const f32x4 bu0p = bu0 + 1.0f, bu1p = bu1 + 1.0f;
        EPI_LOOP_AM { const size_t off = (size_t)(row0 + ai * HALF + m * 16) * FFN + f0;
            f32x4 r[2];
#pragma unroll
            for (int n = 0; n < 2; ++n) { const f32x4 gv = acc[ai][0][m][n] * W8_INV + (n ? bg1 : bg0), uv = acc[ai][1][m][n] * W8_INV + (n ? bu1p : bu0p);
#pragma unroll
                for (int x = 0; x < 4; x += 2) { const f32x2 gg = (f32x2){fminf(gv[x], 7.0f), fminf(gv[x + 1], 7.0f)};
                    const f32x2 uu = (f32x2){__builtin_amdgcn_fmed3f(uv[x], -6.0f, 8.0f), __builtin_amdgcn_fmed3f(uv[x + 1], -6.0f, 8.0f)};
                    const f32x2 o = (gg * sigm2(gg * 1.702f)) * uu; r[n][x] = o.x; r[n][x + 1] = o.y; } }
            u32x2 w; w.x = pk4_fp8(r[0][0], r[0][1], r[0][2], r[0][3]); w.y = pk4_fp8(r[1][0], r[1][1], r[1][2], r[1][3]);
            *(u32x2*)(act + off) = w; }
    }
};
constexpr float YB_SCALE = 16.0f, YB_INV = 1.0f / 16.0f;
struct EpiDN {
    static constexpr bool PERM = true, AFTER_DRAIN = false; static constexpr int NSTORE = 16; static constexpr bool HAS_MID = false;
    const float* bdn; unsigned char* yb;
    __device__ __forceinline__ void operator()(const AccT& acc, const Unit& u, int wr, int wc, int fr, int fq) const {
        const int e = u.pn >> 3, ct = u.pn & 7, row0 = u.pm * BM + wr * 64 + fr, col0 = ct * BM + wc * 32 + 8 * fq;
        f32x4 bv[2][2];
        EPI_LOOP_BJ { bv[bj][0] = *(const f32x4*)(bdn + (size_t)e * 2048 + col0 + bj * HALF); bv[bj][1] = *(const f32x4*)(bdn + (size_t)e * 2048 + col0 + bj * HALF + 4); }
        EPI_LOOP_AM { const int row = row0 + ai * HALF + m * 16; const float gt = YB_SCALE; const size_t off = (size_t)row * 2048 + col0;
            EPI_LOOP_BJ { const f32x4 a = (acc[ai][bj][m][0] * W8_INV + bv[bj][0]) * gt, b = (acc[ai][bj][m][1] * W8_INV + bv[bj][1]) * gt;
                u32x2 w; w.x = pk4_fp8(a[0], a[1], a[2], a[3]); w.y = pk4_fp8(b[0], b[1], b[2], b[3]); *(u32x2*)(yb + off + bj * HALF) = w; } }
    }
};
struct EpiPLE {
    static constexpr bool PERM = true, AFTER_DRAIN = false; static constexpr int NSTORE = 16; static constexpr bool HAS_MID = false;
    const bf16_t* x3; const bf16_t* pp; bf16_t* o; float sc;
    __device__ __forceinline__ void operator()(const AccT& acc, const Unit& u, int wr, int wc, int fr, int fq) const {
        const int row0 = u.pm * BM + wr * 64 + fr, col0 = u.pn * BM + wc * 32 + 8 * fq;
        EPI_LOOP_AM { const size_t off = (size_t)(row0 + ai * HALF + m * 16) * 2048 + col0;
            EPI_LOOP_BJ { f32x4 pa, pb; unpack8(*(const u32x4*)(pp + off + bj * HALF), pa, pb);
                f32x4 xa, xb; unpack8(*(const u32x4*)(x3 + off + bj * HALF), xa, xb);
                *(u32x4*)(o + off + bj * HALF) = pack8(xa + sigm4(acc[ai][bj][m][0] * sc) * pa, xb + sigm4(acc[ai][bj][m][1] * sc) * pb); } }
    }
};

typedef int v8i_t __attribute__((ext_vector_type(8)));
typedef int v4i_t __attribute__((ext_vector_type(4)));
__device__ __forceinline__ v8i_t cat8(const bf16x8& lo, const bf16x8& hi) { const v4i_t a = __builtin_bit_cast(v4i_t, lo), b = __builtin_bit_cast(v4i_t, hi); return (v8i_t){a[0], a[1], a[2], a[3], b[0], b[1], b[2], b[3]}; }
template <class Epi, class Sched, bool ALIGN_EPI = false, bool SP2 = false, bool F8 = false>
__device__ __forceinline__ void gemm_phase(PG8_LAS unsigned char* lds, const Gemm g, const Sched& S, const Epi& E) {
    const int tid = threadIdx.x, wid = __builtin_amdgcn_readfirstlane(tid >> 6), lane = tid & 63, wr = wid >> 2, wc = wid & 3, fr = lane & 15, fq = lane >> 4;
    const int K = g.K, nt = K / BK;
    unsigned voffA[2], voffB[2];
#pragma unroll
    for (int i = 0; i < 2; ++i) { int R, C; stage_rc(tid * 16 + i * 8192, R, C); const int Rb = Epi::PERM ? ((R & ~31) + perm32(R & 31)) : R;
        voffA[i] = (unsigned)(R * g.lda + C) * 2u; voffB[i] = (unsigned)(Rb * g.ldb + C) * 2u; }
    const size_t kstep = (size_t)(BK * 2);
    const size_t hstepA = (size_t)HALF * g.lda * 2, hstepB = (size_t)HALF * g.ldb * 2;
    const size_t tstepA = 2 * hstepA, tstepB = 2 * hstepB;
    const unsigned ldsw = (unsigned)wid * 1024u;
    const int aoff = lds_byte(wr * 64 + fr, fq * 8), boff = lds_byte(wc * 32 + fr, fq * 8);
#define PG8_SA(b, h) (((b) * 2 + (h)) * HTB)
#define PG8_SB(b, h) ((4 + (b) * 2 + (h)) * HTB)
#define PG8_STAGE(bufoff, gbase, voff) do { _Pragma("unroll") for (int _i = 0; _i < 2; ++_i) \
        __builtin_amdgcn_global_load_lds((const unsigned*)((const char*)(gbase) + (voff)[_i]), (PG8_LAS unsigned*)(lds + (bufoff) + ldsw + _i * 8192), 16, 0, 0); } while (0)
#define PG8_LD8(p_) __builtin_shufflevector(*(const PG8_LAS v4i_t*)(p_), *(const PG8_LAS v4i_t*)((p_) + 1024), 0, 1, 2, 3, 4, 5, 6, 7)
#define PG8_LDA(dst, b, h) do { if constexpr (F8) { _Pragma("unroll") for (int m = 0; m < 4; ++m) dst##8[m] = PG8_LD8(lds + PG8_SA(b, h) + aoff + m * 2048); } else { \
        _Pragma("unroll") for (int m = 0; m < 4; ++m) _Pragma("unroll") for (int k = 0; k < 2; ++k) dst[m][k] = *(const PG8_LAS bf16x8*)(lds + PG8_SA(b, h) + aoff + m * 2048 + k * 1024); } } while (0)
#define PG8_LDB(dst, b, h) do { if constexpr (F8) { _Pragma("unroll") for (int n = 0; n < 2; ++n) dst##8[n] = PG8_LD8(lds + PG8_SB(b, h) + boff + n * 2048); } else { \
        _Pragma("unroll") for (int n = 0; n < 2; ++n) _Pragma("unroll") for (int k = 0; k < 2; ++k) dst[n][k] = *(const PG8_LAS bf16x8*)(lds + PG8_SB(b, h) + boff + n * 2048 + k * 1024); } } while (0)
#define PG8_MMA(ai, bj, At, Bt) do { __builtin_amdgcn_s_setprio(1); if constexpr (F8) { _Pragma("unroll") for (int m = 0; m < 4; ++m) _Pragma("unroll") for (int n = 0; n < 2; ++n) \
        asm volatile("v_mfma_scale_f32_16x16x128_f8f6f4 %0, %1, %2, %0, %3, %3 op_sel_hi:[0,0,0]" : "+v"(acc[ai][bj][m][n]) : "v"(Bt##8[n]), "v"(At##8[m]), "v"(sc8)); } else { \
        _Pragma("unroll") for (int m = 0; m < 4; ++m) _Pragma("unroll") for (int n = 0; n < 2; ++n) _Pragma("unroll") for (int k = 0; k < 2; ++k) \
        acc[ai][bj][m][n] = __builtin_amdgcn_mfma_f32_16x16x32_bf16(Bt[n][k], At[m][k], acc[ai][bj][m][n], 0, 0, 0); } __builtin_amdgcn_s_setprio(0); } while (0)
#define PG8_WAIT_V(n) asm volatile("s_waitcnt vmcnt(" #n ")" ::: "memory")
#define PG8_WAIT_V8R() do { if (fresh) asm volatile("s_waitcnt vmcnt(%0)" :: "n"(8 + Epi::NSTORE) : "memory"); else asm volatile("s_waitcnt vmcnt(8)" ::: "memory"); } while (0)
#define PG8_WAIT_L(n) asm volatile("s_waitcnt lgkmcnt(" #n ")" ::: "memory")
#define PG8_BAR __builtin_amdgcn_s_barrier()
#define PG8_SCHED __builtin_amdgcn_sched_barrier(0)
    Unit cur, nxt; int ui = 0;
    if (!S.next(0, cur)) return;
    f32x4 acc[2][2][4][2];
#pragma unroll
    for (int a = 0; a < 2; ++a)
#pragma unroll
        for (int b = 0; b < 2; ++b)
#pragma unroll
            for (int m = 0; m < 4; ++m)
#pragma unroll
                for (int n = 0; n < 2; ++n) acc[a][b][m][n] = (f32x4){0.f, 0.f, 0.f, 0.f};
    bf16x8 At[4][2], B0[2][2], B1[2][2]; v8i_t At8[4], B08[2], B18[2]; const int sc8 = 0x7f7f7f7f;
    const char* cA = (const char*)g.A + (size_t)cur.pa * tstepA; const char* cB = (const char*)g.Bt + (size_t)cur.pn * tstepB;
    S.a_ready(cur);
    if constexpr (SP2) {
        PG8_STAGE(PG8_SB(0, 0), cB, voffB); PG8_STAGE(PG8_SB(0, 1), cB + hstepB, voffB); PG8_STAGE(PG8_SA(0, 0), cA, voffA); PG8_STAGE(PG8_SA(0, 1), cA + hstepA, voffA);
        if (wr == 1) PG8_BAR;
        PG8_WAIT_V(2); PG8_BAR;
        PG8_STAGE(PG8_SB(1, 0), cB + kstep, voffB); PG8_STAGE(PG8_SA(1, 0), cA + kstep, voffA); PG8_STAGE(PG8_SB(1, 1), cB + hstepB + kstep, voffB);
        PG8_WAIT_V(6); PG8_BAR;
    } else {
        PG8_STAGE(PG8_SB(0, 0), cB, voffB); PG8_STAGE(PG8_SA(0, 0), cA, voffA); PG8_STAGE(PG8_SB(0, 1), cB + hstepB, voffB); PG8_STAGE(PG8_SA(0, 1), cA + hstepA, voffA);
        if (wr == 1) PG8_BAR;
        PG8_WAIT_V(4); PG8_BAR;
        PG8_STAGE(PG8_SB(1, 0), cB + kstep, voffB); PG8_STAGE(PG8_SA(1, 0), cA + kstep, voffA); PG8_STAGE(PG8_SB(1, 1), cB + hstepB + kstep, voffB);
        PG8_WAIT_V(6); PG8_BAR;
    }
    for (;;) {
        const bool has_next = S.next(ui + 1, nxt);
        const char* nA = has_next ? (const char*)g.A + (size_t)nxt.pa * tstepA : cA; const char* nB = has_next ? (const char*)g.Bt + (size_t)nxt.pn * tstepB : cB;
#pragma nounroll
        for (int t = 0; t < nt; t += 2) {
            const bool last = (t == nt - 2);
            const char* a1 = cA + (size_t)(t + 1) * kstep;
            const char* a2 = last ? nA : cA + (size_t)(t + 2) * kstep; const char* b2 = last ? nB : cB + (size_t)(t + 2) * kstep;
            const char* a3 = a2 + kstep; const char* b3 = b2 + kstep;
            if (last && has_next) S.a_ready(nxt);
            if constexpr (Epi::HAS_MID) { if (t == (nt >> 1)) E.mid(acc, cur, wr, wc, fr, fq); }
            if constexpr (SP2) {
            const bool fresh = (t == 0) && (ui > 0);
            PG8_LDB(B0, 0, 0); PG8_LDB(B1, 0, 1); PG8_SCHED; PG8_LDA(At, 0, 0); PG8_STAGE(PG8_SA(1, 1), a1 + hstepA, voffA);
            PG8_WAIT_V8R(); PG8_WAIT_L(0); PG8_BAR; PG8_MMA(0, 0, At, B0); PG8_MMA(0, 1, At, B1); PG8_BAR; PG8_SCHED;
            PG8_LDA(At, 0, 1); PG8_STAGE(PG8_SB(0, 0), b2, voffB); PG8_STAGE(PG8_SB(0, 1), b2 + hstepB, voffB); PG8_STAGE(PG8_SA(0, 0), a2, voffA);
            PG8_WAIT_V8R(); PG8_WAIT_L(0); PG8_BAR; PG8_MMA(1, 0, At, B0); PG8_MMA(1, 1, At, B1); PG8_BAR; PG8_SCHED;
            PG8_LDB(B0, 1, 0); PG8_LDB(B1, 1, 1); PG8_SCHED; PG8_LDA(At, 1, 0); PG8_STAGE(PG8_SA(0, 1), a2 + hstepA, voffA);
            PG8_WAIT_V(8); PG8_WAIT_L(0); PG8_BAR; PG8_MMA(0, 0, At, B0); PG8_MMA(0, 1, At, B1); PG8_BAR; PG8_SCHED;
            PG8_LDA(At, 1, 1); PG8_STAGE(PG8_SB(1, 0), b3, voffB); PG8_STAGE(PG8_SB(1, 1), b3 + hstepB, voffB); PG8_STAGE(PG8_SA(1, 0), a3, voffA);
            PG8_WAIT_V(8); PG8_WAIT_L(0); PG8_BAR; PG8_MMA(1, 0, At, B0); PG8_MMA(1, 1, At, B1); PG8_BAR; PG8_SCHED;
            } else {
            PG8_LDB(B0, 0, 0); PG8_SCHED; PG8_LDA(At, 0, 0); PG8_STAGE(PG8_SA(1, 1), a1 + hstepA, voffA);
            PG8_WAIT_L(8); PG8_BAR; PG8_WAIT_L(0); PG8_MMA(0, 0, At, B0); PG8_BAR; PG8_SCHED;
            PG8_LDB(B1, 0, 1); PG8_STAGE(PG8_SB(0, 0), b2, voffB);
            PG8_BAR; PG8_WAIT_L(0); PG8_MMA(0, 1, At, B1); PG8_BAR;
            PG8_LDA(At, 0, 1); PG8_STAGE(PG8_SA(0, 0), a2, voffA);
            PG8_BAR; PG8_WAIT_L(0); PG8_MMA(1, 0, At, B0); PG8_BAR; PG8_SCHED;
            PG8_STAGE(PG8_SB(0, 1), b2 + hstepB, voffB);
            PG8_WAIT_V(6); PG8_BAR; PG8_MMA(1, 1, At, B1); PG8_BAR;
            PG8_LDB(B0, 1, 0); PG8_SCHED; PG8_LDA(At, 1, 0); PG8_STAGE(PG8_SA(0, 1), a2 + hstepA, voffA);
            PG8_WAIT_L(8); PG8_BAR; PG8_WAIT_L(0); PG8_MMA(0, 0, At, B0); PG8_BAR; PG8_SCHED;
            PG8_LDB(B1, 1, 1); PG8_STAGE(PG8_SB(1, 0), b3, voffB);
            PG8_BAR; PG8_WAIT_L(0); PG8_MMA(0, 1, At, B1); PG8_BAR;
            PG8_LDA(At, 1, 1); PG8_STAGE(PG8_SA(1, 0), a3, voffA);
            PG8_BAR; PG8_WAIT_L(0); PG8_MMA(1, 0, At, B0); PG8_BAR; PG8_SCHED;
            PG8_STAGE(PG8_SB(1, 1), b3 + hstepB, voffB);
            PG8_WAIT_V(6); PG8_BAR; PG8_MMA(1, 1, At, B1); PG8_BAR;
            }
        }
        if constexpr (ALIGN_EPI) { if (wr == 0) PG8_BAR; }
        if constexpr (F8) asm volatile("s_nop 15\n\ts_nop 15" ::: "memory");
        if constexpr (!Epi::AFTER_DRAIN) { E(acc, cur, wr, wc, fr, fq); S.done(cur); }
        if (!has_next) break;
#pragma unroll
        for (int a = 0; a < 2; ++a)
#pragma unroll
            for (int b = 0; b < 2; ++b)
#pragma unroll
                for (int m = 0; m < 4; ++m)
#pragma unroll
                    for (int n = 0; n < 2; ++n) acc[a][b][m][n] = (f32x4){0.f, 0.f, 0.f, 0.f};
        cur = nxt; cA = nA; cB = nB; ++ui;
        if constexpr (ALIGN_EPI) { if (wr == 1) PG8_BAR; }
    }
    PG8_WAIT_V(0);
    if constexpr (!ALIGN_EPI) { if (wr == 0) PG8_BAR; }
    PG8_BAR;
#undef PG8_SA
#undef PG8_SB
#undef PG8_STAGE
#undef PG8_LDA
#undef PG8_LD8
#undef PG8_LDB
#undef PG8_MMA
#undef PG8_WAIT_V
#undef PG8_WAIT_V8R
#undef PG8_WAIT_L
#undef PG8_BAR
#undef PG8_SCHED
}
}

constexpr size_t MiB = 1u << 20;
constexpr size_t WS_CTL = 0, CTL_ZERO_BYTES = 1 * MiB;
constexpr size_t WS_BTIN  = 1 * MiB;
constexpr size_t WS_BTGLU = WS_BTIN + 36 * MiB;
constexpr size_t WS_BTPS  = WS_BTGLU + 2 * MiB;
constexpr size_t WS_BTPR  = WS_BTPS + 4 * MiB;
constexpr size_t WS_BTOUT = WS_BTPR + 4 * MiB;
constexpr size_t WS_BTPG  = WS_BTOUT + 8 * MiB;
constexpr size_t WS_BTPP  = WS_BTPG + 8 * MiB;
constexpr size_t WS_BTGU  = WS_BTPP + 1 * MiB;
constexpr size_t WS_BTDN  = WS_BTGU + 512 * MiB;
constexpr size_t WS_BTS3  = WS_BTDN + 256 * MiB;
constexpr size_t WS_BTS1  = WS_BTS3 + 40 * MiB;
constexpr size_t WS_ATAB  = WS_BTS1 + 16 * MiB;
constexpr size_t WS_CS    = WS_ATAB + 1 * MiB;
constexpr size_t WS_SN    = WS_CS + 4 * MiB;
constexpr size_t WS_WG    = WS_SN + 4 * MiB;
constexpr size_t WS_PBF   = WS_WG + 1 * MiB;
constexpr size_t WS_HB    = WS_PBF + 8 * MiB;
constexpr size_t WS_XG5   = WS_HB + 64 * MiB;
constexpr size_t WS_Q     = WS_XG5 + 40 * MiB;
constexpr size_t WS_K     = WS_Q + 32 * MiB;
constexpr size_t WS_V     = WS_K + 32 * MiB;
constexpr size_t WS_GS    = WS_V + 32 * MiB;
constexpr size_t WS_SGS   = WS_GS + 32 * MiB;
constexpr size_t WS_SGR   = WS_SGS + 64 * MiB;
constexpr size_t WS_SLOC  = WS_SGR + 64 * MiB;
constexpr size_t WS_KVT   = WS_SLOC + 16 * MiB;
constexpr size_t WS_RT    = WS_KVT + 64 * MiB;
constexpr size_t WS_YSP   = WS_RT + 32 * MiB;
constexpr size_t WS_YS    = WS_YSP + 32 * MiB;
constexpr size_t WS_YR    = WS_YS + 32 * MiB;
constexpr size_t WS_TMP   = WS_YR + 32 * MiB;
constexpr size_t WS_MRG   = WS_TMP + 128 * MiB;
constexpr size_t WS_X2    = WS_MRG + 64 * MiB;
constexpr size_t WS_PP    = WS_X2 + 128 * MiB;
constexpr size_t WS_TOKE  = WS_PP + 64 * MiB;
constexpr size_t WS_TOKG  = WS_TOKE + 1 * MiB;
constexpr size_t WS_TOKP  = WS_TOKG + 1 * MiB;
constexpr size_t WS_ROWG  = WS_TOKP + 1 * MiB;
constexpr size_t WS_AROW  = WS_ROWG + 1 * MiB;
constexpr size_t WS_BLKE  = WS_AROW + 1 * MiB;
constexpr size_t WS_XG    = WS_BLKE + 1 * MiB;
constexpr size_t WS_ACT   = WS_XG + 1024 * MiB;
constexpr size_t WS_YB    = WS_ACT + 288 * MiB;
constexpr size_t WS_BTIN8 = WS_YB + 288 * MiB;
constexpr size_t WS_END   = WS_BTIN8 + 8 * MiB;
constexpr size_t WS_H8    = WS_YB;
constexpr int CW_CNT = 64;
constexpr int CW_BAR = 4096;

constexpr int RING_OFF = 0, RING_BYTES = 131072;
constexpr int LDS_BYTES = 159744;
constexpr int LDSCTL_OFF = LDS_BYTES - 256;
constexpr int MOETAB_OFF = RING_BYTES;
constexpr int NWAVES = 8;

#define GAS __attribute__((address_space(1)))
#define LAS __attribute__((address_space(3)))
typedef unsigned short bf16;
typedef unsigned v4u __attribute__((ext_vector_type(4)));
typedef unsigned v2u __attribute__((ext_vector_type(2)));
typedef float f32x4 __attribute__((ext_vector_type(4)));
typedef float f32x16 __attribute__((ext_vector_type(16)));
typedef short bf16x8 __attribute__((ext_vector_type(8)));
#define RLX_AGENT __ATOMIC_RELAXED, __HIP_MEMORY_SCOPE_AGENT
#define LDS_WAIT() asm volatile("s_waitcnt lgkmcnt(0)" ::: "memory")
#define VM_WAIT() asm volatile("s_waitcnt vmcnt(0)" ::: "memory")
__device__ __forceinline__ unsigned f2bf(float f) { unsigned u = __builtin_bit_cast(unsigned, f); return (u + 0x7fffu + ((u >> 16) & 1u)) >> 16; }
__device__ __forceinline__ unsigned pk2(float lo, float hi) { return f2bf(lo) | (f2bf(hi) << 16); }
__device__ __forceinline__ float bf2f(unsigned short b) { return __builtin_bit_cast(float, (unsigned)b << 16); }

#define XB_TMO      128
#define XB_XCNT(j)  (256  + 64 * (j))
#define XB_XSUB(j)  (1280 + 64 * (j))
#define XB_XGEN(j)  (2304 + 64 * (j))
#define XB_TOP      3328
#define XB_TOPGEN   3392
#define XCD_BAR_WORDS 3456
#define XB_SPIN_CAP (1u << 20)
__device__ __forceinline__ unsigned xb_ld(unsigned* p)              { return __hip_atomic_load(p, __ATOMIC_RELAXED, __HIP_MEMORY_SCOPE_AGENT); }
__device__ __forceinline__ unsigned xb_add(unsigned* p, unsigned v) { return __hip_atomic_fetch_add(p, v, __ATOMIC_RELAXED, __HIP_MEMORY_SCOPE_AGENT); }
__device__ __forceinline__ unsigned xb_xcc_id() { return (unsigned)__builtin_amdgcn_s_getreg((3 << 11) | 20) & 0xFu; }
#define XB_SPIN(cond, bar) do { unsigned _sp = 0; while (cond) { __builtin_amdgcn_s_sleep(1); \
    if ((++_sp & 255u) == 0u) { if (xb_ld(&(bar)[XB_TMO])) break; if (_sp > XB_SPIN_CAP) { atomicAdd(&(bar)[XB_TMO], 1u); break; } } } } while (0)
struct XcdBarrier { unsigned* bar; unsigned x; volatile LAS unsigned* st; };
__device__ __forceinline__ XcdBarrier xcd_barrier_post(unsigned* bar, volatile LAS unsigned* st) {
    XcdBarrier b; b.bar = bar; b.x = xb_xcc_id(); b.st = st;
    if (threadIdx.x == 0) (void)xb_add(&bar[XB_XCNT(b.x)], 1u);
    return b;
}
__device__ __forceinline__ void xcd_barrier_complete(unsigned* bar, unsigned x, unsigned& nloc, unsigned& nx) {
    const unsigned G = gridDim.x * gridDim.y * gridDim.z;
    unsigned sum, cnt, mine, sp = 0u;
    for (;;) {
        sum = 0u; cnt = 0u; mine = 0u;
#pragma unroll
        for (unsigned j = 0; j < 16; ++j) { const unsigned c = xb_ld(&bar[XB_XCNT(j)]); sum += c; cnt += (c > 0u) ? 1u : 0u; mine = (j == x) ? c : mine; }
        if (sum == G) break;
        __builtin_amdgcn_s_sleep(1);
        if ((++sp & 255u) == 0u) { if (xb_ld(&bar[XB_TMO])) break; if (sp > XB_SPIN_CAP) { atomicAdd(&bar[XB_TMO], 1u); break; } }
    }
    nloc = mine > 0u ? mine : 1u; nx = cnt > 0u ? cnt : 1u;
}
__device__ __forceinline__ void xcd_barrier(const XcdBarrier& b) {
    asm volatile("s_waitcnt vmcnt(0)" ::: "memory");
    __syncthreads();
    if (threadIdx.x == 0) {
        unsigned* bar = b.bar;
        __builtin_amdgcn_s_waitcnt(0);
        unsigned nloc = b.st[0], nx = b.st[1];
        if (nloc == 0u) { xcd_barrier_complete(bar, b.x, nloc, nx); b.st[0] = nloc; b.st[1] = nx; }
        const unsigned old = xb_add(&bar[XB_XSUB(b.x)], 1u);
        const unsigned gen = old / nloc;
        if (old + 1u == (gen + 1u) * nloc) {
            __builtin_amdgcn_fence(__ATOMIC_RELEASE, "agent");
            asm volatile("s_waitcnt vmcnt(0)" ::: "memory");
            const unsigned og = xb_add(&bar[XB_TOP], 1u);
            const unsigned tg = og / nx;
            if (og + 1u == (tg + 1u) * nx) xb_add(&bar[XB_TOPGEN], 1u);
            else XB_SPIN(xb_ld(&bar[XB_TOPGEN]) == tg, bar);
            __builtin_amdgcn_fence(__ATOMIC_ACQUIRE, "agent");
            xb_add(&bar[XB_XGEN(b.x)], 1u);
            asm volatile("s_waitcnt vmcnt(0)" ::: "memory");
        } else {
            XB_SPIN(xb_ld(&bar[XB_XGEN(b.x)]) == gen, bar);
            __builtin_amdgcn_fence(__ATOMIC_ACQUIRE, "agent");
            asm volatile("s_waitcnt vmcnt(0)" ::: "memory");
        }
    }
    __syncthreads();
}

__device__ __forceinline__ float wave_sum(float v) {
#pragma unroll
    for (int o = 1; o < 64; o <<= 1) v += __shfl_xor(v, o);
    return v;
}
__device__ __forceinline__ int rowmap(int mode, int n) {
    if (mode == 1) { if (n < 1024 || n >= 3072) return n; const int nn = n - 1024, r = nn >> 10, hn = nn & 1023, head = hn >> 7, half = (hn >> 6) & 1, dd = hn & 63;
        return 1024 + r * 1024 + (head >> 1) * 256 + half * 128 + (head & 1) * 64 + dd; }
    if (mode == 2) { const int f = n >> 1, s = n & 1; return (f >> 7) * 256 + (f & 127) + 128 * s; }
    if (mode == 3) { const int s = n >> 11, c = n & 2047; return (c >> 7) * 256 + (c & 127) + 128 * s; }
    return n;
}
template <bool F8> __device__ __forceinline__ void transpose_run(const float* W, int K, int N, int ldw, void* WT, int ldo, int mode, int nmat, size_t sstride, size_t dstride, LAS float* scr, int gw, int NGW, int lane) {
    const int nbk = N / 64, per = (K / 64) * nbk, total = nmat * per;
    int it = gw; if (it >= total) return;
    float r[64];
#define TR_SRC(it_) ((const GAS float*)W + (size_t)((it_) / per) * sstride + (size_t)(64 * (((it_) % per) / nbk)) * ldw + 64 * (((it_) % per) % nbk) + lane)
    { const GAS float* src = TR_SRC(it);
#pragma unroll
      for (int i = 0; i < 64; ++i) r[i] = src[(size_t)i * ldw]; }
    for (;;) {
#pragma unroll
        for (int i = 0; i < 64; ++i) scr[i * 65 + lane] = F8 ? r[i] * 64.0f : r[i];
        LDS_WAIT(); asm volatile("" ::: "memory");
        const int mat = it / per, rr = it % per, k0 = 64 * (rr / nbk), n0 = 64 * (rr % nbk);
        const int nit = it + NGW; const bool hn = nit < total;
        if (hn) { const GAS float* src = TR_SRC(nit);
#pragma unroll
            for (int i = 0; i < 64; ++i) r[i] = src[(size_t)i * ldw]; }
        if constexpr (F8) { const int c = lane & 3; GAS unsigned char* dst = (GAS unsigned char*)WT + (size_t)mat * dstride;
#pragma unroll
            for (int j = 0; j < 4; ++j) { const int n = (lane >> 2) + 16 * j; const LAS float* s = scr + (16 * c) * 65 + n;
                v4u o; o.x = pg8::pk4_fp8(s[0 * 65], s[1 * 65], s[2 * 65], s[3 * 65]); o.y = pg8::pk4_fp8(s[4 * 65], s[5 * 65], s[6 * 65], s[7 * 65]);
                o.z = pg8::pk4_fp8(s[8 * 65], s[9 * 65], s[10 * 65], s[11 * 65]); o.w = pg8::pk4_fp8(s[12 * 65], s[13 * 65], s[14 * 65], s[15 * 65]);
                *(GAS v4u*)(dst + (size_t)rowmap(mode, n0 + n) * ldo + k0 + 16 * c) = o; }
        } else { const int c = lane & 7; GAS bf16* dst = (GAS bf16*)WT + (size_t)mat * dstride;
#pragma unroll
            for (int j = 0; j < 8; ++j) { const int n = (lane >> 3) + 8 * j; const LAS float* s = scr + (8 * c) * 65 + n;
                v4u o; o.x = pk2(s[0 * 65], s[1 * 65]); o.y = pk2(s[2 * 65], s[3 * 65]); o.z = pk2(s[4 * 65], s[5 * 65]); o.w = pk2(s[6 * 65], s[7 * 65]);
                *(GAS v4u*)(dst + (size_t)rowmap(mode, n0 + n) * ldo + k0 + 8 * c) = o; } }
        LDS_WAIT(); asm volatile("" ::: "memory");
        if (!hn) break;
        it = nit;
    }
#undef TR_SRC
}
#ifndef TR8_NT
#define TR8_NT 0
#endif
__device__ __forceinline__ void transpose_run8(const float* W, int K, int N, int ldw, unsigned char* WT, int mode, int nmat, size_t sstride, size_t dstride, LAS unsigned* scr, int gw, int NGW, int lane) {
    const int nkb = K / 256, per = nkb * (N / 64), total = nmat * per, nkh = nkb / 2;
#define TR_KB(it_) (2 * ((((it_) % per) >> 3) % nkh) + ((((it_) % per) >> 2) & 1))
#define TR_NB(it_) (4 * ((((it_) % per) >> 3) / nkh) + (((it_) % per) & 3))
    int it = gw; if (it >= total) return;
    const int kr = lane >> 4, nc = 4 * (lane & 15);
    f32x4 ra[16], rb[16];
#define TR_SRC(it_, q_) ((const GAS float*)W + (size_t)((it_) / per) * sstride + (size_t)(256 * TR_KB(it_) + 64 * (q_) + 16 * kr) * ldw + 64 * TR_NB(it_) + nc)
#define TR_LOAD(r_, it_, q_) do { const GAS float* src_ = TR_SRC(it_, q_); _Pragma("unroll") for (int i = 0; i < 16; ++i) r_[i] = TR8_NT ? __builtin_nontemporal_load((const GAS f32x4*)(src_ + (size_t)i * ldw)) : *(const GAS f32x4*)(src_ + (size_t)i * ldw); } while (0)
#define TR_PACK(r_, q_) do { _Pragma("unroll") for (int m = 0; m < 4; ++m) _Pragma("unroll") for (int c = 0; c < 4; ++c) \
        scr[(nc + c) * 65 + (q_) * 16 + 4 * kr + m] = pg8::pk4_fp8(r_[4 * m][c] * 64.0f, r_[4 * m + 1][c] * 64.0f, r_[4 * m + 2][c] * 64.0f, r_[4 * m + 3][c] * 64.0f); } while (0)
    TR_LOAD(ra, it, 0); TR_LOAD(rb, it, 1);
    for (;;) {
        const int nit = it + NGW; const bool hn = nit < total;
        TR_PACK(ra, 0); TR_LOAD(ra, it, 2);
        TR_PACK(rb, 1); TR_LOAD(rb, it, 3);
        TR_PACK(ra, 2); if (hn) TR_LOAD(ra, nit, 0);
        TR_PACK(rb, 3); if (hn) TR_LOAD(rb, nit, 1);
        LDS_WAIT(); asm volatile("" ::: "memory");
        const int mat = it / per, k0 = 256 * TR_KB(it), n0 = 64 * TR_NB(it), c16 = lane & 15;
        GAS unsigned char* dst = (GAS unsigned char*)WT + (size_t)mat * dstride;
#pragma unroll
        for (int j = 0; j < 16; ++j) { const int n = (lane >> 4) + 4 * j; const LAS unsigned* sp = scr + n * 65 + 4 * c16;
            v4u o; o.x = sp[0]; o.y = sp[1]; o.z = sp[2]; o.w = sp[3];
            if (TR8_NT) __builtin_nontemporal_store(o, (GAS v4u*)(dst + (size_t)rowmap(mode, n0 + n) * K + k0 + 16 * c16)); else *(GAS v4u*)(dst + (size_t)rowmap(mode, n0 + n) * K + k0 + 16 * c16) = o; }
        LDS_WAIT(); asm volatile("" ::: "memory");
        if (!hn) break;
        it = nit;
    }
#undef TR_SRC
#undef TR_LOAD
#undef TR_PACK
#undef TR_KB
#undef TR_NB
}
__device__ __forceinline__ void rms_row_bf16(const float* xrow, const float* gain, bf16* orow, unsigned char* orow8, int lane) {
    const f32x4* xr = (const f32x4*)xrow + lane; const f32x4* gr = (const f32x4*)gain + lane;
    f32x4 v[8]; float s = 0.f;
#pragma unroll
    for (int j = 0; j < 8; ++j) { v[j] = xr[64 * j]; s += (v[j].x * v[j].x + v[j].y * v[j].y) + (v[j].z * v[j].z + v[j].w * v[j].w); }
    const float rstd = 1.0f / sqrtf(wave_sum(s) * (1.0f / 2048.0f) + 1e-6f);
    v2u* o8 = (v2u*)orow + lane;
#pragma unroll
    for (int j = 0; j < 8; ++j) { const f32x4 g = gr[64 * j]; const f32x4 y = v[j] * rstd * g; v2u w; w.x = pk2(y.x, y.y); w.y = pk2(y.z, y.w); o8[64 * j] = w;
        ((unsigned*)orow8)[lane + 64 * j] = pg8::pk4_fp8(y.x, y.y, y.z, y.w); }
}

struct Args {
    const float* x; const float* p; const int* pos; const float* norm1_g; const float* w_in;
    const float* lam_re; const float* lam_im; const float* log_dt; const float* b_re; const float* b_im; const float* c_re; const float* c_im; const float* d_skip;
    const float* w_glu; const float* b_glu; const float* w_bs; const float* w_br; const float* w_out; const float* norm2_g; const float* router_w; const float* router_b;
    const float* w_gu; const float* b_gu; const float* w_dn; const float* b_dn; const float* norm3_g; const float* w_pg; const float* w_pp; const float* fin_g;
    float* out; unsigned char* ws; int ph_lo, ph_hi, li, pad;
};

__device__ __forceinline__ void s5_tables(const Args& a, int g, LAS unsigned char* lds, int tid) {
    LAS float* Pre = (LAS float*)lds;
    LAS float* Pim = Pre + 33 * 64;
    LAS float* Bre = Pim + 33 * 64;
    LAS float* Bim = Bre + 1024;
    LAS float* Cre = Bim + 1024;
    LAS float* Cim = Cre + 1024;
    LAS float* Kt  = Cim + 1024;
    const float dt = expf(a.log_dt[g]);
    for (int e = tid; e < 33 * 64; e += 512) { const int p = e >> 6, n = e & 63; const float lr = a.lam_re[g * 64 + n], li = a.lam_im[g * 64 + n];
        const float mag = expf(lr * dt * (float)p), ang = li * dt * (float)p; Pre[e] = mag * cosf(ang); Pim[e] = mag * sinf(ang); }
    for (int e = tid; e < 1024; e += 512) { const int n = e >> 4; const float lr = a.lam_re[g * 64 + n], li = a.lam_im[g * 64 + n];
        const float mag = expf(lr * dt), abr = mag * cosf(li * dt), abi = mag * sinf(li * dt);
        const float den = lr * lr + li * li, nr = abr - 1.0f, ni = abi, fre = (nr * lr + ni * li) / den, fim = (ni * lr - nr * li) / den;
        const float br = a.b_re[(size_t)g * 1024 + e], bi = a.b_im[(size_t)g * 1024 + e];
        Bre[e] = fre * br - fim * bi; Bim[e] = fre * bi + fim * br;
        Cre[e] = a.c_re[(size_t)g * 1024 + e]; Cim[e] = a.c_im[(size_t)g * 1024 + e]; }
    __syncthreads();
    { const int tau = tid >> 4, cp = tid & 15; float kacc[16];
#pragma unroll
      for (int c = 0; c < 16; ++c) kacc[c] = 0.f;
      for (int n = 0; n < 64; ++n) { const float pr = Pre[tau * 64 + n], pi = Pim[tau * 64 + n], br = Bre[n * 16 + cp], bi = Bim[n * 16 + cp];
          const float zr = pr * br - pi * bi, zi = pr * bi + pi * br;
#pragma unroll
          for (int c = 0; c < 16; ++c) kacc[c] += Cre[c * 64 + n] * zr - Cim[c * 64 + n] * zi; }
#pragma unroll
      for (int c = 0; c < 16; ++c) Kt[tau * 256 + c * 16 + cp] = kacc[c] + ((tau == 0 && c == cp) ? a.d_skip[g * 16 + c] : 0.f); }
    __syncthreads();
    bf16* bt3 = (bf16*)(a.ws + WS_BTS3) + (size_t)g * 512 * K5;
    for (int ch = tid; ch < 512 * 80; ch += 512) { const int row = ch / 80, cc = ch % 80, i = row >> 4, c = row & 15; float v[8];
        if (cc < 64) { const int ip = cc >> 1, c0 = (cc & 1) * 8;
#pragma unroll
            for (int x = 0; x < 8; ++x) v[x] = (i >= ip) ? Kt[(i - ip) * 256 + c * 16 + c0 + x] : 0.f;
        } else { const int m0 = (cc - 64) * 8;
#pragma unroll
            for (int x = 0; x < 8; ++x) { const int m = m0 + x, n = m & 63; const float cr = Cre[c * 64 + n], ci = Cim[c * 64 + n], pr = Pre[(i + 1) * 64 + n], pi = Pim[(i + 1) * 64 + n];
                v[x] = (m < 64) ? (cr * pr - ci * pi) : -(cr * pi + ci * pr); } }
        v4u o; o.x = pk2(v[0], v[1]); o.y = pk2(v[2], v[3]); o.z = pk2(v[4], v[5]); o.w = pk2(v[6], v[7]);
        *(v4u*)(bt3 + (size_t)row * K5 + cc * 8) = o; }
    bf16* bt1 = (bf16*)(a.ws + WS_BTS1) + (size_t)g * 256 * 512;
    for (int ch = tid; ch < 256 * 64; ch += 512) { const int row = ch >> 6, cc = ch & 63, ip = cc >> 1, c0 = (cc & 1) * 8; float v[8];
#pragma unroll
        for (int x = 0; x < 8; ++x) { if (row < 128) { const int n = row & 63; const float pr = Pre[(31 - ip) * 64 + n], pi = Pim[(31 - ip) * 64 + n], br = Bre[n * 16 + c0 + x], bi = Bim[n * 16 + c0 + x];
                v[x] = (row < 64) ? (pr * br - pi * bi) : (pr * bi + pi * br); } else v[x] = 0.f; }
        v4u o; o.x = pk2(v[0], v[1]); o.y = pk2(v[2], v[3]); o.z = pk2(v[4], v[5]); o.w = pk2(v[6], v[7]);
        *(v4u*)(bt1 + (size_t)row * 512 + cc * 8) = o; }
    float* at = (float*)(a.ws + WS_ATAB) + g * 128;
    if (tid < 64) { at[tid * 2] = Pre[32 * 64 + tid]; at[tid * 2 + 1] = Pim[32 * 64 + tid]; }
    __syncthreads();
}

__device__ __forceinline__ void s5_scan_item(const Args& a, int item, LAS unsigned char* lds, int tid) {
    LAS float* seg_re = (LAS float*)lds; LAS float* seg_im = seg_re + 512;
    const int sl = tid & 31, seg = tid >> 5, sidx = item * 32 + sl, g = sidx >> 6, n = sidx & 63;
    const float* at = (const float*)(a.ws + WS_ATAB) + g * 128 + n * 2; const float ar = at[0], ai = at[1];
    const float* sloc = (const float*)(a.ws + WS_SLOC) + ((size_t)g * NCH5 + seg * 32) * 128 + n;
    float er = 0.f, ei = 0.f;
#pragma unroll 8
    for (int j = 0; j < 32; ++j) { const float lr = sloc[j * 128], li = sloc[j * 128 + 64]; const float tr = ar * er - ai * ei + lr, ti = ar * ei + ai * er + li; er = tr; ei = ti; }
    seg_re[seg * 32 + sl] = er; seg_im[seg * 32 + sl] = ei;
    __syncthreads();
    float pr = ar, pi = ai;
#pragma unroll
    for (int q = 0; q < 5; ++q) { const float tr = pr * pr - pi * pi, ti = 2.f * pr * pi; pr = tr; pi = ti; }
    float sr = 0.f, si = 0.f;
    for (int s2 = 0; s2 < seg; ++s2) { const float tr = pr * sr - pi * si + seg_re[s2 * 32 + sl], ti = pr * si + pi * sr + seg_im[s2 * 32 + sl]; sr = tr; si = ti; }
    bf16* xg = (bf16*)(a.ws + WS_XG5) + ((size_t)g * NCH5 + seg * 32) * K5 + 512 + n;
#pragma unroll 8
    for (int j = 0; j < 32; ++j) { xg[(size_t)j * K5] = (bf16)f2bf(sr); xg[(size_t)j * K5 + 64] = (bf16)f2bf(si);
        const float lr = sloc[j * 128], li = sloc[j * 128 + 64]; const float tr = ar * sr - ai * si + lr, ti = ar * si + ai * sr + li; sr = tr; si = ti; }
    __syncthreads();
}

constexpr int RS = 136;
__device__ __forceinline__ float ret_l2g(int h) { return log2f(1.0f - exp2f(-5.0f - (float)h)); }
__device__ __forceinline__ v4u ret_scale8(v4u w, float z) {
    w.x = pk2(pg8::bf_lo(w.x) * z, pg8::bf_hi(w.x) * z); w.y = pk2(pg8::bf_lo(w.y) * z, pg8::bf_hi(w.y) * z); w.z = pk2(pg8::bf_lo(w.z) * z, pg8::bf_hi(w.z) * z); w.w = pk2(pg8::bf_lo(w.w) * z, pg8::bf_hi(w.w) * z); return w; }
__device__ __forceinline__ void ret_stage_rm(const bf16* src_, LAS bf16* dst, int tid) {
    const GAS bf16* src = (const GAS bf16*)src_; v4u wv[4];
#pragma unroll
    for (int q = 0; q < 4; ++q) { const int id = tid + 512 * q, row = id >> 4, c8 = id & 15; wv[q] = *(const GAS v4u*)(src + (size_t)row * 1024 + 8 * c8); }
#pragma unroll
    for (int q = 0; q < 4; ++q) { const int id = tid + 512 * q, row = id >> 4, c8 = id & 15; *(LAS v4u*)(dst + row * RS + 8 * c8) = wv[q]; }
}
template <bool ZETA> __device__ __forceinline__ void ret_stage_tr(const bf16* src_, LAS bf16* dst, int tid, float l2g) {
    const GAS bf16* src = (const GAS bf16*)src_; v4u wv[4];
#pragma unroll
    for (int q = 0; q < 4; ++q) { const int id = tid + 512 * q, row = id & 127, c8 = id >> 7; wv[q] = *(const GAS v4u*)(src + (size_t)row * 1024 + 8 * c8); }
#pragma unroll
    for (int q = 0; q < 4; ++q) { const int id = tid + 512 * q, row = id & 127, c8 = id >> 7; v4u w = wv[q];
        if (ZETA) w = ret_scale8(w, exp2f(l2g * (float)(127 - row)));
        LAS bf16* d = dst + (8 * c8) * RS + row;
        d[0 * RS] = (bf16)(w.x & 0xffffu); d[1 * RS] = (bf16)(w.x >> 16); d[2 * RS] = (bf16)(w.y & 0xffffu); d[3 * RS] = (bf16)(w.y >> 16);
        d[4 * RS] = (bf16)(w.z & 0xffffu); d[5 * RS] = (bf16)(w.z >> 16); d[6 * RS] = (bf16)(w.w & 0xffffu); d[7 * RS] = (bf16)(w.w >> 16); }
}
__device__ __forceinline__ void ret_kv_unit(const Args& a, int unit, LAS unsigned char* lds, int tid) {
    const int n = unit >> 3, h = unit & 7, t0 = n * RCH, lane = tid & 63, w = __builtin_amdgcn_readfirstlane(tid >> 6), fr = lane & 15, fg = lane >> 4;
    LAS bf16* Kt = (LAS bf16*)lds; LAS bf16* Vt = Kt + 128 * RS;
    const float l2g = ret_l2g(h);
    ret_stage_tr<true>((const bf16*)(a.ws + WS_K) + (size_t)t0 * 1024 + h * 128, Kt, tid, l2g);
    ret_stage_tr<false>((const bf16*)(a.ws + WS_V) + (size_t)t0 * 1024 + h * 128, Vt, tid, l2g);
    __syncthreads();
    bf16x8 af[4];
#pragma unroll
    for (int ks = 0; ks < 4; ++ks) af[ks] = *(const LAS bf16x8*)(Vt + (16 * w + fr) * RS + 32 * ks + 8 * fg);
    float* out = (float*)(a.ws + WS_KVT) + ((size_t)unit * 128 + 16 * w + 4 * fg) * 128 + fr;
#pragma unroll
    for (int dt = 0; dt < 8; ++dt) { f32x4 acc = (f32x4){0.f, 0.f, 0.f, 0.f};
#pragma unroll
        for (int ks = 0; ks < 4; ++ks) { const bf16x8 bfv = *(const LAS bf16x8*)(Kt + (16 * dt + fr) * RS + 32 * ks + 8 * fg);
            acc = __builtin_amdgcn_mfma_f32_16x16x32_bf16(af[ks], bfv, acc, 0, 0, 0); }
#pragma unroll
        for (int r = 0; r < 4; ++r) out[(size_t)r * 128 + 16 * dt] = acc[r]; }
    __syncthreads();
}
__device__ __forceinline__ void ret_state_scan(const Args& a, int gtid, int gthreads) {
    const float* kvt = (const float*)(a.ws + WS_KVT); bf16* rt = (bf16*)(a.ws + WS_RT);
    for (int idx = gtid; idx < RH * 128 * 128; idx += gthreads) { const int h = idx >> 14; const float dec = exp2f(128.0f * ret_l2g(h)); float st = 0.f;
#pragma unroll 8
        for (int n = 0; n < NRC; ++n) { rt[(size_t)n * 131072 + idx] = (bf16)f2bf(st); st = st * dec + kvt[(size_t)n * 131072 + idx]; } }
}
struct RetPre { v4u k[4], v[4]; bf16x8 q[4]; };
__device__ __forceinline__ void ret_out_load(const Args& a, int unit, int tid, RetPre& P) {
    const int n = unit >> 3, h = unit & 7, t0 = n * RCH, lane = tid & 63, w = tid >> 6, fr = lane & 15, fg = lane >> 4, il = 16 * w + fr;
    const GAS bf16* ks = (const GAS bf16*)(a.ws + WS_K) + (size_t)t0 * 1024 + h * 128; const GAS bf16* vs = (const GAS bf16*)(a.ws + WS_V) + (size_t)t0 * 1024 + h * 128;
#pragma unroll
    for (int q = 0; q < 4; ++q) { const int id = tid + 512 * q;
        P.k[q] = *(const GAS v4u*)(ks + (size_t)(id >> 4) * 1024 + 8 * (id & 15));
        P.v[q] = *(const GAS v4u*)(vs + (size_t)(id & 127) * 1024 + 8 * (id >> 7)); }
    const GAS bf16* qp = (const GAS bf16*)(a.ws + WS_Q) + (size_t)(t0 + il) * 1024 + h * 128 + 8 * fg;
#pragma unroll
    for (int ks2 = 0; ks2 < 4; ++ks2) P.q[ks2] = *(const GAS bf16x8*)(qp + 32 * ks2);
}
__device__ __forceinline__ void ret_out_units(const Args& a, int u0, int ustride, int uend, LAS unsigned char* lds, int tid) {
    if (u0 >= uend) return;
    const int lane = tid & 63, w = __builtin_amdgcn_readfirstlane(tid >> 6), fr = lane & 15, fg = lane >> 4, i0 = 16 * w, il = i0 + fr;
    LAS bf16* Ks = (LAS bf16*)lds; LAS bf16* Vt = Ks + 128 * RS; LAS bf16* Ps = Vt + 128 * RS; LAS bf16* Rs = Ps + 128 * RS;
    RetPre P; ret_out_load(a, u0, tid, P);
    for (int unit = u0; unit < uend; unit += ustride) {
        const int n = unit >> 3, h = unit & 7, t0 = n * RCH; const float l2g = ret_l2g(h);
#pragma unroll
        for (int q = 0; q < 4; ++q) { const int id = tid + 512 * q;
            *(LAS v4u*)(Ks + (id >> 4) * RS + 8 * (id & 15)) = P.k[q];
            const v4u wv = P.v[q]; LAS bf16* d = Vt + (8 * (id >> 7)) * RS + (id & 127);
            d[0 * RS] = (bf16)(wv.x & 0xffffu); d[1 * RS] = (bf16)(wv.x >> 16); d[2 * RS] = (bf16)(wv.y & 0xffffu); d[3 * RS] = (bf16)(wv.y >> 16);
            d[4 * RS] = (bf16)(wv.z & 0xffffu); d[5 * RS] = (bf16)(wv.z >> 16); d[6 * RS] = (bf16)(wv.w & 0xffffu); d[7 * RS] = (bf16)(wv.w >> 16); }
        bf16x8 qf[4]; v2u gt[8];
#pragma unroll
        for (int ks = 0; ks < 4; ++ks) qf[ks] = P.q[ks];
        __syncthreads();
        { const GAS bf16* gp = (const GAS bf16*)(a.ws + WS_GS) + (size_t)(t0 + il) * 1024 + h * 128 + 4 * fg;
#pragma unroll
          for (int et = 0; et < 8; ++et) gt[et] = *(const GAS v2u*)(gp + 16 * et); }
        v4u rv[4];
        { const GAS bf16* rs = (const GAS bf16*)(a.ws + WS_RT) + (size_t)unit * 16384;
#pragma unroll
          for (int q = 0; q < 4; ++q) { const int id = tid + 512 * q; rv[q] = *(const GAS v4u*)(rs + (size_t)(id >> 4) * 128 + 8 * (id & 15)); } }
        if (unit + ustride < uend) ret_out_load(a, unit + ustride, tid, P);
#pragma unroll
        for (int jt = 0; jt < 8; ++jt) {
            if (jt <= w) { f32x4 acc = (f32x4){0.f, 0.f, 0.f, 0.f};
#pragma unroll
                for (int ks = 0; ks < 4; ++ks) { const bf16x8 kf = *(const LAS bf16x8*)(Ks + (16 * jt + fr) * RS + 32 * ks + 8 * fg);
                    acc = __builtin_amdgcn_mfma_f32_16x16x32_bf16(kf, qf[ks], acc, 0, 0, 0); }
                float pv[4];
#pragma unroll
                for (int r = 0; r < 4; ++r) { const int j = 16 * jt + 4 * fg + r; pv[r] = (il >= j) ? acc[r] * exp2f(l2g * (float)(il - j)) : 0.f; }
                LAS unsigned* pp = (LAS unsigned*)(Ps + il * RS + 16 * jt + 4 * fg); pp[0] = pk2(pv[0], pv[1]); pp[1] = pk2(pv[2], pv[3]);
            } else if (jt == w + 1 && (w & 1) == 0) { LAS unsigned* pp = (LAS unsigned*)(Ps + il * RS + 16 * jt + 4 * fg); pp[0] = 0u; pp[1] = 0u; }
        }
#pragma unroll
        for (int q = 0; q < 4; ++q) { const int id = tid + 512 * q; *(LAS v4u*)(Rs + (id >> 4) * RS + 8 * (id & 15)) = rv[q]; }
        __syncthreads();
        f32x4 accI[8], accC[8];
#pragma unroll
        for (int et = 0; et < 8; ++et) { accI[et] = (f32x4){0.f, 0.f, 0.f, 0.f}; accC[et] = (f32x4){0.f, 0.f, 0.f, 0.f}; }
        const int nks = (w >> 1) + 1;
        for (int ks = 0; ks < nks; ++ks) { const bf16x8 pf = *(const LAS bf16x8*)(Ps + il * RS + 32 * ks + 8 * fg);
#pragma unroll
            for (int et = 0; et < 8; ++et) { const bf16x8 vf = *(const LAS bf16x8*)(Vt + (16 * et + fr) * RS + 32 * ks + 8 * fg);
                accI[et] = __builtin_amdgcn_mfma_f32_16x16x32_bf16(vf, pf, accI[et], 0, 0, 0); }
            __builtin_amdgcn_sched_barrier(0); }
#pragma unroll
        for (int ks = 0; ks < 4; ++ks) {
#pragma unroll
            for (int et = 0; et < 8; ++et) { const bf16x8 rf = *(const LAS bf16x8*)(Rs + (16 * et + fr) * RS + 32 * ks + 8 * fg);
                accC[et] = __builtin_amdgcn_mfma_f32_16x16x32_bf16(rf, qf[ks], accC[et], 0, 0, 0); }
            __builtin_amdgcn_sched_barrier(0); }
        const float xi = exp2f(l2g * (float)(il + 1));
        float s = 0.f;
#pragma unroll
        for (int et = 0; et < 8; ++et) { accI[et] = accI[et] + accC[et] * xi; s += (accI[et][0] + accI[et][1]) + (accI[et][2] + accI[et][3]); }
        s += __shfl_xor(s, 16); s += __shfl_xor(s, 32);
        const float mu = s * (1.0f / 128.0f); float q2 = 0.f;
#pragma unroll
        for (int et = 0; et < 8; ++et) { accI[et] = accI[et] - mu; q2 += (accI[et][0] * accI[et][0] + accI[et][1] * accI[et][1]) + (accI[et][2] * accI[et][2] + accI[et][3] * accI[et][3]); }
        q2 += __shfl_xor(q2, 16); q2 += __shfl_xor(q2, 32);
        const float rstd = 1.0f / sqrtf(q2 * (1.0f / 128.0f) + 1e-6f);
        GAS bf16* yp = (GAS bf16*)(a.ws + WS_YS) + (size_t)(t0 + il) * 2048 + 1024 + h * 128 + 4 * fg;
#pragma unroll
        for (int et = 0; et < 8; ++et) { const v2u gw = gt[et]; v2u o;
            o.x = pk2(accI[et][0] * rstd * pg8::bf_lo(gw.x), accI[et][1] * rstd * pg8::bf_hi(gw.x)); o.y = pk2(accI[et][2] * rstd * pg8::bf_lo(gw.y), accI[et][3] * rstd * pg8::bf_hi(gw.y));
            *(GAS v2u*)(yp + 16 * et) = o; }
        __syncthreads();
    }
}

__device__ __forceinline__ void router_item(const Args& a, int item, LAS unsigned char* lds, int tid) {
    LAS float* rs = (LAS float*)lds;
    LAS float* part = rs + 64;
    LAS float* lg = part + 4 * 64 * 33;
    LAS int* hist = (LAS int*)(lg + 64 * 33);
    LAS int* base = hist + 32;
    LAS int* slot = base + 32;
    const int lane = tid & 63, w = __builtin_amdgcn_readfirstlane(tid >> 6), tb = item * 64;
    const float* x2 = (const float*)(a.ws + WS_X2);
    if (tid < 32) hist[tid] = 0;
    { f32x4 va[8], vb[8];
#define P8_LOAD(V_, r_) do { const GAS f32x4* xr_ = (const GAS f32x4*)(x2 + (size_t)(tb + 8 * w + (r_)) * 2048) + lane; _Pragma("unroll") for (int j = 0; j < 8; ++j) V_[j] = xr_[64 * j]; } while (0)
#define P8_PROC(V_, r_) do { float s_ = 0.f; _Pragma("unroll") for (int j = 0; j < 8; ++j) s_ += (V_[j].x * V_[j].x + V_[j].y * V_[j].y) + (V_[j].z * V_[j].z + V_[j].w * V_[j].w); \
          const float rstd_ = 1.0f / sqrtf(wave_sum(s_) * (1.0f / 2048.0f) + 1e-6f); if (lane == 0) rs[8 * w + (r_)] = rstd_; } while (0)
      P8_LOAD(va, 0);
#pragma unroll
      for (int rp = 0; rp < 4; ++rp) { P8_LOAD(vb, 2 * rp + 1); P8_PROC(va, 2 * rp); if (rp < 3) P8_LOAD(va, 2 * rp + 2); P8_PROC(vb, 2 * rp + 1); }
#undef P8_LOAD
#undef P8_PROC
    }
    { const int tg = w & 1, kq = w >> 1, hl = lane >> 5, l31 = lane & 31;
      const GAS float* xp = (const GAS float*)x2 + (size_t)(tb + 32 * tg + l31) * 2048 + 512 * kq + 4 * hl;
      const GAS float* wp = (const GAS float*)(a.ws + WS_WG) + (size_t)(512 * kq + 4 * hl) * 32 + l31;
      f32x16 acc;
#pragma unroll
      for (int x = 0; x < 16; ++x) acc[x] = 0.f;
#pragma unroll 4
      for (int kk = 0; kk < 64; ++kk) { const f32x4 av = *(const GAS f32x4*)(xp + 8 * kk); const GAS float* wq = wp + (size_t)(8 * kk) * 32;
          acc = __builtin_amdgcn_mfma_f32_32x32x2f32(av.x, wq[0], acc, 0, 0, 0); acc = __builtin_amdgcn_mfma_f32_32x32x2f32(av.y, wq[32], acc, 0, 0, 0);
          acc = __builtin_amdgcn_mfma_f32_32x32x2f32(av.z, wq[64], acc, 0, 0, 0); acc = __builtin_amdgcn_mfma_f32_32x32x2f32(av.w, wq[96], acc, 0, 0, 0); }
#pragma unroll
      for (int x = 0; x < 16; ++x) { const int tl = (x & 3) + 8 * (x >> 2) + 4 * hl; part[(kq * 64 + 32 * tg + tl) * 33 + l31] = acc[x]; } }
    __syncthreads();
    for (int e = tid; e < 64 * 32; e += 512) { const int tl = e >> 5, ex = e & 31;
        lg[tl * 33 + ex] = rs[tl] * ((part[(0 * 64 + tl) * 33 + ex] + part[(1 * 64 + tl) * 33 + ex]) + (part[(2 * 64 + tl) * 33 + ex] + part[(3 * 64 + tl) * 33 + ex])) + a.router_b[ex]; }
    __syncthreads();
    int e0 = 0, e1 = 0, e2 = 0, e3 = 0, r0 = 0, r1 = 0, r2 = 0, r3 = 0; float g0 = 0.f, g1 = 0.f, g2 = 0.f, g3 = 0.f;
    if (tid < 64) { const LAS float* L = lg + tid * 33; float v0 = -3.0e38f, v1 = -3.0e38f, v2 = -3.0e38f, v3 = -3.0e38f;
        for (int ex = 0; ex < 32; ++ex) { const float v = L[ex]; if (v > v0) { v0 = v; e0 = ex; } }
        for (int ex = 0; ex < 32; ++ex) { const float v = L[ex]; if (ex != e0 && v > v1) { v1 = v; e1 = ex; } }
        for (int ex = 0; ex < 32; ++ex) { const float v = L[ex]; if (ex != e0 && ex != e1 && v > v2) { v2 = v; e2 = ex; } }
        for (int ex = 0; ex < 32; ++ex) { const float v = L[ex]; if (ex != e0 && ex != e1 && ex != e2 && v > v3) { v3 = v; e3 = ex; } }
        const float p0 = 1.0f, p1 = expf(v1 - v0), p2 = expf(v2 - v0), p3 = expf(v3 - v0), inv = 1.0f / (p0 + p1 + p2 + p3);
        g0 = p0 * inv; g1 = p1 * inv; g2 = p2 * inv; g3 = p3 * inv;
        r0 = __hip_atomic_fetch_add(&hist[e0], 1, __ATOMIC_RELAXED, __HIP_MEMORY_SCOPE_WORKGROUP); r1 = __hip_atomic_fetch_add(&hist[e1], 1, __ATOMIC_RELAXED, __HIP_MEMORY_SCOPE_WORKGROUP);
        r2 = __hip_atomic_fetch_add(&hist[e2], 1, __ATOMIC_RELAXED, __HIP_MEMORY_SCOPE_WORKGROUP); r3 = __hip_atomic_fetch_add(&hist[e3], 1, __ATOMIC_RELAXED, __HIP_MEMORY_SCOPE_WORKGROUP); }
    __syncthreads();
    if (tid < 32) base[tid] = (int)__hip_atomic_fetch_add((unsigned*)(a.ws + WS_CTL) + CW_CNT + tid, (unsigned)hist[tid], RLX_AGENT);
    __syncthreads();
    if (tid < 64) { const int t = tb + tid; int* te = (int*)(a.ws + WS_TOKE) + t * 4; float* tg = (float*)(a.ws + WS_TOKG) + t * 4; int* tp = (int*)(a.ws + WS_TOKP) + t * 4;
        const int q0 = base[e0] + r0, q1 = base[e1] + r1, q2 = base[e2] + r2, q3 = base[e3] + r3;
        te[0] = e0; te[1] = e1; te[2] = e2; te[3] = e3; tg[0] = g0; tg[1] = g1; tg[2] = g2; tg[3] = g3; tp[0] = q0; tp[1] = q1; tp[2] = q2; tp[3] = q3;
        slot[tid * 4] = e0 * 16384 + q0; slot[tid * 4 + 1] = e1 * 16384 + q1; slot[tid * 4 + 2] = e2 * 16384 + q2; slot[tid * 4 + 3] = e3 * 16384 + q3; }
    __syncthreads();
    { const GAS f32x4* gr = (const GAS f32x4*)a.norm2_g + lane; GAS unsigned char* xg = (GAS unsigned char*)(a.ws + WS_XG); f32x4 va[8], vb[8];
#define P8_LOAD(V_, r_) do { const GAS f32x4* xr_ = (const GAS f32x4*)(x2 + (size_t)(tb + 8 * w + (r_)) * 2048) + lane; _Pragma("unroll") for (int j = 0; j < 8; ++j) V_[j] = xr_[64 * j]; } while (0)
#define P8_PROC(V_, r_) do { const int tl_ = 8 * w + (r_); const float rstd_ = rs[tl_]; const int s0 = slot[tl_ * 4], s1 = slot[tl_ * 4 + 1], s2 = slot[tl_ * 4 + 2], s3 = slot[tl_ * 4 + 3]; \
          GAS unsigned* d0 = (GAS unsigned*)(xg + (size_t)s0 * 2048) + lane; GAS unsigned* d1 = (GAS unsigned*)(xg + (size_t)s1 * 2048) + lane; \
          GAS unsigned* d2 = (GAS unsigned*)(xg + (size_t)s2 * 2048) + lane; GAS unsigned* d3 = (GAS unsigned*)(xg + (size_t)s3 * 2048) + lane; \
          _Pragma("unroll") for (int j = 0; j < 8; ++j) { const f32x4 v = V_[j], g = gr[64 * j]; const unsigned dw = pg8::pk4_fp8(v.x * rstd_ * g.x, v.y * rstd_ * g.y, v.z * rstd_ * g.z, v.w * rstd_ * g.w); \
              d0[64 * j] = dw; d1[64 * j] = dw; d2[64 * j] = dw; d3[64 * j] = dw; } } while (0)
      P8_LOAD(va, 0);
#pragma unroll
      for (int rp = 0; rp < 4; ++rp) { P8_LOAD(vb, 2 * rp + 1); P8_PROC(va, 2 * rp); if (rp < 3) P8_LOAD(va, 2 * rp + 2); P8_PROC(vb, 2 * rp + 1); }
#undef P8_LOAD
#undef P8_PROC
    }
    __syncthreads();
}
__device__ __forceinline__ int moe_table(const Args& a, LAS unsigned char* lds, int tid) {
    LAS int* tab = (LAS int*)(lds + MOETAB_OFF);
    if (tid < 64) {
        const int e = tid, c = (e < NEXP) ? (int)__hip_atomic_load((unsigned*)(a.ws + WS_CTL) + CW_CNT + e, RLX_AGENT) : 0, nt = (c + 255) >> 8;
        int incl = nt;
#pragma unroll
        for (int o = 1; o < 64; o <<= 1) { const int v = __shfl_up(incl, o); if (tid >= o) incl += v; }
        const int start = incl - nt;
        if (e <= NEXP) tab[e] = start;
        for (int j = 0; j < nt; ++j) tab[33 + start + j] = e; }
    __syncthreads();
    return __builtin_amdgcn_readfirstlane(tab[NEXP]);
}

constexpr int N_PHASES = 15;
__global__ void __launch_bounds__(NWAVES * 64, 2) mk_fwd(Args kargs) {
    extern __shared__ __attribute__((aligned(16))) unsigned char lds_raw[];
    LAS unsigned char* lds = (LAS unsigned char*)lds_raw;
    const int tid = threadIdx.x, lane = tid & 63, wave = __builtin_amdgcn_readfirstlane(tid >> 6);
    const int G = gridDim.x, bx = blockIdx.x, gw = bx * NWAVES + wave, NGW = G * NWAVES, gtid = bx * (NWAVES * 64) + tid, GT = G * NWAVES * 64;
    unsigned char* const ws = kargs.ws;
#define LOAD_ARGS() const __attribute__((address_space(4))) Args* ap_ = (const __attribute__((address_space(4))) Args*)__builtin_amdgcn_kernarg_segment_ptr(); asm volatile("" : "+s"(ap_)); Args a; { const __attribute__((address_space(4))) unsigned long long* q_ = (const __attribute__((address_space(4))) unsigned long long*)ap_; unsigned long long* d_ = (unsigned long long*)&a; _Pragma("unroll") for (int i_ = 0; i_ < (int)(sizeof(Args) / 8); ++i_) d_[i_] = q_[i_]; }
    for (int u = tid; u < (LDS_BYTES - LDSCTL_OFF) / 4; u += NWAVES * 64) ((LAS unsigned*)(lds + LDSCTL_OFF))[u] = 0u;
    __syncthreads();
    XcdBarrier bar = xcd_barrier_post((unsigned*)(ws + WS_CTL) + CW_BAR + kargs.li * XCD_BAR_WORDS, (volatile LAS unsigned*)(lds + LDSCTL_OFF) + 8);
    const int lo = kargs.ph_lo, hi = kargs.ph_hi;
#ifndef PH_MASK
#define PH_MASK 0x7fff
#endif
#define IN(k) (((PH_MASK >> (k)) & 1) && lo <= (k) && (k) < hi)
#define SEAM(k) do { if (IN(k) && IN((k) + 1)) xcd_barrier(bar); } while (0)
    bf16* const HB = (bf16*)(ws + WS_HB);
#ifndef STAG_US
#define STAG_US 0
#endif
#define STAGGER(us) do { if ((us) > 0 && (bx & 1)) { const unsigned long long t0_ = __builtin_amdgcn_s_memrealtime(); while (__builtin_amdgcn_s_memrealtime() - t0_ < (unsigned long long)(us) * 100ull) __builtin_amdgcn_s_sleep(32); } } while (0)

#ifndef MK_SPLIT
#define MK_SPLIT 0
#endif
    const bool split = MK_SPLIT && (G == 256);
    const bool is_conv = !split || (((bx >> 3) & 3) == 3);
    const bool is_gemm = !split || !is_conv;
    const int convG = split ? 64 : G, convRank = split ? ((bx >> 5) * 8 + (bx & 7)) : bx;
    const int gemmG = split ? 192 : G, gemmRank = split ? ((bx >> 5) * 24 + (bx & 31)) : bx;
    if (IN(0)) { LOAD_ARGS();
        const int nsk = (G > 2 * NG5) ? NG5 : 0;
        if (bx < nsk || nsk == 0) for (int g = bx; g < NG5; g += G) s5_tables(a, g, lds, tid);
        if (bx >= nsk) { LAS float* scr = (LAS float*)(lds + wave * 16640);
            const int gw2 = (bx - nsk) * NWAVES + wave, NGW2 = (G - nsk) * NWAVES, gt2 = (bx - nsk) * (NWAVES * 64) + tid, GT2 = (G - nsk) * NWAVES * 64;
            transpose_run<false>(a.w_in, 2048, 5120, INC, ws + WS_BTIN, 2048, 1, 1, 0, 0, scr, gw2, NGW2, lane);
            transpose_run8(a.w_in + 5120, 2048, 4096, INC, ws + WS_BTIN8, 3, 1, 0, 0, (LAS unsigned*)scr, gw2, NGW2, lane);
            transpose_run<false>(a.w_pp, PLED, 2048, 2048, ws + WS_BTPP, PLED, 0, 1, 0, 0, scr, gw2, NGW2, lane);
            for (int t = gw2; t < SEQ; t += NGW2) rms_row_bf16(a.x + (size_t)t * 2048, a.norm1_g, HB + (size_t)t * 2048, ws + WS_H8 + (size_t)t * 2048, lane);
            { float* cs = (float*)(ws + WS_CS); float* sn = (float*)(ws + WS_SN);
              for (int e = gt2; e < SEQ * 64; e += GT2) { const int t = e >> 6, i = e & 63; const float inv = powf(10000.0f, -(float)i / 64.0f), ang = (float)a.pos[t] * inv; cs[e] = cosf(ang); sn[e] = sinf(ang); } }
            { float* wg = (float*)(ws + WS_WG); for (int e = gt2; e < 2048 * 32; e += GT2) wg[e] = a.norm2_g[e >> 5] * a.router_w[e]; }
            { v2u* pb = (v2u*)(ws + WS_PBF); const f32x4* pf = (const f32x4*)a.p;
              for (int e = gt2; e < SEQ * PLED / 4; e += GT2) { const f32x4 v = pf[e]; v2u o; o.x = pk2(v.x, v.y); o.y = pk2(v.z, v.w); pb[e] = o; } } }
    }
    SEAM(0);
    if (IN(1)) { LOAD_ARGS();
#ifndef MK_INTERLEAVE
#define MK_INTERLEAVE 0
#endif
        const bool gemm_first = MK_INTERLEAVE && !split && (((bx >> 3) & 1) != 0);
#define P1_CONV() do { LAS float* scr = (LAS float*)(lds + wave * 16640); const int cw = convRank * NWAVES + wave, NCW = convG * NWAVES; \
            transpose_run<false>(a.w_glu, 1024, 1024, 1024, ws + WS_BTGLU, 1024, 0, 1, 0, 0, scr, cw, NCW, lane); \
            transpose_run<false>(a.w_bs, 1024, 2048, 2048, ws + WS_BTPS, 2048, 0, 1, 0, 0, scr, cw, NCW, lane); \
            transpose_run<false>(a.w_br, 1024, 2048, 2048, (bf16*)(ws + WS_BTPS) + 1024, 2048, 0, 1, 0, 0, scr, cw, NCW, lane); \
            transpose_run<false>(a.w_out, 2048, 2048, 2048, ws + WS_BTOUT, 2048, 0, 1, 0, 0, scr, cw, NCW, lane); \
            transpose_run<true>(a.w_pg, 2048, 2048, 2048, ws + WS_BTPG, 2048, 0, 1, 0, 0, scr, cw, NCW, lane); \
            transpose_run8(a.w_gu, 2048, 4096, 4096, ws + WS_BTGU, 2, NEXP, (size_t)2048 * 4096, (size_t)4096 * 2048, (LAS unsigned*)scr, cw, NCW, lane); \
            transpose_run8(a.w_dn, 2048, 2048, 2048, ws + WS_BTDN, 0, NEXP, (size_t)2048 * 2048, (size_t)2048 * 2048, (LAS unsigned*)scr, cw, NCW, lane); \
            __syncthreads(); } while (0)
#define P1_GEMMS() do { \
        { pg8::Gemm g{HB, (const bf16*)(ws + WS_BTIN), 2048, 2048, 2048}; pg8::StaticOrder S; S.init(SEQ, 1024, gemmG, gemmRank); \
          pg8::EpiZU E{(bf16*)(ws + WS_XG5)}; \
          pg8::gemm_phase<pg8::EpiZU, pg8::StaticOrder, true, true>(lds + RING_OFF, g, S, E); } \
        { pg8::Gemm g{HB, (const bf16*)(ws + WS_BTIN) + (size_t)1024 * 2048, 2048, 2048, 2048}; pg8::StaticOrder S; S.init(SEQ, 2048, gemmG, gemmRank); \
          pg8::EpiZR E{(bf16*)(ws + WS_Q), (bf16*)(ws + WS_K), (const float*)(ws + WS_CS), (const float*)(ws + WS_SN)}; \
          pg8::gemm_phase<pg8::EpiZR, pg8::StaticOrder, true, true>(lds + RING_OFF, g, S, E); } \
        { pg8::Gemm g{HB, (const bf16*)(ws + WS_BTIN) + (size_t)3072 * 2048, 2048, 2048, 2048}; pg8::StaticOrder S; S.init(SEQ, 2048, gemmG, gemmRank); \
          pg8::EpiZA E{(bf16*)(ws + WS_V), (bf16*)(ws + WS_GS), (bf16*)(ws + WS_SGS), (bf16*)(ws + WS_SGR), 0, 1.0f}; \
          pg8::gemm_phase<pg8::EpiZA, pg8::StaticOrder, true, true>(lds + RING_OFF, g, S, E); } \
        { pg8::Gemm g{(const bf16*)(ws + WS_H8), (const bf16*)(ws + WS_BTIN8), 1024, 1024, 1024}; pg8::StaticOrder S; S.init(SEQ, 4096, gemmG, gemmRank);     \
          pg8::EpiZG E{(bf16*)(ws + WS_SGS), (bf16*)(ws + WS_SGR), pg8::W8_INV}; \
          pg8::gemm_phase<pg8::EpiZG, pg8::StaticOrder, true, true, true>(lds + RING_OFF, g, S, E); } \
        __syncthreads(); } while (0)
        if (gemm_first) { P1_GEMMS(); P1_CONV(); }
        else { if (is_conv) P1_CONV(); if (is_gemm) P1_GEMMS(); }
#undef P1_CONV
#undef P1_GEMMS
        if (is_conv) { pg8::Gemm g{(const bf16*)(ws + WS_PBF), (const bf16*)(ws + WS_BTPP), PLED, PLED, PLED}; pg8::StaticOrder S; S.init(SEQ, 2048, convG, convRank);
          pg8::EpiPlain E{(bf16*)(ws + WS_PP), 2048};
          pg8::gemm_phase<pg8::EpiPlain, pg8::StaticOrder, true, true>(lds + RING_OFF, g, S, E); }
    }
    SEAM(1);
    if (IN(2)) { LOAD_ARGS();
        { pg8::Gemm g{(const bf16*)(ws + WS_XG5), (const bf16*)(ws + WS_BTS1), K5, 512, 512}; pg8::OrderS1 S{G, bx}; pg8::EpiS1 E{(float*)(ws + WS_SLOC)};
          pg8::gemm_phase<pg8::EpiS1, pg8::OrderS1, false, true>(lds + RING_OFF, g, S, E); }
        __syncthreads();
        for (int u = bx; u < NRC * RH; u += G) ret_kv_unit(a, u, lds, tid);
    }
    SEAM(2);
    if (IN(3)) { LOAD_ARGS();
        for (int it = G - 1 - bx; it < 128; it += G) s5_scan_item(a, it, lds, tid);
        ret_state_scan(a, gtid, GT);
    }
    SEAM(3);
    if (IN(4)) { LOAD_ARGS();
#if defined(P4_SKIP_GEMM)
        if (kargs.li == 0)
#endif
        { pg8::Gemm g{(const bf16*)(ws + WS_XG5), (const bf16*)(ws + WS_BTS3), K5, K5, K5}; pg8::OrderS3 S{G, bx}; pg8::EpiS3 E{(bf16*)(ws + WS_YSP)};
          pg8::gemm_phase<pg8::EpiS3, pg8::OrderS3, false, true>(lds + RING_OFF, g, S, E); }
        __syncthreads();
#if defined(P4_SKIP_RET)
        if (kargs.li == 0)
#endif
        ret_out_units(a, bx, G, NRC * RH, lds, tid);
    }
    SEAM(4);
    if (IN(5)) { LOAD_ARGS();
        pg8::Gemm g{(const bf16*)(ws + WS_YSP), (const bf16*)(ws + WS_BTGLU), 1024, 1024, 1024}; pg8::StaticOrder S; S.init(SEQ, 1024, G, bx);
        pg8::EpiGLU E{(const bf16*)(ws + WS_YSP), a.b_glu, (bf16*)(ws + WS_YS), 2048};
        pg8::gemm_phase<pg8::EpiGLU, pg8::StaticOrder, true, true>(lds + RING_OFF, g, S, E);
    }
    SEAM(5);
#ifdef EXTRA_BAR
    for (int eb_ = 0; eb_ < EXTRA_BAR; ++eb_) xcd_barrier(bar);
#endif
    if (IN(6)) { LOAD_ARGS();
        pg8::Gemm g{(const bf16*)(ws + WS_YS), (const bf16*)(ws + WS_BTPS), 2048, 2048, 2048}; pg8::StaticOrder S; S.init(SEQ, 2048, G, bx);
        pg8::EpiMF E{(const bf16*)(ws + WS_SGS), (const bf16*)(ws + WS_SGR), (bf16*)(ws + WS_MRG)};
        pg8::gemm_phase<pg8::EpiMF, pg8::StaticOrder, true, true>(lds + RING_OFF, g, S, E);
    }
    SEAM(6);
    if (IN(7)) { LOAD_ARGS(); STAGGER(STAG_US);
        pg8::Gemm g{(const bf16*)(ws + WS_MRG), (const bf16*)(ws + WS_BTOUT), 2048, 2048, 2048}; pg8::StaticOrder S; S.init(SEQ, 2048, G, bx);
        pg8::EpiRes E{a.x, (float*)(ws + WS_X2)};
        pg8::gemm_phase<pg8::EpiRes, pg8::StaticOrder, true, true>(lds + RING_OFF, g, S, E);
    }
    SEAM(7);
    if (IN(8)) { LOAD_ARGS(); for (int it = bx; it < SEQ / 64; it += G) router_item(a, it, lds, tid); }
    do { if (IN(8) && IN(10)) xcd_barrier(bar); } while (0);
    if (IN(10)) { LOAD_ARGS();
        const int nrt = moe_table(a, lds, tid);
        pg8::Gemm g{(const bf16*)(ws + WS_XG), (const bf16*)(ws + WS_BTGU), 1024, 1024, 1024};     pg8::OrderMoe S; S.so.init(nrt * 256, 4096, G, bx); S.tab = (const LAS int*)(lds + MOETAB_OFF); S.ntn = 16; S.gather_a = true;
        pg8::EpiGU E{a.b_gu, ws + WS_ACT};
        pg8::gemm_phase<pg8::EpiGU, pg8::OrderMoe, true, true, true>(lds + RING_OFF, g, S, E);
    }
    SEAM(10);
    if (IN(11)) { LOAD_ARGS();
        const int nrt = moe_table(a, lds, tid);
        pg8::Gemm g{(const bf16*)(ws + WS_ACT), (const bf16*)(ws + WS_BTDN), 1024, 1024, 1024}; pg8::OrderMoe S; S.so.init(nrt * 256, 2048, G, bx); S.tab = (const LAS int*)(lds + MOETAB_OFF); S.ntn = 8; S.gather_a = false;
        pg8::EpiDN E{a.b_dn, ws + WS_YB};
        pg8::gemm_phase<pg8::EpiDN, pg8::OrderMoe, true, true, true>(lds + RING_OFF, g, S, E);
    }
    SEAM(11);
    if (IN(12)) { LOAD_ARGS();
        (void)moe_table(a, lds, tid); const LAS int* tab = (const LAS int*)(lds + MOETAB_OFF);
        const GAS int* toke = (const GAS int*)(ws + WS_TOKE); const GAS int* tokp = (const GAS int*)(ws + WS_TOKP); const GAS float* tokg = (const GAS float*)(ws + WS_TOKG);
        const GAS unsigned char* yb = (const GAS unsigned char*)(ws + WS_YB); const GAS float* x2 = (const GAS float*)(ws + WS_X2);
        GAS bf16* x3b = (GAS bf16*)(ws + WS_TMP + 64 * MiB); GAS unsigned char* h3b = (GAS unsigned char*)HB; const GAS f32x4* gr = (const GAS f32x4*)a.norm3_g + lane;
        typedef float f32x2_ __attribute__((ext_vector_type(2)));
        for (int tb = gw * 8; tb < SEQ; tb += NGW * 8) {
            int rowv = 0; float gv = 0.f;
            if (lane < 32) { const int as = tb * 4 + lane; rowv = tab[toke[as]] * 256 + tokp[as]; gv = tokg[as] * pg8::YB_INV; }
            f32x4 xa[8], xb[8]; unsigned ya[32], yc[32];
#define P12_LOAD(X_, Y_, tk_) do { const GAS f32x4* xr_ = (const GAS f32x4*)(x2 + (size_t)(tb + (tk_)) * 2048) + lane; \
                _Pragma("unroll") for (int j = 0; j < 8; ++j) X_[j] = xr_[64 * j]; \
                _Pragma("unroll") for (int k = 0; k < 4; ++k) { const int r_ = __shfl(rowv, (tk_) * 4 + k); const GAS unsigned* yp_ = (const GAS unsigned*)(yb + (size_t)r_ * 2048) + lane; \
                    _Pragma("unroll") for (int j = 0; j < 8; ++j) Y_[k * 8 + j] = yp_[64 * j]; } } while (0)
#define P12_PROC(X_, Y_, tk_) do { const float q0 = __shfl(gv, (tk_) * 4), q1 = __shfl(gv, (tk_) * 4 + 1), q2 = __shfl(gv, (tk_) * 4 + 2), q3 = __shfl(gv, (tk_) * 4 + 3); float s_ = 0.f; \
                GAS v2u* x3o = (GAS v2u*)(x3b + (size_t)(tb + (tk_)) * 2048) + lane; GAS unsigned* o4 = (GAS unsigned*)(h3b + (size_t)(tb + (tk_)) * 2048) + lane; \
                _Pragma("unroll") for (int j = 0; j < 8; ++j) { f32x4 x = X_[j]; const unsigned w0 = Y_[j], w1 = Y_[8 + j], w2 = Y_[16 + j], w3 = Y_[24 + j]; \
                    const f32x2_ a0 = __builtin_amdgcn_cvt_pk_f32_fp8(w0, false), b0 = __builtin_amdgcn_cvt_pk_f32_fp8(w0, true), a1 = __builtin_amdgcn_cvt_pk_f32_fp8(w1, false), b1 = __builtin_amdgcn_cvt_pk_f32_fp8(w1, true); \
                    const f32x2_ a2 = __builtin_amdgcn_cvt_pk_f32_fp8(w2, false), b2 = __builtin_amdgcn_cvt_pk_f32_fp8(w2, true), a3 = __builtin_amdgcn_cvt_pk_f32_fp8(w3, false), b3 = __builtin_amdgcn_cvt_pk_f32_fp8(w3, true); \
                    x.x += (a0.x * q0 + a1.x * q1) + (a2.x * q2 + a3.x * q3); x.y += (a0.y * q0 + a1.y * q1) + (a2.y * q2 + a3.y * q3); \
                    x.z += (b0.x * q0 + b1.x * q1) + (b2.x * q2 + b3.x * q3); x.w += (b0.y * q0 + b1.y * q1) + (b2.y * q2 + b3.y * q3); \
                    X_[j] = x; v2u xo; xo.x = pk2(x.x, x.y); xo.y = pk2(x.z, x.w); x3o[64 * j] = xo; s_ += (x.x * x.x + x.y * x.y) + (x.z * x.z + x.w * x.w); __builtin_amdgcn_sched_barrier(0); } \
                const float rstd_ = 1.0f / sqrtf(wave_sum(s_) * (1.0f / 2048.0f) + 1e-6f); \
                _Pragma("unroll") for (int j = 0; j < 8; ++j) { const f32x4 g = gr[64 * j]; o4[64 * j] = pg8::pk4_fp8(X_[j].x * rstd_ * g.x, X_[j].y * rstd_ * g.y, X_[j].z * rstd_ * g.z, X_[j].w * rstd_ * g.w); } } while (0)
            P12_LOAD(xa, ya, 0);
#pragma unroll
            for (int tp = 0; tp < 4; ++tp) { P12_LOAD(xb, yc, 2 * tp + 1); P12_PROC(xa, ya, 2 * tp); if (tp < 3) P12_LOAD(xa, ya, 2 * tp + 2); P12_PROC(xb, yc, 2 * tp + 1); }
#undef P12_LOAD
#undef P12_PROC
        }
    }
    SEAM(12);
    if (IN(13)) { LOAD_ARGS(); STAGGER(STAG_US);
        pg8::Gemm g{HB, (const bf16*)(ws + WS_BTPG), 1024, 1024, 1024}; pg8::StaticOrder S; S.init(SEQ, 2048, G, bx);
        pg8::EpiPLE E{(const bf16*)(ws + WS_TMP + 64 * MiB), (const bf16*)(ws + WS_PP), (bf16*)(ws + WS_MRG), pg8::W8_INV};
        pg8::gemm_phase<pg8::EpiPLE, pg8::StaticOrder, true, true, true>(lds + RING_OFF, g, S, E);
    }
    SEAM(13);
    if (IN(14)) { LOAD_ARGS();
        const GAS f32x4* gr = (const GAS f32x4*)a.fin_g + lane; const GAS bf16* x4 = (const GAS bf16*)(ws + WS_MRG); GAS float* outp = (GAS float*)a.out;
        for (int tb = gw * 8; tb < SEQ; tb += NGW * 8) { v2u wa[8], wb[8];
#define P14_LOAD(W_, tk_) do { const GAS v2u* xb_ = (const GAS v2u*)(x4 + (size_t)(tb + (tk_)) * 2048) + lane; _Pragma("unroll") for (int j = 0; j < 8; ++j) W_[j] = xb_[64 * j]; } while (0)
#define P14_PROC(W_, tk_) do { f32x4 v_[8]; float s_ = 0.f; \
                _Pragma("unroll") for (int j = 0; j < 8; ++j) { const v2u w = W_[j]; v_[j] = (f32x4){pg8::bf_lo(w.x), pg8::bf_hi(w.x), pg8::bf_lo(w.y), pg8::bf_hi(w.y)}; s_ += (v_[j].x * v_[j].x + v_[j].y * v_[j].y) + (v_[j].z * v_[j].z + v_[j].w * v_[j].w); } \
                const float rstd_ = 1.0f / sqrtf(wave_sum(s_) * (1.0f / 2048.0f) + 1e-6f); GAS f32x4* xr_ = (GAS f32x4*)(outp + (size_t)(tb + (tk_)) * 2048) + lane; \
                _Pragma("unroll") for (int j = 0; j < 8; ++j) xr_[64 * j] = v_[j] * rstd_ * gr[64 * j]; } while (0)
            P14_LOAD(wa, 0);
#pragma unroll
            for (int tp = 0; tp < 4; ++tp) { P14_LOAD(wb, 2 * tp + 1); P14_PROC(wa, 2 * tp); if (tp < 3) P14_LOAD(wa, 2 * tp + 2); P14_PROC(wb, 2 * tp + 1); }
#undef P14_LOAD
#undef P14_PROC
        }
    }
#undef IN
#undef SEAM
}

extern "C" void kernel_launch(void* const* d_in, const int* in_sizes, int n_in, void* d_out, int out_size, void* d_ws, size_t ws_size, hipStream_t stream) {
    static int grid = 0;
    if (grid == 0) {
        if (n_in != 29 || in_sizes[0] != SEQ * DM || out_size != SEQ * DM || ws_size < WS_END) { fprintf(stderr, "kernel_launch: unexpected shapes (n_in %d, ws %zu < %zu?)\n", n_in, ws_size, (size_t)WS_END); grid = -1; return; }
        int dev = 0, cus = 0, per_cu = 0;
        if (hipGetDevice(&dev) != hipSuccess || hipDeviceGetAttribute(&cus, hipDeviceAttributeMultiprocessorCount, dev) != hipSuccess) { grid = -1; return; }
        if (hipFuncSetAttribute((const void*)mk_fwd, hipFuncAttributeMaxDynamicSharedMemorySize, LDS_BYTES) != hipSuccess) { fprintf(stderr, "kernel_launch: hipFuncSetAttribute failed\n"); grid = -1; return; }
        if (hipOccupancyMaxActiveBlocksPerMultiprocessor(&per_cu, (const void*)mk_fwd, NWAVES * 64, LDS_BYTES) != hipSuccess || per_cu < 1) { fprintf(stderr, "kernel_launch: occupancy query says %d\n", per_cu); }
        (void)hipGetLastError();
        grid = cus;
    }
    if (grid < 0) return;
    if (hipMemsetAsync((char*)d_ws + WS_CTL, 0, CTL_ZERO_BYTES, stream) != hipSuccess) return;
    Args a{};
    a.x = (const float*)d_in[0]; a.p = (const float*)d_in[1]; a.pos = (const int*)d_in[2]; a.norm1_g = (const float*)d_in[3]; a.w_in = (const float*)d_in[4];
    a.lam_re = (const float*)d_in[5]; a.lam_im = (const float*)d_in[6]; a.log_dt = (const float*)d_in[7]; a.b_re = (const float*)d_in[8]; a.b_im = (const float*)d_in[9];
    a.c_re = (const float*)d_in[10]; a.c_im = (const float*)d_in[11]; a.d_skip = (const float*)d_in[12]; a.w_glu = (const float*)d_in[13]; a.b_glu = (const float*)d_in[14];
    a.w_bs = (const float*)d_in[15]; a.w_br = (const float*)d_in[16]; a.w_out = (const float*)d_in[17]; a.norm2_g = (const float*)d_in[18]; a.router_w = (const float*)d_in[19];
    a.router_b = (const float*)d_in[20]; a.w_gu = (const float*)d_in[21]; a.b_gu = (const float*)d_in[22]; a.w_dn = (const float*)d_in[23]; a.b_dn = (const float*)d_in[24];
    a.norm3_g = (const float*)d_in[25]; a.w_pg = (const float*)d_in[26]; a.w_pp = (const float*)d_in[27]; a.fin_g = (const float*)d_in[28];
    a.out = (float*)d_out; a.ws = (unsigned char*)d_ws;
#if defined(PROBE_LO)
#ifndef PROBE_REP
#define PROBE_REP 1
#endif
    a.ph_lo = 0; a.ph_hi = PROBE_HI; a.li = 0; hipLaunchKernelGGL(mk_fwd, dim3(grid), dim3(NWAVES * 64), LDS_BYTES, stream, a);
    for (int rep = 0; rep < PROBE_REP; ++rep) { a.ph_lo = PROBE_LO; a.ph_hi = (rep == PROBE_REP - 1) ? N_PHASES : PROBE_HI; a.li = 1 + rep; hipLaunchKernelGGL(mk_fwd, dim3(grid), dim3(NWAVES * 64), LDS_BYTES, stream, a); }
#elif MK_N_LAUNCHES == 1
    a.ph_lo = 0; a.ph_hi = N_PHASES;
    hipLaunchKernelGGL(mk_fwd, dim3(grid), dim3(NWAVES * 64), LDS_BYTES, stream, a);
#else
    for (int ph = 0; ph < N_PHASES; ++ph) { a.ph_lo = ph; a.ph_hi = ph + 1; hipLaunchKernelGGL(mk_fwd, dim3(grid), dim3(NWAVES * 64), LDS_BYTES, stream, a); }
#endif
    const hipError_t le = hipPeekAtLastError();
    if (le != hipSuccess) fprintf(stderr, "kernel_launch: launch failed: %s\n", hipGetErrorName(le));
}
```

```cpp
#include <hip/hip_runtime.h>
#include <cstdio>
#include <cstdint>

#ifndef MK_N_LAUNCHES
#define MK_N_LAUNCHES 1
#define MOE_WGM 8
#endif

constexpr int SEQ = 16384, DM = 2048, INC = 9216, NEXP = 32, FFN = 2048, PLED = 256;
constexpr int NG5 = 64, T5 = 32, NCH5 = SEQ / T5, K5 = 640;
constexpr int RCH = 128, NRC = SEQ / RCH, RH = 8;
constexpr int MAXROWS = SEQ * 4 + NEXP * 256;

namespace pg8 {
#define PG8_LAS __attribute__((address_space(3)))
typedef unsigned short bf16_t;
typedef short bf16x8 __attribute__((ext_vector_type(8)));
typedef float f32x4 __attribute__((ext_vector_type(4)));
typedef unsigned u32x4 __attribute__((ext_vector_type(4)));
typedef unsigned u32x2 __attribute__((ext_vector_type(2)));
constexpr int BM = 256, BK = 64, HALF = 128, HTB = HALF * BK * 2, STAGE_BYTES = 8 * HTB, NXCD = 8, WGM = 4;

__host__ __device__ __forceinline__ int lds_byte(int r, int c) { const int st = (r >> 4) * 2 + (c >> 5), rr = r & 15, cc = c & 31, ob = rr * 64 + cc * 2; return st * 1024 + (ob ^ (((ob >> 9) & 1) << 5)); }
__host__ __device__ __forceinline__ void stage_rc(int b, int& R, int& C) { const int st = b / 1024, sb = b % 1024, swz = sb ^ (((sb >> 9) & 1) << 5); R = (st >> 1) * 16 + swz / 64; C = (st & 1) * 32 + (swz % 64) / 2; }
__host__ __device__ __forceinline__ int perm32(int rho) { const int n = rho >> 4, i = rho & 15; return 8 * (i >> 2) + 4 * n + (i & 3); }

struct Unit { int pm, pn, pa; };
struct Gemm { const bf16_t* A; const bf16_t* Bt; int lda, ldb, K; };

struct StaticOrder {
    int nM, nN, nwg, G, c, wgm;
    __host__ __device__ void init(int M, int N, int G_, int c_, int wgm_ = WGM) { nM = M / BM; nN = N / BM; nwg = nM * nN; G = G_; c = c_; wgm = wgm_; }
    __host__ __device__ bool next(int i, Unit& u) const {
        const long L = (long)i * G + c; if (L >= nwg) return false;
        int wgid = (int)L; { const int q = nwg / NXCD, r = nwg % NXCD, xcd = wgid % NXCD, off = wgid / NXCD; wgid = (xcd < r ? xcd * (q + 1) : r * (q + 1) + (xcd - r) * q) + off; }
        const int nig = wgm * nN, gid = wgid / nig, fm = gid * wgm, gsz = (nM - fm) < wgm ? (nM - fm) : wgm;
        u.pm = fm + ((wgid % nig) % gsz); u.pn = (wgid % nig) / gsz; u.pa = u.pm; return true;
    }
    __device__ __forceinline__ void a_ready(const Unit&) const {}
    __device__ __forceinline__ void done(const Unit&) const {}
};
struct OrderS3 {
    int G, c;
    __device__ bool next(int i, Unit& u) const { const int L = i * G + c; if (L >= 256) return false; const int g = L >> 2; u.pm = 2 * g + ((L >> 1) & 1); u.pn = 2 * g + (L & 1); u.pa = u.pm; return true; }
    __device__ __forceinline__ void a_ready(const Unit&) const {}
    __device__ __forceinline__ void done(const Unit&) const {}
};
struct OrderS1 {
    int G, c;
    __device__ bool next(int i, Unit& u) const { const int L = i * G + c; if (L >= 128) return false; u.pm = L; u.pn = L >> 1; u.pa = L; return true; }
    __device__ __forceinline__ void a_ready(const Unit&) const {}
    __device__ __forceinline__ void done(const Unit&) const {}
};
struct OrderMoe {
    StaticOrder so; const PG8_LAS int* tab; int ntn; bool gather_a;
    __device__ bool next(int i, Unit& u) const { if (!so.next(i, u)) return false;
        const int e = __builtin_amdgcn_readfirstlane(tab[33 + u.pm]), t0 = __builtin_amdgcn_readfirstlane(tab[e]);
        u.pn = e * ntn + u.pn; u.pa = gather_a ? e * 64 + (u.pm - t0) : u.pm; return true; }
    __device__ __forceinline__ void a_ready(const Unit&) const {}
    __device__ __forceinline__ void done(const Unit&) const {}
};

__device__ __forceinline__ unsigned cvt_pk_bf16(float lo, float hi) { unsigned r; asm volatile("v_cvt_pk_bf16_f32 %0, %1, %2" : "=v"(r) : "v"(lo), "v"(hi)); return r; }
__device__ __forceinline__ u32x4 pack8(const f32x4& a, const f32x4& b) { u32x4 w; w.x = cvt_pk_bf16(a[0], a[1]); w.y = cvt_pk_bf16(a[2], a[3]); w.z = cvt_pk_bf16(b[0], b[1]); w.w = cvt_pk_bf16(b[2], b[3]); return w; }
__device__ __forceinline__ float bf_lo(unsigned w) { return __builtin_bit_cast(float, w << 16); }
__device__ __forceinline__ float bf_hi(unsigned w) { return __builtin_bit_cast(float, w & 0xffff0000u); }
__device__ __forceinline__ void unpack8(const u32x4& w, f32x4& a, f32x4& b) { a = (f32x4){bf_lo(w.x), bf_hi(w.x), bf_lo(w.y), bf_hi(w.y)}; b = (f32x4){bf_lo(w.z), bf_hi(w.z), bf_lo(w.w), bf_hi(w.w)}; }
typedef float f32x2 __attribute__((ext_vector_type(2)));
__device__ __forceinline__ float sigm(float x) { return __builtin_amdgcn_rcpf(1.0f + __builtin_amdgcn_exp2f(-1.4426950408889634f * x)); }
__device__ __forceinline__ f32x2 sigm2(f32x2 x) { const f32x2 t = x * (-1.4426950408889634f); f32x2 e; e.x = __builtin_amdgcn_exp2f(t.x); e.y = __builtin_amdgcn_exp2f(t.y);
    const f32x2 d = e + 1.0f; f32x2 r; r.x = __builtin_amdgcn_rcpf(d.x); r.y = __builtin_amdgcn_rcpf(d.y); return r; }
__device__ __forceinline__ f32x4 sigm4(const f32x4& x) { const f32x2 a = sigm2((f32x2){x[0], x[1]}), b = sigm2((f32x2){x[2], x[3]}); return (f32x4){a.x, a.y, b.x, b.y}; }
__device__ __forceinline__ float gelu_t(float x) { return x * sigm(1.5957691216057308f * (x + 0.044715f * x * x * x)); }
__device__ __forceinline__ f32x2 gelu2(f32x2 x) { const f32x2 u = x * x, w = (u * 0.044715f + 1.0f) * x; return x * sigm2(w * 1.5957691216057308f); }
__device__ __forceinline__ f32x4 gelu4(const f32x4& x) { const f32x2 a = gelu2((f32x2){x[0], x[1]}), b = gelu2((f32x2){x[2], x[3]}); return (f32x4){a.x, a.y, b.x, b.y}; }

#define EPI_LOOP_AM _Pragma("unroll") for (int ai = 0; ai < 2; ++ai) _Pragma("unroll") for (int m = 0; m < 4; ++m)
#define EPI_LOOP_BJ _Pragma("unroll") for (int bj = 0; bj < 2; ++bj)
typedef f32x4 AccT[2][2][4][2];
#ifndef EPIZ_MASK
#define EPIZ_MASK 31
#endif
#define EPIZ_EN(k) ((EPIZ_MASK >> (k)) & 1)

struct EpiZU {
    static constexpr bool PERM = true, AFTER_DRAIN = false; static constexpr int NSTORE = 16; static constexpr bool HAS_MID = false;
    bf16_t* xg5;
    __device__ __forceinline__ void operator()(const AccT& acc, const Unit& u, int wr, int wc, int fr, int fq) const {
        const int row0 = u.pm * BM + wr * 64 + fr, tc = wc * 32 + 8 * fq, pn = u.pn;
        EPI_LOOP_AM { const int t = row0 + ai * HALF + m * 16, j = t >> 5, i = t & 31;
            EPI_LOOP_BJ { const int col = pn * BM + bj * HALF + tc, g = col >> 4, c0 = col & 15;
                *(u32x4*)(xg5 + ((size_t)(g * NCH5 + j) * K5 + i * 16 + c0)) = pack8(acc[ai][bj][m][0], acc[ai][bj][m][1]); } }
    }
};
struct EpiZR {
    static constexpr bool PERM = true, AFTER_DRAIN = false; static constexpr int NSTORE = 16; static constexpr bool HAS_MID = false;
    bf16_t *q, *k; const float *cs, *sn;
    __device__ __forceinline__ void operator()(const AccT& acc, const Unit& u, int wr, int wc, int fr, int fq) const {
        const int row0 = u.pm * BM + wr * 64 + fr, pn = u.pn;
        const bool isk = pn >= 4; bf16_t* dst = isk ? k : q; const float sc = isk ? 0.08838834764831845f : 1.0f;
        const int head = 2 * (pn & 3) + (wc >> 1), dd = 32 * (wc & 1) + 8 * fq;
        EPI_LOOP_AM { const int t = row0 + ai * HALF + m * 16;
            const float* cp = cs + (size_t)t * 64 + dd; const float* sp = sn + (size_t)t * 64 + dd;
            const f32x4 c0 = *(const f32x4*)cp * sc, c1 = *(const f32x4*)(cp + 4) * sc, s0 = *(const f32x4*)sp * sc, s1 = *(const f32x4*)(sp + 4) * sc;
            const f32x4 x1a = acc[ai][0][m][0], x1b = acc[ai][0][m][1], x2a = acc[ai][1][m][0], x2b = acc[ai][1][m][1];
            bf16_t* o = dst + (size_t)t * 1024 + head * 128 + dd;
            *(u32x4*)o = pack8(x1a * c0 - x2a * s0, x1b * c1 - x2b * s1);
            *(u32x4*)(o + 64) = pack8(x1a * s0 + x2a * c0, x1b * s1 + x2b * c1); asm volatile("" ::: "memory"); }
    }
};
struct EpiZA {
    static constexpr bool PERM = true, AFTER_DRAIN = false; static constexpr int NSTORE = 16; static constexpr bool HAS_MID = false;
    bf16_t *v, *gs, *sgs, *sgr; int pn0; float sc;
    __device__ __forceinline__ void operator()(const AccT& acc, const Unit& u, int wr, int wc, int fr, int fq) const {
        const int row0 = u.pm * BM + wr * 64 + fr, tc = wc * 32 + 8 * fq, pn = u.pn + pn0;
        bf16_t* dst = pn < 4 ? v : (pn < 8 ? gs : (pn < 16 ? sgs : sgr));
        const int ldc = pn < 8 ? 1024 : 2048, cb = (pn < 8 ? (pn & 3) : (pn & 7)) * BM + tc;
        if (pn < 4) {
            EPI_LOOP_AM { const size_t off = (size_t)(row0 + ai * HALF + m * 16) * ldc + cb;
                EPI_LOOP_BJ { *(u32x4*)(dst + off + bj * HALF) = pack8(acc[ai][bj][m][0] * sc, acc[ai][bj][m][1] * sc); } }
        } else {
            const float kb = pn < 8 ? 1.0f : 0.0f;
            EPI_LOOP_AM { const size_t off = (size_t)(row0 + ai * HALF + m * 16) * ldc + cb;
                EPI_LOOP_BJ { f32x4 r[2];
#pragma unroll
                    for (int n = 0; n < 2; ++n) { const f32x4 x = acc[ai][bj][m][n] * sc, sg = sigm4(x); r[n] = sg * (1.0f - kb) + (x * sg) * kb; }
                    *(u32x4*)(dst + off + bj * HALF) = pack8(r[0], r[1]); } }
        }
    }
};
struct EpiS1 {
    static constexpr bool PERM = true, AFTER_DRAIN = false; static constexpr int NSTORE = 16; static constexpr bool HAS_MID = false;
    float* sloc;
    __device__ __forceinline__ void operator()(const AccT& acc, const Unit& u, int wr, int wc, int fr, int fq) const {
        const int row0 = u.pm * BM + wr * 64 + fr, tc = wc * 32 + 8 * fq;
        EPI_LOOP_AM { float* o = sloc + (size_t)(row0 + ai * HALF + m * 16) * 128 + tc; *(f32x4*)o = acc[ai][0][m][0]; *(f32x4*)(o + 4) = acc[ai][0][m][1]; }
    }
};
struct EpiS3 {
    static constexpr bool PERM = true, AFTER_DRAIN = false; static constexpr int NSTORE = 16; static constexpr bool HAS_MID = false;
    bf16_t* ysp;
    __device__ __forceinline__ void operator()(const AccT& acc, const Unit& u, int wr, int wc, int fr, int fq) const {
        const int g = u.pm >> 1, j0 = (u.pm & 1) * BM + wr * 64 + fr, cl0 = (u.pn & 1) * BM + wc * 32 + 8 * fq;
        EPI_LOOP_AM { const int j = j0 + ai * HALF + m * 16;
            EPI_LOOP_BJ { const int cl = cl0 + bj * HALF, i = cl >> 4, c0 = cl & 15;
                *(u32x4*)(ysp + (size_t)(j * T5 + i) * 1024 + g * 16 + c0) = pack8(gelu4(acc[ai][bj][m][0]), gelu4(acc[ai][bj][m][1])); } }
    }
};
struct EpiGLU {
    static constexpr bool PERM = true, AFTER_DRAIN = false; static constexpr int NSTORE = 16; static constexpr bool HAS_MID = false;
    const bf16_t* ysp; const float* bias; bf16_t* ys; int ldy;
    __device__ __forceinline__ void operator()(const AccT& acc, const Unit& u, int wr, int wc, int fr, int fq) const {
        const int row0 = u.pm * BM + wr * 64 + fr, col0 = u.pn * BM + wc * 32 + 8 * fq;
        f32x4 bv[2][2];
        EPI_LOOP_BJ { bv[bj][0] = *(const f32x4*)(bias + col0 + bj * HALF); bv[bj][1] = *(const f32x4*)(bias + col0 + bj * HALF + 4); }
        EPI_LOOP_AM { const size_t off = (size_t)(row0 + ai * HALF + m * 16) * 1024 + col0, offy = (size_t)(row0 + ai * HALF + m * 16) * ldy + col0;
            EPI_LOOP_BJ { f32x4 ya, yb; unpack8(*(const u32x4*)(ysp + off + bj * HALF), ya, yb);
                *(u32x4*)(ys + offy + bj * HALF) = pack8(ya * sigm4(acc[ai][bj][m][0] + bv[bj][0]), yb * sigm4(acc[ai][bj][m][1] + bv[bj][1])); } }
    }
};
struct EpiZG {
    static constexpr bool PERM = true, AFTER_DRAIN = false; static constexpr int NSTORE = 16; static constexpr bool HAS_MID = false;
    bf16_t *rat, *sgr; float sc;
    __device__ __forceinline__ void operator()(const AccT& acc, const Unit& u, int wr, int wc, int fr, int fq) const {
        const int row0 = u.pm * BM + wr * 64 + fr, col0 = u.pn * HALF + wc * 32 + 8 * fq; const float k2 = -1.4426950408889634f * sc;
        EPI_LOOP_AM { const size_t off = (size_t)(row0 + ai * HALF + m * 16) * 2048 + col0; f32x4 rr[2], sr[2];
#pragma unroll
            for (int n = 0; n < 2; ++n) { const f32x4 ts = acc[ai][0][m][n] * k2, tr = acc[ai][1][m][n] * k2;
#pragma unroll
                for (int x = 0; x < 4; ++x) { const float ds = 1.0f + __builtin_amdgcn_exp2f(ts[x]), dr = 1.0f + __builtin_amdgcn_exp2f(tr[x]); rr[n][x] = dr * __builtin_amdgcn_rcpf(ds); sr[n][x] = __builtin_amdgcn_rcpf(dr); } }
            *(u32x4*)(rat + off) = pack8(rr[0], rr[1]); *(u32x4*)(sgr + off) = pack8(sr[0], sr[1]); }
    }
};
struct EpiMF {
    static constexpr bool PERM = true, AFTER_DRAIN = false; static constexpr int NSTORE = 16; static constexpr bool HAS_MID = true;
    const bf16_t *rat, *sgr; bf16_t* mrg;
    __device__ __forceinline__ void mid(AccT& acc, const Unit& u, int wr, int wc, int fr, int fq) const {
        int row0 = u.pm * BM + wr * 64 + fr, col0 = u.pn * BM + wc * 32 + 8 * fq; asm volatile("" : "+v"(row0), "+v"(col0));
#pragma unroll
        for (int ai = 0; ai < 2; ++ai) { u32x4 rv[4][2];
#pragma unroll
            for (int m = 0; m < 4; ++m) { const size_t off = (size_t)(row0 + ai * HALF + m * 16) * 2048 + col0; EPI_LOOP_BJ rv[m][bj] = *(const u32x4*)(rat + off + bj * HALF); }
#pragma unroll
            for (int m = 0; m < 4; ++m) EPI_LOOP_BJ { f32x4 ra, rb; unpack8(rv[m][bj], ra, rb); acc[ai][bj][m][0] = acc[ai][bj][m][0] * ra; acc[ai][bj][m][1] = acc[ai][bj][m][1] * rb; }
            asm volatile("" ::: "memory"); }
    }
    __device__ __forceinline__ void operator()(const AccT& acc, const Unit& u, int wr, int wc, int fr, int fq) const {
        const int row0 = u.pm * BM + wr * 64 + fr, col0 = u.pn * BM + wc * 32 + 8 * fq;
        EPI_LOOP_AM { const size_t off = (size_t)(row0 + ai * HALF + m * 16) * 2048 + col0;
            EPI_LOOP_BJ { f32x4 ga, gb; unpack8(*(const u32x4*)(sgr + off + bj * HALF), ga, gb);
                *(u32x4*)(mrg + off + bj * HALF) = pack8(ga * acc[ai][bj][m][0], gb * acc[ai][bj][m][1]); } }
    }
};
struct EpiRes {
    static constexpr bool PERM = true, AFTER_DRAIN = false; static constexpr int NSTORE = 32; static constexpr bool HAS_MID = false;
    const float* x; float* o;
    __device__ __forceinline__ void operator()(const AccT& acc, const Unit& u, int wr, int wc, int fr, int fq) const {
        const int row0 = u.pm * BM + wr * 64 + fr, col0 = u.pn * BM + wc * 32 + 8 * fq;
        EPI_LOOP_AM { const size_t off = (size_t)(row0 + ai * HALF + m * 16) * 2048 + col0;
            EPI_LOOP_BJ { *(f32x4*)(o + off + bj * HALF) = *(const f32x4*)(x + off + bj * HALF) + acc[ai][bj][m][0];
                *(f32x4*)(o + off + bj * HALF + 4) = *(const f32x4*)(x + off + bj * HALF + 4) + acc[ai][bj][m][1]; } }
    }
};
struct EpiPlain {
    static constexpr bool PERM = true, AFTER_DRAIN = false; static constexpr int NSTORE = 16; static constexpr bool HAS_MID = false;
    bf16_t* o; int ldc;
    __device__ __forceinline__ void operator()(const AccT& acc, const Unit& u, int wr, int wc, int fr, int fq) const {
        const int row0 = u.pm * BM + wr * 64 + fr, col0 = u.pn * BM + wc * 32 + 8 * fq;
        EPI_LOOP_AM { const size_t off = (size_t)(row0 + ai * HALF + m * 16) * ldc + col0;
            EPI_LOOP_BJ { *(u32x4*)(o + off + bj * HALF) = pack8(acc[ai][bj][m][0], acc[ai][bj][m][1]); } }
    }
};
__device__ __forceinline__ unsigned pk4_fp8(float a, float b, float c, float d) { int r = 0; r = __builtin_amdgcn_cvt_pk_fp8_f32(a, b, r, false); r = __builtin_amdgcn_cvt_pk_fp8_f32(c, d, r, true); return (unsigned)r; }
constexpr float W8_SCALE = 64.0f, W8_INV = 1.0f / 64.0f;
struct EpiGU {
    static constexpr bool PERM = true, AFTER_DRAIN = false; static constexpr int NSTORE = 8; static constexpr bool HAS_MID = false;
    const float* bgu; unsigned char* act;
    __device__ __forceinline__ void operator()(const AccT& acc, const Unit& u, int wr, int wc, int fr, int fq) const {
        const int e = u.pn >> 4, ct = u.pn & 15, row0 = u.pm * BM + wr * 64 + fr, f0 = ct * HALF + wc * 32 + 8 * fq;
        const float* bp = bgu + (size_t)e * 4096 + 2 * f0;
        const f32x4 b0 = *(const f32x4*)bp, b1 = *(const f32x4*)(bp + 4), b2 = *(const f32x4*)(bp + 8), b3 = *(const f32x4*)(bp + 12);
        const f32x4 bg0 = (f32x4){b0[0], b0[2], b1[0], b1[2]}, bu0 = (f32x4){b0[1], b0[3], b1[1], b1[3]}, bg1 = (f32x4){b2[0], b2[2], b3[0], b3[2]}, bu1 = (f32x4){b2[1], b2[3], b3[1], b3[3]};
        const f32x4 bu0p = bu0 + 1.0f, bu1p = bu1 + 1.0f;
        EPI_LOOP_AM { const size_t off = (size_t)(row0 + ai * HALF + m * 16) * FFN + f0;
            f32x4 r[2];
#pragma unroll
            for (int n = 0; n < 2; ++n) { const f32x4 gv = acc[ai][0][m][n] * W8_INV + (n ? bg1 : bg0), uv = acc[ai][1][m][n] * W8_INV + (n ? bu1p : bu0p);
#pragma unroll
                for (int x = 0; x < 4; x += 2) { const f32x2 gg = (f32x2){fminf(gv[x], 7.0f), fminf(gv[x + 1], 7.0f)};
                    const f32x2 uu = (f32x2){__builtin_amdgcn_fmed3f(uv[x], -6.0f, 8.0f), __builtin_amdgcn_fmed3f(uv[x + 1], -6.0f, 8.0f)};
                    const f32x2 o = (gg * sigm2(gg * 1.702f)) * uu; r[n][x] = o.x; r[n][x + 1] = o.y; } }
            u32x2 w; w.x = pk4_fp8(r[0][0], r[0][1], r[0][2], r[0][3]); w.y = pk4_fp8(r[1][0], r[1][1], r[1][2], r[1][3]);
            *(u32x2*)(act + off) = w; }
    }
};
constexpr float YB_SCALE = 16.0f, YB_INV = 1.0f / 16.0f;
struct EpiDN {
    static constexpr bool PERM = true, AFTER_DRAIN = false; static constexpr int NSTORE = 16; static constexpr bool HAS_MID = false;
    const float* bdn; unsigned char* yb;
    __device__ __forceinline__ void operator()(const AccT& acc, const Unit& u, int wr, int wc, int fr, int fq) const {
        const int e = u.pn >> 3, ct = u.pn & 7, row0 = u.pm * BM + wr * 64 + fr, col0 = ct * BM + wc * 32 + 8 * fq;
        f32x4 bv[2][2];
        EPI_LOOP_BJ { bv[bj][0] = *(const f32x4*)(bdn + (size_t)e * 2048 + col0 + bj * HALF); bv[bj][1] = *(const f32x4*)(bdn + (size_t)e * 2048 + col0 + bj * HALF + 4); }
        EPI_LOOP_AM { const int row = row0 + ai * HALF + m * 16; const float gt = YB_SCALE; const size_t off = (size_t)row * 2048 + col0;
            EPI_LOOP_BJ { const f32x4 a = (acc[ai][bj][m][0] * W8_INV + bv[bj][0]) * gt, b = (acc[ai][bj][m][1] * W8_INV + bv[bj][1]) * gt;
                u32x2 w; w.x = pk4_fp8(a[0], a[1], a[2], a[3]); w.y = pk4_fp8(b[0], b[1], b[2], b[3]); *(u32x2*)(yb + off + bj * HALF) = w; } }
    }
};
struct EpiPLE {
    static constexpr bool PERM = true, AFTER_DRAIN = false; static constexpr int NSTORE = 16; static constexpr bool HAS_MID = false;
    const bf16_t* x3; const bf16_t* pp; bf16_t* o; float sc;
    __device__ __forceinline__ void operator()(const AccT& acc, const Unit& u, int wr, int wc, int fr, int fq) const {
        const int row0 = u.pm * BM + wr * 64 + fr, col0 = u.pn * BM + wc * 32 + 8 * fq;
        EPI_LOOP_AM { const size_t off = (size_t)(row0 + ai * HALF + m * 16) * 2048 + col0;
            EPI_LOOP_BJ { f32x4 pa, pb; unpack8(*(const u32x4*)(pp + off + bj * HALF), pa, pb);
                f32x4 xa, xb; unpack8(*(const u32x4*)(x3 + off + bj * HALF), xa, xb);
                *(u32x4*)(o + off + bj * HALF) = pack8(xa + sigm4(acc[ai][bj][m][0] * sc) * pa, xb + sigm4(acc[ai][bj][m][1] * sc) * pb); } }
    }
};

typedef int v8i_t __attribute__((ext_vector_type(8)));
typedef int v4i_t __attribute__((ext_vector_type(4)));
__device__ __forceinline__ v8i_t cat8(const bf16x8& lo, const bf16x8& hi) { const v4i_t a = __builtin_bit_cast(v4i_t, lo), b = __builtin_bit_cast(v4i_t, hi); return (v8i_t){a[0], a[1], a[2], a[3], b[0], b[1], b[2], b[3]}; }
template <class Epi, class Sched, bool ALIGN_EPI = false, bool SP2 = false, bool F8 = false>
__device__ __forceinline__ void gemm_phase(PG8_LAS unsigned char* lds, const Gemm g, const Sched& S, const Epi& E) {
    const int tid = threadIdx.x, wid = __builtin_amdgcn_readfirstlane(tid >> 6), lane = tid & 63, wr = wid >> 2, wc = wid & 3, fr = lane & 15, fq = lane >> 4;
    const int K = g.K, nt = K / BK;
    unsigned voffA[2], voffB[2];
#pragma unroll
    for (int i = 0; i < 2; ++i) { int R, C; stage_rc(tid * 16 + i * 8192, R, C); const int Rb = Epi::PERM ? ((R & ~31) + perm32(R & 31)) : R;
        voffA[i] = (unsigned)(R * g.lda + C) * 2u; voffB[i] = (unsigned)(Rb * g.ldb + C) * 2u; }
    const size_t kstep = (size_t)(BK * 2);
    const size_t hstepA = (size_t)HALF * g.lda * 2, hstepB = (size_t)HALF * g.ldb * 2;
    const size_t tstepA = 2 * hstepA, tstepB = 2 * hstepB;
    const unsigned ldsw = (unsigned)wid * 1024u;
    const int aoff = lds_byte(wr * 64 + fr, fq * 8), boff = lds_byte(wc * 32 + fr, fq * 8);
#define PG8_SA(b, h) (((b) * 2 + (h)) * HTB)
#define PG8_SB(b, h) ((4 + (b) * 2 + (h)) * HTB)
#define PG8_STAGE(bufoff, gbase, voff) do { _Pragma("unroll") for (int _i = 0; _i < 2; ++_i) \
        __builtin_amdgcn_global_load_lds((const unsigned*)((const char*)(gbase) + (voff)[_i]), (PG8_LAS unsigned*)(lds + (bufoff) + ldsw + _i * 8192), 16, 0, 0); } while (0)
#define PG8_LD8(p_) __builtin_shufflevector(*(const PG8_LAS v4i_t*)(p_), *(const PG8_LAS v4i_t*)((p_) + 1024), 0, 1, 2, 3, 4, 5, 6, 7)
#define PG8_LDA(dst, b, h) do { if constexpr (F8) { _Pragma("unroll") for (int m = 0; m < 4; ++m) dst##8[m] = PG8_LD8(lds + PG8_SA(b, h) + aoff + m * 2048); } else { \
        _Pragma("unroll") for (int m = 0; m < 4; ++m) _Pragma("unroll") for (int k = 0; k < 2; ++k) dst[m][k] = *(const PG8_LAS bf16x8*)(lds + PG8_SA(b, h) + aoff + m * 2048 + k * 1024); } } while (0)
#define PG8_LDB(dst, b, h) do { if constexpr (F8) { _Pragma("unroll") for (int n = 0; n < 2; ++n) dst##8[n] = PG8_LD8(lds + PG8_SB(b, h) + boff + n * 2048); } else { \
        _Pragma("unroll") for (int n = 0; n < 2; ++n) _Pragma("unroll") for (int k = 0; k < 2; ++k) dst[n][k] = *(const PG8_LAS bf16x8*)(lds + PG8_SB(b, h) + boff + n * 2048 + k * 1024); } } while (0)
#define PG8_MMA(ai, bj, At, Bt) do { __builtin_amdgcn_s_setprio(1); if constexpr (F8) { _Pragma("unroll") for (int m = 0; m < 4; ++m) _Pragma("unroll") for (int n = 0; n < 2; ++n) \
        asm volatile("v_mfma_scale_f32_16x16x128_f8f6f4 %0, %1, %2, %0, %3, %3 op_sel_hi:[0,0,0]" : "+v"(acc[ai][bj][m][n]) : "v"(Bt##8[n]), "v"(At##8[m]), "v"(sc8)); } else { \
        _Pragma("unroll") for (int m = 0; m < 4; ++m) _Pragma("unroll") for (int n = 0; n < 2; ++n) _Pragma("unroll") for (int k = 0; k < 2; ++k) \
        acc[ai][bj][m][n] = __builtin_amdgcn_mfma_f32_16x16x32_bf16(Bt[n][k], At[m][k], acc[ai][bj][m][n], 0, 0, 0); } __builtin_amdgcn_s_setprio(0); } while (0)
#define PG8_WAIT_V(n) asm volatile("s_waitcnt vmcnt(" #n ")" ::: "memory")
#define PG8_WAIT_V8R() do { if (fresh) asm volatile("s_waitcnt vmcnt(%0)" :: "n"(8 + Epi::NSTORE) : "memory"); else asm volatile("s_waitcnt vmcnt(8)" ::: "memory"); } while (0)
#define PG8_WAIT_L(n) asm volatile("s_waitcnt lgkmcnt(" #n ")" ::: "memory")
#define PG8_BAR __builtin_amdgcn_s_barrier()
#define PG8_SCHED __builtin_amdgcn_sched_barrier(0)
    Unit cur, nxt; int ui = 0;
    if (!S.next(0, cur)) return;
    f32x4 acc[2][2][4][2];
#pragma unroll
    for (int a = 0; a < 2; ++a)
#pragma unroll
        for (int b = 0; b < 2; ++b)
#pragma unroll
            for (int m = 0; m < 4; ++m)
#pragma unroll
                for (int n = 0; n < 2; ++n) acc[a][b][m][n] = (f32x4){0.f, 0.f, 0.f, 0.f};
    bf16x8 At[4][2], B0[2][2], B1[2][2]; v8i_t At8[4], B08[2], B18[2]; const int sc8 = 0x7f7f7f7f;
    const char* cA = (const char*)g.A + (size_t)cur.pa * tstepA; const char* cB = (const char*)g.Bt + (size_t)cur.pn * tstepB;
    S.a_ready(cur);
    if constexpr (SP2) {
        PG8_STAGE(PG8_SB(0, 0), cB, voffB); PG8_STAGE(PG8_SB(0, 1), cB + hstepB, voffB); PG8_STAGE(PG8_SA(0, 0), cA, voffA); PG8_STAGE(PG8_SA(0, 1), cA + hstepA, voffA);
        if (wr == 1) PG8_BAR;
        PG8_WAIT_V(2); PG8_BAR;
        PG8_STAGE(PG8_SB(1, 0), cB + kstep, voffB); PG8_STAGE(PG8_SA(1, 0), cA + kstep, voffA); PG8_STAGE(PG8_SB(1, 1), cB + hstepB + kstep, voffB);
        PG8_WAIT_V(6); PG8_BAR;
    } else {
        PG8_STAGE(PG8_SB(0, 0), cB, voffB); PG8_STAGE(PG8_SA(0, 0), cA, voffA); PG8_STAGE(PG8_SB(0, 1), cB + hstepB, voffB); PG8_STAGE(PG8_SA(0, 1), cA + hstepA, voffA);
        if (wr == 1) PG8_BAR;
        PG8_WAIT_V(4); PG8_BAR;
        PG8_STAGE(PG8_SB(1, 0), cB + kstep, voffB); PG8_STAGE(PG8_SA(1, 0), cA + kstep, voffA); PG8_STAGE(PG8_SB(1, 1), cB + hstepB + kstep, voffB);
        PG8_WAIT_V(6); PG8_BAR;
    }
    for (;;) {
        const bool has_next = S.next(ui + 1, nxt);
        const char* nA = has_next ? (const char*)g.A + (size_t)nxt.pa * tstepA : cA; const char* nB = has_next ? (const char*)g.Bt + (size_t)nxt.pn * tstepB : cB;
#pragma nounroll
        for (int t = 0; t < nt; t += 2) {
            const bool last = (t == nt - 2);
            const char* a1 = cA + (size_t)(t + 1) * kstep;
            const char* a2 = last ? nA : cA + (size_t)(t + 2) * kstep; const char* b2 = last ? nB : cB + (size_t)(t + 2) * kstep;
            const char* a3 = a2 + kstep; const char* b3 = b2 + kstep;
            if (last && has_next) S.a_ready(nxt);
            if constexpr (Epi::HAS_MID) { if (t == (nt >> 1)) E.mid(acc, cur, wr, wc, fr, fq); }
            if constexpr (SP2) {
            const bool fresh = (t == 0) && (ui > 0);
            PG8_LDB(B0, 0, 0); PG8_LDB(B1, 0, 1); PG8_SCHED; PG8_LDA(At, 0, 0); PG8_STAGE(PG8_SA(1, 1), a1 + hstepA, voffA);
            PG8_WAIT_V8R(); PG8_WAIT_L(0); PG8_BAR; PG8_MMA(0, 0, At, B0); PG8_MMA(0, 1, At, B1); PG8_BAR; PG8_SCHED;
            PG8_LDA(At, 0, 1); PG8_STAGE(PG8_SB(0, 0), b2, voffB); PG8_STAGE(PG8_SB(0, 1), b2 + hstepB, voffB); PG8_STAGE(PG8_SA(0, 0), a2, voffA);
            PG8_WAIT_V8R(); PG8_WAIT_L(0); PG8_BAR; PG8_MMA(1, 0, At, B0); PG8_MMA(1, 1, At, B1); PG8_BAR; PG8_SCHED;
            PG8_LDB(B0, 1, 0); PG8_LDB(B1, 1, 1); PG8_SCHED; PG8_LDA(At, 1, 0); PG8_STAGE(PG8_SA(0, 1), a2 + hstepA, voffA);
            PG8_WAIT_V(8); PG8_WAIT_L(0); PG8_BAR; PG8_MMA(0, 0, At, B0); PG8_MMA(0, 1, At, B1); PG8_BAR; PG8_SCHED;
            PG8_LDA(At, 1, 1); PG8_STAGE(PG8_SB(1, 0), b3, voffB); PG8_STAGE(PG8_SB(1, 1), b3 + hstepB, voffB); PG8_STAGE(PG8_SA(1, 0), a3, voffA);
            PG8_WAIT_V(8); PG8_WAIT_L(0); PG8_BAR; PG8_MMA(1, 0, At, B0); PG8_MMA(1, 1, At, B1); PG8_BAR; PG8_SCHED;
            } else {
            PG8_LDB(B0, 0, 0); PG8_SCHED; PG8_LDA(At, 0, 0); PG8_STAGE(PG8_SA(1, 1), a1 + hstepA, voffA);
            PG8_WAIT_L(8); PG8_BAR; PG8_WAIT_L(0); PG8_MMA(0, 0, At, B0); PG8_BAR; PG8_SCHED;
            PG8_LDB(B1, 0, 1); PG8_STAGE(PG8_SB(0, 0), b2, voffB);
            PG8_BAR; PG8_WAIT_L(0); PG8_MMA(0, 1, At, B1); PG8_BAR;
            PG8_LDA(At, 0, 1); PG8_STAGE(PG8_SA(0, 0), a2, voffA);
            PG8_BAR; PG8_WAIT_L(0); PG8_MMA(1, 0, At, B0); PG8_BAR; PG8_SCHED;
            PG8_STAGE(PG8_SB(0, 1), b2 + hstepB, voffB);
            PG8_WAIT_V(6); PG8_BAR; PG8_MMA(1, 1, At, B1); PG8_BAR;
            PG8_LDB(B0, 1, 0); PG8_SCHED; PG8_LDA(At, 1, 0); PG8_STAGE(PG8_SA(0, 1), a2 + hstepA, voffA);
            PG8_WAIT_L(8); PG8_BAR; PG8_WAIT_L(0); PG8_MMA(0, 0, At, B0); PG8_BAR; PG8_SCHED;
            PG8_LDB(B1, 1, 1); PG8_STAGE(PG8_SB(1, 0), b3, voffB);
            PG8_BAR; PG8_WAIT_L(0); PG8_MMA(0, 1, At, B1); PG8_BAR;
            PG8_LDA(At, 1, 1); PG8_STAGE(PG8_SA(1, 0), a3, voffA);
            PG8_BAR; PG8_WAIT_L(0); PG8_MMA(1, 0, At, B0); PG8_BAR; PG8_SCHED;
            PG8_STAGE(PG8_SB(1, 1), b3 + hstepB, voffB);
            PG8_WAIT_V(6); PG8_BAR; PG8_MMA(1, 1, At, B1); PG8_BAR;
            }
        }
        if constexpr (ALIGN_EPI) { if (wr == 0) PG8_BAR; }
        if constexpr (F8) asm volatile("s_nop 15\n\ts_nop 15" ::: "memory");
        if constexpr (!Epi::AFTER_DRAIN) { E(acc, cur, wr, wc, fr, fq); S.done(cur); }
        if (!has_next) break;
#pragma unroll
        for (int a = 0; a < 2; ++a)
#pragma unroll
            for (int b = 0; b < 2; ++b)
#pragma unroll
                for (int m = 0; m < 4; ++m)
#pragma unroll
                    for (int n = 0; n < 2; ++n) acc[a][b][m][n] = (f32x4){0.f, 0.f, 0.f, 0.f};
        cur = nxt; cA = nA; cB = nB; ++ui;
        if constexpr (ALIGN_EPI) { if (wr == 1) PG8_BAR; }
    }
    PG8_WAIT_V(0);
    if constexpr (!ALIGN_EPI) { if (wr == 0) PG8_BAR; }
    PG8_BAR;
#undef PG8_SA
#undef PG8_SB
#undef PG8_STAGE
#undef PG8_LDA
#undef PG8_LD8
#undef PG8_LDB
#undef PG8_MMA
#undef PG8_WAIT_V
#undef PG8_WAIT_V8R
#undef PG8_WAIT_L
#undef PG8_BAR
#undef PG8_SCHED
}
}

constexpr size_t MiB = 1u << 20;
constexpr size_t WS_CTL = 0, CTL_ZERO_BYTES = 1 * MiB;
constexpr size_t WS_BTIN  = 1 * MiB;
constexpr size_t WS_BTGLU = WS_BTIN + 36 * MiB;
constexpr size_t WS_BTPS  = WS_BTGLU + 2 * MiB;
constexpr size_t WS_BTPR  = WS_BTPS + 4 * MiB;
constexpr size_t WS_BTOUT = WS_BTPR + 4 * MiB;
constexpr size_t WS_BTPG  = WS_BTOUT + 8 * MiB;
constexpr size_t WS_BTPP  = WS_BTPG + 8 * MiB;
constexpr size_t WS_BTGU  = WS_BTPP + 1 * MiB;
constexpr size_t WS_BTDN  = WS_BTGU + 512 * MiB;
constexpr size_t WS_BTS3  = WS_BTDN + 256 * MiB;
constexpr size_t WS_BTS1  = WS_BTS3 + 40 * MiB;
constexpr size_t WS_ATAB  = WS_BTS1 + 16 * MiB;
constexpr size_t WS_CS    = WS_ATAB + 1 * MiB;
constexpr size_t WS_SN    = WS_CS + 4 * MiB;
constexpr size_t WS_WG    = WS_SN + 4 * MiB;
constexpr size_t WS_PBF   = WS_WG + 1 * MiB;
constexpr size_t WS_HB    = WS_PBF + 8 * MiB;
constexpr size_t WS_XG5   = WS_HB + 64 * MiB;
constexpr size_t WS_Q     = WS_XG5 + 40 * MiB;
constexpr size_t WS_K     = WS_Q + 32 * MiB;
constexpr size_t WS_V     = WS_K + 32 * MiB;
constexpr size_t WS_GS    = WS_V + 32 * MiB;
constexpr size_t WS_SGS   = WS_GS + 32 * MiB;
constexpr size_t WS_SGR   = WS_SGS + 64 * MiB;
constexpr size_t WS_SLOC  = WS_SGR + 64 * MiB;
constexpr size_t WS_KVT   = WS_SLOC + 16 * MiB;
constexpr size_t WS_RT    = WS_KVT + 64 * MiB;
constexpr size_t WS_YSP   = WS_RT + 32 * MiB;
constexpr size_t WS_YS    = WS_YSP + 32 * MiB;
constexpr size_t WS_YR    = WS_YS + 32 * MiB;
constexpr size_t WS_TMP   = WS_YR + 32 * MiB;
constexpr size_t WS_MRG   = WS_TMP + 128 * MiB;
constexpr size_t WS_X2    = WS_MRG + 64 * MiB;
constexpr size_t WS_PP    = WS_X2 + 128 * MiB;
constexpr size_t WS_TOKE  = WS_PP + 64 * MiB;
constexpr size_t WS_TOKG  = WS_TOKE + 1 * MiB;
constexpr size_t WS_TOKP  = WS_TOKG + 1 * MiB;
constexpr size_t WS_ROWG  = WS_TOKP + 1 * MiB;
constexpr size_t WS_AROW  = WS_ROWG + 1 * MiB;
constexpr size_t WS_BLKE  = WS_AROW + 1 * MiB;
constexpr size_t WS_XG    = WS_BLKE + 1 * MiB;
constexpr size_t WS_ACT   = WS_XG + 1024 * MiB;
constexpr size_t WS_YB    = WS_ACT + 288 * MiB;
constexpr size_t WS_BTIN8 = WS_YB + 288 * MiB;
constexpr size_t WS_END   = WS_BTIN8 + 8 * MiB;
constexpr size_t WS_H8    = WS_YB;
constexpr int CW_CNT = 64;
constexpr int CW_BAR = 4096;

constexpr int RING_OFF = 0, RING_BYTES = 131072;
constexpr int LDS_BYTES = 159744;
constexpr int LDSCTL_OFF = LDS_BYTES - 256;
constexpr int MOETAB_OFF = RING_BYTES;
constexpr int NWAVES = 8;

#define GAS __attribute__((address_space(1)))
#define LAS __attribute__((address_space(3)))
typedef unsigned short bf16;
typedef unsigned v4u __attribute__((ext_vector_type(4)));
typedef unsigned v2u __attribute__((ext_vector_type(2)));
typedef float f32x4 __attribute__((ext_vector_type(4)));
typedef float f32x16 __attribute__((ext_vector_type(16)));
typedef short bf16x8 __attribute__((ext_vector_type(8)));
#define RLX_AGENT __ATOMIC_RELAXED, __HIP_MEMORY_SCOPE_AGENT
#define LDS_WAIT() asm volatile("s_waitcnt lgkmcnt(0)" ::: "memory")
#define VM_WAIT() asm volatile("s_waitcnt vmcnt(0)" ::: "memory")
__device__ __forceinline__ unsigned f2bf(float f) { unsigned u = __builtin_bit_cast(unsigned, f); return (u + 0x7fffu + ((u >> 16) & 1u)) >> 16; }
__device__ __forceinline__ unsigned pk2(float lo, float hi) { return f2bf(lo) | (f2bf(hi) << 16); }
__device__ __forceinline__ float bf2f(unsigned short b) { return __builtin_bit_cast(float, (unsigned)b << 16); }

#define XB_TMO      128
#define XB_XCNT(j)  (256  + 64 * (j))
#define XB_XSUB(j)  (1280 + 64 * (j))
#define XB_XGEN(j)  (2304 + 64 * (j))
#define XB_TOP      3328
#define XB_TOPGEN   3392
#define XCD_BAR_WORDS 3456
#define XB_SPIN_CAP (1u << 20)
__device__ __forceinline__ unsigned xb_ld(unsigned* p)              { return __hip_atomic_load(p, __ATOMIC_RELAXED, __HIP_MEMORY_SCOPE_AGENT); }
__device__ __forceinline__ unsigned xb_add(unsigned* p, unsigned v) { return __hip_atomic_fetch_add(p, v, __ATOMIC_RELAXED, __HIP_MEMORY_SCOPE_AGENT); }
__device__ __forceinline__ unsigned xb_xcc_id() { return (unsigned)__builtin_amdgcn_s_getreg((3 << 11) | 20) & 0xFu; }
#define XB_SPIN(cond, bar) do { unsigned _sp = 0; while (cond) { __builtin_amdgcn_s_sleep(1); \
    if ((++_sp & 255u) == 0u) { if (xb_ld(&(bar)[XB_TMO])) break; if (_sp > XB_SPIN_CAP) { atomicAdd(&(bar)[XB_TMO], 1u); break; } } } } while (0)
struct XcdBarrier { unsigned* bar; unsigned x; volatile LAS unsigned* st; };
__device__ __forceinline__ XcdBarrier xcd_barrier_post(unsigned* bar, volatile LAS unsigned* st) {
    XcdBarrier b; b.bar = bar; b.x = xb_xcc_id(); b.st = st;
    if (threadIdx.x == 0) (void)xb_add(&bar[XB_XCNT(b.x)], 1u);
    return b;
}
__device__ __forceinline__ void xcd_barrier_complete(unsigned* bar, unsigned x, unsigned& nloc, unsigned& nx) {
    const unsigned G = gridDim.x * gridDim.y * gridDim.z;
    unsigned sum, cnt, mine, sp = 0u;
    for (;;) {
        sum = 0u; cnt = 0u; mine = 0u;
#pragma unroll
        for (unsigned j = 0; j < 16; ++j) { const unsigned c = xb_ld(&bar[XB_XCNT(j)]); sum += c; cnt += (c > 0u) ? 1u : 0u; mine = (j == x) ? c : mine; }
        if (sum == G) break;
        __builtin_amdgcn_s_sleep(1);
        if ((++sp & 255u) == 0u) { if (xb_ld(&bar[XB_TMO])) break; if (sp > XB_SPIN_CAP) { atomicAdd(&bar[XB_TMO], 1u); break; } }
    }
    nloc = mine > 0u ? mine : 1u; nx = cnt > 0u ? cnt : 1u;
}
__device__ __forceinline__ void xcd_barrier(const XcdBarrier& b) {
    asm volatile("s_waitcnt vmcnt(0)" ::: "memory");
    __syncthreads();
    if (threadIdx.x == 0) {
        unsigned* bar = b.bar;
        __builtin_amdgcn_s_waitcnt(0);
        unsigned nloc = b.st[0], nx = b.st[1];
        if (nloc == 0u) { xcd_barrier_complete(bar, b.x, nloc, nx); b.st[0] = nloc; b.st[1] = nx; }
        const unsigned old = xb_add(&bar[XB_XSUB(b.x)], 1u);
        const unsigned gen = old / nloc;
        if (old + 1u == (gen + 1u) * nloc) {
            __builtin_amdgcn_fence(__ATOMIC_RELEASE, "agent");
            asm volatile("s_waitcnt vmcnt(0)" ::: "memory");
            const unsigned og = xb_add(&bar[XB_TOP], 1u);
            const unsigned tg = og / nx;
            if (og + 1u == (tg + 1u) * nx) xb_add(&bar[XB_TOPGEN], 1u);
            else XB_SPIN(xb_ld(&bar[XB_TOPGEN]) == tg, bar);
            __builtin_amdgcn_fence(__ATOMIC_ACQUIRE, "agent");
            xb_add(&bar[XB_XGEN(b.x)], 1u);
            asm volatile("s_waitcnt vmcnt(0)" ::: "memory");
        } else {
            XB_SPIN(xb_ld(&bar[XB_XGEN(b.x)]) == gen, bar);
            __builtin_amdgcn_fence(__ATOMIC_ACQUIRE, "agent");
            asm volatile("s_waitcnt vmcnt(0)" ::: "memory");
        }
    }
    __syncthreads();
}

__device__ __forceinline__ float wave_sum(float v) {
#pragma unroll
    for (int o = 1; o < 64; o <<= 1) v += __shfl_xor(v, o);
    return v;
}
__device__ __forceinline__ int rowmap(int mode, int n) {
    if (mode == 1) { if (n < 1024 || n >= 3072) return n; const int nn = n - 1024, r = nn >> 10, hn = nn & 1023, head = hn >> 7, half = (hn >> 6) & 1, dd = hn & 63;
        return 1024 + r * 1024 + (head >> 1) * 256 + half * 128 + (head & 1) * 64 + dd; }
    if (mode == 2) { const int f = n >> 1, s = n & 1; return (f >> 7) * 256 + (f & 127) + 128 * s; }
    if (mode == 3) { const int s = n >> 11, c = n & 2047; return (c >> 7) * 256 + (c & 127) + 128 * s; }
    return n;
}
template <bool F8> __device__ __forceinline__ void transpose_run(const float* W, int K, int N, int ldw, void* WT, int ldo, int mode, int nmat, size_t sstride, size_t dstride, LAS float* scr, int gw, int NGW, int lane) {
    const int nbk = N / 64, per = (K / 64) * nbk, total = nmat * per;
    int it = gw; if (it >= total) return;
    float r[64];
#define TR_SRC(it_) ((const GAS float*)W + (size_t)((it_) / per) * sstride + (size_t)(64 * (((it_) % per) / nbk)) * ldw + 64 * (((it_) % per) % nbk) + lane)
    { const GAS float* src = TR_SRC(it);
#pragma unroll
      for (int i = 0; i < 64; ++i) r[i] = src[(size_t)i * ldw]; }
    for (;;) {
#pragma unroll
        for (int i = 0; i < 64; ++i) scr[i * 65 + lane] = F8 ? r[i] * 64.0f : r[i];
        LDS_WAIT(); asm volatile("" ::: "memory");
        const int mat = it / per, rr = it % per, k0 = 64 * (rr / nbk), n0 = 64 * (rr % nbk);
        const int nit = it + NGW; const bool hn = nit < total;
        if (hn) { const GAS float* src = TR_SRC(nit);
#pragma unroll
            for (int i = 0; i < 64; ++i) r[i] = src[(size_t)i * ldw]; }
        if constexpr (F8) { const int c = lane & 3; GAS unsigned char* dst = (GAS unsigned char*)WT + (size_t)mat * dstride;
#pragma unroll
            for (int j = 0; j < 4; ++j) { const int n = (lane >> 2) + 16 * j; const LAS float* s = scr + (16 * c) * 65 + n;
                v4u o; o.x = pg8::pk4_fp8(s[0 * 65], s[1 * 65], s[2 * 65], s[3 * 65]); o.y = pg8::pk4_fp8(s[4 * 65], s[5 * 65], s[6 * 65], s[7 * 65]);
                o.z = pg8::pk4_fp8(s[8 * 65], s[9 * 65], s[10 * 65], s[11 * 65]); o.w = pg8::pk4_fp8(s[12 * 65], s[13 * 65], s[14 * 65], s[15 * 65]);
                *(GAS v4u*)(dst + (size_t)rowmap(mode, n0 + n) * ldo + k0 + 16 * c) = o; }
        } else { const int c = lane & 7; GAS bf16* dst = (GAS bf16*)WT + (size_t)mat * dstride;
#pragma unroll
            for (int j = 0; j < 8; ++j) { const int n = (lane >> 3) + 8 * j; const LAS float* s = scr + (8 * c) * 65 + n;
                v4u o; o.x = pk2(s[0 * 65], s[1 * 65]); o.y = pk2(s[2 * 65], s[3 * 65]); o.z = pk2(s[4 * 65], s[5 * 65]); o.w = pk2(s[6 * 65], s[7 * 65]);
                *(GAS v4u*)(dst + (size_t)rowmap(mode, n0 + n) * ldo + k0 + 8 * c) = o; } }
        LDS_WAIT(); asm volatile("" ::: "memory");
        if (!hn) break;
        it = nit;
    }
#undef TR_SRC
}
#ifndef TR8_NT
#define TR8_NT 0
#endif
__device__ __forceinline__ void transpose_run8(const float* W, int K, int N, int ldw, unsigned char* WT, int mode, int nmat, size_t sstride, size_t dstride, LAS unsigned* scr, int gw, int NGW, int lane) {
    const int nkb = K / 256, per = nkb * (N / 64), total = nmat * per, nkh = nkb / 2;
#define TR_KB(it_) (2 * ((((it_) % per) >> 3) % nkh) + ((((it_) % per) >> 2) & 1))
#define TR_NB(it_) (4 * ((((it_) % per) >> 3) / nkh) + (((it_) % per) & 3))
    int it = gw; if (it >= total) return;
    const int kr = lane >> 4, nc = 4 * (lane & 15);
    f32x4 ra[16], rb[16];
#define TR_SRC(it_, q_) ((const GAS float*)W + (size_t)((it_) / per) * sstride + (size_t)(256 * TR_KB(it_) + 64 * (q_) + 16 * kr) * ldw + 64 * TR_NB(it_) + nc)
#define TR_LOAD(r_, it_, q_) do { const GAS float* src_ = TR_SRC(it_, q_); _Pragma("unroll") for (int i = 0; i < 16; ++i) r_[i] = TR8_NT ? __builtin_nontemporal_load((const GAS f32x4*)(src_ + (size_t)i * ldw)) : *(const GAS f32x4*)(src_ + (size_t)i * ldw); } while (0)
#define TR_PACK(r_, q_) do { _Pragma("unroll") for (int m = 0; m < 4; ++m) _Pragma("unroll") for (int c = 0; c < 4; ++c) \
        scr[(nc + c) * 65 + (q_) * 16 + 4 * kr + m] = pg8::pk4_fp8(r_[4 * m][c] * 64.0f, r_[4 * m + 1][c] * 64.0f, r_[4 * m + 2][c] * 64.0f, r_[4 * m + 3][c] * 64.0f); } while (0)
    TR_LOAD(ra, it, 0); TR_LOAD(rb, it, 1);
    for (;;) {
        const int nit = it + NGW; const bool hn = nit < total;
        TR_PACK(ra, 0); TR_LOAD(ra, it, 2);
        TR_PACK(rb, 1); TR_LOAD(rb, it, 3);
        TR_PACK(ra, 2); if (hn) TR_LOAD(ra, nit, 0);
        TR_PACK(rb, 3); if (hn) TR_LOAD(rb, nit, 1);
        LDS_WAIT(); asm volatile("" ::: "memory");
        const int mat = it / per, k0 = 256 * TR_KB(it), n0 = 64 * TR_NB(it), c16 = lane & 15;
        GAS unsigned char* dst = (GAS unsigned char*)WT + (size_t)mat * dstride;
#pragma unroll
        for (int j = 0; j < 16; ++j) { const int n = (lane >> 4) + 4 * j; const LAS unsigned* sp = scr + n * 65 + 4 * c16;
            v4u o; o.x = sp[0]; o.y = sp[1]; o.z = sp[2]; o.w = sp[3];
            if (TR8_NT) __builtin_nontemporal_store(o, (GAS v4u*)(dst + (size_t)rowmap(mode, n0 + n) * K + k0 + 16 * c16)); else *(GAS v4u*)(dst + (size_t)rowmap(mode, n0 + n) * K + k0 + 16 * c16) = o; }
        LDS_WAIT(); asm volatile("" ::: "memory");
        if (!hn) break;
        it = nit;
    }
#undef TR_SRC
#undef TR_LOAD
#undef TR_PACK
#undef TR_KB
#undef TR_NB
}
__device__ __forceinline__ void rms_row_bf16(const float* xrow, const float* gain, bf16* orow, unsigned char* orow8, int lane) {
    const f32x4* xr = (const f32x4*)xrow + lane; const f32x4* gr = (const f32x4*)gain + lane;
    f32x4 v[8]; float s = 0.f;
#pragma unroll
    for (int j = 0; j < 8; ++j) { v[j] = xr[64 * j]; s += (v[j].x * v[j].x + v[j].y * v[j].y) + (v[j].z * v[j].z + v[j].w * v[j].w); }
    const float rstd = 1.0f / sqrtf(wave_sum(s) * (1.0f / 2048.0f) + 1e-6f);
    v2u* o8 = (v2u*)orow + lane;
#pragma unroll
    for (int j = 0; j < 8; ++j) { const f32x4 g = gr[64 * j]; const f32x4 y = v[j] * rstd * g; v2u w; w.x = pk2(y.x, y.y); w.y = pk2(y.z, y.w); o8[64 * j] = w;
        ((unsigned*)orow8)[lane + 64 * j] = pg8::pk4_fp8(y.x, y.y, y.z, y.w); }
}

struct Args {
    const float* x; const float* p; const int* pos; const float* norm1_g; const float* w_in;
    const float* lam_re; const float* lam_im; const float* log_dt; const float* b_re; const float* b_im; const float* c_re; const float* c_im; const float* d_skip;
    const float* w_glu; const float* b_glu; const float* w_bs; const float* w_br; const float* w_out; const float* norm2_g; const float* router_w; const float* router_b;
    const float* w_gu; const float* b_gu; const float* w_dn; const float* b_dn; const float* norm3_g; const float* w_pg; const float* w_pp; const float* fin_g;
    float* out; unsigned char* ws; int ph_lo, ph_hi, li, pad;
};

__device__ __forceinline__ void s5_tables(const Args& a, int g, LAS unsigned char* lds, int tid) {
    LAS float* Pre = (LAS float*)lds;
    LAS float* Pim = Pre + 33 * 64;
    LAS float* Bre = Pim + 33 * 64;
    LAS float* Bim = Bre + 1024;
    LAS float* Cre = Bim + 1024;
    LAS float* Cim = Cre + 1024;
    LAS float* Kt  = Cim + 1024;
    const float dt = expf(a.log_dt[g]);
    for (int e = tid; e < 33 * 64; e += 512) { const int p = e >> 6, n = e & 63; const float lr = a.lam_re[g * 64 + n], li = a.lam_im[g * 64 + n];
        const float mag = expf(lr * dt * (float)p), ang = li * dt * (float)p; Pre[e] = mag * cosf(ang); Pim[e] = mag * sinf(ang); }
    for (int e = tid; e < 1024; e += 512) { const int n = e >> 4; const float lr = a.lam_re[g * 64 + n], li = a.lam_im[g * 64 + n];
        const float mag = expf(lr * dt), abr = mag * cosf(li * dt), abi = mag * sinf(li * dt);
        const float den = lr * lr + li * li, nr = abr - 1.0f, ni = abi, fre = (nr * lr + ni * li) / den, fim = (ni * lr - nr * li) / den;
        const float br = a.b_re[(size_t)g * 1024 + e], bi = a.b_im[(size_t)g * 1024 + e];
        Bre[e] = fre * br - fim * bi; Bim[e] = fre * bi + fim * br;
        Cre[e] = a.c_re[(size_t)g * 1024 + e]; Cim[e] = a.c_im[(size_t)g * 1024 + e]; }
    __syncthreads();
    { const int tau = tid >> 4, cp = tid & 15; float kacc[16];
#pragma unroll
      for (int c = 0; c < 16; ++c) kacc[c] = 0.f;
      for (int n = 0; n < 64; ++n) { const float pr = Pre[tau * 64 + n], pi = Pim[tau * 64 + n], br = Bre[n * 16 + cp], bi = Bim[n * 16 + cp];
          const float zr = pr * br - pi * bi, zi = pr * bi + pi * br;
#pragma unroll
          for (int c = 0; c < 16; ++c) kacc[c] += Cre[c * 64 + n] * zr - Cim[c * 64 + n] * zi; }
#pragma unroll
      for (int c = 0; c < 16; ++c) Kt[tau * 256 + c * 16 + cp] = kacc[c] + ((tau == 0 && c == cp) ? a.d_skip[g * 16 + c] : 0.f); }
    __syncthreads();
    bf16* bt3 = (bf16*)(a.ws + WS_BTS3) + (size_t)g * 512 * K5;
    for (int ch = tid; ch < 512 * 80; ch += 512) { const int row = ch / 80, cc = ch % 80, i = row >> 4, c = row & 15; float v[8];
        if (cc < 64) { const int ip = cc >> 1, c0 = (cc & 1) * 8;
#pragma unroll
            for (int x = 0; x < 8; ++x) v[x] = (i >= ip) ? Kt[(i - ip) * 256 + c * 16 + c0 + x] : 0.f;
        } else { const int m0 = (cc - 64) * 8;
#pragma unroll
            for (int x = 0; x < 8; ++x) { const int m = m0 + x, n = m & 63; const float cr = Cre[c * 64 + n], ci = Cim[c * 64 + n], pr = Pre[(i + 1) * 64 + n], pi = Pim[(i + 1) * 64 + n];
                v[x] = (m < 64) ? (cr * pr - ci * pi) : -(cr * pi + ci * pr); } }
        v4u o; o.x = pk2(v[0], v[1]); o.y = pk2(v[2], v[3]); o.z = pk2(v[4], v[5]); o.w = pk2(v[6], v[7]);
        *(v4u*)(bt3 + (size_t)row * K5 + cc * 8) = o; }
    bf16* bt1 = (bf16*)(a.ws + WS_BTS1) + (size_t)g * 256 * 512;
    for (int ch = tid; ch < 256 * 64; ch += 512) { const int row = ch >> 6, cc = ch & 63, ip = cc >> 1, c0 = (cc & 1) * 8; float v[8];
#pragma unroll
        for (int x = 0; x < 8; ++x) { if (row < 128) { const int n = row & 63; const float pr = Pre[(31 - ip) * 64 + n], pi = Pim[(31 - ip) * 64 + n], br = Bre[n * 16 + c0 + x], bi = Bim[n * 16 + c0 + x];
                v[x] = (row < 64) ? (pr * br - pi * bi) : (pr * bi + pi * br); } else v[x] = 0.f; }
        v4u o; o.x = pk2(v[0], v[1]); o.y = pk2(v[2], v[3]); o.z = pk2(v[4], v[5]); o.w = pk2(v[6], v[7]);
        *(v4u*)(bt1 + (size_t)row * 512 + cc * 8) = o; }
    float* at = (float*)(a.ws + WS_ATAB) + g * 128;
    if (tid < 64) { at[tid * 2] = Pre[32 * 64 + tid]; at[tid * 2 + 1] = Pim[32 * 64 + tid]; }
    __syncthreads();
}

__device__ __forceinline__ void s5_scan_item(const Args& a, int item, LAS unsigned char* lds, int tid) {
    LAS float* seg_re = (LAS float*)lds; LAS float* seg_im = seg_re + 512;
    const int sl = tid & 31, seg = tid >> 5, sidx = item * 32 + sl, g = sidx >> 6, n = sidx & 63;
    const float* at = (const float*)(a.ws + WS_ATAB) + g * 128 + n * 2; const float ar = at[0], ai = at[1];
    const float* sloc = (const float*)(a.ws + WS_SLOC) + ((size_t)g * NCH5 + seg * 32) * 128 + n;
    float er = 0.f, ei = 0.f;
#pragma unroll 8
    for (int j = 0; j < 32; ++j) { const float lr = sloc[j * 128], li = sloc[j * 128 + 64]; const float tr = ar * er - ai * ei + lr, ti = ar * ei + ai * er + li; er = tr; ei = ti; }
    seg_re[seg * 32 + sl] = er; seg_im[seg * 32 + sl] = ei;
    __syncthreads();
    float pr = ar, pi = ai;
#pragma unroll
    for (int q = 0; q < 5; ++q) { const float tr = pr * pr - pi * pi, ti = 2.f * pr * pi; pr = tr; pi = ti; }
    float sr = 0.f, si = 0.f;
    for (int s2 = 0; s2 < seg; ++s2) { const float tr = pr * sr - pi * si + seg_re[s2 * 32 + sl], ti = pr * si + pi * sr + seg_im[s2 * 32 + sl]; sr = tr; si = ti; }
    bf16* xg = (bf16*)(a.ws + WS_XG5) + ((size_t)g * NCH5 + seg * 32) * K5 + 512 + n;
#pragma unroll 8
    for (int j = 0; j < 32; ++j) { xg[(size_t)j * K5] = (bf16)f2bf(sr); xg[(size_t)j * K5 + 64] = (bf16)f2bf(si);
        const float lr = sloc[j * 128], li = sloc[j * 128 + 64]; const float tr = ar * sr - ai * si + lr, ti = ar * si + ai * sr + li; sr = tr; si = ti; }
    __syncthreads();
}

constexpr int RS = 136;
__device__ __forceinline__ float ret_l2g(int h) { return log2f(1.0f - exp2f(-5.0f - (float)h)); }
__device__ __forceinline__ v4u ret_scale8(v4u w, float z) {
    w.x = pk2(pg8::bf_lo(w.x) * z, pg8::bf_hi(w.x) * z); w.y = pk2(pg8::bf_lo(w.y) * z, pg8::bf_hi(w.y) * z); w.z = pk2(pg8::bf_lo(w.z) * z, pg8::bf_hi(w.z) * z); w.w = pk2(pg8::bf_lo(w.w) * z, pg8::bf_hi(w.w) * z); return w; }
__device__ __forceinline__ void ret_stage_rm(const bf16* src_, LAS bf16* dst, int tid) {
    const GAS bf16* src = (const GAS bf16*)src_; v4u wv[4];
#pragma unroll
    for (int q = 0; q < 4; ++q) { const int id = tid + 512 * q, row = id >> 4, c8 = id & 15; wv[q] = *(const GAS v4u*)(src + (size_t)row * 1024 + 8 * c8); }
#pragma unroll
    for (int q = 0; q < 4; ++q) { const int id = tid + 512 * q, row = id >> 4, c8 = id & 15; *(LAS v4u*)(dst + row * RS + 8 * c8) = wv[q]; }
}
template <bool ZETA> __device__ __forceinline__ void ret_stage_tr(const bf16* src_, LAS bf16* dst, int tid, float l2g) {
    const GAS bf16* src = (const GAS bf16*)src_; v4u wv[4];
#pragma unroll
    for (int q = 0; q < 4; ++q) { const int id = tid + 512 * q, row = id & 127, c8 = id >> 7; wv[q] = *(const GAS v4u*)(src + (size_t)row * 1024 + 8 * c8); }
#pragma unroll
    for (int q = 0; q < 4; ++q) { const int id = tid + 512 * q, row = id & 127, c8 = id >> 7; v4u w = wv[q];
        if (ZETA) w = ret_scale8(w, exp2f(l2g * (float)(127 - row)));
        LAS bf16* d = dst + (8 * c8) * RS + row;
        d[0 * RS] = (bf16)(w.x & 0xffffu); d[1 * RS] = (bf16)(w.x >> 16); d[2 * RS] = (bf16)(w.y & 0xffffu); d[3 * RS] = (bf16)(w.y >> 16);
        d[4 * RS] = (bf16)(w.z & 0xffffu); d[5 * RS] = (bf16)(w.z >> 16); d[6 * RS] = (bf16)(w.w & 0xffffu); d[7 * RS] = (bf16)(w.w >> 16); }
}
__device__ __forceinline__ void ret_kv_unit(const Args& a, int unit, LAS unsigned char* lds, int tid) {
    const int n = unit >> 3, h = unit & 7, t0 = n * RCH, lane = tid & 63, w = __builtin_amdgcn_readfirstlane(tid >> 6), fr = lane & 15, fg = lane >> 4;
    LAS bf16* Kt = (LAS bf16*)lds; LAS bf16* Vt = Kt + 128 * RS;
    const float l2g = ret_l2g(h);
    ret_stage_tr<true>((const bf16*)(a.ws + WS_K) + (size_t)t0 * 1024 + h * 128, Kt, tid, l2g);
    ret_stage_tr<false>((const bf16*)(a.ws + WS_V) + (size_t)t0 * 1024 + h * 128, Vt, tid, l2g);
    __syncthreads();
    bf16x8 af[4];
#pragma unroll
    for (int ks = 0; ks < 4; ++ks) af[ks] = *(const LAS bf16x8*)(Vt + (16 * w + fr) * RS + 32 * ks + 8 * fg);
    float* out = (float*)(a.ws + WS_KVT) + ((size_t)unit * 128 + 16 * w + 4 * fg) * 128 + fr;
#pragma unroll
    for (int dt = 0; dt < 8; ++dt) { f32x4 acc = (f32x4){0.f, 0.f, 0.f, 0.f};
#pragma unroll
        for (int ks = 0; ks < 4; ++ks) { const bf16x8 bfv = *(const LAS bf16x8*)(Kt + (16 * dt + fr) * RS + 32 * ks + 8 * fg);
            acc = __builtin_amdgcn_mfma_f32_16x16x32_bf16(af[ks], bfv, acc, 0, 0, 0); }
#pragma unroll
        for (int r = 0; r < 4; ++r) out[(size_t)r * 128 + 16 * dt] = acc[r]; }
    __syncthreads();
}
__device__ __forceinline__ void ret_state_scan(const Args& a, int gtid, int gthreads) {
    const float* kvt = (const float*)(a.ws + WS_KVT); bf16* rt = (bf16*)(a.ws + WS_RT);
    for (int idx = gtid; idx < RH * 128 * 128; idx += gthreads) { const int h = idx >> 14; const float dec = exp2f(128.0f * ret_l2g(h)); float st = 0.f;
#pragma unroll 8
        for (int n = 0; n < NRC; ++n) { rt[(size_t)n * 131072 + idx] = (bf16)f2bf(st); st = st * dec + kvt[(size_t)n * 131072 + idx]; } }
}
struct RetPre { v4u k[4], v[4]; bf16x8 q[4]; };
__device__ __forceinline__ void ret_out_load(const Args& a, int unit, int tid, RetPre& P) {
    const int n = unit >> 3, h = unit & 7, t0 = n * RCH, lane = tid & 63, w = tid >> 6, fr = lane & 15, fg = lane >> 4, il = 16 * w + fr;
    const GAS bf16* ks = (const GAS bf16*)(a.ws + WS_K) + (size_t)t0 * 1024 + h * 128; const GAS bf16* vs = (const GAS bf16*)(a.ws + WS_V) + (size_t)t0 * 1024 + h * 128;
#pragma unroll
    for (int q = 0; q < 4; ++q) { const int id = tid + 512 * q;
        P.k[q] = *(const GAS v4u*)(ks + (size_t)(id >> 4) * 1024 + 8 * (id & 15));
        P.v[q] = *(const GAS v4u*)(vs + (size_t)(id & 127) * 1024 + 8 * (id >> 7)); }
    const GAS bf16* qp = (const GAS bf16*)(a.ws + WS_Q) + (size_t)(t0 + il) * 1024 + h * 128 + 8 * fg;
#pragma unroll
    for (int ks2 = 0; ks2 < 4; ++ks2) P.q[ks2] = *(const GAS bf16x8*)(qp + 32 * ks2);
}
__device__ __forceinline__ void ret_out_units(const Args& a, int u0, int ustride, int uend, LAS unsigned char* lds, int tid) {
    if (u0 >= uend) return;
    const int lane = tid & 63, w = __builtin_amdgcn_readfirstlane(tid >> 6), fr = lane & 15, fg = lane >> 4, i0 = 16 * w, il = i0 + fr;
    LAS bf16* Ks = (LAS bf16*)lds; LAS bf16* Vt = Ks + 128 * RS; LAS bf16* Ps = Vt + 128 * RS; LAS bf16* Rs = Ps + 128 * RS;
    RetPre P; ret_out_load(a, u0, tid, P);
    for (int unit = u0; unit < uend; unit += ustride) {
        const int n = unit >> 3, h = unit & 7, t0 = n * RCH; const float l2g = ret_l2g(h);
#pragma unroll
        for (int q = 0; q < 4; ++q) { const int id = tid + 512 * q;
            *(LAS v4u*)(Ks + (id >> 4) * RS + 8 * (id & 15)) = P.k[q];
            const v4u wv = P.v[q]; LAS bf16* d = Vt + (8 * (id >> 7)) * RS + (id & 127);
            d[0 * RS] = (bf16)(wv.x & 0xffffu); d[1 * RS] = (bf16)(wv.x >> 16); d[2 * RS] = (bf16)(wv.y & 0xffffu); d[3 * RS] = (bf16)(wv.y >> 16);
            d[4 * RS] = (bf16)(wv.z & 0xffffu); d[5 * RS] = (bf16)(wv.z >> 16); d[6 * RS] = (bf16)(wv.w & 0xffffu); d[7 * RS] = (bf16)(wv.w >> 16); }
        bf16x8 qf[4]; v2u gt[8];
#pragma unroll
        for (int ks = 0; ks < 4; ++ks) qf[ks] = P.q[ks];
        __syncthreads();
        { const GAS bf16* gp = (const GAS bf16*)(a.ws + WS_GS) + (size_t)(t0 + il) * 1024 + h * 128 + 4 * fg;
#pragma unroll
          for (int et = 0; et < 8; ++et) gt[et] = *(const GAS v2u*)(gp + 16 * et); }
        v4u rv[4];
        { const GAS bf16* rs = (const GAS bf16*)(a.ws + WS_RT) + (size_t)unit * 16384;
#pragma unroll
          for (int q = 0; q < 4; ++q) { const int id = tid + 512 * q; rv[q] = *(const GAS v4u*)(rs + (size_t)(id >> 4) * 128 + 8 * (id & 15)); } }
        if (unit + ustride < uend) ret_out_load(a, unit + ustride, tid, P);
#pragma unroll
        for (int jt = 0; jt < 8; ++jt) {
            if (jt <= w) { f32x4 acc = (f32x4){0.f, 0.f, 0.f, 0.f};
#pragma unroll
                for (int ks = 0; ks < 4; ++ks) { const bf16x8 kf = *(const LAS bf16x8*)(Ks + (16 * jt + fr) * RS + 32 * ks + 8 * fg);
                    acc = __builtin_amdgcn_mfma_f32_16x16x32_bf16(kf, qf[ks], acc, 0, 0, 0); }
                float pv[4];
#pragma unroll
                for (int r = 0; r < 4; ++r) { const int j = 16 * jt + 4 * fg + r; pv[r] = (il >= j) ? acc[r] * exp2f(l2g * (float)(il - j)) : 0.f; }
                LAS unsigned* pp = (LAS unsigned*)(Ps + il * RS + 16 * jt + 4 * fg); pp[0] = pk2(pv[0], pv[1]); pp[1] = pk2(pv[2], pv[3]);
            } else if (jt == w + 1 && (w & 1) == 0) { LAS unsigned* pp = (LAS unsigned*)(Ps + il * RS + 16 * jt + 4 * fg); pp[0] = 0u; pp[1] = 0u; }
        }
#pragma unroll
        for (int q = 0; q < 4; ++q) { const int id = tid + 512 * q; *(LAS v4u*)(Rs + (id >> 4) * RS + 8 * (id & 15)) = rv[q]; }
        __syncthreads();
        f32x4 accI[8], accC[8];
#pragma unroll
        for (int et = 0; et < 8; ++et) { accI[et] = (f32x4){0.f, 0.f, 0.f, 0.f}; accC[et] = (f32x4){0.f, 0.f, 0.f, 0.f}; }
        const int nks = (w >> 1) + 1;
        for (int ks = 0; ks < nks; ++ks) { const bf16x8 pf = *(const LAS bf16x8*)(Ps + il * RS + 32 * ks + 8 * fg);
#pragma unroll
            for (int et = 0; et < 8; ++et) { const bf16x8 vf = *(const LAS bf16x8*)(Vt + (16 * et + fr) * RS + 32 * ks + 8 * fg);
                accI[et] = __builtin_amdgcn_mfma_f32_16x16x32_bf16(vf, pf, accI[et], 0, 0, 0); }
            __builtin_amdgcn_sched_barrier(0); }
#pragma unroll
        for (int ks = 0; ks < 4; ++ks) {
#pragma unroll
            for (int et = 0; et < 8; ++et) { const bf16x8 rf = *(const LAS bf16x8*)(Rs + (16 * et + fr) * RS + 32 * ks + 8 * fg);
                accC[et] = __builtin_amdgcn_mfma_f32_16x16x32_bf16(rf, qf[ks], accC[et], 0, 0, 0); }
            __builtin_amdgcn_sched_barrier(0); }
        const float xi = exp2f(l2g * (float)(il + 1));
        float s = 0.f;
#pragma unroll
        for (int et = 0; et < 8; ++et) { accI[et] = accI[et] + accC[et] * xi; s += (accI[et][0] + accI[et][1]) + (accI[et][2] + accI[et][3]); }
        s += __shfl_xor(s, 16); s += __shfl_xor(s, 32);
        const float mu = s * (1.0f / 128.0f); float q2 = 0.f;
#pragma unroll
        for (int et = 0; et < 8; ++et) { accI[et] = accI[et] - mu; q2 += (accI[et][0] * accI[et][0] + accI[et][1] * accI[et][1]) + (accI[et][2] * accI[et][2] + accI[et][3] * accI[et][3]); }
        q2 += __shfl_xor(q2, 16); q2 += __shfl_xor(q2, 32);
        const float rstd = 1.0f / sqrtf(q2 * (1.0f / 128.0f) + 1e-6f);
        GAS bf16* yp = (GAS bf16*)(a.ws + WS_YS) + (size_t)(t0 + il) * 2048 + 1024 + h * 128 + 4 * fg;
#pragma unroll
        for (int et = 0; et < 8; ++et) { const v2u gw = gt[et]; v2u o;
            o.x = pk2(accI[et][0] * rstd * pg8::bf_lo(gw.x), accI[et][1] * rstd * pg8::bf_hi(gw.x)); o.y = pk2(accI[et][2] * rstd * pg8::bf_lo(gw.y), accI[et][3] * rstd * pg8::bf_hi(gw.y));
            *(GAS v2u*)(yp + 16 * et) = o; }
        __syncthreads();
    }
}

__device__ __forceinline__ void router_item(const Args& a, int item, LAS unsigned char* lds, int tid) {
    LAS float* rs = (LAS float*)lds;
    LAS float* part = rs + 64;
    LAS float* lg = part + 4 * 64 * 33;
    LAS int* hist = (LAS int*)(lg + 64 * 33);
    LAS int* base = hist + 32;
    LAS int* slot = base + 32;
    const int lane = tid & 63, w = __builtin_amdgcn_readfirstlane(tid >> 6), tb = item * 64;
    const float* x2 = (const float*)(a.ws + WS_X2);
    if (tid < 32) hist[tid] = 0;
    { f32x4 va[8], vb[8];
#define P8_LOAD(V_, r_) do { const GAS f32x4* xr_ = (const GAS f32x4*)(x2 + (size_t)(tb + 8 * w + (r_)) * 2048) + lane; _Pragma("unroll") for (int j = 0; j < 8; ++j) V_[j] = xr_[64 * j]; } while (0)
#define P8_PROC(V_, r_) do { float s_ = 0.f; _Pragma("unroll") for (int j = 0; j < 8; ++j) s_ += (V_[j].x * V_[j].x + V_[j].y * V_[j].y) + (V_[j].z * V_[j].z + V_[j].w * V_[j].w); \
          const float rstd_ = 1.0f / sqrtf(wave_sum(s_) * (1.0f / 2048.0f) + 1e-6f); if (lane == 0) rs[8 * w + (r_)] = rstd_; } while (0)
      P8_LOAD(va, 0);
#pragma unroll
      for (int rp = 0; rp < 4; ++rp) { P8_LOAD(vb, 2 * rp + 1); P8_PROC(va, 2 * rp); if (rp < 3) P8_LOAD(va, 2 * rp + 2); P8_PROC(vb, 2 * rp + 1); }
#undef P8_LOAD
#undef P8_PROC
    }
    { const int tg = w & 1, kq = w >> 1, hl = lane >> 5, l31 = lane & 31;
      const GAS float* xp = (const GAS float*)x2 + (size_t)(tb + 32 * tg + l31) * 2048 + 512 * kq + 4 * hl;
      const GAS float* wp = (const GAS float*)(a.ws + WS_WG) + (size_t)(512 * kq + 4 * hl) * 32 + l31;
      f32x16 acc;
#pragma unroll
      for (int x = 0; x < 16; ++x) acc[x] = 0.f;
#pragma unroll 4
      for (int kk = 0; kk < 64; ++kk) { const f32x4 av = *(const GAS f32x4*)(xp + 8 * kk); const GAS float* wq = wp + (size_t)(8 * kk) * 32;
          acc = __builtin_amdgcn_mfma_f32_32x32x2f32(av.x, wq[0], acc, 0, 0, 0); acc = __builtin_amdgcn_mfma_f32_32x32x2f32(av.y, wq[32], acc, 0, 0, 0);
          acc = __builtin_amdgcn_mfma_f32_32x32x2f32(av.z, wq[64], acc, 0, 0, 0); acc = __builtin_amdgcn_mfma_f32_32x32x2f32(av.w, wq[96], acc, 0, 0, 0); }
#pragma unroll
      for (int x = 0; x < 16; ++x) { const int tl = (x & 3) + 8 * (x >> 2) + 4 * hl; part[(kq * 64 + 32 * tg + tl) * 33 + l31] = acc[x]; } }
    __syncthreads();
    for (int e = tid; e < 64 * 32; e += 512) { const int tl = e >> 5, ex = e & 31;
        lg[tl * 33 + ex] = rs[tl] * ((part[(0 * 64 + tl) * 33 + ex] + part[(1 * 64 + tl) * 33 + ex]) + (part[(2 * 64 + tl) * 33 + ex] + part[(3 * 64 + tl) * 33 + ex])) + a.router_b[ex]; }
    __syncthreads();
    int e0 = 0, e1 = 0, e2 = 0, e3 = 0, r0 = 0, r1 = 0, r2 = 0, r3 = 0; float g0 = 0.f, g1 = 0.f, g2 = 0.f, g3 = 0.f;
    if (tid < 64) { const LAS float* L = lg + tid * 33; float v0 = -3.0e38f, v1 = -3.0e38f, v2 = -3.0e38f, v3 = -3.0e38f;
        for (int ex = 0; ex < 32; ++ex) { const float v = L[ex]; if (v > v0) { v0 = v; e0 = ex; } }
        for (int ex = 0; ex < 32; ++ex) { const float v = L[ex]; if (ex != e0 && v > v1) { v1 = v; e1 = ex; } }
        for (int ex = 0; ex < 32; ++ex) { const float v = L[ex]; if (ex != e0 && ex != e1 && v > v2) { v2 = v; e2 = ex; } }
        for (int ex = 0; ex < 32; ++ex) { const float v = L[ex]; if (ex != e0 && ex != e1 && ex != e2 && v > v3) { v3 = v; e3 = ex; } }
        const float p0 = 1.0f, p1 = expf(v1 - v0), p2 = expf(v2 - v0), p3 = expf(v3 - v0), inv = 1.0f / (p0 + p1 + p2 + p3);
        g0 = p0 * inv; g1 = p1 * inv; g2 = p2 * inv; g3 = p3 * inv;
        r0 = __hip_atomic_fetch_add(&hist[e0], 1, __ATOMIC_RELAXED, __HIP_MEMORY_SCOPE_WORKGROUP); r1 = __hip_atomic_fetch_add(&hist[e1], 1, __ATOMIC_RELAXED, __HIP_MEMORY_SCOPE_WORKGROUP);
        r2 = __hip_atomic_fetch_add(&hist[e2], 1, __ATOMIC_RELAXED, __HIP_MEMORY_SCOPE_WORKGROUP); r3 = __hip_atomic_fetch_add(&hist[e3], 1, __ATOMIC_RELAXED, __HIP_MEMORY_SCOPE_WORKGROUP); }
    __syncthreads();
    if (tid < 32) base[tid] = (int)__hip_atomic_fetch_add((unsigned*)(a.ws + WS_CTL) + CW_CNT + tid, (unsigned)hist[tid], RLX_AGENT);
    __syncthreads();
    if (tid < 64) { const int t = tb + tid; int* te = (int*)(a.ws + WS_TOKE) + t * 4; float* tg = (float*)(a.ws + WS_TOKG) + t * 4; int* tp = (int*)(a.ws + WS_TOKP) + t * 4;
        const int q0 = base[e0] + r0, q1 = base[e1] + r1, q2 = base[e2] + r2, q3 = base[e3] + r3;
        te[0] = e0; te[1] = e1; te[2] = e2; te[3] = e3; tg[0] = g0; tg[1] = g1; tg[2] = g2; tg[3] = g3; tp[0] = q0; tp[1] = q1; tp[2] = q2; tp[3] = q3;
        slot[tid * 4] = e0 * 16384 + q0; slot[tid * 4 + 1] = e1 * 16384 + q1; slot[tid * 4 + 2] = e2 * 16384 + q2; slot[tid * 4 + 3] = e3 * 16384 + q3; }
    __syncthreads();
    { const GAS f32x4* gr = (const GAS f32x4*)a.norm2_g + lane; GAS unsigned char* xg = (GAS unsigned char*)(a.ws + WS_XG); f32x4 va[8], vb[8];
#define P8_LOAD(V_, r_) do { const GAS f32x4* xr_ = (const GAS f32x4*)(x2 + (size_t)(tb + 8 * w + (r_)) * 2048) + lane; _Pragma("unroll") for (int j = 0; j < 8; ++j) V_[j] = xr_[64 * j]; } while (0)
#define P8_PROC(V_, r_) do { const int tl_ = 8 * w + (r_); const float rstd_ = rs[tl_]; const int s0 = slot[tl_ * 4], s1 = slot[tl_ * 4 + 1], s2 = slot[tl_ * 4 + 2], s3 = slot[tl_ * 4 + 3]; \
          GAS unsigned* d0 = (GAS unsigned*)(xg + (size_t)s0 * 2048) + lane; GAS unsigned* d1 = (GAS unsigned*)(xg + (size_t)s1 * 2048) + lane; \
          GAS unsigned* d2 = (GAS unsigned*)(xg + (size_t)s2 * 2048) + lane; GAS unsigned* d3 = (GAS unsigned*)(xg + (size_t)s3 * 2048) + lane; \
          _Pragma("unroll") for (int j = 0; j < 8; ++j) { const f32x4 v = V_[j], g = gr[64 * j]; const unsigned dw = pg8::pk4_fp8(v.x * rstd_ * g.x, v.y * rstd_ * g.y, v.z * rstd_ * g.z, v.w * rstd_ * g.w); \
              d0[64 * j] = dw; d1[64 * j] = dw; d2[64 * j] = dw; d3[64 * j] = dw; } } while (0)
      P8_LOAD(va, 0);
#pragma unroll
      for (int rp = 0; rp < 4; ++rp) { P8_LOAD(vb, 2 * rp + 1); P8_PROC(va, 2 * rp); if (rp < 3) P8_LOAD(va, 2 * rp + 2); P8_PROC(vb, 2 * rp + 1); }
#undef P8_LOAD
#undef P8_PROC
    }
    __syncthreads();
}
__device__ __forceinline__ int moe_table(const Args& a, LAS unsigned char* lds, int tid) {
    LAS int* tab = (LAS int*)(lds + MOETAB_OFF);
    if (tid < 64) {
        const int e = tid, c = (e < NEXP) ? (int)__hip_atomic_load((unsigned*)(a.ws + WS_CTL) + CW_CNT + e, RLX_AGENT) : 0, nt = (c + 255) >> 8;
        int incl = nt;
#pragma unroll
        for (int o = 1; o < 64; o <<= 1) { const int v = __shfl_up(incl, o); if (tid >= o) incl += v; }
        const int start = incl - nt;
        if (e <= NEXP) tab[e] = start;
        for (int j = 0; j < nt; ++j) tab[33 + start + j] = e; }
    __syncthreads();
    return __builtin_amdgcn_readfirstlane(tab[NEXP]);
}

constexpr int N_PHASES = 15;
#ifndef MOE_WGM
#define MOE_WGM 4
#endif
__global__ void __launch_bounds__(NWAVES * 64, 2) mk_fwd(Args kargs) {
    extern __shared__ __attribute__((aligned(16))) unsigned char lds_raw[];
    LAS unsigned char* lds = (LAS unsigned char*)lds_raw;
    const int tid = threadIdx.x, lane = tid & 63, wave = __builtin_amdgcn_readfirstlane(tid >> 6);
    const int G = gridDim.x, bx = blockIdx.x, gw = bx * NWAVES + wave, NGW = G * NWAVES, gtid = bx * (NWAVES * 64) + tid, GT = G * NWAVES * 64;
    unsigned char* const ws = kargs.ws;
#define LOAD_ARGS() const __attribute__((address_space(4))) Args* ap_ = (const __attribute__((address_space(4))) Args*)__builtin_amdgcn_kernarg_segment_ptr(); asm volatile("" : "+s"(ap_)); Args a; { const __attribute__((address_space(4))) unsigned long long* q_ = (const __attribute__((address_space(4))) unsigned long long*)ap_; unsigned long long* d_ = (unsigned long long*)&a; _Pragma("unroll") for (int i_ = 0; i_ < (int)(sizeof(Args) / 8); ++i_) d_[i_] = q_[i_]; }
    for (int u = tid; u < (LDS_BYTES - LDSCTL_OFF) / 4; u += NWAVES * 64) ((LAS unsigned*)(lds + LDSCTL_OFF))[u] = 0u;
    __syncthreads();
    XcdBarrier bar = xcd_barrier_post((unsigned*)(ws + WS_CTL) + CW_BAR + kargs.li * XCD_BAR_WORDS, (volatile LAS unsigned*)(lds + LDSCTL_OFF) + 8);
    const int lo = kargs.ph_lo, hi = kargs.ph_hi;
#ifndef PH_MASK
#define PH_MASK 0x7fff
#endif
#define IN(k) (((PH_MASK >> (k)) & 1) && lo <= (k) && (k) < hi)
#define SEAM(k) do { if (IN(k) && IN((k) + 1)) xcd_barrier(bar); } while (0)
    bf16* const HB = (bf16*)(ws + WS_HB);
#ifndef STAG_US
#define STAG_US 0
#endif
#define STAGGER(us) do { if ((us) > 0 && (bx & 1)) { const unsigned long long t0_ = __builtin_amdgcn_s_memrealtime(); while (__builtin_amdgcn_s_memrealtime() - t0_ < (unsigned long long)(us) * 100ull) __builtin_amdgcn_s_sleep(32); } } while (0)

#ifndef MK_SPLIT
#define MK_SPLIT 0
#endif
    const bool split = MK_SPLIT && (G == 256);
    const bool is_conv = !split || (((bx >> 3) & 3) == 3);
    const bool is_gemm = !split || !is_conv;
    const int convG = split ? 64 : G, convRank = split ? ((bx >> 5) * 8 + (bx & 7)) : bx;
    const int gemmG = split ? 192 : G, gemmRank = split ? ((bx >> 5) * 24 + (bx & 31)) : bx;
    if (IN(0)) { LOAD_ARGS();
        const int nsk = (G > 2 * NG5) ? NG5 : 0;
        if (bx < nsk || nsk == 0) for (int g = bx; g < NG5; g += G) s5_tables(a, g, lds, tid);
        if (bx >= nsk) { LAS float* scr = (LAS float*)(lds + wave * 16640);
            const int gw2 = (bx - nsk) * NWAVES + wave, NGW2 = (G - nsk) * NWAVES, gt2 = (bx - nsk) * (NWAVES * 64) + tid, GT2 = (G - nsk) * NWAVES * 64;
            transpose_run<false>(a.w_in, 2048, 5120, INC, ws + WS_BTIN, 2048, 1, 1, 0, 0, scr, gw2, NGW2, lane);
            transpose_run8(a.w_in + 5120, 2048, 4096, INC, ws + WS_BTIN8, 3, 1, 0, 0, (LAS unsigned*)scr, gw2, NGW2, lane);
            transpose_run<false>(a.w_pp, PLED, 2048, 2048, ws + WS_BTPP, PLED, 0, 1, 0, 0, scr, gw2, NGW2, lane);
            for (int t = gw2; t < SEQ; t += NGW2) rms_row_bf16(a.x + (size_t)t * 2048, a.norm1_g, HB + (size_t)t * 2048, ws + WS_H8 + (size_t)t * 2048, lane);
            { float* cs = (float*)(ws + WS_CS); float* sn = (float*)(ws + WS_SN);
              for (int e = gt2; e < SEQ * 64; e += GT2) { const int t = e >> 6, i = e & 63; const float inv = powf(10000.0f, -(float)i / 64.0f), ang = (float)a.pos[t] * inv; cs[e] = cosf(ang); sn[e] = sinf(ang); } }
            { float* wg = (float*)(ws + WS_WG); for (int e = gt2; e < 2048 * 32; e += GT2) wg[e] = a.norm2_g[e >> 5] * a.router_w[e]; }
            { v2u* pb = (v2u*)(ws + WS_PBF); const f32x4* pf = (const f32x4*)a.p;
              for (int e = gt2; e < SEQ * PLED / 4; e += GT2) { const f32x4 v = pf[e]; v2u o; o.x = pk2(v.x, v.y); o.y = pk2(v.z, v.w); pb[e] = o; } } }
    }
    SEAM(0);
    if (IN(1)) { LOAD_ARGS();
#ifndef MK_INTERLEAVE
#define MK_INTERLEAVE 0
#endif
        const bool gemm_first = MK_INTERLEAVE && !split && (((bx >> 3) & 1) != 0);
#define P1_CONV() do { LAS float* scr = (LAS float*)(lds + wave * 16640); const int cw = convRank * NWAVES + wave, NCW = convG * NWAVES; \
            transpose_run<false>(a.w_glu, 1024, 1024, 1024, ws + WS_BTGLU, 1024, 0, 1, 0, 0, scr, cw, NCW, lane); \
            transpose_run<false>(a.w_bs, 1024, 2048, 2048, ws + WS_BTPS, 2048, 0, 1, 0, 0, scr, cw, NCW, lane); \
            transpose_run<false>(a.w_br, 1024, 2048, 2048, (bf16*)(ws + WS_BTPS) + 1024, 2048, 0, 1, 0, 0, scr, cw, NCW, lane); \
            transpose_run<false>(a.w_out, 2048, 2048, 2048, ws + WS_BTOUT, 2048, 0, 1, 0, 0, scr, cw, NCW, lane); \
            transpose_run<true>(a.w_pg, 2048, 2048, 2048, ws + WS_BTPG, 2048, 0, 1, 0, 0, scr, cw, NCW, lane); \
            transpose_run8(a.w_gu, 2048, 4096, 4096, ws + WS_BTGU, 2, NEXP, (size_t)2048 * 4096, (size_t)4096 * 2048, (LAS unsigned*)scr, cw, NCW, lane); \
            transpose_run8(a.w_dn, 2048, 2048, 2048, ws + WS_BTDN, 0, NEXP, (size_t)2048 * 2048, (size_t)2048 * 2048, (LAS unsigned*)scr, cw, NCW, lane); \
            __syncthreads(); } while (0)
#define P1_GEMMS() do { \
        { pg8::Gemm g{HB, (const bf16*)(ws + WS_BTIN), 2048, 2048, 2048}; pg8::StaticOrder S; S.init(SEQ, 1024, gemmG, gemmRank); \
          pg8::EpiZU E{(bf16*)(ws + WS_XG5)}; \
          pg8::gemm_phase<pg8::EpiZU, pg8::StaticOrder, true, true>(lds + RING_OFF, g, S, E); } \
        { pg8::Gemm g{HB, (const bf16*)(ws + WS_BTIN) + (size_t)1024 * 2048, 2048, 2048, 2048}; pg8::StaticOrder S; S.init(SEQ, 2048, gemmG, gemmRank); \
          pg8::EpiZR E{(bf16*)(ws + WS_Q), (bf16*)(ws + WS_K), (const float*)(ws + WS_CS), (const float*)(ws + WS_SN)}; \
          pg8::gemm_phase<pg8::EpiZR, pg8::StaticOrder, true, true>(lds + RING_OFF, g, S, E); } \
        { pg8::Gemm g{HB, (const bf16*)(ws + WS_BTIN) + (size_t)3072 * 2048, 2048, 2048, 2048}; pg8::StaticOrder S; S.init(SEQ, 2048, gemmG, gemmRank); \
          pg8::EpiZA E{(bf16*)(ws + WS_V), (bf16*)(ws + WS_GS), (bf16*)(ws + WS_SGS), (bf16*)(ws + WS_SGR), 0, 1.0f}; \
          pg8::gemm_phase<pg8::EpiZA, pg8::StaticOrder, true, true>(lds + RING_OFF, g, S, E); } \
        { pg8::Gemm g{(const bf16*)(ws + WS_H8), (const bf16*)(ws + WS_BTIN8), 1024, 1024, 1024}; pg8::StaticOrder S; S.init(SEQ, 4096, gemmG, gemmRank);     \
          pg8::EpiZG E{(bf16*)(ws + WS_SGS), (bf16*)(ws + WS_SGR), pg8::W8_INV}; \
          pg8::gemm_phase<pg8::EpiZG, pg8::StaticOrder, true, true, true>(lds + RING_OFF, g, S, E); } \
        __syncthreads(); } while (0)
        if (gemm_first) { P1_GEMMS(); P1_CONV(); }
        else { if (is_conv) P1_CONV(); if (is_gemm) P1_GEMMS(); }
#undef P1_CONV
#undef P1_GEMMS
        if (is_conv) { pg8::Gemm g{(const bf16*)(ws + WS_PBF), (const bf16*)(ws + WS_BTPP), PLED, PLED, PLED}; pg8::StaticOrder S; S.init(SEQ, 2048, convG, convRank);
          pg8::EpiPlain E{(bf16*)(ws + WS_PP), 2048};
          pg8::gemm_phase<pg8::EpiPlain, pg8::StaticOrder, true, true>(lds + RING_OFF, g, S, E); }
    }
    SEAM(1);
    if (IN(2)) { LOAD_ARGS();
        { pg8::Gemm g{(const bf16*)(ws + WS_XG5), (const bf16*)(ws + WS_BTS1), K5, 512, 512}; pg8::OrderS1 S{G, bx}; pg8::EpiS1 E{(float*)(ws + WS_SLOC)};
          pg8::gemm_phase<pg8::EpiS1, pg8::OrderS1, false, true>(lds + RING_OFF, g, S, E); }
        __syncthreads();
        for (int u = bx; u < NRC * RH; u += G) ret_kv_unit(a, u, lds, tid);
    }
    SEAM(2);
    if (IN(3)) { LOAD_ARGS();
        for (int it = G - 1 - bx; it < 128; it += G) s5_scan_item(a, it, lds, tid);
        ret_state_scan(a, gtid, GT);
    }
    SEAM(3);
    if (IN(4)) { LOAD_ARGS();
#if defined(P4_SKIP_GEMM)
        if (kargs.li == 0)
#endif
        { pg8::Gemm g{(const bf16*)(ws + WS_XG5), (const bf16*)(ws + WS_BTS3), K5, K5, K5}; pg8::OrderS3 S{G, bx}; pg8::EpiS3 E{(bf16*)(ws + WS_YSP)};
          pg8::gemm_phase<pg8::EpiS3, pg8::OrderS3, false, true>(lds + RING_OFF, g, S, E); }
        __syncthreads();
#if defined(P4_SKIP_RET)
        if (kargs.li == 0)
#endif
        ret_out_units(a, bx, G, NRC * RH, lds, tid);
    }
    SEAM(4);
    if (IN(5)) { LOAD_ARGS();
        pg8::Gemm g{(const bf16*)(ws + WS_YSP), (const bf16*)(ws + WS_BTGLU), 1024, 1024, 1024}; pg8::StaticOrder S; S.init(SEQ, 1024, G, bx);
        pg8::EpiGLU E{(const bf16*)(ws + WS_YSP), a.b_glu, (bf16*)(ws + WS_YS), 2048};
        pg8::gemm_phase<pg8::EpiGLU, pg8::StaticOrder, true, true>(lds + RING_OFF, g, S, E);
    }
    SEAM(5);
#ifdef EXTRA_BAR
    for (int eb_ = 0; eb_ < EXTRA_BAR; ++eb_) xcd_barrier(bar);
#endif
    if (IN(6)) { LOAD_ARGS();
        pg8::Gemm g{(const bf16*)(ws + WS_YS), (const bf16*)(ws + WS_BTPS), 2048, 2048, 2048}; pg8::StaticOrder S; S.init(SEQ, 2048, G, bx);
        pg8::EpiMF E{(const bf16*)(ws + WS_SGS), (const bf16*)(ws + WS_SGR), (bf16*)(ws + WS_MRG)};
        pg8::gemm_phase<pg8::EpiMF, pg8::StaticOrder, true, true>(lds + RING_OFF, g, S, E);
    }
    SEAM(6);
    if (IN(7)) { LOAD_ARGS(); STAGGER(STAG_US);
        pg8::Gemm g{(const bf16*)(ws + WS_MRG), (const bf16*)(ws + WS_BTOUT), 2048, 2048, 2048}; pg8::StaticOrder S; S.init(SEQ, 2048, G, bx);
        pg8::EpiRes E{a.x, (float*)(ws + WS_X2)};
        pg8::gemm_phase<pg8::EpiRes, pg8::StaticOrder, true, true>(lds + RING_OFF, g, S, E);
    }
    SEAM(7);
    if (IN(8)) { LOAD_ARGS(); for (int it = bx; it < SEQ / 64; it += G) router_item(a, it, lds, tid); }
    do { if (IN(8) && IN(10)) xcd_barrier(bar); } while (0);
    if (IN(10)) { LOAD_ARGS();
        const int nrt = moe_table(a, lds, tid);
        pg8::Gemm g{(const bf16*)(ws + WS_XG), (const bf16*)(ws + WS_BTGU), 1024, 1024, 1024};     pg8::OrderMoe S; S.so.init(nrt * 256, 4096, G, bx, MOE_WGM); S.tab = (const LAS int*)(lds + MOETAB_OFF); S.ntn = 16; S.gather_a = true;
        pg8::EpiGU E{a.b_gu, ws + WS_ACT};
        pg8::gemm_phase<pg8::EpiGU, pg8::OrderMoe, true, true, true>(lds + RING_OFF, g, S, E);
    }
    SEAM(10);
    if (IN(11)) { LOAD_ARGS();
        const int nrt = moe_table(a, lds, tid);
        pg8::Gemm g{(const bf16*)(ws + WS_ACT), (const bf16*)(ws + WS_BTDN), 1024, 1024, 1024}; pg8::OrderMoe S; S.so.init(nrt * 256, 2048, G, bx, MOE_WGM); S.tab = (const LAS int*)(lds + MOETAB_OFF); S.ntn = 8; S.gather_a = false;
        pg8::EpiDN E{a.b_dn, ws + WS_YB};
        pg8::gemm_phase<pg8::EpiDN, pg8::OrderMoe, true, true, true>(lds + RING_OFF, g, S, E);
    }
    SEAM(11);
    if (IN(12)) { LOAD_ARGS();
        (void)moe_table(a, lds, tid); const LAS int* tab = (const LAS int*)(lds + MOETAB_OFF);
        const GAS int* toke = (const GAS int*)(ws + WS_TOKE); const GAS int* tokp = (const GAS int*)(ws + WS_TOKP); const GAS float* tokg = (const GAS float*)(ws + WS_TOKG);
        const GAS unsigned char* yb = (const GAS unsigned char*)(ws + WS_YB); const GAS float* x2 = (const GAS float*)(ws + WS_X2);
        GAS bf16* x3b = (GAS bf16*)(ws + WS_TMP + 64 * MiB); GAS unsigned char* h3b = (GAS unsigned char*)HB; const GAS f32x4* gr = (const GAS f32x4*)a.norm3_g + lane;
        typedef float f32x2_ __attribute__((ext_vector_type(2)));
        for (int tb = gw * 8; tb < SEQ; tb += NGW * 8) {
            int rowv = 0; float gv = 0.f;
            if (lane < 32) { const int as = tb * 4 + lane; rowv = tab[toke[as]] * 256 + tokp[as]; gv = tokg[as] * pg8::YB_INV; }
            f32x4 xa[8], xb[8]; unsigned ya[32], yc[32];
#define P12_LOAD(X_, Y_, tk_) do { const GAS f32x4* xr_ = (const GAS f32x4*)(x2 + (size_t)(tb + (tk_)) * 2048) + lane; \
                _Pragma("unroll") for (int j = 0; j < 8; ++j) X_[j] = xr_[64 * j]; \
                _Pragma("unroll") for (int k = 0; k < 4; ++k) { const int r_ = __shfl(rowv, (tk_) * 4 + k); const GAS unsigned* yp_ = (const GAS unsigned*)(yb + (size_t)r_ * 2048) + lane; \
                    _Pragma("unroll") for (int j = 0; j < 8; ++j) Y_[k * 8 + j] = yp_[64 * j]; } } while (0)
#define P12_PROC(X_, Y_, tk_) do { const float q0 = __shfl(gv, (tk_) * 4), q1 = __shfl(gv, (tk_) * 4 + 1), q2 = __shfl(gv, (tk_) * 4 + 2), q3 = __shfl(gv, (tk_) * 4 + 3); float s_ = 0.f; \
                GAS v2u* x3o = (GAS v2u*)(x3b + (size_t)(tb + (tk_)) * 2048) + lane; GAS unsigned* o4 = (GAS unsigned*)(h3b + (size_t)(tb + (tk_)) * 2048) + lane; \
                _Pragma("unroll") for (int j = 0; j < 8; ++j) { f32x4 x = X_[j]; const unsigned w0 = Y_[j], w1 = Y_[8 + j], w2 = Y_[16 + j], w3 = Y_[24 + j]; \
                    const f32x2_ a0 = __builtin_amdgcn_cvt_pk_f32_fp8(w0, false), b0 = __builtin_amdgcn_cvt_pk_f32_fp8(w0, true), a1 = __builtin_amdgcn_cvt_pk_f32_fp8(w1, false), b1 = __builtin_amdgcn_cvt_pk_f32_fp8(w1, true); \
                    const f32x2_ a2 = __builtin_amdgcn_cvt_pk_f32_fp8(w2, false), b2 = __builtin_amdgcn_cvt_pk_f32_fp8(w2, true), a3 = __builtin_amdgcn_cvt_pk_f32_fp8(w3, false), b3 = __builtin_amdgcn_cvt_pk_f32_fp8(w3, true); \
                    x.x += (a0.x * q0 + a1.x * q1) + (a2.x * q2 + a3.x * q3); x.y += (a0.y * q0 + a1.y * q1) + (a2.y * q2 + a3.y * q3); \
                    x.z += (b0.x * q0 + b1.x * q1) + (b2.x * q2 + b3.x * q3); x.w += (b0.y * q0 + b1.y * q1) + (b2.y * q2 + b3.y * q3); \
                    X_[j] = x; v2u xo; xo.x = pk2(x.x, x.y); xo.y = pk2(x.z, x.w); x3o[64 * j] = xo; s_ += (x.x * x.x + x.y * x.y) + (x.z * x.z + x.w * x.w); __builtin_amdgcn_sched_barrier(0); } \
                const float rstd_ = 1.0f / sqrtf(wave_sum(s_) * (1.0f / 2048.0f) + 1e-6f); \
                _Pragma("unroll") for (int j = 0; j < 8; ++j) { const f32x4 g = gr[64 * j]; o4[64 * j] = pg8::pk4_fp8(X_[j].x * rstd_ * g.x, X_[j].y * rstd_ * g.y, X_[j].z * rstd_ * g.z, X_[j].w * rstd_ * g.w); } } while (0)
            P12_LOAD(xa, ya, 0);
#pragma unroll
            for (int tp = 0; tp < 4; ++tp) { P12_LOAD(xb, yc, 2 * tp + 1); P12_PROC(xa, ya, 2 * tp); if (tp < 3) P12_LOAD(xa, ya, 2 * tp + 2); P12_PROC(xb, yc, 2 * tp + 1); }
#undef P12_LOAD
#undef P12_PROC
        }
    }
    SEAM(12);
    if (IN(13)) { LOAD_ARGS(); STAGGER(STAG_US);
        pg8::Gemm g{HB, (const bf16*)(ws + WS_BTPG), 1024, 1024, 1024}; pg8::StaticOrder S; S.init(SEQ, 2048, G, bx);
        pg8::EpiPLE E{(const bf16*)(ws + WS_TMP + 64 * MiB), (const bf16*)(ws + WS_PP), (bf16*)(ws + WS_MRG), pg8::W8_INV};
        pg8::gemm_phase<pg8::EpiPLE, pg8::StaticOrder, true, true, true>(lds + RING_OFF, g, S, E);
    }
    SEAM(13);
    if (IN(14)) { LOAD_ARGS();
        const GAS f32x4* gr = (const GAS f32x4*)a.fin_g + lane; const GAS bf16* x4 = (const GAS bf16*)(ws + WS_MRG); GAS float* outp = (GAS float*)a.out;
        for (int tb = gw * 8; tb < SEQ; tb += NGW * 8) { v2u wa[8], wb[8];
#define P14_LOAD(W_, tk_) do { const GAS v2u* xb_ = (const GAS v2u*)(x4 + (size_t)(tb + (tk_)) * 2048) + lane; _Pragma("unroll") for (int j = 0; j < 8; ++j) W_[j] = xb_[64 * j]; } while (0)
#define P14_PROC(W_, tk_) do { f32x4 v_[8]; float s_ = 0.f; \
                _Pragma("unroll") for (int j = 0; j < 8; ++j) { const v2u w = W_[j]; v_[j] = (f32x4){pg8::bf_lo(w.x), pg8::bf_hi(w.x), pg8::bf_lo(w.y), pg8::bf_hi(w.y)}; s_ += (v_[j].x * v_[j].x + v_[j].y * v_[j].y) + (v_[j].z * v_[j].z + v_[j].w * v_[j].w); } \
                const float rstd_ = 1.0f / sqrtf(wave_sum(s_) * (1.0f / 2048.0f) + 1e-6f); GAS f32x4* xr_ = (GAS f32x4*)(outp + (size_t)(tb + (tk_)) * 2048) + lane; \
                _Pragma("unroll") for (int j = 0; j < 8; ++j) xr_[64 * j] = v_[j] * rstd_ * gr[64 * j]; } while (0)
            P14_LOAD(wa, 0);
#pragma unroll
            for (int tp = 0; tp < 4; ++tp) { P14_LOAD(wb, 2 * tp + 1); P14_PROC(wa, 2 * tp); if (tp < 3) P14_LOAD(wa, 2 * tp + 2); P14_PROC(wb, 2 * tp + 1); }
#undef P14_LOAD
#undef P14_PROC
        }
    }
#undef IN
#undef SEAM
}

extern "C" void kernel_launch(void* const* d_in, const int* in_sizes, int n_in, void* d_out, int out_size, void* d_ws, size_t ws_size, hipStream_t stream) {
    static int grid = 0;
    if (grid == 0) {
        if (n_in != 29 || in_sizes[0] != SEQ * DM || out_size != SEQ * DM || ws_size < WS_END) { fprintf(stderr, "kernel_launch: unexpected shapes (n_in %d, ws %zu < %zu?)\n", n_in, ws_size, (size_t)WS_END); grid = -1; return; }
        int dev = 0, cus = 0, per_cu = 0;
        if (hipGetDevice(&dev) != hipSuccess || hipDeviceGetAttribute(&cus, hipDeviceAttributeMultiprocessorCount, dev) != hipSuccess) { grid = -1; return; }
        if (hipFuncSetAttribute((const void*)mk_fwd, hipFuncAttributeMaxDynamicSharedMemorySize, LDS_BYTES) != hipSuccess) { fprintf(stderr, "kernel_launch: hipFuncSetAttribute failed\n"); grid = -1; return; }
        if (hipOccupancyMaxActiveBlocksPerMultiprocessor(&per_cu, (const void*)mk_fwd, NWAVES * 64, LDS_BYTES) != hipSuccess || per_cu < 1) { fprintf(stderr, "kernel_launch: occupancy query says %d\n", per_cu); }
        (void)hipGetLastError();
        grid = cus;
    }
    if (grid < 0) return;
    if (hipMemsetAsync((char*)d_ws + WS_CTL, 0, CTL_ZERO_BYTES, stream) != hipSuccess) return;
    Args a{};
    a.x = (const float*)d_in[0]; a.p = (const float*)d_in[1]; a.pos = (const int*)d_in[2]; a.norm1_g = (const float*)d_in[3]; a.w_in = (const float*)d_in[4];
    a.lam_re = (const float*)d_in[5]; a.lam_im = (const float*)d_in[6]; a.log_dt = (const float*)d_in[7]; a.b_re = (const float*)d_in[8]; a.b_im = (const float*)d_in[9];
    a.c_re = (const float*)d_in[10]; a.c_im = (const float*)d_in[11]; a.d_skip = (const float*)d_in[12]; a.w_glu = (const float*)d_in[13]; a.b_glu = (const float*)d_in[14];
    a.w_bs = (const float*)d_in[15]; a.w_br = (const float*)d_in[16]; a.w_out = (const float*)d_in[17]; a.norm2_g = (const float*)d_in[18]; a.router_w = (const float*)d_in[19];
    a.router_b = (const float*)d_in[20]; a.w_gu = (const float*)d_in[21]; a.b_gu = (const float*)d_in[22]; a.w_dn = (const float*)d_in[23]; a.b_dn = (const float*)d_in[24];
    a.norm3_g = (const float*)d_in[25]; a.w_pg = (const float*)d_in[26]; a.w_pp = (const float*)d_in[27]; a.fin_g = (const float*)d_in[28];
    a.out = (float*)d_out; a.ws = (unsigned char*)d_ws;
#if defined(PROBE_LO)
#ifndef PROBE_REP
#define PROBE_REP 1
#endif
    a.ph_lo = 0; a.ph_hi = PROBE_HI; a.li = 0; hipLaunchKernelGGL(mk_fwd, dim3(grid), dim3(NWAVES * 64), LDS_BYTES, stream, a);
    for (int rep = 0; rep < PROBE_REP; ++rep) { a.ph_lo = PROBE_LO; a.ph_hi = (rep == PROBE_REP - 1) ? N_PHASES : PROBE_HI; a.li = 1 + rep; hipLaunchKernelGGL(mk_fwd, dim3(grid), dim3(NWAVES * 64), LDS_BYTES, stream, a); }
#elif MK_N_LAUNCHES == 1
    a.ph_lo = 0; a.ph_hi = N_PHASES;
    hipLaunchKernelGGL(mk_fwd, dim3(grid), dim3(NWAVES * 64), LDS_BYTES, stream, a);
#else
    for (int ph = 0; ph < N_PHASES; ++ph) { a.ph_lo = ph; a.ph_hi = ph + 1; hipLaunchKernelGGL(mk_fwd, dim3(grid), dim3(NWAVES * 64), LDS_BYTES, stream, a); }
#endif
    const hipError_t le = hipPeekAtLastError();
    if (le != hipSuccess) fprintf(stderr, "kernel_launch: launch failed: %s\n", hipGetErrorName(le));
}
```
